# Optimizing an MI355X kernel written in HIP

```python
import jax
import jax.numpy as jnp
from jax import lax
import numpy as np

D_MODEL = 1024
BATCH = 8
SEQ = 2048
DEPTH = 4

GRID_W = 64
CTX_LEN = 256
N_EVEN = (DEPTH + 1) // 2
N_ODD = DEPTH // 2
MIX_W = D_MODEL
CHUNK = 128
A_GROUPS = 8
A_GROUP_DIM = MIX_W // A_GROUPS
CONV_W = 31
N_HEADS = 16
N_KV_HEADS = 4
HEAD_DIM = D_MODEL // N_HEADS
KV_GROUP = N_HEADS // N_KV_HEADS
WINDOW = 128
BLOCK = 128
ROPE_THETA = 10000.0
ROPE_AXIS_DIM = HEAD_DIM // 2
D_FF = 3584
N_EXPERTS = 8
TOP_K = 2
EPS = 1e-6
NEG_INF = -1e30

kernel_name = 'hybrid_dit_gmlp_conformer_swa_moe'


def rms_norm(x, g):
    xf = x.astype(jnp.float32)
    y = xf * lax.rsqrt(jnp.mean(xf * xf, axis=-1, keepdims=True) + EPS)
    return (y * g.astype(jnp.float32)).astype(x.dtype)


def layer_norm(x, g, b):
    xf = x.astype(jnp.float32)
    mu = jnp.mean(xf, axis=-1, keepdims=True)
    xc = xf - mu
    y = xc * lax.rsqrt(jnp.mean(xc * xc, axis=-1, keepdims=True) + EPS)
    return (y * g.astype(jnp.float32) + b.astype(jnp.float32)).astype(x.dtype)


def ada_mod(cvec, w, b):
    m = jax.nn.silu(cvec) @ w + b
    m = m.reshape(-1, 1, 6 * D_MODEL)
    return jnp.split(m, 6, axis=-1)


def rope_1d(x, ang):
    x1, x2 = jnp.split(x, 2, axis=-1)
    shp = (1, ang.shape[0]) + (1,) * (x.ndim - 3) + (ang.shape[1],)
    cos = jnp.cos(ang).reshape(shp).astype(x.dtype)
    sin = jnp.sin(ang).reshape(shp).astype(x.dtype)
    return jnp.concatenate([x1 * cos - x2 * sin, x2 * cos + x1 * sin], axis=-1)


def rope_2d(x, ang_row, ang_col):
    xr, xc = jnp.split(x, 2, axis=-1)
    return jnp.concatenate([rope_1d(xr, ang_row), rope_1d(xc, ang_col)], axis=-1)


def even_mixer(h, w_in, ln_g, ln_b, ws, bs, conv_w, conv_b, cn_g, w_out):
    bsz, length, _ = h.shape
    z = h @ w_in
    za, zb = z[..., :2 * MIX_W], z[..., 2 * MIX_W:]
    za = jax.nn.gelu(za)
    u, v = jnp.split(za, 2, axis=-1)
    v = layer_norm(v, ln_g, ln_b)
    v = v.reshape(bsz, length // CHUNK, CHUNK, A_GROUPS, A_GROUP_DIM)
    v = jnp.einsum('gpq,bnqgc->bnpgc', ws, v) + bs.T[None, None, :, :, None]
    y_a = u * v.reshape(bsz, length, MIX_W)
    a, gt = jnp.split(zb, 2, axis=-1)
    g = a * jax.nn.sigmoid(gt)
    g = lax.conv_general_dilated(
        g, conv_w[:, None, :], window_strides=(1,),
        padding=[(CONV_W // 2, CONV_W // 2)],
        dimension_numbers=('NWC', 'WIO', 'NWC'),
        feature_group_count=MIX_W) + conv_b
    y_b = jax.nn.silu(rms_norm(g, cn_g))
    return jnp.concatenate([y_a, y_b], axis=-1) @ w_out


def sink_softmax(scores, sink_g):
    lead = scores[0].shape[:-1]
    sink_col = jnp.broadcast_to(sink_g[None, :, :, None, None], lead + (1,))
    p = jax.nn.softmax(jnp.concatenate(list(scores) + [sink_col], axis=-1), axis=-1)
    cuts, acc = [], 0
    for s in scores[:-1]:
        acc += s.shape[-1]
        cuts.append(acc)
    return jnp.split(p[..., :-1], cuts, axis=-1)


def window_attention(hl, hc, w_qkv, q_g, k_g, sink, w_o, ang_row, ang_col, need_ctx):
    bsz, s_len, _ = hl.shape
    c_len = hc.shape[1]
    n_q = N_HEADS * HEAD_DIM
    n_kv = N_KV_HEADS * HEAD_DIM
    scale = HEAD_DIM ** -0.5
    sink_g = sink.astype(jnp.float32).reshape(N_KV_HEADS, KV_GROUP)

    def split_q(z, length):
        return rms_norm(z[..., :n_q].reshape(bsz, length, N_KV_HEADS, KV_GROUP, HEAD_DIM), q_g)

    def split_kv(z, length):
        k = rms_norm(z[..., n_q:n_q + n_kv].reshape(bsz, length, N_KV_HEADS, HEAD_DIM), k_g)
        v = z[..., n_q + n_kv:].reshape(bsz, length, N_KV_HEADS, HEAD_DIM)
        return k, v

    zl = hl @ w_qkv
    zc = hc @ w_qkv
    ql = rope_2d(split_q(zl, s_len), ang_row, ang_col)
    kl, vl = split_kv(zl, s_len)
    kl = rope_2d(kl, ang_row, ang_col)
    kc, vc = split_kv(zc, c_len)

    kpad = jnp.pad(kl, ((0, 0), (BLOCK, BLOCK), (0, 0), (0, 0)))
    vpad = jnp.pad(vl, ((0, 0), (BLOCK, BLOCK), (0, 0), (0, 0)))
    n_blocks = s_len // BLOCK

    def block(i):
        q0 = i * BLOCK
        qb = lax.dynamic_slice_in_dim(ql, q0, BLOCK, axis=1)
        kb = lax.dynamic_slice_in_dim(kpad, q0, 3 * BLOCK, axis=1)
        vb = lax.dynamic_slice_in_dim(vpad, q0, 3 * BLOCK, axis=1)
        s_win = jnp.einsum('bqkgd,bskd->bkgqs', qb, kb).astype(jnp.float32) * scale
        qpos = q0 + jnp.arange(BLOCK)
        kpos = q0 - BLOCK + jnp.arange(3 * BLOCK)
        valid = (kpos[None, :] >= 0) & (kpos[None, :] < s_len) & (jnp.abs(qpos[:, None] - kpos[None, :]) <= WINDOW)
        s_win = jnp.where(valid, s_win, NEG_INF)
        s_ctx = jnp.einsum('bqkgd,bskd->bkgqs', qb, kc).astype(jnp.float32) * scale
        p_win, p_ctx = sink_softmax([s_win, s_ctx], sink_g)
        o = (jnp.einsum('bkgqs,bskd->bqkgd', p_win.astype(vb.dtype), vb)
             + jnp.einsum('bkgqs,bskd->bqkgd', p_ctx.astype(vc.dtype), vc))
        return o.reshape(bsz, BLOCK, n_q)

    o_lat = lax.map(block, jnp.arange(n_blocks))
    y_lat = jnp.moveaxis(o_lat, 0, 1).reshape(bsz, s_len, n_q) @ w_o

    y_ctx = None
    if need_ctx:
        qc = split_q(zc, c_len)
        s_c = jnp.einsum('bqkgd,bskd->bkgqs', qc, kc).astype(jnp.float32) * scale
        (p_c,) = sink_softmax([s_c], sink_g)
        o_c = jnp.einsum('bkgqs,bskd->bqkgd', p_c.astype(vc.dtype), vc)
        y_ctx = o_c.reshape(bsz, c_len, n_q) @ w_o
    return y_lat, y_ctx


def swiglu(h, w1, w3, w2):
    return (jax.nn.silu(h @ w1) * (h @ w3)) @ w2


def moe_swiglu(h, router, w1, w3, w2):
    logits = (h @ router).astype(jnp.float32)
    vals, idx = lax.top_k(logits, TOP_K)
    wts = jax.nn.softmax(vals, axis=-1)
    combine = jnp.sum(jax.nn.one_hot(idx, N_EXPERTS, dtype=jnp.float32) * wts[..., None], axis=-2).astype(h.dtype)
    y = jnp.zeros_like(h)
    for e in range(N_EXPERTS):
        y = y + combine[..., e:e + 1] * swiglu(h, w1[e], w3[e], w2[e])
    return y


def _normal(key, shape, scale):
    return jax.random.normal(key, shape, dtype=jnp.float32) * scale


def setup_inputs(seed: int = 0) -> dict:
    key = jax.random.key(seed)
    ks = jax.random.split(key, 29)
    D = D_MODEL
    return {
        'x': _normal(ks[0], (BATCH, SEQ, D), 1.0),
        'c': _normal(ks[1], (BATCH, D), 1.0),
        'ctx': _normal(ks[2], (BATCH, CTX_LEN, D), 1.0),
        'c_ctx': _normal(ks[3], (D,), 1.0),
        'ada_w': _normal(ks[4], (DEPTH, D, 6 * D), 0.5 * D ** -0.5),
        'ada_b': _normal(ks[5], (DEPTH, 6 * D), 0.02),
        'norm_mix_g': 1.0 + _normal(ks[6], (DEPTH, D), 0.05),
        'norm_ffn_g': 1.0 + _normal(ks[7], (DEPTH, D), 0.05),
        'ev_w_in': _normal(ks[8], (N_EVEN, D, 4 * MIX_W), D ** -0.5),
        'ev_ln_g': 1.0 + _normal(ks[9], (N_EVEN, MIX_W), 0.05),
        'ev_ln_b': _normal(ks[10], (N_EVEN, MIX_W), 0.02),
        'ev_ws': _normal(ks[11], (N_EVEN, A_GROUPS, CHUNK, CHUNK), CHUNK ** -0.5),
        'ev_bs': 1.0 + _normal(ks[12], (N_EVEN, A_GROUPS, CHUNK), 0.05),
        'ev_conv_w': _normal(ks[13], (N_EVEN, CONV_W, MIX_W), CONV_W ** -0.5),
        'ev_conv_b': _normal(ks[14], (N_EVEN, MIX_W), 0.02),
        'ev_cnorm_g': 1.0 + _normal(ks[15], (N_EVEN, MIX_W), 0.05),
        'ev_w_out': _normal(ks[16], (N_EVEN, 2 * MIX_W, D), (2 * MIX_W) ** -0.5),
        'od_w_qkv': _normal(ks[17], (N_ODD, D, (N_HEADS + 2 * N_KV_HEADS) * HEAD_DIM), D ** -0.5),
        'od_q_g': 1.0 + _normal(ks[18], (N_ODD, HEAD_DIM), 0.05),
        'od_k_g': 1.0 + _normal(ks[19], (N_ODD, HEAD_DIM), 0.05),
        'od_sink': _normal(ks[20], (N_ODD, N_HEADS), 0.5),
        'od_w_o': _normal(ks[21], (N_ODD, N_HEADS * HEAD_DIM, D), (N_HEADS * HEAD_DIM) ** -0.5),
        'ff_w1': _normal(ks[22], (N_EVEN, D, D_FF), D ** -0.5),
        'ff_w3': _normal(ks[23], (N_EVEN, D, D_FF), D ** -0.5),
        'ff_w2': _normal(ks[24], (N_EVEN, D_FF, D), D_FF ** -0.5),
        'moe_router': _normal(ks[25], (N_ODD, D, N_EXPERTS), D ** -0.5),
        'moe_w1': _normal(ks[26], (N_ODD, N_EXPERTS, D, D_FF), D ** -0.5),
        'moe_w3': _normal(ks[27], (N_ODD, N_EXPERTS, D, D_FF), D ** -0.5),
        'moe_w2': _normal(ks[28], (N_ODD, N_EXPERTS, D_FF, D), D_FF ** -0.5),
    }


def reference(x, c, ctx, c_ctx, ada_w, ada_b, norm_mix_g, norm_ffn_g,
              ev_w_in, ev_ln_g, ev_ln_b, ev_ws, ev_bs, ev_conv_w, ev_conv_b, ev_cnorm_g, ev_w_out,
              od_w_qkv, od_q_g, od_k_g, od_sink, od_w_o,
              ff_w1, ff_w3, ff_w2, moe_router, moe_w1, moe_w3, moe_w2):
    s_len = x.shape[1]
    ROWS = s_len // GRID_W
    pos_row = jnp.repeat(jnp.arange(ROWS), GRID_W).astype(jnp.float32)
    pos_col = jnp.tile(jnp.arange(GRID_W), ROWS).astype(jnp.float32)
    inv_freq = ROPE_THETA ** (-jnp.arange(0, ROPE_AXIS_DIM, 2, dtype=jnp.float32) / ROPE_AXIS_DIM)
    ang_row = pos_row[:, None] * inv_freq[None, :]
    ang_col = pos_col[:, None] * inv_freq[None, :]

    xl, xc = x, ctx
    for li in range(DEPTH):
        need_ctx = li < DEPTH - 1
        j = li // 2
        sh1, sc1, g1, sh2, sc2, g2 = ada_mod(c, ada_w[li], ada_b[li])
        csh1, csc1, cg1, csh2, csc2, cg2 = ada_mod(c_ctx, ada_w[li], ada_b[li])

        hl = rms_norm(xl, norm_mix_g[li]) * (1 + sc1) + sh1
        hc = rms_norm(xc, norm_mix_g[li]) * (1 + csc1) + csh1
        if li % 2 == 0:
            p = (ev_w_in[j], ev_ln_g[j], ev_ln_b[j], ev_ws[j], ev_bs[j],
                 ev_conv_w[j], ev_conv_b[j], ev_cnorm_g[j], ev_w_out[j])
            yl = even_mixer(hl, *p)
            yc = even_mixer(hc, *p) if need_ctx else None
        else:
            yl, yc = window_attention(hl, hc, od_w_qkv[j], od_q_g[j], od_k_g[j], od_sink[j], od_w_o[j],
                                      ang_row, ang_col, need_ctx)
        xl = xl + g1 * yl
        if need_ctx:
            xc = xc + cg1 * yc

        hl = rms_norm(xl, norm_ffn_g[li]) * (1 + sc2) + sh2
        if li % 2 == 0:
            xl = xl + g2 * swiglu(hl, ff_w1[j], ff_w3[j], ff_w2[j])
        else:
            xl = xl + g2 * moe_swiglu(hl, moe_router[j], moe_w1[j], moe_w3[j], moe_w2[j])
        if need_ctx:
            hc = rms_norm(xc, norm_ffn_g[li]) * (1 + csc2) + csh2
            if li % 2 == 0:
                xc = xc + cg2 * swiglu(hc, ff_w1[j], ff_w3[j], ff_w2[j])
            else:
                xc = xc + cg2 * moe_swiglu(hc, moe_router[j], moe_w1[j], moe_w3[j], moe_w2[j])
    return xl
```

```cpp
#include <hip/hip_runtime.h>
#include <cstdio>
#include <cstdint>
namespace pg8 {
#define PG8_LAS __attribute__((address_space(3)))
typedef unsigned short bf16_t;
typedef short bf16x8 __attribute__((ext_vector_type(8)));
typedef float f32x4 __attribute__((ext_vector_type(4)));
typedef unsigned u32x4 __attribute__((ext_vector_type(4)));
constexpr int BM = 256, BK = 64, HALF = 128, HTB = HALF * BK * 2  , STAGE_BYTES = 8 * HTB, NXCD = 8, WGM = 8;

__host__ __device__ __forceinline__ int lds_byte(int r, int c) { const int st = (r >> 4) * 2 + (c >> 5), rr = r & 15, cc = c & 31, ob = rr * 64 + cc * 2; return st * 1024 + (ob ^ (((ob >> 9) & 1) << 5)); }
__host__ __device__ __forceinline__ void stage_rc(int b, int& R, int& C) { const int st = b / 1024, sb = b % 1024, swz = sb ^ (((sb >> 9) & 1) << 5); R = (st >> 1) * 16 + swz / 64; C = (st & 1) * 32 + (swz % 64) / 2; }
__host__ __device__ __forceinline__ int perm32(int rho) { const int n = rho >> 4, i = rho & 15; return 8 * (i >> 2) + 4 * n + (i & 3); }

struct Unit { int pm, pn, e, j; };
struct Gemm { const bf16_t* A; const bf16_t* Bt; int M, N, K; };

struct StaticOrder {
    int nM, nN, nwg, G, c;
    __host__ __device__ void init(int M, int N, int G_, int c_) { nM = M / BM; nN = N / BM; nwg = nM * nN; G = G_; c = c_; }
    __host__ __device__ bool next(int i, Unit& u) const {
        const long L = (long)i * G + c; if (L >= nwg) return false;
        int wgid = (int)L; { const int q = nwg / NXCD, r = nwg % NXCD, xcd = wgid % NXCD, off = wgid / NXCD; wgid = (xcd < r ? xcd * (q + 1) : r * (q + 1) + (xcd - r) * q) + off; }
        const int nig = WGM * nN, gid = wgid / nig, fm = gid * WGM, gsz = (nM - fm) < WGM ? (nM - fm) : WGM;
        u.pm = fm + ((wgid % nig) % gsz); u.pn = (wgid % nig) / gsz; u.e = 0; u.j = u.pn; return true;
    }
    __device__ __forceinline__ void a_ready(const Unit&) const {}
    __device__ __forceinline__ void done(const Unit&) const {}
};

__device__ __forceinline__ unsigned cvt_pk_bf16(float lo, float hi) { unsigned r; asm volatile("v_cvt_pk_bf16_f32 %0, %1, %2" : "=v"(r) : "v"(lo), "v"(hi)); return r; }
typedef float f32x2 __attribute__((ext_vector_type(2)));
__device__ __forceinline__ f32x2 gelu_pk(f32x2 v) {
    const f32x2 av = __builtin_elementwise_abs(v), d = av * 0.2316418882f + 1.0f;
    f32x2 t; t.x = __builtin_amdgcn_rcpf(d.x); t.y = __builtin_amdgcn_rcpf(d.y);
    f32x2 q = t * 0.5307027145f + (-0.7265760135f); q = q * t + 0.7107068705f; q = q * t + (-0.142248368f); q = q * t + 0.127414796f; q = q * t;
    const f32x2 s = (v * v) * (-0.72134752044f);
    f32x2 e; e.x = __builtin_amdgcn_exp2f(s.x); e.y = __builtin_amdgcn_exp2f(s.y);
    const f32x2 m = v * (q * e), r = v - m;
    f32x2 o; o.x = v.x < 0.f ? m.x : r.x; o.y = v.y < 0.f ? m.y : r.y; return o;
}

template <int ACT  > struct EpiBf16 {
    static constexpr bool PERM = true, AFTER_DRAIN = false; static_assert(ACT == 0 || ACT == 1, "EpiBf16: ACT is 0 (none) or 1 (gelu_pk)");
    bf16_t* O; int ldc; const float* bias; int split_cols; size_t split_stride; float scale0;
    __device__ __forceinline__ void operator()(const f32x4 (&acc)[2][2][4][2], const Unit& u, int wr, int wc, int fr, int fq) const {
        const int row0 = u.pm * BM + wr * 64 + fr; int colt = u.pn * BM; bf16_t* base = O;
        float sc = 1.f; if (split_cols) { const int t = colt / split_cols; base += (size_t)t * split_stride; colt -= t * split_cols; if (t == 0) sc = scale0; }
        const int col0 = colt + wc * 32 + 8 * fq, bcol0 = u.pn * BM + wc * 32 + 8 * fq;
        f32x4 bv[2][2];
#pragma unroll
        for (int bj = 0; bj < 2; ++bj)
#pragma unroll
            for (int n = 0; n < 2; ++n) bv[bj][n] = bias ? *(const f32x4*)(bias + bcol0 + bj * HALF + 4 * n) : (f32x4){0.f, 0.f, 0.f, 0.f};
#pragma unroll
        for (int ai = 0; ai < 2; ++ai)
#pragma unroll
            for (int m = 0; m < 4; ++m) { bf16_t* rowp = base + (size_t)(row0 + ai * HALF + m * 16) * ldc + col0;
#pragma unroll
                for (int bj = 0; bj < 2; ++bj) { f32x4 v0 = acc[ai][bj][m][0] + bv[bj][0], v1 = acc[ai][bj][m][1] + bv[bj][1];
                    if (ACT == 1) { f32x2 a = gelu_pk((f32x2){v0[0], v0[1]}), b = gelu_pk((f32x2){v0[2], v0[3]}), c = gelu_pk((f32x2){v1[0], v1[1]}), d = gelu_pk((f32x2){v1[2], v1[3]});
                        v0 = (f32x4){a.x, a.y, b.x, b.y}; v1 = (f32x4){c.x, c.y, d.x, d.y}; }
                    v0 = v0 * sc; v1 = v1 * sc; u32x4 w; w.x = cvt_pk_bf16(v0[0], v0[1]); w.y = cvt_pk_bf16(v0[2], v0[3]); w.z = cvt_pk_bf16(v1[0], v1[1]); w.w = cvt_pk_bf16(v1[2], v1[3]);
                    *(u32x4*)(rowp + bj * HALF) = w; } }
    }
};
__device__ __forceinline__ float sigm_f(float x) { return __builtin_amdgcn_rcpf(1.f + __builtin_amdgcn_exp2f(-1.4426950409f * x)); }
__device__ __forceinline__ float silu_f(float x) { return x * sigm_f(x); }
__device__ __forceinline__ float gelu_tanh_f(float x) { const float t = x * (1.f + 0.044715f * x * x); return x * __builtin_amdgcn_rcpf(1.f + __builtin_amdgcn_exp2f(-2.3022082f * t)); }

struct EpiWin {
    static constexpr bool PERM = true, AFTER_DRAIN = false;
    bf16_t *U, *V, *G;
    __device__ __forceinline__ void operator()(const f32x4 (&acc)[2][2][4][2], const Unit& u, int wr, int wc, int fr, int fq) const {
        const int row0 = u.pm * BM + wr * 64 + fr;
        if (u.pn < 8) {
            bf16_t* base = (u.pn < 4) ? U : V; const int col0 = (u.pn & 3) * 256 + wc * 32 + 8 * fq;
#pragma unroll
            for (int ai = 0; ai < 2; ++ai)
#pragma unroll
                for (int m = 0; m < 4; ++m) { bf16_t* rowp = base + (size_t)(row0 + ai * HALF + m * 16) * 1024 + col0;
#pragma unroll
                    for (int bj = 0; bj < 2; ++bj) { const f32x4 v0 = acc[ai][bj][m][0], v1 = acc[ai][bj][m][1]; u32x4 w;
                        w.x = cvt_pk_bf16(gelu_tanh_f(v0[0]), gelu_tanh_f(v0[1])); w.y = cvt_pk_bf16(gelu_tanh_f(v0[2]), gelu_tanh_f(v0[3]));
                        w.z = cvt_pk_bf16(gelu_tanh_f(v1[0]), gelu_tanh_f(v1[1])); w.w = cvt_pk_bf16(gelu_tanh_f(v1[2]), gelu_tanh_f(v1[3]));
                        *(u32x4*)(rowp + bj * HALF) = w; } }
        } else {
            const int col0 = (u.pn - 8) * 128 + wc * 32 + 8 * fq;
#pragma unroll
            for (int ai = 0; ai < 2; ++ai)
#pragma unroll
                for (int m = 0; m < 4; ++m) { bf16_t* rowp = G + (size_t)(row0 + ai * HALF + m * 16) * 1024 + col0;
                    const f32x4 a0 = acc[ai][0][m][0], a1 = acc[ai][0][m][1], g0 = acc[ai][1][m][0], g1 = acc[ai][1][m][1]; u32x4 w;
                    w.x = cvt_pk_bf16(a0[0] * sigm_f(g0[0]), a0[1] * sigm_f(g0[1])); w.y = cvt_pk_bf16(a0[2] * sigm_f(g0[2]), a0[3] * sigm_f(g0[3]));
                    w.z = cvt_pk_bf16(a1[0] * sigm_f(g1[0]), a1[1] * sigm_f(g1[1])); w.w = cvt_pk_bf16(a1[2] * sigm_f(g1[2]), a1[3] * sigm_f(g1[3]));
                    *(u32x4*)rowp = w; }
        }
    }
};
struct EpiSwiGLU {
    static constexpr bool PERM = true, AFTER_DRAIN = false;
    bf16_t* T; int ldc;
    __device__ __forceinline__ void operator()(const f32x4 (&acc)[2][2][4][2], const Unit& u, int wr, int wc, int fr, int fq) const {
        const int row0 = u.pm * BM + wr * 64 + fr; const int col0 = u.j * 128 + wc * 32 + 8 * fq;
#pragma unroll
        for (int ai = 0; ai < 2; ++ai)
#pragma unroll
            for (int m = 0; m < 4; ++m) { bf16_t* rowp = T + (size_t)(row0 + ai * HALF + m * 16) * ldc + col0;
                const f32x4 a0 = acc[ai][0][m][0], a1 = acc[ai][0][m][1], g0 = acc[ai][1][m][0], g1 = acc[ai][1][m][1]; u32x4 w;
                w.x = cvt_pk_bf16(silu_f(a0[0]) * g0[0], silu_f(a0[1]) * g0[1]); w.y = cvt_pk_bf16(silu_f(a0[2]) * g0[2], silu_f(a0[3]) * g0[3]);
                w.z = cvt_pk_bf16(silu_f(a1[0]) * g1[0], silu_f(a1[1]) * g1[1]); w.w = cvt_pk_bf16(silu_f(a1[2]) * g1[2], silu_f(a1[3]) * g1[3]);
                *(u32x4*)rowp = w; }
    }
};
struct EpiResid {
    static constexpr bool PERM = false, AFTER_DRAIN = false;
    float* X; const float* gate;
    __device__ __forceinline__ void operator()(const f32x4 (&acc)[2][2][4][2], const Unit& u, int wr, int wc, int fr, int fq) const {
        const int mr = (u.pm < 64) ? (u.pm >> 3) : 8; const float* gp = gate + (size_t)mr * 6144;
        const int col0 = u.pn * BM + wc * 32 + 4 * fq;
        f32x4 gv[2][2];
#pragma unroll
        for (int bj = 0; bj < 2; ++bj)
#pragma unroll
            for (int n = 0; n < 2; ++n) gv[bj][n] = *(const f32x4*)(gp + col0 + bj * HALF + n * 16);
#pragma unroll
        for (int ai = 0; ai < 2; ++ai)
#pragma unroll
            for (int m = 0; m < 4; ++m) { float* xp = X + (size_t)(u.pm * BM + ai * HALF + wr * 64 + m * 16 + fr) * 1024 + col0;
#pragma unroll
                for (int bj = 0; bj < 2; ++bj)
#pragma unroll
                    for (int n = 0; n < 2; ++n) { f32x4 x = *(const f32x4*)(xp + bj * HALF + n * 16); x = x + gv[bj][n] * acc[ai][bj][m][n]; *(f32x4*)(xp + bj * HALF + n * 16) = x; } }
    }
};
struct EpiMoeDown {
    static constexpr bool PERM = false, AFTER_DRAIN = false;
    bf16_t* YS; const int* rowmap; const float* roww;
    __device__ __forceinline__ void operator()(const f32x4 (&acc)[2][2][4][2], const Unit& u, int wr, int wc, int fr, int fq) const {
        const int col0 = u.j * BM + wc * 32 + 4 * fq;
#pragma unroll
        for (int ai = 0; ai < 2; ++ai)
#pragma unroll
            for (int m = 0; m < 4; ++m) { const int prow = u.pm * BM + ai * HALF + wr * 64 + m * 16 + fr; const int ts = rowmap[prow]; const float w = roww[prow];
                if (ts >= 0) { bf16_t* yp = YS + (size_t)ts * 1024 + col0;
#pragma unroll
                    for (int bj = 0; bj < 2; ++bj)
#pragma unroll
                        for (int n = 0; n < 2; ++n) { const f32x4 v = acc[ai][bj][m][n] * w; unsigned lo = cvt_pk_bf16(v[0], v[1]), hi = cvt_pk_bf16(v[2], v[3]);
                            *(unsigned long long*)(yp + bj * HALF + n * 16) = (unsigned long long)lo | ((unsigned long long)hi << 32); } } }
    }
};
template <class Epi, class Sched, bool ALIGN_EPI = false, bool SP2 = false>
__device__ __forceinline__ void gemm_phase(PG8_LAS unsigned char* lds, const Gemm g, const Sched& S, const Epi& E) {
    int tid_ = threadIdx.x; asm volatile("" : "+v"(tid_));
    const int tid = tid_, wid = __builtin_amdgcn_readfirstlane(tid >> 6), lane = tid & 63, wr = wid >> 2, wc = wid & 3, fr = lane & 15, fq = lane >> 4;
    const int K = g.K, nt = K / BK;
    unsigned voffA[2], voffB[2];
#pragma unroll
    for (int i = 0; i < 2; ++i) { int R, C; stage_rc(tid * 16 + i * 8192, R, C); const int Rb = Epi::PERM ? ((R & ~31) + perm32(R & 31)) : R;
        voffA[i] = (unsigned)(R * K + C) * 2u; voffB[i] = (unsigned)(Rb * K + C) * 2u; }
    const size_t kstep = (size_t)(BK * 2);
    const size_t hstep = (size_t)HALF * K * 2;
    const size_t tstep = 2 * hstep;
    const unsigned ldsw = (unsigned)wid * 1024u;
    const int aoff = lds_byte(wr * 64 + fr, fq * 8), boff = lds_byte(wc * 32 + fr, fq * 8);
#define PG8_SA(b, h) (((b) * 2 + (h)) * HTB)
#define PG8_SB(b, h) ((4 + (b) * 2 + (h)) * HTB)
#define PG8_STAGE(bufoff, gbase, voff) do { _Pragma("unroll") for (int _i = 0; _i < 2; ++_i) \
        __builtin_amdgcn_global_load_lds((const unsigned*)((const char*)(gbase) + (voff)[_i]), (PG8_LAS unsigned*)(lds + (bufoff) + ldsw + _i * 8192), 16, 0, 0); } while (0)
#define PG8_LDA(dst, b, h) do { _Pragma("unroll") for (int m = 0; m < 4; ++m) _Pragma("unroll") for (int k = 0; k < 2; ++k) dst[m][k] = *(const PG8_LAS bf16x8*)(lds + PG8_SA(b, h) + aoff + m * 2048 + k * 1024); } while (0)
#define PG8_LDB(dst, b, h) do { _Pragma("unroll") for (int n = 0; n < 2; ++n) _Pragma("unroll") for (int k = 0; k < 2; ++k) dst[n][k] = *(const PG8_LAS bf16x8*)(lds + PG8_SB(b, h) + boff + n * 2048 + k * 1024); } while (0)
#define PG8_MMA(ai, bj, At, Bt) do { __builtin_amdgcn_s_setprio(1); _Pragma("unroll") for (int m = 0; m < 4; ++m) _Pragma("unroll") for (int n = 0; n < 2; ++n) _Pragma("unroll") for (int k = 0; k < 2; ++k) \
        acc[ai][bj][m][n] = __builtin_amdgcn_mfma_f32_16x16x32_bf16(Bt[n][k], At[m][k], acc[ai][bj][m][n], 0, 0, 0); __builtin_amdgcn_s_setprio(0); } while (0)
#define PG8_WAIT_V(n) asm volatile("s_waitcnt vmcnt(" #n ")" ::: "memory")
#define PG8_WAIT_L(n) asm volatile("s_waitcnt lgkmcnt(" #n ")" ::: "memory")
#define PG8_BAR __builtin_amdgcn_s_barrier()
#define PG8_SCHED __builtin_amdgcn_sched_barrier(0)
    Unit cur, nxt; int ui = 0;
    if (!S.next(0, cur)) return;
    f32x4 acc[2][2][4][2];
#pragma unroll
    for (int a = 0; a < 2; ++a)
#pragma unroll
        for (int b = 0; b < 2; ++b)
#pragma unroll
            for (int m = 0; m < 4; ++m)
#pragma unroll
                for (int n = 0; n < 2; ++n) acc[a][b][m][n] = (f32x4){0.f, 0.f, 0.f, 0.f};
    bf16x8 At[4][2], B0[2][2], B1[2][2];
    const char* cA = (const char*)g.A + (size_t)cur.pm * tstep; const char* cB = (const char*)g.Bt + (size_t)cur.pn * tstep;
    S.a_ready(cur);
    if constexpr (SP2) {
        PG8_STAGE(PG8_SB(0, 0), cB, voffB); PG8_STAGE(PG8_SB(0, 1), cB + hstep, voffB); PG8_STAGE(PG8_SA(0, 0), cA, voffA); PG8_STAGE(PG8_SA(0, 1), cA + hstep, voffA);
        if (wr == 1) PG8_BAR;
        PG8_WAIT_V(2); PG8_BAR;
        PG8_STAGE(PG8_SB(1, 0), cB + kstep, voffB); PG8_STAGE(PG8_SA(1, 0), cA + kstep, voffA); PG8_STAGE(PG8_SB(1, 1), cB + hstep + kstep, voffB);
        PG8_WAIT_V(6); PG8_BAR;
    } else {
        PG8_STAGE(PG8_SB(0, 0), cB, voffB); PG8_STAGE(PG8_SA(0, 0), cA, voffA); PG8_STAGE(PG8_SB(0, 1), cB + hstep, voffB); PG8_STAGE(PG8_SA(0, 1), cA + hstep, voffA);
        if (wr == 1) PG8_BAR;
        PG8_WAIT_V(4); PG8_BAR;
        PG8_STAGE(PG8_SB(1, 0), cB + kstep, voffB); PG8_STAGE(PG8_SA(1, 0), cA + kstep, voffA); PG8_STAGE(PG8_SB(1, 1), cB + hstep + kstep, voffB);
        PG8_WAIT_V(6); PG8_BAR;
    }
    for (;;) {
        const bool has_next = S.next(ui + 1, nxt);
        const char* nA = has_next ? (const char*)g.A + (size_t)nxt.pm * tstep : cA; const char* nB = has_next ? (const char*)g.Bt + (size_t)nxt.pn * tstep : cB;
        for (int t = 0; t < nt; t += 2) {
            const bool last = (t == nt - 2);
            const char* a1 = cA + (size_t)(t + 1) * kstep;
            const char* a2 = last ? nA : cA + (size_t)(t + 2) * kstep; const char* b2 = last ? nB : cB + (size_t)(t + 2) * kstep;
            const char* a3 = a2 + kstep; const char* b3 = b2 + kstep;
            if (last && has_next) S.a_ready(nxt);
            if constexpr (SP2) {
            PG8_LDB(B0, 0, 0); PG8_LDB(B1, 0, 1); PG8_SCHED; PG8_LDA(At, 0, 0); PG8_STAGE(PG8_SA(1, 1), a1 + hstep, voffA);
            PG8_WAIT_V(8); PG8_WAIT_L(0); PG8_BAR; PG8_MMA(0, 0, At, B0); PG8_MMA(0, 1, At, B1); PG8_BAR; PG8_SCHED;
            PG8_LDA(At, 0, 1); PG8_STAGE(PG8_SB(0, 0), b2, voffB); PG8_STAGE(PG8_SB(0, 1), b2 + hstep, voffB); PG8_STAGE(PG8_SA(0, 0), a2, voffA);
            PG8_WAIT_V(8); PG8_WAIT_L(0); PG8_BAR; PG8_MMA(1, 0, At, B0); PG8_MMA(1, 1, At, B1); PG8_BAR; PG8_SCHED;
            PG8_LDB(B0, 1, 0); PG8_LDB(B1, 1, 1); PG8_SCHED; PG8_LDA(At, 1, 0); PG8_STAGE(PG8_SA(0, 1), a2 + hstep, voffA);
            PG8_WAIT_V(8); PG8_WAIT_L(0); PG8_BAR; PG8_MMA(0, 0, At, B0); PG8_MMA(0, 1, At, B1); PG8_BAR; PG8_SCHED;
            PG8_LDA(At, 1, 1); PG8_STAGE(PG8_SB(1, 0), b3, voffB); PG8_STAGE(PG8_SB(1, 1), b3 + hstep, voffB); PG8_STAGE(PG8_SA(1, 0), a3, voffA);
            PG8_WAIT_V(8); PG8_WAIT_L(0); PG8_BAR; PG8_MMA(1, 0, At, B0); PG8_MMA(1, 1, At, B1); PG8_BAR; PG8_SCHED;
            } else {
            PG8_LDB(B0, 0, 0); PG8_SCHED; PG8_LDA(At, 0, 0); PG8_STAGE(PG8_SA(1, 1), a1 + hstep, voffA);
            PG8_WAIT_L(8); PG8_BAR; PG8_WAIT_L(0); PG8_MMA(0, 0, At, B0); PG8_BAR; PG8_SCHED;
            PG8_LDB(B1, 0, 1); PG8_STAGE(PG8_SB(0, 0), b2, voffB);
            PG8_BAR; PG8_WAIT_L(0); PG8_MMA(0, 1, At, B1); PG8_BAR;
            PG8_LDA(At, 0, 1); PG8_STAGE(PG8_SA(0, 0), a2, voffA);
            PG8_BAR; PG8_WAIT_L(0); PG8_MMA(1, 0, At, B0); PG8_BAR; PG8_SCHED;
            PG8_STAGE(PG8_SB(0, 1), b2 + hstep, voffB);
            PG8_WAIT_V(6); PG8_BAR; PG8_MMA(1, 1, At, B1); PG8_BAR;
            PG8_LDB(B0, 1, 0); PG8_SCHED; PG8_LDA(At, 1, 0); PG8_STAGE(PG8_SA(0, 1), a2 + hstep, voffA);
            PG8_WAIT_L(8); PG8_BAR; PG8_WAIT_L(0); PG8_MMA(0, 0, At, B0); PG8_BAR; PG8_SCHED;
            PG8_LDB(B1, 1, 1); PG8_STAGE(PG8_SB(1, 0), b3, voffB);
            PG8_BAR; PG8_WAIT_L(0); PG8_MMA(0, 1, At, B1); PG8_BAR;
            PG8_LDA(At, 1, 1); PG8_STAGE(PG8_SA(1, 0), a3, voffA);
            PG8_BAR; PG8_WAIT_L(0); PG8_MMA(1, 0, At, B0); PG8_BAR; PG8_SCHED;
            PG8_STAGE(PG8_SB(1, 1), b3 + hstep, voffB);
            PG8_WAIT_V(6); PG8_BAR; PG8_MMA(1, 1, At, B1); PG8_BAR;
            }
        }
        if constexpr (ALIGN_EPI) { if (wr == 0) PG8_BAR; }
        if constexpr (!Epi::AFTER_DRAIN) { E(acc, cur, wr, wc, fr, fq); S.done(cur); }
        if (!has_next) break;
#pragma unroll
        for (int a = 0; a < 2; ++a)
#pragma unroll
            for (int b = 0; b < 2; ++b)
#pragma unroll
                for (int m = 0; m < 4; ++m)
#pragma unroll
                    for (int n = 0; n < 2; ++n) acc[a][b][m][n] = (f32x4){0.f, 0.f, 0.f, 0.f};
        cur = nxt; cA = nA; cB = nB; ++ui;
        if constexpr (ALIGN_EPI) { if (wr == 1) PG8_BAR; }
    }
    PG8_WAIT_V(0);
    if constexpr (!ALIGN_EPI) { if (wr == 0) PG8_BAR; }
    PG8_BAR;
    if constexpr (Epi::AFTER_DRAIN) { E.fused(acc, cur, wr, wc, fr, fq, lds, wid, lane); S.done(cur); }
#undef PG8_SA
#undef PG8_SB
#undef PG8_STAGE
#undef PG8_LDA
#undef PG8_LDB
#undef PG8_MMA
#undef PG8_WAIT_V
#undef PG8_WAIT_L
#undef PG8_BAR
#undef PG8_SCHED
}
}
#define GAS __attribute__((address_space(1)))
#define LAS __attribute__((address_space(3)))
typedef unsigned short bf16;
typedef unsigned v4u __attribute__((ext_vector_type(4)));
typedef float f32x4 __attribute__((ext_vector_type(4)));
typedef short bf16x8 __attribute__((ext_vector_type(8)));
typedef GAS unsigned gu32;
typedef GAS unsigned long long gu64;
#define RLX_AGENT __ATOMIC_RELAXED, __HIP_MEMORY_SCOPE_AGENT
#define LDS_WAIT() asm volatile("s_waitcnt lgkmcnt(0)" ::: "memory")
#define VM_WAIT() asm volatile("s_waitcnt vmcnt(0)" ::: "memory")
__device__ __forceinline__ unsigned long long rt() { return __builtin_amdgcn_s_memrealtime(); }
__device__ __forceinline__ unsigned f2bf(float f) { unsigned u = __builtin_bit_cast(unsigned, f); return (u + 0x7fffu + ((u >> 16) & 1u)) >> 16; }
__device__ __forceinline__ unsigned pk2(float lo, float hi) { return f2bf(lo) | (f2bf(hi) << 16); }

#define XB_TMO      128
#define XB_XCNT(j)  (256  + 64 * (j))
#define XB_XSUB(j)  (1280 + 64 * (j))
#define XB_XGEN(j)  (2304 + 64 * (j))
#define XB_TOP      3328
#define XB_TOPGEN   3392
#define XCD_BAR_WORDS 3456
#define XB_SPIN_CAP (1u << 18)

__device__ __forceinline__ unsigned xb_ld(unsigned* p)              { return __hip_atomic_load(p, __ATOMIC_RELAXED, __HIP_MEMORY_SCOPE_AGENT); }
__device__ __forceinline__ unsigned xb_add(unsigned* p, unsigned v) { return __hip_atomic_fetch_add(p, v, __ATOMIC_RELAXED, __HIP_MEMORY_SCOPE_AGENT); }
__device__ __forceinline__ unsigned xb_xcc_id() { return (unsigned)__builtin_amdgcn_s_getreg((3 << 11) | 20) & 0xFu; }
#define XB_SPIN(cond, bar) do { unsigned _sp = 0; while (cond) { __builtin_amdgcn_s_sleep(1); \
    if ((++_sp & 255u) == 0u) { if (xb_ld(&(bar)[XB_TMO])) break; if (_sp > XB_SPIN_CAP) { atomicAdd(&(bar)[XB_TMO], 1u); break; } } } } while (0)

struct XcdBarrier {
    unsigned* bar; unsigned x;
    volatile LAS unsigned* st;
};

__device__ __forceinline__ XcdBarrier xcd_barrier_post(unsigned* bar, volatile LAS unsigned* st) {
    XcdBarrier b; b.bar = bar; b.x = xb_xcc_id(); b.st = st;
    if (threadIdx.x == 0) (void)xb_add(&bar[XB_XCNT(b.x)], 1u);
    return b;
}
__device__ __forceinline__ void xcd_barrier_complete(unsigned* bar, unsigned x, unsigned& nloc, unsigned& nx) {
    const unsigned G = gridDim.x * gridDim.y * gridDim.z;
    unsigned sum, cnt, mine, sp = 0u;
    for (;;) {
        sum = 0u; cnt = 0u; mine = 0u;
#pragma unroll
        for (unsigned j = 0; j < 16; ++j) { const unsigned c = xb_ld(&bar[XB_XCNT(j)]); sum += c; cnt += (c > 0u) ? 1u : 0u; mine = (j == x) ? c : mine; }
        if (sum == G) break;
        __builtin_amdgcn_s_sleep(1);
        if ((++sp & 255u) == 0u) { if (xb_ld(&bar[XB_TMO])) break; if (sp > XB_SPIN_CAP) { atomicAdd(&bar[XB_TMO], 1u); break; } }
    }
    nloc = mine > 0u ? mine : 1u; nx = cnt > 0u ? cnt : 1u;
}

__device__ __forceinline__ void xcd_barrier(const XcdBarrier& b) {
    asm volatile("s_waitcnt vmcnt(0)" ::: "memory");
    __syncthreads();
    if (threadIdx.x == 0) {
        unsigned* bar = b.bar;
        __builtin_amdgcn_s_waitcnt(0);
        unsigned nloc = b.st[0], nx = b.st[1];
        if (nloc == 0u) { xcd_barrier_complete(bar, b.x, nloc, nx); b.st[0] = nloc; b.st[1] = nx; }
        const unsigned old = xb_add(&bar[XB_XSUB(b.x)], 1u);
        const unsigned gen = old / nloc;
        if (old + 1u == (gen + 1u) * nloc) {
            __builtin_amdgcn_fence(__ATOMIC_RELEASE, "agent");
            asm volatile("s_waitcnt vmcnt(0)" ::: "memory");
            const unsigned og = xb_add(&bar[XB_TOP], 1u);
            const unsigned tg = og / nx;
            if (og + 1u == (tg + 1u) * nx) xb_add(&bar[XB_TOPGEN], 1u);
            else XB_SPIN(xb_ld(&bar[XB_TOPGEN]) == tg, bar);
            __builtin_amdgcn_fence(__ATOMIC_ACQUIRE, "agent");
            xb_add(&bar[XB_XGEN(b.x)], 1u);
            asm volatile("s_waitcnt vmcnt(0)" ::: "memory");
        } else {
            XB_SPIN(xb_ld(&bar[XB_XGEN(b.x)]) == gen, bar);
            __builtin_amdgcn_fence(__ATOMIC_ACQUIRE, "agent");
            asm volatile("s_waitcnt vmcnt(0)" ::: "memory");
        }
    }
    __syncthreads();
}
constexpr int NWAVES = 8;
#ifndef MK_PER_PHASE
#define MK_PER_PHASE 1
#endif
constexpr int D = 1024, NB = 8, SEQ = 2048, CTXL = 256, ML = NB * SEQ, MC = NB * CTXL, MT = ML + MC;
constexpr int FF = 3584, NE = 8;
constexpr float EPS = 1e-6f;
constexpr float LOG2E = 1.4426950408889634f;
constexpr float QSCALE = 0.125f * LOG2E;
constexpr int N_PHASES = 34;
constexpr size_t MiB = 1u << 20;
constexpr size_t WS_CTL = 0, CTL_ZERO_BYTES = 1 * MiB;
constexpr size_t WS_MOD = 1 * MiB;
constexpr size_t WS_ROPE = 2 * MiB;
constexpr size_t WS_WSB = 2 * MiB + 65536;
constexpr size_t WS_TOKI = 3 * MiB;
constexpr size_t WS_TOKW = 3 * MiB + 524288;
constexpr size_t WS_ROWMAP = 4 * MiB;
constexpr size_t WS_ROWW = 4 * MiB + 262144;
constexpr size_t WS_WIN = 8 * MiB, WS_WOUT = 24 * MiB, WS_WQKV = 32 * MiB, WS_WO = 38 * MiB, WS_FF13 = 42 * MiB, WS_FF2 = 70 * MiB;
constexpr size_t WS_MOE13 = 84 * MiB, WS_MOE2 = 196 * MiB;
constexpr size_t WS_X = 252 * MiB;
constexpr size_t WS_H = 324 * MiB;
constexpr size_t WS_R = 360 * MiB;
constexpr size_t WS_U = WS_R, WS_V = WS_R + 36 * MiB, WS_G = WS_R + 72 * MiB, WS_YAB = WS_R + 108 * MiB;
constexpr size_t WS_QKV = WS_R, WS_Q = WS_R + 54 * MiB, WS_K = WS_R + 90 * MiB, WS_O = WS_R + 99 * MiB;
constexpr size_t WS_T = WS_R;
constexpr size_t WS_HP = WS_R, WS_TP = WS_R + 76 * MiB, WS_YS = WS_R + 342 * MiB;
constexpr size_t WS_END = WS_R + 414 * MiB;
constexpr int CW_TMO = 0, CW_CODE = 1, CW_CNT = 64, CW_BAR = 4096;
constexpr int RING_OFF = 0;
constexpr int LDSCTL_OFF = 143360, MISC_OFF = LDSCTL_OFF + 64;
constexpr int LDS_BYTES = 147456;
__constant__ float INVF[16] = {1.0f, 0.5623413324356079f, 0.3162277638912201f, 0.17782793939113617f, 0.10000000149011612f, 0.05623413249850273f, 0.03162277489900589f, 0.017782794311642647f,
    0.009999999776482582f, 0.005623413249850273f, 0.003162277629598975f, 0.0017782794311642647f, 0.0010000000474974513f, 0.000562341301701963f, 0.0003162277571391314f, 0.00017782794020604342f};

typedef unsigned v2u __attribute__((ext_vector_type(2)));
struct Args { const float* in[29]; float* out; unsigned char* ws; int ph_lo, ph_hi; };
struct Frame { LAS unsigned char* lds; volatile LAS unsigned* MISC; gu32* ctl; int tid, lane, wave, G, bid; };

__device__ __forceinline__ float wave_sum(float v) {
#pragma unroll
    for (int o = 1; o < 64; o <<= 1) v += __shfl_xor(v, o);
    return v;
}
__device__ __forceinline__ float bf2f(unsigned short b) { return __uint_as_float((unsigned)b << 16); }
__device__ __forceinline__ float bflo(unsigned w) { return __uint_as_float(w << 16); }
__device__ __forceinline__ float bfhi(unsigned w) { return __uint_as_float(w & 0xffff0000u); }
__device__ __forceinline__ unsigned pkbf(float lo, float hi) { return pg8::cvt_pk_bf16(lo, hi); }
__device__ __forceinline__ float fsigm(float x) { return pg8::sigm_f(x); }

__device__ __forceinline__ int dst_row(int mode, int n) {
    if (mode == 0) return n;
    if (mode == 1) return ((n >> 7) << 8) + (n & 127);
    if (mode == 2) return ((n >> 7) << 8) + 128 + (n & 127);
    if (n < 2048) return n;
    if (n < 3072) { const int j = n - 2048; return 2048 + ((j >> 7) << 8) + (j & 127); }
    { const int j = n - 3072; return 2048 + ((j >> 7) << 8) + 128 + (j & 127); }
}
__device__ __forceinline__ void conv_item(const float* W, int N, int K, bf16* WT, int mode, int item, LAS float* scr, int lane) {
    const int nblk = N >> 6, kb = item / nblk, nb = item - kb * nblk, k0 = kb << 6, n0 = nb << 6;
    const int c4 = (lane & 15) << 2, kr = lane >> 4;
#pragma unroll 4
    for (int i = 0; i < 16; ++i) { const int kk = 4 * i + kr; const f32x4 v = *(const GAS f32x4*)(W + (size_t)(k0 + kk) * N + n0 + c4);
        LAS float* s = scr + kk * 65 + c4; s[0] = v.x; s[1] = v.y; s[2] = v.z; s[3] = v.w; }
    LDS_WAIT(); asm volatile("" ::: "memory");
    const int c = lane & 7;
#pragma unroll
    for (int jj = 0; jj < 8; ++jj) { const int n = (lane >> 3) + 8 * jj; const LAS float* s = scr + (8 * c) * 65 + n;
        v4u o; o.x = pkbf(s[0], s[65]); o.y = pkbf(s[130], s[195]); o.z = pkbf(s[260], s[325]); o.w = pkbf(s[390], s[455]);
        *(GAS v4u*)(WT + (size_t)dst_row(mode, n0 + n) * K + k0 + 8 * c) = o; }
    LDS_WAIT(); asm volatile("" ::: "memory");
}
__device__ __forceinline__ void conv_nonmoe(const Args& a, int it, LAS float* scr, int lane) {
    const int j = it / 4864; int r = it - j * 4864; const float* src; int N, K, mode; bf16* dst;
    if (r < 1024) { src = a.in[8] + (size_t)j * 1024 * 4096; N = 4096; K = 1024; mode = 3; dst = (bf16*)(a.ws + WS_WIN) + (size_t)j * 4096 * 1024; }
    else if ((r -= 1024) < 512) { src = a.in[16] + (size_t)j * 2048 * 1024; N = 1024; K = 2048; mode = 0; dst = (bf16*)(a.ws + WS_WOUT) + (size_t)j * 1024 * 2048; }
    else if ((r -= 512) < 384) { src = a.in[17] + (size_t)j * 1024 * 1536; N = 1536; K = 1024; mode = 0; dst = (bf16*)(a.ws + WS_WQKV) + (size_t)j * 1536 * 1024; }
    else if ((r -= 384) < 256) { src = a.in[21] + (size_t)j * 1024 * 1024; N = 1024; K = 1024; mode = 0; dst = (bf16*)(a.ws + WS_WO) + (size_t)j * 1024 * 1024; }
    else if ((r -= 256) < 896) { src = a.in[22] + (size_t)j * 1024 * 3584; N = 3584; K = 1024; mode = 1; dst = (bf16*)(a.ws + WS_FF13) + (size_t)j * 7168 * 1024; }
    else if ((r -= 896) < 896) { src = a.in[23] + (size_t)j * 1024 * 3584; N = 3584; K = 1024; mode = 2; dst = (bf16*)(a.ws + WS_FF13) + (size_t)j * 7168 * 1024; }
    else { r -= 896; src = a.in[24] + (size_t)j * 3584 * 1024; N = 1024; K = 3584; mode = 0; dst = (bf16*)(a.ws + WS_FF2) + (size_t)j * 1024 * 3584; }
    conv_item(src, N, K, dst, mode, r, scr, lane);
}
__device__ __forceinline__ void conv_moe(const Args& a, int jm, int it, LAS float* scr, int lane) {
    const int e = it / 2688; int r = it - e * 2688; const size_t eo = (size_t)(jm * 8 + e); const float* src; int N, K, mode; bf16* dst;
    if (r < 896) { src = a.in[26] + eo * 1024 * 3584; N = 3584; K = 1024; mode = 1; dst = (bf16*)(a.ws + WS_MOE13) + (size_t)e * 7168 * 1024; }
    else if ((r -= 896) < 896) { src = a.in[27] + eo * 1024 * 3584; N = 3584; K = 1024; mode = 2; dst = (bf16*)(a.ws + WS_MOE13) + (size_t)e * 7168 * 1024; }
    else { r -= 896; src = a.in[28] + eo * 3584 * 1024; N = 1024; K = 3584; mode = 0; dst = (bf16*)(a.ws + WS_MOE2) + (size_t)e * 1024 * 3584; }
    conv_item(src, N, K, dst, mode, r, scr, lane);
}
__device__ __forceinline__ void conv_moe_all(const Args& a, Frame& F, int jm) {
    LAS float* scr = (LAS float*)(F.lds + F.wave * 16640);
    const int gw = F.bid * NWAVES + F.wave, NGW = F.G * NWAVES;
    for (int it = gw; it < 8 * 2688; it += NGW) conv_moe(a, jm, it, scr, F.lane);
}
__device__ __forceinline__ void sincos_d(double x, double& s, double& c) {
    const double TWO_PI = 6.283185307179586476925286766559;
    const double k = __builtin_rint(x / TWO_PI); const double r = x - k * TWO_PI, r2 = r * r;
    double ts = r, ss = r, tc = 1.0, cs = 1.0;
#pragma unroll 1
    for (int n = 1; n <= 14; ++n) { tc = -tc * r2 / (double)((2 * n - 1) * (2 * n)); cs += tc; ts = -ts * r2 / (double)((2 * n) * (2 * n + 1)); ss += ts; }
    s = ss; c = cs;
}
__device__ __forceinline__ void prologue_phase(const Args& a, Frame& F) {
    const int gw = F.bid * NWAVES + F.wave, NGW = F.G * NWAVES;
    {
        LAS float* sc = (LAS float*)F.lds; LAS float* red = sc + 9 * 1024;
        for (int i = F.tid; i < 9 * 1024; i += NWAVES * 64) { const float v = (i < 8192) ? a.in[1][i] : a.in[3][i - 8192]; sc[i] = v * fsigm(v); }
        __syncthreads();
        float* MOD = (float*)(a.ws + WS_MOD);
        for (int job = F.bid; job < 192; job += F.G) {
            const int li = job / 48, nb = job - li * 48; const int cl = F.tid & 127, kg = F.tid >> 7;
            const float* w = a.in[4] + (size_t)li * 1024 * 6144 + nb * 128 + cl;
            float acc[9];
#pragma unroll
            for (int r = 0; r < 9; ++r) acc[r] = 0.f;
            for (int k = kg * 256; k < kg * 256 + 256; k += 4) {
                const float w0 = w[(size_t)k * 6144], w1 = w[(size_t)(k + 1) * 6144], w2 = w[(size_t)(k + 2) * 6144], w3 = w[(size_t)(k + 3) * 6144];
#pragma unroll
                for (int r = 0; r < 9; ++r) { const LAS float* s = sc + r * 1024 + k; acc[r] += s[0] * w0 + s[1] * w1 + s[2] * w2 + s[3] * w3; }
            }
#pragma unroll
            for (int r = 0; r < 9; ++r) red[(kg * 9 + r) * 128 + cl] = acc[r];
            __syncthreads();
            for (int o = F.tid; o < 9 * 128; o += NWAVES * 64) { const int r = o >> 7, c = o & 127;
                const float s = (red[(0 * 9 + r) * 128 + c] + red[(1 * 9 + r) * 128 + c]) + (red[(2 * 9 + r) * 128 + c] + red[(3 * 9 + r) * 128 + c]) + a.in[5][li * 6144 + nb * 128 + c];
                MOD[(size_t)(li * 9 + r) * 6144 + nb * 128 + c] = s; }
            __syncthreads();
        }
    }
    {
        const int gt = F.bid * (NWAVES * 64) + F.tid, NT = F.G * NWAVES * 64;
        if (gt < 1024) { const int pos = gt >> 4, i = gt & 15; const float ang = (float)pos * INVF[i]; double s, c; sincos_d((double)ang, s, c);
            float* rp = (float*)(a.ws + WS_ROPE) + gt * 2; rp[0] = (float)c; rp[1] = (float)s; }
        bf16* wsb = (bf16*)(a.ws + WS_WSB);
        for (int i = gt; i < 2 * 8 * 128 * 128 / 2; i += NT) { const float2 v = *(const float2*)(a.in[11] + 2 * i); *(unsigned*)(wsb + 2 * i) = pkbf(v.x, v.y); }
    }
    __syncthreads();
    {
        LAS float* scr = (LAS float*)(F.lds + F.wave * 16640);
        for (int it = gw; it < 2 * 4864; it += NGW) conv_nonmoe(a, it, scr, F.lane);
    }
    conv_moe_all(a, F, 0);
}

__device__ __forceinline__ void norm_row_core(const float* xsrc, float* xdst, const bf16* ys, const float* g2p, const float* gn, const float* scp, const float* shp, bf16* hdst, int lane, f32x4 (&h)[4]) {
    f32x4 v[4];
#pragma unroll
    for (int j = 0; j < 4; ++j) v[j] = *(const GAS f32x4*)(xsrc + 4 * lane + 256 * j);
    if (ys) {
#pragma unroll
        for (int j = 0; j < 4; ++j) { const v2u y0 = *(const GAS v2u*)(ys + 4 * lane + 256 * j), y1 = *(const GAS v2u*)(ys + 1024 + 4 * lane + 256 * j); const f32x4 g = *(const GAS f32x4*)(g2p + 4 * lane + 256 * j);
            v[j].x += g.x * (bflo(y0.x) + bflo(y1.x)); v[j].y += g.y * (bfhi(y0.x) + bfhi(y1.x)); v[j].z += g.z * (bflo(y0.y) + bflo(y1.y)); v[j].w += g.w * (bfhi(y0.y) + bfhi(y1.y)); }
    }
    if (xdst) {
#pragma unroll
        for (int j = 0; j < 4; ++j) *(GAS f32x4*)(xdst + 4 * lane + 256 * j) = v[j];
    }
    float ss = 0.f;
#pragma unroll
    for (int j = 0; j < 4; ++j) ss += (v[j].x * v[j].x + v[j].y * v[j].y) + (v[j].z * v[j].z + v[j].w * v[j].w);
    const float r = 1.0f / sqrtf(wave_sum(ss) * (1.0f / 1024.0f) + EPS);
#pragma unroll
    for (int j = 0; j < 4; ++j) { const f32x4 g = *(const GAS f32x4*)(gn + 4 * lane + 256 * j), sc = *(const GAS f32x4*)(scp + 4 * lane + 256 * j), sh = *(const GAS f32x4*)(shp + 4 * lane + 256 * j);
        h[j] = (v[j] * r) * g * (sc + 1.0f) + sh;
        v2u o; o.x = pkbf(h[j].x, h[j].y); o.y = pkbf(h[j].z, h[j].w); *(GAS v2u*)(hdst + 4 * lane + 256 * j) = o; }
}
__device__ __forceinline__ void norm_phase(const Args& a, Frame& F, int li, int which, int nrows, bool src_in, int pend_li) {
    const int gw = F.bid * NWAVES + F.wave, NGW = F.G * NWAVES;
    float* X = (float*)(a.ws + WS_X); bf16* H = (bf16*)(a.ws + WS_H); const float* MOD = (const float*)(a.ws + WS_MOD); const bf16* YS = (const bf16*)(a.ws + WS_YS);
    const float* gn = (which == 0 ? a.in[6] : a.in[7]) + li * 1024;
    for (int row = gw; row < nrows; row += NGW) {
        const int mr = (row < ML) ? (row >> 11) : 8;
        const float* mp = MOD + (size_t)(li * 9 + mr) * 6144 + (which ? 3 * 1024 : 0);
        const float* xs = src_in ? ((row < ML) ? a.in[0] + (size_t)row * 1024 : a.in[2] + (size_t)(row - ML) * 1024) : X + (size_t)row * 1024;
        const bool wx = src_in || (pend_li >= 0);
        f32x4 h[4];
        norm_row_core(xs, wx ? X + (size_t)row * 1024 : nullptr, (pend_li >= 0) ? YS + (size_t)row * 2048 : nullptr, MOD + (size_t)((pend_li >= 0 ? pend_li : 0) * 9 + mr) * 6144 + 5 * 1024,
                      gn, mp + 1024, mp, H + (size_t)row * 1024, F.lane, h);
    }
}
__device__ __forceinline__ void norm_router_phase(const Args& a, Frame& F, int li, int nrows) {
    constexpr int RPW = 72;
    float* X = (float*)(a.ws + WS_X); bf16* H = (bf16*)(a.ws + WS_H); const float* MOD = (const float*)(a.ws + WS_MOD);
    int4* TOKI = (int4*)(a.ws + WS_TOKI); float2* TOKW = (float2*)(a.ws + WS_TOKW);
    const int jm = li >> 1;
    LAS float* Rt = (LAS float*)F.lds;
    LAS int* lcnt = (LAS int*)(F.lds + 32768);
    LAS int* lbase = (LAS int*)(F.lds + 32768 + 64);
    LAS int* rinfo = (LAS int*)(F.lds + 32768 + 128);
    LAS float* rwt = (LAS float*)(F.lds + 32768 + 128 + 72 * 16);
    const float* router = a.in[25] + (size_t)jm * 1024 * 8;
    for (int i = F.tid; i < 8192; i += NWAVES * 64) { const int col = i >> 3, e = i & 7; Rt[e * 1024 + col] = router[i]; }
    if (F.tid < 8) lcnt[F.tid] = 0;
    __syncthreads();
    const float* gn = a.in[7] + li * 1024;
    gu32* CNT = F.ctl + CW_CNT + 16 * jm;
    for (int base = F.bid * RPW; base < nrows; base += F.G * RPW) {
        for (int i = 0; i < 9; ++i) {
            const int lr = F.wave * 9 + i, row = base + lr;
            if (row < nrows) {
                const int mr = (row < ML) ? (row >> 11) : 8; const float* mp = MOD + (size_t)(li * 9 + mr) * 6144 + 3 * 1024;
                f32x4 h[4];
                norm_row_core(X + (size_t)row * 1024, nullptr, nullptr, nullptr, gn, mp + 1024, mp, H + (size_t)row * 1024, F.lane, h);
                float lg[8];
#pragma unroll
                for (int e = 0; e < 8; ++e) { float p = 0.f;
#pragma unroll
                    for (int j = 0; j < 4; ++j) { const f32x4 rv = *(const LAS f32x4*)(Rt + e * 1024 + 4 * F.lane + 256 * j); p += (h[j].x * rv.x + h[j].y * rv.y) + (h[j].z * rv.z + h[j].w * rv.w); }
                    lg[e] = wave_sum(p); }
                int i0 = 0; float l0 = lg[0];
#pragma unroll
                for (int e = 1; e < 8; ++e) if (lg[e] > l0) { l0 = lg[e]; i0 = e; }
                int i1 = -1; float l1 = -3.0e38f;
#pragma unroll
                for (int e = 0; e < 8; ++e) if (e != i0 && lg[e] > l1) { l1 = lg[e]; i1 = e; }
                const float w0 = 1.0f / (1.0f + __expf(l1 - l0)), w1 = 1.0f - w0;
                if (F.lane == 0) { const int r0 = __hip_atomic_fetch_add(lcnt + i0, 1, __ATOMIC_RELAXED, __HIP_MEMORY_SCOPE_WORKGROUP), r1 = __hip_atomic_fetch_add(lcnt + i1, 1, __ATOMIC_RELAXED, __HIP_MEMORY_SCOPE_WORKGROUP);
                    rinfo[lr * 4 + 0] = i0; rinfo[lr * 4 + 1] = i1; rinfo[lr * 4 + 2] = r0; rinfo[lr * 4 + 3] = r1; rwt[lr * 2] = w0; rwt[lr * 2 + 1] = w1; }
            }
        }
        __syncthreads();
        if (F.tid < 8) { const int c = lcnt[F.tid]; lbase[F.tid] = (int)__hip_atomic_fetch_add(CNT + F.tid, (unsigned)c, RLX_AGENT); lcnt[F.tid] = 0; }
        __syncthreads();
        if (F.tid < RPW) { const int row = base + F.tid; if (row < nrows) { const int e0 = rinfo[F.tid * 4], e1 = rinfo[F.tid * 4 + 1];
            TOKI[row] = make_int4(e0 | (e1 << 8), lbase[e0] + rinfo[F.tid * 4 + 2], lbase[e1] + rinfo[F.tid * 4 + 3], 0); TOKW[row] = make_float2(rwt[F.tid * 2], rwt[F.tid * 2 + 1]); } }
        __syncthreads();
    }
}
struct MoeSeg { int np[8]; int pst[9]; };
__device__ __forceinline__ void moe_seg(Frame& F, int jm, MoeSeg& s) {
    gu32* CNT = F.ctl + CW_CNT + 16 * jm; int acc = 0;
#pragma unroll
    for (int e = 0; e < 8; ++e) { const int c = __builtin_amdgcn_readfirstlane((int)__hip_atomic_load(CNT + e, RLX_AGENT)); s.np[e] = (c + 255) >> 8; s.pst[e] = acc; acc += s.np[e]; }
    s.pst[8] = acc;
}
__device__ __forceinline__ int seg_start(const MoeSeg& s, int e) { int r = 0;
#pragma unroll
    for (int q = 0; q < 8; ++q) r += (q < e) ? s.np[q] : 0;
    return r; }
__device__ __forceinline__ void scatter_phase(const Args& a, Frame& F, int jm, int nrows) {
    const int gw = F.bid * NWAVES + F.wave, NGW = F.G * NWAVES;
    MoeSeg sg; moe_seg(F, jm, sg);
    const bf16* H = (const bf16*)(a.ws + WS_H); bf16* HP = (bf16*)(a.ws + WS_HP); int* ROWMAP = (int*)(a.ws + WS_ROWMAP); float* ROWW = (float*)(a.ws + WS_ROWW);
    const int4* TOKI = (const int4*)(a.ws + WS_TOKI); const float2* TOKW = (const float2*)(a.ws + WS_TOKW);
    for (int row = gw; row < nrows; row += NGW) {
        const int4 ti = TOKI[row]; const float2 tw = TOKW[row]; const int e0 = ti.x & 255, e1 = ti.x >> 8;
        const int p0 = seg_start(sg, e0) * 256 + ti.y, p1 = seg_start(sg, e1) * 256 + ti.z;
        const GAS v4u* hs = (const GAS v4u*)(H + (size_t)row * 1024) + F.lane; const v4u x0 = hs[0], x1 = hs[64];
        GAS v4u* d0 = (GAS v4u*)(HP + (size_t)p0 * 1024) + F.lane; d0[0] = x0; d0[64] = x1;
        GAS v4u* d1 = (GAS v4u*)(HP + (size_t)p1 * 1024) + F.lane; d1[0] = x0; d1[64] = x1;
        if (F.lane == 0) { ROWMAP[p0] = row * 2; ROWW[p0] = tw.x; ROWMAP[p1] = row * 2 + 1; ROWW[p1] = tw.y; }
    }
    if (F.bid == 0) {
        gu32* CNT = F.ctl + CW_CNT + 16 * jm;
#pragma unroll
        for (int e = 0; e < 8; ++e) { const int c = (int)__hip_atomic_load(CNT + e, RLX_AGENT); const int s0 = sg.pst[e] * 256;
            for (int i = c + F.tid; i < sg.np[e] * 256; i += NWAVES * 64) { ROWMAP[s0 + i] = -1; ROWW[s0 + i] = 0.f; } }
    }
}
struct MoeOrder {
    int pst[9]; int nt, G, c;
    __device__ __forceinline__ bool next(int i, pg8::Unit& u) const {
        const int L = i * G + c; if (L >= pst[8] * nt) return false;
        const int p = L / nt, j = L - p * nt; int e = 0;
#pragma unroll
        for (int q = 1; q < 8; ++q) e += (p >= pst[q]) ? 1 : 0;
        u.pm = p; u.e = e; u.j = j; u.pn = e * nt + j; return true;
    }
    __device__ __forceinline__ void a_ready(const pg8::Unit&) const {}
    __device__ __forceinline__ void done(const pg8::Unit&) const {}
};

__device__ __forceinline__ void gate_unit(const Args& a, Frame& F, int j, int n) {
    LAS float* stat = (LAS float*)F.lds;
    LAS bf16* VT = (LAS bf16*)(F.lds + 1024);
    LAS bf16* WSl = (LAS bf16*)(F.lds + 1024 + 34816);
    const bf16* U = (const bf16*)(a.ws + WS_U); const bf16* V = (const bf16*)(a.ws + WS_V); bf16* YAB = (bf16*)(a.ws + WS_YAB); const bf16* WSB = (const bf16*)(a.ws + WS_WSB);
    const float* lng = a.in[9] + j * 1024; const float* lnb = a.in[10] + j * 1024; const float* bs = a.in[12] + j * 1024;
    const int r0 = n * 128, lane = F.lane, w = F.wave;
    for (int i = 0; i < 16; ++i) { const int q = w * 16 + i; const GAS v4u* vr = (const GAS v4u*)(V + (size_t)(r0 + q) * 1024 + lane * 16); const v4u x0 = vr[0], x1 = vr[1];
        float f[16]; f[0] = bflo(x0.x); f[1] = bfhi(x0.x); f[2] = bflo(x0.y); f[3] = bfhi(x0.y); f[4] = bflo(x0.z); f[5] = bfhi(x0.z); f[6] = bflo(x0.w); f[7] = bfhi(x0.w);
        f[8] = bflo(x1.x); f[9] = bfhi(x1.x); f[10] = bflo(x1.y); f[11] = bfhi(x1.y); f[12] = bflo(x1.z); f[13] = bfhi(x1.z); f[14] = bflo(x1.w); f[15] = bfhi(x1.w);
        float s = 0.f;
#pragma unroll
        for (int t = 0; t < 16; ++t) s += f[t];
        const float mean = wave_sum(s) * (1.0f / 1024.0f); float s2 = 0.f;
#pragma unroll
        for (int t = 0; t < 16; ++t) { const float d = f[t] - mean; s2 += d * d; }
        const float rstd = 1.0f / sqrtf(wave_sum(s2) * (1.0f / 1024.0f) + EPS);
        if (lane == 0) { stat[2 * q] = mean; stat[2 * q + 1] = rstd; } }
    __syncthreads();
    for (int g = 0; g < 8; ++g) {
#pragma unroll
        for (int i = 0; i < 4; ++i) { const int idx = F.tid + 512 * i, p = idx >> 4, c8 = (idx & 15) << 3;
            *(LAS v4u*)(WSl + p * 136 + c8) = *(const GAS v4u*)(WSB + ((size_t)((j * 8 + g) * 128 + p)) * 128 + c8);
            const v4u raw = *(const GAS v4u*)(V + (size_t)(r0 + p) * 1024 + g * 128 + c8); const float mean = stat[2 * p], rstd = stat[2 * p + 1];
            const f32x4 ga = *(const GAS f32x4*)(lng + g * 128 + c8), gb = *(const GAS f32x4*)(lng + g * 128 + c8 + 4), ba = *(const GAS f32x4*)(lnb + g * 128 + c8), bb = *(const GAS f32x4*)(lnb + g * 128 + c8 + 4);
            float y[8];
            y[0] = (bflo(raw.x) - mean) * rstd * ga.x + ba.x; y[1] = (bfhi(raw.x) - mean) * rstd * ga.y + ba.y; y[2] = (bflo(raw.y) - mean) * rstd * ga.z + ba.z; y[3] = (bfhi(raw.y) - mean) * rstd * ga.w + ba.w;
            y[4] = (bflo(raw.z) - mean) * rstd * gb.x + bb.x; y[5] = (bfhi(raw.z) - mean) * rstd * gb.y + bb.y; y[6] = (bflo(raw.w) - mean) * rstd * gb.z + bb.z; y[7] = (bfhi(raw.w) - mean) * rstd * gb.w + bb.w;
#pragma unroll
            for (int e = 0; e < 8; ++e) VT[(c8 + e) * 136 + p] = (bf16)(pkbf(y[e], 0.f) & 0xffffu); }
        __syncthreads();
        f32x4 acc[8];
#pragma unroll
        for (int nt = 0; nt < 8; ++nt) acc[nt] = (f32x4){0.f, 0.f, 0.f, 0.f};
#pragma unroll
        for (int ks = 0; ks < 4; ++ks) { const bf16x8 af = *(const LAS bf16x8*)(WSl + (16 * w + (lane & 15)) * 136 + 32 * ks + 8 * (lane >> 4));
#pragma unroll
            for (int nt = 0; nt < 8; ++nt) { const bf16x8 bfr = *(const LAS bf16x8*)(VT + (16 * nt + (lane & 15)) * 136 + 32 * ks + 8 * (lane >> 4));
                acc[nt] = __builtin_amdgcn_mfma_f32_16x16x32_bf16(bfr, af, acc[nt], 0, 0, 0); } }
        const int p = 16 * w + (lane & 15); const float bsv = bs[g * 128 + p];
#pragma unroll
        for (int nt = 0; nt < 8; ++nt) { const int c = g * 128 + 16 * nt + 4 * (lane >> 4); const v2u uu = *(const GAS v2u*)(U + (size_t)(r0 + p) * 1024 + c);
            v2u o; o.x = pkbf(bflo(uu.x) * (acc[nt][0] + bsv), bfhi(uu.x) * (acc[nt][1] + bsv)); o.y = pkbf(bflo(uu.y) * (acc[nt][2] + bsv), bfhi(uu.y) * (acc[nt][3] + bsv));
            *(GAS v2u*)(YAB + (size_t)(r0 + p) * 2048 + c) = o; }
        __syncthreads();
    }
}
__device__ __forceinline__ void conv_units(const Args& a, Frame& F, int j, int u_begin, int u_step, int nunits) {
    const bf16* G = (const bf16*)(a.ws + WS_G); bf16* YAB = (bf16*)(a.ws + WS_YAB);
    LAS float* part = (LAS float*)(F.lds + 73728);
    const int ch = 2 * F.tid;
    float wk[31][2];
#pragma unroll
    for (int k = 0; k < 31; ++k) { const float2 t = *(const float2*)(a.in[13] + (size_t)(j * 31 + k) * 1024 + ch); wk[k][0] = t.x; wk[k][1] = t.y; }
    const float2 cb = *(const float2*)(a.in[14] + j * 1024 + ch), cg = *(const float2*)(a.in[15] + j * 1024 + ch);
    for (int u = u_begin; u < nunits; u += u_step) {
        const int r0 = u * 8;
        int lo, hi; if (r0 < ML) { lo = r0 & ~2047; hi = lo + 2048; } else { lo = ML + ((r0 - ML) & ~255); hi = lo + 256; }
        float acc[8][2];
#pragma unroll
        for (int t = 0; t < 8; ++t) { acc[t][0] = cb.x; acc[t][1] = cb.y; }
#pragma unroll
        for (int ri = 0; ri < 38; ++ri) { const int row = r0 - 15 + ri; float x0 = 0.f, x1 = 0.f;
            if (row >= lo && row < hi) { const unsigned wv = *(const GAS unsigned*)(G + (size_t)row * 1024 + ch); x0 = bflo(wv); x1 = bfhi(wv); }
#pragma unroll
            for (int t = 0; t < 8; ++t) { const int k = ri - t; if (k >= 0 && k <= 30) { acc[t][0] += x0 * wk[k][0]; acc[t][1] += x1 * wk[k][1]; } } }
#pragma unroll
        for (int t = 0; t < 8; ++t) { const float s = wave_sum(acc[t][0] * acc[t][0] + acc[t][1] * acc[t][1]); if (F.lane == 0) part[F.wave * 8 + t] = s; }
        __syncthreads();
#pragma unroll
        for (int t = 0; t < 8; ++t) { float s = 0.f;
#pragma unroll
            for (int w = 0; w < 8; ++w) s += part[w * 8 + t];
            const float r = 1.0f / sqrtf(s * (1.0f / 1024.0f) + EPS); const float y0 = acc[t][0] * r * cg.x, y1 = acc[t][1] * r * cg.y;
            *(GAS unsigned*)(YAB + (size_t)(r0 + t) * 2048 + 1024 + ch) = pkbf(y0 * fsigm(y0), y1 * fsigm(y1)); }
        __syncthreads();
    }
}
__device__ __forceinline__ void mix_phase(const Args& a, Frame& F, int j) {
    for (int n = F.bid; n < 144; n += F.G) gate_unit(a, F, j, n);
    __syncthreads();
    const int nfree = (F.G > 144) ? F.G - 144 : 0;
    if (nfree > 0) { const int shares = 144 + 3 * nfree; int ub, cnt; if (F.bid < 144) { ub = F.bid; cnt = 1; } else { ub = 144 + 3 * (F.bid - 144); cnt = 3; }
        for (int s = 0; s < cnt; ++s) conv_units(a, F, j, ub + s, shares, 2304); }
    else conv_units(a, F, j, F.bid, F.G, 2304);
}

__device__ __forceinline__ void qkrope_phase(const Args& a, Frame& F, int jm, int nrows) {
    const int gw = F.bid * NWAVES + F.wave, NGW = F.G * NWAVES, lane = F.lane;
    const bf16* QKV = (const bf16*)(a.ws + WS_QKV); bf16* Q = (bf16*)(a.ws + WS_Q); bf16* Kb = (bf16*)(a.ws + WS_K); const float* ROPE = (const float*)(a.ws + WS_ROPE);
    const float* qg = a.in[18] + jm * 64; const float* kg = a.in[19] + jm * 64; const int sub = lane & 15;
    float gq[4], gk[4];
#pragma unroll
    for (int k = 0; k < 4; ++k) { gq[k] = qg[sub + 16 * k]; gk[k] = kg[sub + 16 * k]; }
    for (int row = gw; row < nrows; row += NGW) {
        const bool lat = row < ML; float cr = 1.f, sr = 0.f, cc = 1.f, sc = 0.f;
        if (lat) { const int t = row & 2047, pr = t >> 6, pc = t & 63; const float2 a0 = *(const float2*)(ROPE + (pr * 16 + sub) * 2), a1 = *(const float2*)(ROPE + (pc * 16 + sub) * 2); cr = a0.x; sr = a0.y; cc = a1.x; sc = a1.y; }
#pragma unroll
        for (int hg = 0; hg < 5; ++hg) { const int head = 4 * hg + (lane >> 4); const bf16* src = QKV + (size_t)row * 1536 + head * 64 + sub;
            float x[4];
#pragma unroll
            for (int k = 0; k < 4; ++k) x[k] = bf2f(src[16 * k]);
            float ss = (x[0] * x[0] + x[1] * x[1]) + (x[2] * x[2] + x[3] * x[3]);
            ss += __shfl_xor(ss, 1); ss += __shfl_xor(ss, 2); ss += __shfl_xor(ss, 4); ss += __shfl_xor(ss, 8);
            const float r = 1.0f / sqrtf(ss * (1.0f / 64.0f) + EPS);
            float y[4];
#pragma unroll
            for (int k = 0; k < 4; ++k) y[k] = x[k] * r * (hg < 4 ? gq[k] : gk[k]);
            float o[4]; o[0] = y[0] * cr - y[1] * sr; o[1] = y[1] * cr + y[0] * sr; o[2] = y[2] * cc - y[3] * sc; o[3] = y[3] * cc + y[2] * sc;
            if (hg < 4) { bf16* d = Q + (size_t)row * 1024 + head * 64 + sub;
#pragma unroll
                for (int k = 0; k < 4; ++k) d[16 * k] = (bf16)(pkbf(o[k] * QSCALE, 0.f) & 0xffffu); }
            else { bf16* d = Kb + (size_t)row * 256 + (head - 16) * 64 + sub;
#pragma unroll
                for (int k = 0; k < 4; ++k) d[16 * k] = (bf16)(pkbf(o[k], 0.f) & 0xffffu); } }
    }
}
__device__ __forceinline__ void attn_phase(const Args& a, Frame& F, int jm, int nunits) {
    typedef short s16x4 __attribute__((ext_vector_type(4)));
    const bf16* Q = (const bf16*)(a.ws + WS_Q); const bf16* Kb = (const bf16*)(a.ws + WS_K); const bf16* QKV = (const bf16*)(a.ws + WS_QKV); bf16* O = (bf16*)(a.ws + WS_O);
    LAS bf16* Kt = (LAS bf16*)F.lds;
    LAS bf16* VT = (LAS bf16*)(F.lds + 9216);
    const int lane = F.lane, w = F.wave, li15 = lane & 15, lq = lane >> 4;
    for (int ui = F.bid; ui < nunits; ui += F.G) {
        int b, hq, q0, qrow0, t_lo, t_hi;
        if (ui < 2048) { b = ui >> 8; hq = (ui >> 4) & 15; q0 = (ui & 15) * 128; qrow0 = b * 2048 + q0; t_lo = 0; t_hi = 10; }
        else { const int v = ui - 2048; b = v >> 5; hq = (v >> 1) & 15; q0 = (v & 1) * 128; qrow0 = ML + b * 256 + q0; t_lo = 6; t_hi = 10; }
        const int kvh = hq >> 2;
        const bf16* qp = Q + (size_t)(qrow0 + 16 * w + li15) * 1024 + hq * 64 + 8 * lq;
        const bf16x8 qf0 = *(const GAS bf16x8*)qp, qf1 = *(const GAS bf16x8*)(qp + 32);
        float m = a.in[20][jm * 16 + hq] * LOG2E, l = (lq == 0) ? 1.0f : 0.0f;
        f32x4 o[4];
#pragma unroll
        for (int dt = 0; dt < 4; ++dt) o[dt] = (f32x4){0.f, 0.f, 0.f, 0.f};
        const int qpos = q0 + 16 * w + li15;
        for (int tt = t_lo; tt < t_hi; ++tt) {
            int krow0; bool win = tt < 6; int kpos0 = 0;
            if (win) { kpos0 = q0 - 128 + 64 * tt; if (kpos0 < 0 || kpos0 >= 2048) continue; krow0 = b * 2048 + kpos0; }
            else krow0 = ML + b * 256 + 64 * (tt - 6);
            __syncthreads();
            { const int key = F.tid >> 3, d8 = (F.tid & 7) << 3;
              const v4u kv = *(const GAS v4u*)(Kb + (size_t)(krow0 + key) * 256 + kvh * 64 + d8); *(LAS v4u*)(Kt + key * 72 + d8) = kv;
              const v4u vv = *(const GAS v4u*)(QKV + (size_t)(krow0 + key) * 1536 + 1280 + kvh * 64 + d8);
              VT[(d8 + 0) * 72 + key] = (bf16)(vv.x & 0xffffu); VT[(d8 + 1) * 72 + key] = (bf16)(vv.x >> 16); VT[(d8 + 2) * 72 + key] = (bf16)(vv.y & 0xffffu); VT[(d8 + 3) * 72 + key] = (bf16)(vv.y >> 16);
              VT[(d8 + 4) * 72 + key] = (bf16)(vv.z & 0xffffu); VT[(d8 + 5) * 72 + key] = (bf16)(vv.z >> 16); VT[(d8 + 6) * 72 + key] = (bf16)(vv.w & 0xffffu); VT[(d8 + 7) * 72 + key] = (bf16)(vv.w >> 16); }
            __syncthreads();
            f32x4 s[4];
#pragma unroll
            for (int kt = 0; kt < 4; ++kt) { const LAS bf16* kp = Kt + (16 * kt + li15) * 72 + 8 * lq;
                s[kt] = __builtin_amdgcn_mfma_f32_16x16x32_bf16(*(const LAS bf16x8*)kp, qf0, (f32x4){0.f, 0.f, 0.f, 0.f}, 0, 0, 0);
                s[kt] = __builtin_amdgcn_mfma_f32_16x16x32_bf16(*(const LAS bf16x8*)(kp + 32), qf1, s[kt], 0, 0, 0); }
            if (win) {
#pragma unroll
                for (int kt = 0; kt < 4; ++kt)
#pragma unroll
                    for (int jj = 0; jj < 4; ++jj) { const int dlt = qpos - (kpos0 + 16 * kt + 4 * lq + jj); if (dlt > 128 || dlt < -128) s[kt][jj] = -INFINITY; }
            }
            float tm = fmaxf(fmaxf(s[0][0], s[0][1]), fmaxf(s[0][2], s[0][3]));
#pragma unroll
            for (int kt = 1; kt < 4; ++kt) tm = fmaxf(tm, fmaxf(fmaxf(s[kt][0], s[kt][1]), fmaxf(s[kt][2], s[kt][3])));
            tm = fmaxf(tm, __shfl_xor(tm, 16)); tm = fmaxf(tm, __shfl_xor(tm, 32));
            const float mn = fmaxf(m, tm), alpha = __builtin_amdgcn_exp2f(m - mn); m = mn;
            float ls = 0.f;
#pragma unroll
            for (int kt = 0; kt < 4; ++kt)
#pragma unroll
                for (int jj = 0; jj < 4; ++jj) { const float p = __builtin_amdgcn_exp2f(s[kt][jj] - mn); s[kt][jj] = p; ls += p; }
            l = l * alpha + ls;
#pragma unroll
            for (int dt = 0; dt < 4; ++dt) o[dt] = o[dt] * alpha;
#pragma unroll
            for (int s2 = 0; s2 < 2; ++s2) {
                v4u pw; pw.x = pkbf(s[2 * s2][0], s[2 * s2][1]); pw.y = pkbf(s[2 * s2][2], s[2 * s2][3]); pw.z = pkbf(s[2 * s2 + 1][0], s[2 * s2 + 1][1]); pw.w = pkbf(s[2 * s2 + 1][2], s[2 * s2 + 1][3]);
                const bf16x8 pb = __builtin_bit_cast(bf16x8, pw);
#pragma unroll
                for (int dt = 0; dt < 4; ++dt) { const LAS bf16* vp = VT + (16 * dt + li15) * 72 + 32 * s2 + 4 * lq;
                    const s16x4 lo = *(const LAS s16x4*)vp, hi = *(const LAS s16x4*)(vp + 16);
                    const bf16x8 af = __builtin_shufflevector(lo, hi, 0, 1, 2, 3, 4, 5, 6, 7);
                    o[dt] = __builtin_amdgcn_mfma_f32_16x16x32_bf16(af, pb, o[dt], 0, 0, 0); } }
        }
        l += __shfl_xor(l, 16); l += __shfl_xor(l, 32);
        const float inv = 1.0f / l;
        bf16* op = O + (size_t)(qrow0 + 16 * w + li15) * 1024 + hq * 64 + 4 * lq;
#pragma unroll
        for (int dt = 0; dt < 4; ++dt) { v2u ov; ov.x = pkbf(o[dt][0] * inv, o[dt][1] * inv); ov.y = pkbf(o[dt][2] * inv, o[dt][3] * inv); *(GAS v2u*)(op + 16 * dt) = ov; }
    }
}
__device__ __forceinline__ void final_phase(const Args& a, Frame& F) {
    const int gw = F.bid * NWAVES + F.wave, NGW = F.G * NWAVES, lane = F.lane;
    const float* X = (const float*)(a.ws + WS_X); const bf16* YS = (const bf16*)(a.ws + WS_YS); const float* MOD = (const float*)(a.ws + WS_MOD);
    for (int row = gw; row < ML; row += NGW) {
        const float* g2p = MOD + (size_t)(3 * 9 + (row >> 11)) * 6144 + 5 * 1024; const bf16* ys = YS + (size_t)row * 2048;
#pragma unroll
        for (int j = 0; j < 4; ++j) { f32x4 v = *(const GAS f32x4*)(X + (size_t)row * 1024 + 4 * lane + 256 * j);
            const v2u y0 = *(const GAS v2u*)(ys + 4 * lane + 256 * j), y1 = *(const GAS v2u*)(ys + 1024 + 4 * lane + 256 * j); const f32x4 g = *(const GAS f32x4*)(g2p + 4 * lane + 256 * j);
            v.x += g.x * (bflo(y0.x) + bflo(y1.x)); v.y += g.y * (bfhi(y0.x) + bfhi(y1.x)); v.z += g.z * (bflo(y0.y) + bflo(y1.y)); v.w += g.w * (bfhi(y0.y) + bfhi(y1.y));
            *(GAS f32x4*)(a.out + (size_t)row * 1024 + 4 * lane + 256 * j) = v; }
    }
}

__global__ void __launch_bounds__(NWAVES * 64, 2) mk_fwd(Args args) {
    extern __shared__ __attribute__((aligned(16))) unsigned char lds[];
    Frame F;
    F.lds = (LAS unsigned char*)lds; F.MISC = (volatile LAS unsigned*)(F.lds + MISC_OFF);
    F.tid = threadIdx.x; F.lane = F.tid & 63; F.wave = __builtin_amdgcn_readfirstlane(F.tid >> 6); F.G = gridDim.x; F.bid = blockIdx.x;
    F.ctl = (gu32*)(args.ws + WS_CTL);
    for (int u = F.tid; u < (LDS_BYTES - LDSCTL_OFF) / 4; u += NWAVES * 64) ((LAS unsigned*)(F.lds + LDSCTL_OFF))[u] = 0u;
    __syncthreads();
    XcdBarrier bar; bar.bar = (unsigned*)(F.ctl + CW_BAR); bar.x = 0; bar.st = nullptr;
    if (!MK_PER_PHASE) bar = xcd_barrier_post((unsigned*)(F.ctl + CW_BAR), F.MISC + 8);
#define GRID_BAR() do { if (!MK_PER_PHASE) xcd_barrier(bar); } while (0)
    const int lo = args.ph_lo, hi = args.ph_hi;
#define IN(k) (lo <= (k) && (k) < hi)
#define BOTH(k) (IN(k) && IN((k) + 1))
#ifndef MK_MASK
#define MK_MASK 0xFFFFFFFFu
#endif
#define EN(b) (((MK_MASK) >> (b)) & 1u)
#define FRESH() do { int t_ = threadIdx.x, b_ = blockIdx.x; asm volatile("" : "+v"(t_)); asm volatile("" : "+s"(b_)); F.tid = t_; F.lane = t_ & 63; F.wave = __builtin_amdgcn_readfirstlane(t_ >> 6); F.bid = b_; } while (0)
    unsigned char* ws = args.ws;
    float* X = (float*)(ws + WS_X); const float* MOD = (const float*)(ws + WS_MOD); bf16* H = (bf16*)(ws + WS_H);

    if (EN(0) && IN(0)) { FRESH(); prologue_phase(args, F); if (BOTH(0)) GRID_BAR(); }

#pragma unroll
    for (int jp = 0; jp < 2; ++jp) {
        const int pb = 1 + 16 * jp, le = 2 * jp, lo_ = 2 * jp + 1;
        const int rows_tail = (jp == 1) ? ML : MT;
        if (EN(1) && IN(pb + 0)) { FRESH(); if (jp == 1) conv_moe_all(args, F, 1);
            norm_phase(args, F, le, 0, MT, jp == 0, jp == 1 ? 1 : -1); if (BOTH(pb + 0)) GRID_BAR(); }
        if (EN(2) && IN(pb + 1)) { FRESH(); pg8::Gemm g{H, (const bf16*)(ws + WS_WIN) + (size_t)jp * 4096 * 1024, MT, 4096, 1024}; pg8::StaticOrder S; S.init(MT, 4096, F.G, F.bid);
            pg8::EpiWin E{(bf16*)(ws + WS_U), (bf16*)(ws + WS_V), (bf16*)(ws + WS_G)};
            pg8::gemm_phase<pg8::EpiWin, pg8::StaticOrder, true, true>(F.lds + RING_OFF, g, S, E); if (BOTH(pb + 1)) GRID_BAR(); }
        if (EN(3) && IN(pb + 2)) { FRESH(); mix_phase(args, F, jp); if (BOTH(pb + 2)) GRID_BAR(); }
        if (EN(4) && IN(pb + 3)) { FRESH(); pg8::Gemm g{(const bf16*)(ws + WS_YAB), (const bf16*)(ws + WS_WOUT) + (size_t)jp * 1024 * 2048, MT, 1024, 2048}; pg8::StaticOrder S; S.init(MT, 1024, F.G, F.bid);
            pg8::EpiResid E{X, MOD + (size_t)(le * 9) * 6144 + 2 * 1024};
            pg8::gemm_phase<pg8::EpiResid, pg8::StaticOrder, true, true>(F.lds + RING_OFF, g, S, E); if (BOTH(pb + 3)) GRID_BAR(); }
        if (EN(5) && IN(pb + 4)) { FRESH(); norm_phase(args, F, le, 1, MT, false, -1); if (BOTH(pb + 4)) GRID_BAR(); }
        if (EN(6) && IN(pb + 5)) { FRESH(); pg8::Gemm g{H, (const bf16*)(ws + WS_FF13) + (size_t)jp * 7168 * 1024, MT, 7168, 1024}; pg8::StaticOrder S; S.init(MT, 7168, F.G, F.bid);
            pg8::EpiSwiGLU E{(bf16*)(ws + WS_T), FF};
            pg8::gemm_phase<pg8::EpiSwiGLU, pg8::StaticOrder, true, true>(F.lds + RING_OFF, g, S, E); if (BOTH(pb + 5)) GRID_BAR(); }
        if (EN(7) && IN(pb + 6)) { FRESH(); pg8::Gemm g{(const bf16*)(ws + WS_T), (const bf16*)(ws + WS_FF2) + (size_t)jp * 1024 * 3584, MT, 1024, FF}; pg8::StaticOrder S; S.init(MT, 1024, F.G, F.bid);
            pg8::EpiResid E{X, MOD + (size_t)(le * 9) * 6144 + 5 * 1024};
            pg8::gemm_phase<pg8::EpiResid, pg8::StaticOrder, true, true>(F.lds + RING_OFF, g, S, E); if (BOTH(pb + 6)) GRID_BAR(); }
        if (EN(8) && IN(pb + 7)) { FRESH(); norm_phase(args, F, lo_, 0, MT, false, -1); if (BOTH(pb + 7)) GRID_BAR(); }
        if (EN(9) && IN(pb + 8)) { FRESH(); pg8::Gemm g{H, (const bf16*)(ws + WS_WQKV) + (size_t)jp * 1536 * 1024, MT, 1536, 1024}; pg8::StaticOrder S; S.init(MT, 1536, F.G, F.bid);
            pg8::EpiBf16<0> E{(bf16*)(ws + WS_QKV), 1536, nullptr, 0, 0, 1.f};
            pg8::gemm_phase<pg8::EpiBf16<0>, pg8::StaticOrder, true, true>(F.lds + RING_OFF, g, S, E); if (BOTH(pb + 8)) GRID_BAR(); }
        if (EN(10) && IN(pb + 9)) { FRESH(); qkrope_phase(args, F, jp, MT); if (BOTH(pb + 9)) GRID_BAR(); }
        if (EN(11) && IN(pb + 10)) { FRESH(); attn_phase(args, F, jp, (jp == 1) ? 2048 : 2304); if (BOTH(pb + 10)) GRID_BAR(); }
        if (EN(12) && IN(pb + 11)) { FRESH(); pg8::Gemm g{(const bf16*)(ws + WS_O), (const bf16*)(ws + WS_WO) + (size_t)jp * 1024 * 1024, rows_tail, 1024, 1024}; pg8::StaticOrder S; S.init(rows_tail, 1024, F.G, F.bid);
            pg8::EpiResid E{X, MOD + (size_t)(lo_ * 9) * 6144 + 2 * 1024};
            pg8::gemm_phase<pg8::EpiResid, pg8::StaticOrder, true, true>(F.lds + RING_OFF, g, S, E); if (BOTH(pb + 11)) GRID_BAR(); }
        if (EN(13) && IN(pb + 12)) { FRESH(); norm_router_phase(args, F, lo_, rows_tail); if (BOTH(pb + 12)) GRID_BAR(); }
        if (EN(14) && IN(pb + 13)) { FRESH(); scatter_phase(args, F, jp, rows_tail); if (BOTH(pb + 13)) GRID_BAR(); }
        if (EN(15) && IN(pb + 14)) { FRESH(); MoeSeg sg; moe_seg(F, jp, sg); MoeOrder S;
#pragma unroll
            for (int q = 0; q < 9; ++q) S.pst[q] = sg.pst[q];
            S.nt = 28; S.G = F.G; S.c = F.bid;
            pg8::Gemm g{(const bf16*)(ws + WS_HP), (const bf16*)(ws + WS_MOE13), 0, 0, 1024};
            pg8::EpiSwiGLU E{(bf16*)(ws + WS_TP), FF};
            pg8::gemm_phase<pg8::EpiSwiGLU, MoeOrder, true, true>(F.lds + RING_OFF, g, S, E); if (BOTH(pb + 14)) GRID_BAR(); }
        if (EN(16) && IN(pb + 15)) { FRESH(); MoeSeg sg; moe_seg(F, jp, sg); MoeOrder S;
#pragma unroll
            for (int q = 0; q < 9; ++q) S.pst[q] = sg.pst[q];
            S.nt = 4; S.G = F.G; S.c = F.bid;
            pg8::Gemm g{(const bf16*)(ws + WS_TP), (const bf16*)(ws + WS_MOE2), 0, 0, FF};
            pg8::EpiMoeDown E{(bf16*)(ws + WS_YS), (const int*)(ws + WS_ROWMAP), (const float*)(ws + WS_ROWW)};
            pg8::gemm_phase<pg8::EpiMoeDown, MoeOrder, true, true>(F.lds + RING_OFF, g, S, E); if (BOTH(pb + 15)) GRID_BAR(); }
    }
    if (EN(17) && IN(33)) { FRESH(); final_phase(args, F); }
#undef IN
#undef BOTH
}

extern "C" void kernel_launch(void* const* d_in, const int* in_sizes, int n_in, void* d_out, int out_size, void* d_ws, size_t ws_size, hipStream_t stream) {
    static int grid = 0;
    if (grid == 0) {
        if (n_in != 29 || out_size != ML * D || ws_size < WS_END) { fprintf(stderr, "kernel_launch: unexpected shapes (n_in %d out %d ws %zu)\n", n_in, out_size, ws_size); grid = -1; return; }
        int dev = 0, cus = 0;
        if (hipGetDevice(&dev) != hipSuccess || hipDeviceGetAttribute(&cus, hipDeviceAttributeMultiprocessorCount, dev) != hipSuccess) { grid = -1; return; }
        if (hipFuncSetAttribute((const void*)mk_fwd, hipFuncAttributeMaxDynamicSharedMemorySize, LDS_BYTES) != hipSuccess) { grid = -1; return; }
        int per_cu = 0; (void)hipOccupancyMaxActiveBlocksPerMultiprocessor(&per_cu, (const void*)mk_fwd, NWAVES * 64, LDS_BYTES); (void)hipGetLastError();
        grid = cus;
    }
    if (grid < 0) return;
    (void)hipMemsetAsync((char*)d_ws + WS_CTL, 0, CTL_ZERO_BYTES, stream);
    Args a{};
    for (int i = 0; i < 29; ++i) a.in[i] = (const float*)d_in[i];
    a.out = (float*)d_out; a.ws = (unsigned char*)d_ws;
#if MK_PER_PHASE
    for (int p = 0; p < N_PHASES; ++p) { a.ph_lo = p; a.ph_hi = p + 1; hipLaunchKernelGGL(mk_fwd, dim3(grid), dim3(NWAVES * 64), LDS_BYTES, stream, a); }
#else
    a.ph_lo = 0; a.ph_hi = N_PHASES; hipLaunchKernelGGL(mk_fwd, dim3(grid), dim3(NWAVES * 64), LDS_BYTES, stream, a);
#endif
}
```

```cpp
#include <hip/hip_runtime.h>
#include <cstdio>
#include <cstdint>
namespace pg8 {
#define PG8_LAS __attribute__((address_space(3)))
typedef unsigned short bf16_t;
typedef short bf16x8 __attribute__((ext_vector_type(8)));
typedef float f32x4 __attribute__((ext_vector_type(4)));
typedef unsigned u32x4 __attribute__((ext_vector_type(4)));
typedef int v4i32 __attribute__((ext_vector_type(4)));
typedef int v8i32 __attribute__((ext_vector_type(8)));
constexpr int BM = 256, BK = 64, HALF = 128, HTB = HALF * BK * 2  , STAGE_BYTES = 8 * HTB, NXCD = 8, WGM = 8;

__host__ __device__ __forceinline__ int lds_byte(int r, int c) { const int st = (r >> 4) * 2 + (c >> 5), rr = r & 15, cc = c & 31, ob = rr * 64 + cc * 2; return st * 1024 + (ob ^ (((ob >> 9) & 1) << 5)); }
__host__ __device__ __forceinline__ void stage_rc(int b, int& R, int& C) { const int st = b / 1024, sb = b % 1024, swz = sb ^ (((sb >> 9) & 1) << 5); R = (st >> 1) * 16 + swz / 64; C = (st & 1) * 32 + (swz % 64) / 2; }
__host__ __device__ __forceinline__ int perm32(int rho) { const int n = rho >> 4, i = rho & 15; return 8 * (i >> 2) + 4 * n + (i & 3); }

struct Unit { int pm, pn, e, j, k0, nt, s, pa, pl, cn; };
struct Gemm { const bf16_t* A; const bf16_t* Bt; int M, N, K; };

struct StaticOrder {
    int nM, nN, nwg, G, c, ntk;
    __host__ __device__ void init(int M, int N, int K, int G_, int c_) { nM = M / BM; nN = N / BM; nwg = nM * nN; G = G_; c = c_; ntk = K / BK; }
    __host__ __device__ bool next(int i, Unit& u) const {
        const long L = (long)i * G + c; if (L >= nwg) return false;
        int wgid = (int)L; { const int q = nwg / NXCD, r = nwg % NXCD, xcd = wgid % NXCD, off = wgid / NXCD; wgid = (xcd < r ? xcd * (q + 1) : r * (q + 1) + (xcd - r) * q) + off; }
        const int nig = WGM * nN, gid = wgid / nig, fm = gid * WGM, gsz = (nM - fm) < WGM ? (nM - fm) : WGM;
        u.pm = fm + ((wgid % nig) % gsz); u.pn = (wgid % nig) / gsz; u.e = 0; u.j = u.pn; u.k0 = 0; u.nt = ntk; u.s = 0; u.pa = u.pm; u.pl = 0; u.cn = 0; return true;
    }
    __device__ __forceinline__ void a_ready(const Unit&) const {}
    __device__ __forceinline__ void done(const Unit&) const {}
};

__device__ __forceinline__ unsigned cvt_pk_bf16(float lo, float hi) { unsigned r; asm volatile("v_cvt_pk_bf16_f32 %0, %1, %2" : "=v"(r) : "v"(lo), "v"(hi)); return r; }
typedef float f32x2 __attribute__((ext_vector_type(2)));
__device__ __forceinline__ f32x2 gelu_pk(f32x2 v) {
    const f32x2 av = __builtin_elementwise_abs(v), d = av * 0.2316418882f + 1.0f;
    f32x2 t; t.x = __builtin_amdgcn_rcpf(d.x); t.y = __builtin_amdgcn_rcpf(d.y);
    f32x2 q = t * 0.5307027145f + (-0.7265760135f); q = q * t + 0.7107068705f; q = q * t + (-0.142248368f); q = q * t + 0.127414796f; q = q * t;
    const f32x2 s = (v * v) * (-0.72134752044f);
    f32x2 e; e.x = __builtin_amdgcn_exp2f(s.x); e.y = __builtin_amdgcn_exp2f(s.y);
    const f32x2 m = v * (q * e), r = v - m;
    f32x2 o; o.x = v.x < 0.f ? m.x : r.x; o.y = v.y < 0.f ? m.y : r.y; return o;
}

template <int ACT  > struct EpiBf16 {
    static constexpr bool PERM = true, AFTER_DRAIN = false; static_assert(ACT == 0 || ACT == 1, "EpiBf16: ACT is 0 (none) or 1 (gelu_pk)");
    bf16_t* O; int ldc; const float* bias; int split_cols; size_t split_stride; float scale0;
    __device__ __forceinline__ void operator()(const f32x4 (&acc)[2][2][4][2], const Unit& u, int wr, int wc, int fr, int fq) const {
        const int row0 = u.pm * BM + wr * 64 + fr; int colt = u.pn * BM; bf16_t* base = O;
        float sc = 1.f; if (split_cols) { const int t = colt / split_cols; base += (size_t)t * split_stride; colt -= t * split_cols; if (t == 0) sc = scale0; }
        const int col0 = colt + wc * 32 + 8 * fq, bcol0 = u.pn * BM + wc * 32 + 8 * fq;
        f32x4 bv[2][2];
#pragma unroll
        for (int bj = 0; bj < 2; ++bj)
#pragma unroll
            for (int n = 0; n < 2; ++n) bv[bj][n] = bias ? *(const f32x4*)(bias + bcol0 + bj * HALF + 4 * n) : (f32x4){0.f, 0.f, 0.f, 0.f};
#pragma unroll
        for (int ai = 0; ai < 2; ++ai)
#pragma unroll
            for (int m = 0; m < 4; ++m) { bf16_t* rowp = base + (size_t)(row0 + ai * HALF + m * 16) * ldc + col0;
#pragma unroll
                for (int bj = 0; bj < 2; ++bj) { f32x4 v0 = acc[ai][bj][m][0] + bv[bj][0], v1 = acc[ai][bj][m][1] + bv[bj][1];
                    if (ACT == 1) { f32x2 a = gelu_pk((f32x2){v0[0], v0[1]}), b = gelu_pk((f32x2){v0[2], v0[3]}), c = gelu_pk((f32x2){v1[0], v1[1]}), d = gelu_pk((f32x2){v1[2], v1[3]});
                        v0 = (f32x4){a.x, a.y, b.x, b.y}; v1 = (f32x4){c.x, c.y, d.x, d.y}; }
                    v0 = v0 * sc; v1 = v1 * sc; u32x4 w; w.x = cvt_pk_bf16(v0[0], v0[1]); w.y = cvt_pk_bf16(v0[2], v0[3]); w.z = cvt_pk_bf16(v1[0], v1[1]); w.w = cvt_pk_bf16(v1[2], v1[3]);
                    *(u32x4*)(rowp + bj * HALF) = w; } }
    }
};
__device__ __forceinline__ float sigm_f(float x) { return __builtin_amdgcn_rcpf(1.f + __builtin_amdgcn_exp2f(-1.4426950409f * x)); }
__device__ __forceinline__ float silu_f(float x) { return x * sigm_f(x); }
__device__ __forceinline__ f32x4 exp2_v(f32x4 x) { return (f32x4){__builtin_amdgcn_exp2f(x[0]), __builtin_amdgcn_exp2f(x[1]), __builtin_amdgcn_exp2f(x[2]), __builtin_amdgcn_exp2f(x[3])}; }
__device__ __forceinline__ f32x4 rcp_v(f32x4 x) { return (f32x4){__builtin_amdgcn_rcpf(x[0]), __builtin_amdgcn_rcpf(x[1]), __builtin_amdgcn_rcpf(x[2]), __builtin_amdgcn_rcpf(x[3])}; }
__device__ __forceinline__ f32x4 sigm_v(f32x4 x) { return rcp_v(1.f + exp2_v(x * -1.4426950409f)); }
__device__ __forceinline__ f32x4 swiglu_v(f32x4 a, f32x4 g, float sc) { const float k = 1.0f / (sc * sc); const f32x4 r = rcp_v(exp2_v(a * (-1.4426950409f * sc)) * k + k); return (a * g) * r; }
__device__ __forceinline__ f32x4 gelu_tanh_v(f32x4 x) { const f32x4 t = x * (x * x * (-2.3022082f * 0.044715f) + -2.3022082f); return x * rcp_v(1.f + exp2_v(t)); }
__device__ __forceinline__ float gelu_tanh_f(float x) { const float t = x * (1.f + 0.044715f * x * x); return x * __builtin_amdgcn_rcpf(1.f + __builtin_amdgcn_exp2f(-2.3022082f * t)); }

struct EpiWin {
    static constexpr bool PERM = true, AFTER_DRAIN = false;
    bf16_t *U, *V, *G; float* stats;
    __device__ __forceinline__ void operator()(const f32x4 (&acc)[2][2][4][2], const Unit& u, int wr, int wc, int fr, int fq) const {
        const int row0 = u.pm * BM + wr * 64 + fr;
        if (u.pn < 8) {
            bf16_t* base = (u.pn < 4) ? U : V; const int col0 = (u.pn & 3) * 256 + wc * 32 + 8 * fq;
#pragma unroll
            for (int ai = 0; ai < 2; ++ai)
#pragma unroll
                for (int m = 0; m < 4; ++m) { bf16_t* rowp = base + (size_t)(row0 + ai * HALF + m * 16) * 1024 + col0; f32x4 sv1 = (f32x4){0.f, 0.f, 0.f, 0.f}, sv2 = (f32x4){0.f, 0.f, 0.f, 0.f};
#pragma unroll
                    for (int bj = 0; bj < 2; ++bj) { const f32x4 g0 = gelu_tanh_v(acc[ai][bj][m][0]), g1 = gelu_tanh_v(acc[ai][bj][m][1]);
                        sv1 = sv1 + (g0 + g1); sv2 = sv2 + (g0 * g0 + g1 * g1);
                        u32x4 w; w.x = cvt_pk_bf16(g0[0], g0[1]); w.y = cvt_pk_bf16(g0[2], g0[3]); w.z = cvt_pk_bf16(g1[0], g1[1]); w.w = cvt_pk_bf16(g1[2], g1[3]);
                        *(u32x4*)(rowp + bj * HALF) = w; }
                    float s1 = (sv1[0] + sv1[1]) + (sv1[2] + sv1[3]), s2 = (sv2[0] + sv2[1]) + (sv2[2] + sv2[3]);
                    if (u.pn >= 4) { s1 += __shfl_xor(s1, 16); s1 += __shfl_xor(s1, 32); s2 += __shfl_xor(s2, 16); s2 += __shfl_xor(s2, 32);
                        if (fq == 0) { f32x2 sv; sv.x = s1; sv.y = s2; *(f32x2*)(stats + (size_t)(row0 + ai * HALF + m * 16) * 32 + ((u.pn - 4) * 4 + wc) * 2) = sv; } } }
        } else {
            const int col0 = (u.pn - 8) * 128 + wc * 32 + 8 * fq;
#pragma unroll
            for (int ai = 0; ai < 2; ++ai)
#pragma unroll
                for (int m = 0; m < 4; ++m) { bf16_t* rowp = G + (size_t)(row0 + ai * HALF + m * 16) * 1024 + col0;
                    const f32x4 a0 = acc[ai][0][m][0], a1 = acc[ai][0][m][1], g0 = acc[ai][1][m][0], g1 = acc[ai][1][m][1]; u32x4 w;
                    const f32x4 y0 = a0 * sigm_v(g0), y1 = a1 * sigm_v(g1);
                    w.x = cvt_pk_bf16(y0[0], y0[1]); w.y = cvt_pk_bf16(y0[2], y0[3]); w.z = cvt_pk_bf16(y1[0], y1[1]); w.w = cvt_pk_bf16(y1[2], y1[3]);
                    *(u32x4*)rowp = w; }
        }
    }
};
struct EpiSwiGLU {
    static constexpr bool PERM = true, AFTER_DRAIN = false;
    bf16_t* T; int ldc; float gmul;
    __device__ __forceinline__ void operator()(const f32x4 (&acc)[2][2][4][2], const Unit& u, int wr, int wc, int fr, int fq) const {
#ifdef MK_SKIP_EPI
        if (gmul == 0.f) return;
#endif
        const int row0 = u.pm * BM + wr * 64 + fr; const int col0 = u.j * 128 + wc * 32 + 8 * fq;
#pragma unroll
        for (int ai = 0; ai < 2; ++ai)
#pragma unroll
            for (int m = 0; m < 4; ++m) { bf16_t* rowp = T + (size_t)(row0 + ai * HALF + m * 16) * ldc + col0;
                const f32x4 a0 = acc[ai][0][m][0], a1 = acc[ai][0][m][1], g0 = acc[ai][1][m][0], g1 = acc[ai][1][m][1]; u32x4 w;
                const f32x4 y0 = swiglu_v(a0, g0, 1.0f), y1 = swiglu_v(a1, g1, 1.0f);
                w.x = cvt_pk_bf16(y0[0], y0[1]); w.y = cvt_pk_bf16(y0[2], y0[3]); w.z = cvt_pk_bf16(y1[0], y1[1]); w.w = cvt_pk_bf16(y1[2], y1[3]);
                *(u32x4*)rowp = w; }
    }
};
struct EpiSwiGLU8 {
    static constexpr bool PERM = true, AFTER_DRAIN = false;
    unsigned char* T; int ldc; float isc;
    __device__ __forceinline__ void operator()(const f32x4 (&acc)[2][2][4][2], const Unit& u, int wr, int wc, int fr, int fq) const {
        const int row0 = u.pm * BM + wr * 64 + fr; const int col0 = u.j * 128 + wc * 32 + 8 * fq;
#pragma unroll
        for (int ai = 0; ai < 2; ++ai)
#pragma unroll
            for (int m = 0; m < 4; ++m) { unsigned char* rowp = T + (size_t)(row0 + ai * HALF + m * 16) * ldc + col0;
                const f32x4 y0 = swiglu_v(acc[ai][0][m][0], acc[ai][1][m][0], isc), y1 = swiglu_v(acc[ai][0][m][1], acc[ai][1][m][1], isc);
                int p0 = 0, p1 = 0;
                p0 = __builtin_amdgcn_cvt_pk_fp8_f32(y0[0], y0[1], p0, false); p0 = __builtin_amdgcn_cvt_pk_fp8_f32(y0[2], y0[3], p0, true);
                p1 = __builtin_amdgcn_cvt_pk_fp8_f32(y1[0], y1[1], p1, false); p1 = __builtin_amdgcn_cvt_pk_fp8_f32(y1[2], y1[3], p1, true);
                *(unsigned long long*)rowp = (unsigned long long)(unsigned)p0 | ((unsigned long long)(unsigned)p1 << 32); }
    }
};
struct EpiResid {
    static constexpr bool PERM = true, AFTER_DRAIN = false;
    bf16_t* X; const float* gate; float* PB; int rs0; float gmul; float psc = 1.0f;
    __device__ __forceinline__ void operator()(const f32x4 (&acc)[2][2][4][2], const Unit& u, int wr, int wc, int fr, int fq) const {
        const int col0 = u.pn * BM + wc * 32 + 8 * fq;
        if (u.e == 0) {
            const int mr = (u.pm < 64) ? (u.pm >> 3) : 8; const float* gp = gate + (size_t)mr * 6144;
            f32x4 gv[2][2];
#pragma unroll
            for (int bj = 0; bj < 2; ++bj)
#pragma unroll
                for (int n = 0; n < 2; ++n) gv[bj][n] = *(const f32x4*)(gp + col0 + bj * HALF + 4 * n) * gmul;
#pragma unroll
            for (int ai = 0; ai < 2; ++ai) { bf16_t* xb = X + (size_t)(u.pm * BM + ai * HALF + wr * 64 + fr) * 1024 + col0; u32x4 xv[4][2];
#pragma unroll
                for (int m = 0; m < 4; ++m)
#pragma unroll
                    for (int bj = 0; bj < 2; ++bj) xv[m][bj] = *(const u32x4*)(xb + (size_t)m * 16 * 1024 + bj * HALF);
                asm volatile("" ::: "memory");
#pragma unroll
                for (int m = 0; m < 4; ++m)
#pragma unroll
                    for (int bj = 0; bj < 2; ++bj) { const u32x4 x = xv[m][bj]; const f32x4 a0 = acc[ai][bj][m][0] * gv[bj][0], a1 = acc[ai][bj][m][1] * gv[bj][1]; u32x4 w;
                        w.x = cvt_pk_bf16(__uint_as_float(x.x << 16) + a0[0], __uint_as_float(x.x & 0xffff0000u) + a0[1]); w.y = cvt_pk_bf16(__uint_as_float(x.y << 16) + a0[2], __uint_as_float(x.y & 0xffff0000u) + a0[3]);
                        w.z = cvt_pk_bf16(__uint_as_float(x.z << 16) + a1[0], __uint_as_float(x.z & 0xffff0000u) + a1[1]); w.w = cvt_pk_bf16(__uint_as_float(x.w << 16) + a1[2], __uint_as_float(x.w & 0xffff0000u) + a1[3]);
                        *(u32x4*)(xb + (size_t)m * 16 * 1024 + bj * HALF) = w; }
                asm volatile("" ::: "memory"); }
        } else {
            bf16_t* pb = (bf16_t*)PB + (size_t)(u.e - 1) * 2048 * 1024;
#pragma unroll
            for (int ai = 0; ai < 2; ++ai)
#pragma unroll
                for (int m = 0; m < 4; ++m) { bf16_t* xp = pb + (size_t)(u.pm * BM + ai * HALF + wr * 64 + m * 16 + fr - rs0) * 1024 + col0;
#pragma unroll
                    for (int bj = 0; bj < 2; ++bj) { const f32x4 v0 = acc[ai][bj][m][0] * psc, v1 = acc[ai][bj][m][1] * psc; u32x4 w; w.x = cvt_pk_bf16(v0[0], v0[1]); w.y = cvt_pk_bf16(v0[2], v0[3]); w.z = cvt_pk_bf16(v1[0], v1[1]); w.w = cvt_pk_bf16(v1[2], v1[3]);
                        *(u32x4*)(xp + bj * HALF) = w; } }
        }
    }
};
struct EpiMoeDown {
    static constexpr bool PERM = true, AFTER_DRAIN = false;
    bf16_t* YS; const int* toklist; const float* tokwt; int cap; bf16_t* PB; int ps0, psrows; float osc;
    __device__ __forceinline__ void operator()(const f32x4 (&acc)[2][2][4][2], const Unit& u, int wr, int wc, int fr, int fq) const {
        const int col0 = u.j * BM + wc * 32 + 8 * fq;
        if (u.s > 0) {
#pragma unroll
            for (int ai = 0; ai < 2; ++ai)
#pragma unroll
                for (int m = 0; m < 4; ++m) { const int prow = u.pm * BM + ai * HALF + wr * 64 + m * 16 + fr; bf16_t* pp = PB + ((size_t)(u.s - 1) * psrows + (size_t)(prow - ps0)) * 1024 + col0;
#pragma unroll
                    for (int bj = 0; bj < 2; ++bj) { const f32x4 v0 = acc[ai][bj][m][0] * osc, v1 = acc[ai][bj][m][1] * osc; u32x4 w; w.x = cvt_pk_bf16(v0[0], v0[1]); w.y = cvt_pk_bf16(v0[2], v0[3]); w.z = cvt_pk_bf16(v1[0], v1[1]); w.w = cvt_pk_bf16(v1[2], v1[3]);
                        *(u32x4*)(pp + bj * HALF) = w; } }
            return; }
        int tsv[2][4]; float wv[2][4];
#pragma unroll
        for (int ai = 0; ai < 2; ++ai)
#pragma unroll
            for (int m = 0; m < 4; ++m) { const int pos = u.pl * BM + ai * HALF + wr * 64 + m * 16 + fr; const int tl = toklist[u.e * cap + pos]; wv[ai][m] = tokwt[u.e * cap + pos]; tsv[ai][m] = (pos < u.cn) ? tl : -1; }
        asm volatile("" ::: "memory");
#pragma unroll
        for (int ai = 0; ai < 2; ++ai)
#pragma unroll
            for (int m = 0; m < 4; ++m) { const int ts = tsv[ai][m]; const float w = wv[ai][m] * osc;
                if (ts >= 0) { bf16_t* yp = YS + (size_t)ts * 1024 + col0;
#pragma unroll
                    for (int bj = 0; bj < 2; ++bj) { const f32x4 v0 = acc[ai][bj][m][0] * w, v1 = acc[ai][bj][m][1] * w; u32x4 o; o.x = cvt_pk_bf16(v0[0], v0[1]); o.y = cvt_pk_bf16(v0[2], v0[3]); o.z = cvt_pk_bf16(v1[0], v1[1]); o.w = cvt_pk_bf16(v1[2], v1[3]);
                        *(u32x4*)(yp + bj * HALF) = o; } } }
    }
};
struct EpiQKV {
    static constexpr bool PERM = true, AFTER_DRAIN = false;
    bf16_t *Q, *K, *V; const float *qg, *kg, *rope; int nlat; float qsc, eps;
    __device__ __forceinline__ void operator()(const f32x4 (&acc)[2][2][4][2], const Unit& u, int wr, int wc, int fr, int fq) const {
        const int row0 = u.pm * BM + wr * 64 + fr;
        if (u.pn == 5) {
#pragma unroll
            for (int ai = 0; ai < 2; ++ai)
#pragma unroll
                for (int m = 0; m < 4; ++m) { bf16_t* rowp = V + (size_t)(row0 + ai * HALF + m * 16) * 256 + wc * 32 + 8 * fq;
#pragma unroll
                    for (int bj = 0; bj < 2; ++bj) { const f32x4 v0 = acc[ai][bj][m][0], v1 = acc[ai][bj][m][1]; u32x4 w; w.x = cvt_pk_bf16(v0[0], v0[1]); w.y = cvt_pk_bf16(v0[2], v0[3]); w.z = cvt_pk_bf16(v1[0], v1[1]); w.w = cvt_pk_bf16(v1[2], v1[3]);
                        *(u32x4*)(rowp + bj * HALF) = w; } }
        } else {
            const bool isq = u.pn < 4; const float* gp = isq ? qg : kg; const float osc = isq ? qsc : 1.0f;
            f32x4 gv[2][2];
#pragma unroll
            for (int bj = 0; bj < 2; ++bj)
#pragma unroll
                for (int n = 0; n < 2; ++n) gv[bj][n] = *(const f32x4*)(gp + 32 * bj + 16 * n + 4 * fq);
#pragma unroll
            for (int ai = 0; ai < 2; ++ai)
#pragma unroll
                for (int m = 0; m < 4; ++m) { const int row = row0 + ai * HALF + m * 16;
                    float ss = 0.f;
#pragma unroll
                    for (int bj = 0; bj < 2; ++bj)
#pragma unroll
                        for (int n = 0; n < 2; ++n) { const f32x4 x = acc[ai][bj][m][n]; ss += (x[0] * x[0] + x[1] * x[1]) + (x[2] * x[2] + x[3] * x[3]); }
                    ss += __shfl_xor(ss, 16); ss += __shfl_xor(ss, 32);
                    const float r = osc / sqrtf(ss * (1.0f / 64.0f) + eps);
                    f32x4 y[2][2];
#pragma unroll
                    for (int bj = 0; bj < 2; ++bj)
#pragma unroll
                        for (int n = 0; n < 2; ++n) y[bj][n] = acc[ai][bj][m][n] * r * gv[bj][n];
                    if (row < nlat) { const int t = row & 2047;
#pragma unroll
                        for (int bj = 0; bj < 2; ++bj) { const int pos = bj ? (t & 63) : (t >> 6); const float* tp = rope + (pos * 16 + 4 * fq) * 2; const f32x4 c01 = *(const f32x4*)tp, c23 = *(const f32x4*)(tp + 4);
                            const f32x4 cs = (f32x4){c01[0], c01[2], c23[0], c23[2]}, sn = (f32x4){c01[1], c01[3], c23[1], c23[3]};
                            const f32x4 a = y[bj][0], b = y[bj][1]; y[bj][0] = a * cs - b * sn; y[bj][1] = b * cs + a * sn; } }
                    bf16_t* dp = (isq ? Q + (size_t)row * 1024 + (4 * u.pn + wc) * 64 : K + (size_t)row * 256 + wc * 64) + 8 * fq;
#pragma unroll
                    for (int bj = 0; bj < 2; ++bj) { const f32x4 v0 = y[bj][0], v1 = y[bj][1]; u32x4 w; w.x = cvt_pk_bf16(v0[0], v0[1]); w.y = cvt_pk_bf16(v0[2], v0[3]); w.z = cvt_pk_bf16(v1[0], v1[1]); w.w = cvt_pk_bf16(v1[2], v1[3]);
                        *(u32x4*)(dp + 32 * bj) = w; } }
        }
    }
};
template <class Epi, class Sched, bool ALIGN_EPI = false, bool SP2 = false, int NTC = 0, bool FP8 = false>
__device__ __forceinline__ void gemm_phase(PG8_LAS unsigned char* lds, const Gemm g, const Sched& S, const Epi& E) {
    int tid_ = threadIdx.x; asm volatile("" : "+v"(tid_));
    const int tid = tid_, wid = __builtin_amdgcn_readfirstlane(tid >> 6), lane = tid & 63, wr = wid >> 2, wc = wid & 3, fr = lane & 15, fq = lane >> 4;
    const int K = g.K;
    unsigned voffA[2], voffB[2];
#pragma unroll
    for (int i = 0; i < 2; ++i) { int R, C; stage_rc(tid * 16 + i * 8192, R, C); const int Rb = Epi::PERM ? ((R & ~31) + perm32(R & 31)) : R;
        voffA[i] = (unsigned)(R * K + C) * 2u; voffB[i] = (unsigned)(Rb * K + C) * 2u; }
    const size_t kstep = (size_t)(BK * 2);
    const size_t hstep = (size_t)HALF * K * 2;
    const size_t tstep = 2 * hstep;
    const unsigned ldsw = (unsigned)wid * 1024u;
    const int aoff = lds_byte(wr * 64 + fr, fq * 8), boff = lds_byte(wc * 32 + fr, fq * 8);
#define PG8_SA(b, h) (((b) * 2 + (h)) * HTB)
#define PG8_SB(b, h) ((4 + (b) * 2 + (h)) * HTB)
#define PG8_STAGE(bufoff, gbase, voff) do { _Pragma("unroll") for (int _i = 0; _i < 2; ++_i) \
        __builtin_amdgcn_global_load_lds((const unsigned*)((const char*)(gbase) + (voff)[_i]), (PG8_LAS unsigned*)(lds + (bufoff) + ldsw + _i * 8192), 16, 0, 0); } while (0)
#define PG8_LDA(dst, b, h) do { if constexpr (FP8) { _Pragma("unroll") for (int m = 0; m < 4; ++m) { const v4i32 l0_ = *(const PG8_LAS v4i32*)(lds + PG8_SA(b, h) + aoff + m * 2048), l1_ = *(const PG8_LAS v4i32*)(lds + PG8_SA(b, h) + aoff + m * 2048 + 1024); \
            dst##8[m] = __builtin_shufflevector(l0_, l1_, 0, 1, 2, 3, 4, 5, 6, 7); } } \
        else { _Pragma("unroll") for (int m = 0; m < 4; ++m) _Pragma("unroll") for (int k = 0; k < 2; ++k) dst[m][k] = *(const PG8_LAS bf16x8*)(lds + PG8_SA(b, h) + aoff + m * 2048 + k * 1024); } } while (0)
#define PG8_LDB(dst, b, h) do { if constexpr (FP8) { _Pragma("unroll") for (int n = 0; n < 2; ++n) { const v4i32 l0_ = *(const PG8_LAS v4i32*)(lds + PG8_SB(b, h) + boff + n * 2048), l1_ = *(const PG8_LAS v4i32*)(lds + PG8_SB(b, h) + boff + n * 2048 + 1024); \
            dst##8[n] = __builtin_shufflevector(l0_, l1_, 0, 1, 2, 3, 4, 5, 6, 7); } } \
        else { _Pragma("unroll") for (int n = 0; n < 2; ++n) _Pragma("unroll") for (int k = 0; k < 2; ++k) dst[n][k] = *(const PG8_LAS bf16x8*)(lds + PG8_SB(b, h) + boff + n * 2048 + k * 1024); } } while (0)
#define PG8_MMA(ai, bj, At, Bt) do { __builtin_amdgcn_s_setprio(1); \
        if constexpr (FP8) { asm volatile("s_nop 1"); _Pragma("unroll") for (int m = 0; m < 4; ++m) _Pragma("unroll") for (int n = 0; n < 2; ++n) \
            asm volatile("v_mfma_scale_f32_16x16x128_f8f6f4 %0, %1, %2, %0, %3, %3 op_sel_hi:[0,0,0]" : "+v"(acc[ai][bj][m][n]) : "v"(Bt##8[n]), "v"(At##8[m]), "v"(f8one)); } \
        else { _Pragma("unroll") for (int m = 0; m < 4; ++m) _Pragma("unroll") for (int n = 0; n < 2; ++n) _Pragma("unroll") for (int k = 0; k < 2; ++k) \
            acc[ai][bj][m][n] = __builtin_amdgcn_mfma_f32_16x16x32_bf16(Bt[n][k], At[m][k], acc[ai][bj][m][n], 0, 0, 0); } \
        __builtin_amdgcn_s_setprio(0); } while (0)
#define PG8_WAIT_V(n) asm volatile("s_waitcnt vmcnt(" #n ")" ::: "memory")
#define PG8_WAIT_L(n) asm volatile("s_waitcnt lgkmcnt(" #n ")" ::: "memory")
#define PG8_BAR __builtin_amdgcn_s_barrier()
#define PG8_SCHED __builtin_amdgcn_sched_barrier(0)
    Unit cur, nxt; int ui = 0;
    if (!S.next(0, cur)) return;
    f32x4 acc[2][2][4][2];
#pragma unroll
    for (int a = 0; a < 2; ++a)
#pragma unroll
        for (int b = 0; b < 2; ++b)
#pragma unroll
            for (int m = 0; m < 4; ++m)
#pragma unroll
                for (int n = 0; n < 2; ++n) acc[a][b][m][n] = (f32x4){0.f, 0.f, 0.f, 0.f};
    bf16x8 At[4][2], B0[2][2], B1[2][2];
    const int f8one = 0x7f7f7f7f;
    v8i32 At8[4], B08[2], B18[2];
    const char* cA = (const char*)g.A + (size_t)cur.pa * tstep + (size_t)cur.k0 * 2; const char* cB = (const char*)g.Bt + (size_t)cur.pn * tstep + (size_t)cur.k0 * 2;
    S.a_ready(cur);
    if constexpr (SP2) {
        PG8_STAGE(PG8_SB(0, 0), cB, voffB); PG8_STAGE(PG8_SB(0, 1), cB + hstep, voffB); PG8_STAGE(PG8_SA(0, 0), cA, voffA); PG8_STAGE(PG8_SA(0, 1), cA + hstep, voffA);
        if (wr == 1) PG8_BAR;
        PG8_WAIT_V(2); PG8_BAR;
        PG8_STAGE(PG8_SB(1, 0), cB + kstep, voffB); PG8_STAGE(PG8_SA(1, 0), cA + kstep, voffA); PG8_STAGE(PG8_SB(1, 1), cB + hstep + kstep, voffB);
        PG8_WAIT_V(6); PG8_BAR;
    } else {
        PG8_STAGE(PG8_SB(0, 0), cB, voffB); PG8_STAGE(PG8_SA(0, 0), cA, voffA); PG8_STAGE(PG8_SB(0, 1), cB + hstep, voffB); PG8_STAGE(PG8_SA(0, 1), cA + hstep, voffA);
        if (wr == 1) PG8_BAR;
        PG8_WAIT_V(4); PG8_BAR;
        PG8_STAGE(PG8_SB(1, 0), cB + kstep, voffB); PG8_STAGE(PG8_SA(1, 0), cA + kstep, voffA); PG8_STAGE(PG8_SB(1, 1), cB + hstep + kstep, voffB);
        PG8_WAIT_V(6); PG8_BAR;
    }
    for (;;) {
        const bool has_next = S.next(ui + 1, nxt);
        const char* nA = has_next ? (const char*)g.A + (size_t)nxt.pa * tstep + (size_t)nxt.k0 * 2 : cA; const char* nB = has_next ? (const char*)g.Bt + (size_t)nxt.pn * tstep + (size_t)nxt.k0 * 2 : cB;
        const int nt = NTC ? NTC : cur.nt;
#pragma unroll 1
        for (int t = 0; t < nt; t += 2) {
            const bool last = (t == nt - 2);
            const char* a1 = cA + (size_t)(t + 1) * kstep;
            const char* a2 = last ? nA : cA + (size_t)(t + 2) * kstep; const char* b2 = last ? nB : cB + (size_t)(t + 2) * kstep;
            const char* a3 = a2 + kstep; const char* b3 = b2 + kstep;
            if (last && has_next) S.a_ready(nxt);
            if constexpr (SP2) {
            PG8_LDB(B0, 0, 0); PG8_LDB(B1, 0, 1); PG8_SCHED; PG8_LDA(At, 0, 0); PG8_STAGE(PG8_SA(1, 1), a1 + hstep, voffA);
            PG8_WAIT_V(8); PG8_WAIT_L(0); PG8_BAR; PG8_MMA(0, 0, At, B0); PG8_MMA(0, 1, At, B1); PG8_BAR; PG8_SCHED;
            PG8_LDA(At, 0, 1); PG8_STAGE(PG8_SB(0, 0), b2, voffB); PG8_STAGE(PG8_SB(0, 1), b2 + hstep, voffB); PG8_STAGE(PG8_SA(0, 0), a2, voffA);
            PG8_WAIT_V(8); PG8_WAIT_L(0); PG8_BAR; PG8_MMA(1, 0, At, B0); PG8_MMA(1, 1, At, B1); PG8_BAR; PG8_SCHED;
            PG8_LDB(B0, 1, 0); PG8_LDB(B1, 1, 1); PG8_SCHED; PG8_LDA(At, 1, 0); PG8_STAGE(PG8_SA(0, 1), a2 + hstep, voffA);
            PG8_WAIT_V(8); PG8_WAIT_L(0); PG8_BAR; PG8_MMA(0, 0, At, B0); PG8_MMA(0, 1, At, B1); PG8_BAR; PG8_SCHED;
            PG8_LDA(At, 1, 1); PG8_STAGE(PG8_SB(1, 0), b3, voffB); PG8_STAGE(PG8_SB(1, 1), b3 + hstep, voffB); PG8_STAGE(PG8_SA(1, 0), a3, voffA);
            PG8_WAIT_V(8); PG8_WAIT_L(0); PG8_BAR; PG8_MMA(1, 0, At, B0); PG8_MMA(1, 1, At, B1); PG8_BAR; PG8_SCHED;
            } else {
            PG8_LDB(B0, 0, 0); PG8_SCHED; PG8_LDA(At, 0, 0); PG8_STAGE(PG8_SA(1, 1), a1 + hstep, voffA);
            PG8_WAIT_L(8); PG8_BAR; PG8_WAIT_L(0); PG8_MMA(0, 0, At, B0); PG8_BAR; PG8_SCHED;
            PG8_LDB(B1, 0, 1); PG8_STAGE(PG8_SB(0, 0), b2, voffB);
            PG8_BAR; PG8_WAIT_L(0); PG8_MMA(0, 1, At, B1); PG8_BAR;
            PG8_LDA(At, 0, 1); PG8_STAGE(PG8_SA(0, 0), a2, voffA);
            PG8_BAR; PG8_WAIT_L(0); PG8_MMA(1, 0, At, B0); PG8_BAR; PG8_SCHED;
            PG8_STAGE(PG8_SB(0, 1), b2 + hstep, voffB);
            PG8_WAIT_V(6); PG8_BAR; PG8_MMA(1, 1, At, B1); PG8_BAR;
            PG8_LDB(B0, 1, 0); PG8_SCHED; PG8_LDA(At, 1, 0); PG8_STAGE(PG8_SA(0, 1), a2 + hstep, voffA);
            PG8_WAIT_L(8); PG8_BAR; PG8_WAIT_L(0); PG8_MMA(0, 0, At, B0); PG8_BAR; PG8_SCHED;
            PG8_LDB(B1, 1, 1); PG8_STAGE(PG8_SB(1, 0), b3, voffB);
            PG8_BAR; PG8_WAIT_L(0); PG8_MMA(0, 1, At, B1); PG8_BAR;
            PG8_LDA(At, 1, 1); PG8_STAGE(PG8_SA(1, 0), a3, voffA);
            PG8_BAR; PG8_WAIT_L(0); PG8_MMA(1, 0, At, B0); PG8_BAR; PG8_SCHED;
            PG8_STAGE(PG8_SB(1, 1), b3 + hstep, voffB);
            PG8_WAIT_V(6); PG8_BAR; PG8_MMA(1, 1, At, B1); PG8_BAR;
            }
        }
        if constexpr (ALIGN_EPI) { if (wr == 0) PG8_BAR; }
        if constexpr (FP8) { asm volatile("s_nop 15\n\ts_nop 15\n\ts_nop 15\n\ts_nop 15" ::: "memory"); }
        if constexpr (!Epi::AFTER_DRAIN) { E(acc, cur, wr, wc, fr, fq); S.done(cur); }
        if (!has_next) break;
#pragma unroll
        for (int a = 0; a < 2; ++a)
#pragma unroll
            for (int b = 0; b < 2; ++b)
#pragma unroll
                for (int m = 0; m < 4; ++m)
#pragma unroll
                    for (int n = 0; n < 2; ++n) acc[a][b][m][n] = (f32x4){0.f, 0.f, 0.f, 0.f};
        cur = nxt; cA = nA; cB = nB; ++ui;
        if constexpr (ALIGN_EPI) { if (wr == 1) PG8_BAR; }
    }
    PG8_WAIT_V(0);
    if constexpr (!ALIGN_EPI) { if (wr == 0) PG8_BAR; }
    PG8_BAR;
    if constexpr (Epi::AFTER_DRAIN) { E.fused(acc, cur, wr, wc, fr, fq, lds, wid, lane); S.done(cur); }
#undef PG8_SA
#undef PG8_SB
#undef PG8_STAGE
#undef PG8_LDA
#undef PG8_LDB
#undef PG8_MMA
#undef PG8_WAIT_V
#undef PG8_WAIT_L
#undef PG8_BAR
#undef PG8_SCHED
}
}
#define GAS __attribute__((address_space(1)))
#define LAS __attribute__((address_space(3)))
typedef unsigned short bf16;
typedef unsigned v4u __attribute__((ext_vector_type(4)));
typedef float f32x4 __attribute__((ext_vector_type(4)));
typedef short bf16x8 __attribute__((ext_vector_type(8)));
typedef GAS unsigned gu32;
typedef GAS unsigned long long gu64;
#define RLX_AGENT __ATOMIC_RELAXED, __HIP_MEMORY_SCOPE_AGENT
#define LDS_WAIT() asm volatile("s_waitcnt lgkmcnt(0)" ::: "memory")
#define VM_WAIT() asm volatile("s_waitcnt vmcnt(0)" ::: "memory")
__device__ __forceinline__ unsigned long long rt() { return __builtin_amdgcn_s_memrealtime(); }
__device__ __forceinline__ unsigned f2bf(float f) { unsigned u = __builtin_bit_cast(unsigned, f); return (u + 0x7fffu + ((u >> 16) & 1u)) >> 16; }
__device__ __forceinline__ unsigned pk2(float lo, float hi) { return f2bf(lo) | (f2bf(hi) << 16); }

#define XB_TMO      128
#define XB_XCNT(j)  (256  + 64 * (j))
#define XB_XSUB(j)  (1280 + 64 * (j))
#define XB_XGEN(j)  (2304 + 64 * (j))
#define XB_TOP      3328
#define XB_TOPGEN   3392
#define XCD_BAR_WORDS 3456
#define XB_SPIN_CAP (1u << 18)

__device__ __forceinline__ unsigned xb_ld(unsigned* p)              { return __hip_atomic_load(p, __ATOMIC_RELAXED, __HIP_MEMORY_SCOPE_AGENT); }
__device__ __forceinline__ unsigned xb_add(unsigned* p, unsigned v) { return __hip_atomic_fetch_add(p, v, __ATOMIC_RELAXED, __HIP_MEMORY_SCOPE_AGENT); }
__device__ __forceinline__ unsigned xb_xcc_id() { return (unsigned)__builtin_amdgcn_s_getreg((3 << 11) | 20) & 0xFu; }
#define XB_SPIN(cond, bar) do { unsigned _sp = 0; while (cond) { __builtin_amdgcn_s_sleep(1); \
    if ((++_sp & 255u) == 0u) { if (xb_ld(&(bar)[XB_TMO])) break; if (_sp > XB_SPIN_CAP) { atomicAdd(&(bar)[XB_TMO], 1u); break; } } } } while (0)

struct XcdBarrier {
    unsigned* bar; unsigned x;
    volatile LAS unsigned* st;
};

__device__ __forceinline__ XcdBarrier xcd_barrier_post(unsigned* bar, volatile LAS unsigned* st) {
    XcdBarrier b; b.bar = bar; b.x = xb_xcc_id(); b.st = st;
    if (threadIdx.x == 0) (void)xb_add(&bar[XB_XCNT(b.x)], 1u);
    return b;
}
__device__ __forceinline__ void xcd_barrier_complete(unsigned* bar, unsigned x, unsigned& nloc, unsigned& nx) {
    const unsigned G = gridDim.x * gridDim.y * gridDim.z;
    unsigned sum, cnt, mine, sp = 0u;
    for (;;) {
        sum = 0u; cnt = 0u; mine = 0u;
#pragma unroll
        for (unsigned j = 0; j < 16; ++j) { const unsigned c = xb_ld(&bar[XB_XCNT(j)]); sum += c; cnt += (c > 0u) ? 1u : 0u; mine = (j == x) ? c : mine; }
        if (sum == G) break;
        __builtin_amdgcn_s_sleep(1);
        if ((++sp & 255u) == 0u) { if (xb_ld(&bar[XB_TMO])) break; if (sp > XB_SPIN_CAP) { atomicAdd(&bar[XB_TMO], 1u); break; } }
    }
    nloc = mine > 0u ? mine : 1u; nx = cnt > 0u ? cnt : 1u;
}

__device__ __forceinline__ void xcd_barrier(const XcdBarrier& b) {
    asm volatile("s_waitcnt vmcnt(0)" ::: "memory");
    __syncthreads();
    if (threadIdx.x == 0) {
        unsigned* bar = b.bar;
        __builtin_amdgcn_s_waitcnt(0);
        unsigned nloc = b.st[0], nx = b.st[1];
        if (nloc == 0u) { xcd_barrier_complete(bar, b.x, nloc, nx); b.st[0] = nloc; b.st[1] = nx; }
        const unsigned old = xb_add(&bar[XB_XSUB(b.x)], 1u);
        const unsigned gen = old / nloc;
        if (old + 1u == (gen + 1u) * nloc) {
            __builtin_amdgcn_fence(__ATOMIC_RELEASE, "agent");
            asm volatile("s_waitcnt vmcnt(0)" ::: "memory");
            const unsigned og = xb_add(&bar[XB_TOP], 1u);
            const unsigned tg = og / nx;
            if (og + 1u == (tg + 1u) * nx) xb_add(&bar[XB_TOPGEN], 1u);
            else XB_SPIN(xb_ld(&bar[XB_TOPGEN]) == tg, bar);
            __builtin_amdgcn_fence(__ATOMIC_ACQUIRE, "agent");
            xb_add(&bar[XB_XGEN(b.x)], 1u);
            asm volatile("s_waitcnt vmcnt(0)" ::: "memory");
        } else {
            XB_SPIN(xb_ld(&bar[XB_XGEN(b.x)]) == gen, bar);
            __builtin_amdgcn_fence(__ATOMIC_ACQUIRE, "agent");
            asm volatile("s_waitcnt vmcnt(0)" ::: "memory");
        }
    }
    __syncthreads();
}
constexpr int NWAVES = 8;
#ifndef MK_PER_PHASE
#define MK_PER_PHASE 0
#endif
constexpr int D = 1024, NB = 8, SEQ = 2048, CTXL = 256, ML = NB * SEQ, MC = NB * CTXL, MT = ML + MC;
constexpr int FF = 3584, NE = 8;
constexpr float EPS = 1e-6f;
constexpr float LOG2E = 1.4426950408889634f;
constexpr float QSCALE = 0.125f * LOG2E;
#ifndef MK_FP8_FFN2
#define MK_FP8_FFN2 1
#endif
constexpr float F8_W13 = 32.0f, F8_W2 = 64.0f;
constexpr int N_PHASES = 34;
constexpr size_t MiB = 1u << 20;
constexpr size_t WS_CTL = 0, CTL_ZERO_BYTES = 1 * MiB;
constexpr size_t WS_MOD = 1 * MiB;
constexpr size_t WS_ROPE = 2 * MiB;
constexpr size_t WS_WSB = 2 * MiB + 65536;
constexpr size_t WS_TOKI = 3 * MiB;
constexpr size_t WS_TOKW = 3 * MiB + 524288;
constexpr int CAP = MT;
constexpr size_t WS_TOKLIST = 4 * MiB;
constexpr size_t WS_TOKWT = 4 * MiB + 655360;
constexpr size_t WS_STATS = 5 * MiB + 524288;
constexpr size_t WS_WIN = 8 * MiB, WS_WOUT = 24 * MiB, WS_WQKV = 32 * MiB, WS_WO = 38 * MiB, WS_FF13 = 42 * MiB, WS_FF2 = 70 * MiB;
constexpr size_t WS_MOE13 = 84 * MiB, WS_MOE2 = 196 * MiB;
constexpr size_t WS_X = 252 * MiB;
constexpr size_t WS_H = 324 * MiB;
constexpr size_t WS_R = 360 * MiB;
constexpr size_t WS_U = WS_R, WS_V = WS_R + 36 * MiB, WS_G = WS_R + 72 * MiB, WS_YAB = WS_R + 108 * MiB;
constexpr size_t WS_QKV = WS_R, WS_Q = WS_R + 54 * MiB, WS_K = WS_R + 90 * MiB, WS_O = WS_R + 99 * MiB;
constexpr size_t WS_T = WS_R;
constexpr size_t WS_HP = WS_R, WS_TP = WS_R + 144 * MiB, WS_YS = WS_R + 342 * MiB;
constexpr size_t WS_PB = WS_R + 414 * MiB;
constexpr size_t WS_END = WS_PB + 64 * MiB;
constexpr int CW_TMO = 0, CW_CODE = 1, CW_CNT = 64, CW_BAR = 4096;
constexpr int RING_OFF = 0;
constexpr int LDSCTL_OFF = 143360, MISC_OFF = LDSCTL_OFF + 64;
constexpr int LDS_BYTES = 147456;
__constant__ float INVF[16] = {1.0f, 0.5623413324356079f, 0.3162277638912201f, 0.17782793939113617f, 0.10000000149011612f, 0.05623413249850273f, 0.03162277489900589f, 0.017782794311642647f,
    0.009999999776482582f, 0.005623413249850273f, 0.003162277629598975f, 0.0017782794311642647f, 0.0010000000474974513f, 0.000562341301701963f, 0.0003162277571391314f, 0.00017782794020604342f};

typedef unsigned v2u __attribute__((ext_vector_type(2)));
struct Args { const float* in[29]; float* out; unsigned char* ws; int ph_lo, ph_hi; float gmul; int pad; };
struct Frame { LAS unsigned char* lds; volatile LAS unsigned* MISC; gu32* ctl; int tid, lane, wave, G, bid; };

__device__ __forceinline__ float wave_sum(float v) {
#pragma unroll
    for (int o = 1; o < 64; o <<= 1) v += __shfl_xor(v, o);
    return v;
}
__device__ __forceinline__ float bf2f(unsigned short b) { return __uint_as_float((unsigned)b << 16); }
__device__ __forceinline__ float bflo(unsigned w) { return __uint_as_float(w << 16); }
__device__ __forceinline__ float bfhi(unsigned w) { return __uint_as_float(w & 0xffff0000u); }
__device__ __forceinline__ unsigned pkbf(float lo, float hi) { return pg8::cvt_pk_bf16(lo, hi); }
__device__ __forceinline__ float fsigm(float x) { return pg8::sigm_f(x); }
__device__ __forceinline__ unsigned pk4f8(float a, float b, float c, float d) { int p = 0; p = __builtin_amdgcn_cvt_pk_fp8_f32(a, b, p, false); p = __builtin_amdgcn_cvt_pk_fp8_f32(c, d, p, true); return (unsigned)p; }

__device__ __forceinline__ int dst_row(int mode, int n) {
    if (mode == 0) return n;
    if (mode == 1) return ((n >> 7) << 8) + (n & 127);
    if (mode == 2) return ((n >> 7) << 8) + 128 + (n & 127);
    if (mode == 4) { if (n >= 1280) return n;
        const int tile = n >> 8, r = n & 255, wc = r >> 6, d = r & 63, bj = d >> 5, dh = d & 31, nn = dh >> 4, fq = (dh & 15) >> 2, e = dh & 3; return (tile << 8) + 128 * bj + 32 * wc + 8 * fq + 4 * nn + e; }
    if (n < 2048) return n;
    if (n < 3072) { const int j = n - 2048; return 2048 + ((j >> 7) << 8) + (j & 127); }
    { const int j = n - 3072; return 2048 + ((j >> 7) << 8) + 128 + (j & 127); }
}
struct ConvDesc { const float* W; bf16* WT; int N, K, mode, item; float f8s; };
__device__ __forceinline__ void conv_ld(const ConvDesc& d, int lane, f32x4 (&r)[16]) {
    const int nblk = d.N >> 6, kb = d.item / nblk, nb = d.item - kb * nblk, k0 = kb << 6, n0 = nb << 6; const int c4 = (lane & 15) << 2, kr = lane >> 4;
#pragma unroll
    for (int i = 0; i < 16; ++i) r[i] = __builtin_nontemporal_load((const GAS f32x4*)(d.W + (size_t)(k0 + 4 * i + kr) * d.N + n0 + c4));
}
__device__ __forceinline__ void conv_st(const ConvDesc& d, LAS float* scr, int lane, const f32x4 (&r)[16]) {
    const int nblk = d.N >> 6, kb = d.item / nblk, nb = d.item - kb * nblk, k0 = kb << 6, n0 = nb << 6; const int c4 = (lane & 15) << 2, kr = lane >> 4;
#pragma unroll
    for (int i = 0; i < 16; ++i) { LAS float* s = scr + (4 * i + kr) * 65 + c4; s[0] = r[i].x; s[1] = r[i].y; s[2] = r[i].z; s[3] = r[i].w; }
    LDS_WAIT(); asm volatile("" ::: "memory");
    if (d.f8s != 0.f) {
        const float sc = d.f8s; unsigned char* W8 = (unsigned char*)d.WT;
#pragma unroll
        for (int jj = 0; jj < 4; ++jj) { const int id = lane + 64 * jj, n = id >> 2, c = id & 3; const LAS float* s = scr + (16 * c) * 65 + n; v4u o;
            o.x = pk4f8(s[0] * sc, s[65] * sc, s[130] * sc, s[195] * sc); o.y = pk4f8(s[260] * sc, s[325] * sc, s[390] * sc, s[455] * sc);
            o.z = pk4f8(s[520] * sc, s[585] * sc, s[650] * sc, s[715] * sc); o.w = pk4f8(s[780] * sc, s[845] * sc, s[910] * sc, s[975] * sc);
            *(GAS v4u*)(W8 + (size_t)dst_row(d.mode, n0 + n) * d.K + k0 + 16 * c) = o; }
    } else {
    const int c = lane & 7;
#pragma unroll
    for (int jj = 0; jj < 8; ++jj) { const int n = (lane >> 3) + 8 * jj; const LAS float* s = scr + (8 * c) * 65 + n;
        v4u o; o.x = pkbf(s[0], s[65]); o.y = pkbf(s[130], s[195]); o.z = pkbf(s[260], s[325]); o.w = pkbf(s[390], s[455]);
        *(GAS v4u*)(d.WT + (size_t)dst_row(d.mode, n0 + n) * d.K + k0 + 8 * c) = o; }
    }
    LDS_WAIT(); asm volatile("" ::: "memory");
}
__device__ __forceinline__ ConvDesc dec_nonmoe(const Args& a, int it) {
    ConvDesc d; d.f8s = 0.f; const int j = it / 4864; int r = it - j * 4864; const bool f8 = MK_FP8_FFN2 && (j == 1);
    if (r < 1024) { d.W = a.in[8] + (size_t)j * 1024 * 4096; d.N = 4096; d.K = 1024; d.mode = 3; d.WT = (bf16*)(a.ws + WS_WIN) + (size_t)j * 4096 * 1024; }
    else if ((r -= 1024) < 512) { d.W = a.in[16] + (size_t)j * 2048 * 1024; d.N = 1024; d.K = 2048; d.mode = 0; d.WT = (bf16*)(a.ws + WS_WOUT) + (size_t)j * 1024 * 2048; }
    else if ((r -= 512) < 384) { d.W = a.in[17] + (size_t)j * 1024 * 1536; d.N = 1536; d.K = 1024; d.mode = 4; d.WT = (bf16*)(a.ws + WS_WQKV) + (size_t)j * 1536 * 1024; }
    else if ((r -= 384) < 256) { d.W = a.in[21] + (size_t)j * 1024 * 1024; d.N = 1024; d.K = 1024; d.mode = 0; d.WT = (bf16*)(a.ws + WS_WO) + (size_t)j * 1024 * 1024; }
    else if ((r -= 256) < 896) { d.W = a.in[22] + (size_t)j * 1024 * 3584; d.N = 3584; d.K = 1024; d.mode = 1; d.WT = (bf16*)(a.ws + WS_FF13) + (size_t)j * 7168 * 1024; if (f8) d.f8s = F8_W13; }
    else if ((r -= 896) < 896) { d.W = a.in[23] + (size_t)j * 1024 * 3584; d.N = 3584; d.K = 1024; d.mode = 2; d.WT = (bf16*)(a.ws + WS_FF13) + (size_t)j * 7168 * 1024; if (f8) d.f8s = F8_W13; }
    else { r -= 896; d.W = a.in[24] + (size_t)j * 3584 * 1024; d.N = 1024; d.K = 3584; d.mode = 0; d.WT = (bf16*)(a.ws + WS_FF2) + (size_t)j * 1024 * 3584; if (f8) d.f8s = F8_W2; }
    d.item = r; return d;
}
__device__ __forceinline__ ConvDesc dec_moe(const Args& a, int jm, int sel, int it) {
    ConvDesc d; const int per = (sel == 0) ? 2688 : (sel == 1 ? 1792 : 896);
    const int e = it / per; int r = it - e * per; if (sel == 2) r += 1792;
    const size_t eo = (size_t)(jm * 8 + e);
    unsigned char* m13 = a.ws + WS_MOE13 + (size_t)e * 7168 * 1024; unsigned char* m2 = a.ws + WS_MOE2 + (size_t)e * 1024 * 3584;
    if (r < 896) { d.W = a.in[26] + eo * 1024 * 3584; d.N = 3584; d.K = 1024; d.mode = 1; d.WT = (bf16*)m13; d.f8s = F8_W13; }
    else if ((r -= 896) < 896) { d.W = a.in[27] + eo * 1024 * 3584; d.N = 3584; d.K = 1024; d.mode = 2; d.WT = (bf16*)m13; d.f8s = F8_W13; }
    else { r -= 896; d.W = a.in[28] + eo * 3584 * 1024; d.N = 1024; d.K = 3584; d.mode = 0; d.WT = (bf16*)m2; d.f8s = F8_W2; }
    d.item = r; return d;
}
__device__ __forceinline__ void conv_run(const Args& a, int n_non, int jm, int sel, int moe_lo, int moe_hi, int gw, int NGW, LAS float* scr, int lane) {
    const int total = n_non + ((moe_hi > moe_lo) ? moe_hi - moe_lo : 0);
    if (gw >= total) return;
    ConvDesc cur = (gw < n_non) ? dec_nonmoe(a, gw) : dec_moe(a, jm, sel, gw - n_non + moe_lo);
    f32x4 r[16]; conv_ld(cur, lane, r);
    for (int it = gw; it < total; it += NGW) {
        const int nx = it + NGW; ConvDesc nxt = cur; f32x4 rn[16];
        if (nx < total) { nxt = (nx < n_non) ? dec_nonmoe(a, nx) : dec_moe(a, jm, sel, nx - n_non + moe_lo); conv_ld(nxt, lane, rn); }
        conv_st(cur, scr, lane, r);
        if (nx < total) {
#pragma unroll
            for (int i = 0; i < 16; ++i) r[i] = rn[i];
            cur = nxt; }
    }
}
__device__ __forceinline__ int moe_items(int sel) { return 8 * ((sel == 0) ? 2688 : (sel == 1 ? 1792 : 896)); }
struct TailPlan { int nl[4]; int e[5]; };
__device__ __forceinline__ int last_round_units(int n, int G) { const int r = n % G; return r == 0 ? G : r; }
__device__ __forceinline__ void tail_plan(int G, int att_units, TailPlan& t) {
    t.nl[0] = last_round_units((MT / 256) * 16, G); t.nl[1] = last_round_units((MT / 256) * 28, G); t.nl[2] = last_round_units((MT / 256) * 6, G); t.nl[3] = last_round_units(att_units, G);
    const int quota[4] = {2, 2, 3, 1}; t.e[0] = 0;
#pragma unroll
    for (int k = 0; k < 4; ++k) t.e[k + 1] = t.e[k] + (G - t.nl[k]) * NWAVES * quota[k];
}
__device__ __forceinline__ void tail_fill(const Args& a, Frame& F, const TailPlan& t, int k, int jm, int sel, int wid = -1) {
    const int me = (wid >= 0) ? wid : F.bid;
    const int nl = t.nl[k]; if (me < nl || nl >= F.G) return;
    const int tot = moe_items(sel), lo = t.e[k] < tot ? t.e[k] : tot, hi = t.e[k + 1] < tot ? t.e[k + 1] : tot;
    __syncthreads();
    conv_run(a, 0, jm, sel, lo, hi, (me - nl) * NWAVES + F.wave, (F.G - nl) * NWAVES, (LAS float*)(F.lds + F.wave * 16640), F.lane);
}
__device__ __forceinline__ void conv_moe_all(const Args& a, Frame& F, int jm, int sel, int w0, int nw, int wid = -1, int lo = 0, int hi = -1) {
    const int me = (wid >= 0) ? wid : F.bid;
    if (me < w0 || me >= w0 + nw) return;
    conv_run(a, 0, jm, sel, lo, (hi < 0) ? moe_items(sel) : hi, (me - w0) * NWAVES + F.wave, nw * NWAVES, (LAS float*)(F.lds + F.wave * 16640), F.lane);
}
__device__ __forceinline__ void sincos_d(double x, double& s, double& c) {
    const double TWO_PI = 6.283185307179586476925286766559;
    const double k = __builtin_rint(x / TWO_PI); const double r = x - k * TWO_PI, r2 = r * r;
    double ts = r, ss = r, tc = 1.0, cs = 1.0;
#pragma unroll 1
    for (int n = 1; n <= 14; ++n) { tc = -tc * r2 / (double)((2 * n - 1) * (2 * n)); cs += tc; ts = -ts * r2 / (double)((2 * n) * (2 * n + 1)); ss += ts; }
    s = ss; c = cs;
}
__device__ __forceinline__ void prologue_phase(const Args& a, Frame& F) {
    const int gw = F.bid * NWAVES + F.wave, NGW = F.G * NWAVES;
    {
        LAS float* sc = (LAS float*)F.lds; LAS float* red = sc + 9 * 1024;
        for (int i = F.tid; i < 9 * 1024; i += NWAVES * 64) { const float v = (i < 8192) ? a.in[1][i] : a.in[3][i - 8192]; sc[i] = v * fsigm(v); }
        __syncthreads();
        float* MOD = (float*)(a.ws + WS_MOD);
        for (int job = F.bid; job < 768; job += F.G) {
            const int li = job / 192, nb = job - li * 192; const int cl = F.tid & 31, kg = F.tid >> 5;
            const float* w = a.in[4] + (size_t)li * 1024 * 6144 + (size_t)(kg * 64) * 6144 + nb * 32 + cl;
            float acc[9];
#pragma unroll
            for (int r = 0; r < 9; ++r) acc[r] = 0.f;
            float wv[2][16];
#pragma unroll
            for (int i = 0; i < 16; ++i) wv[0][i] = __builtin_nontemporal_load(w + (size_t)i * 6144);
#pragma unroll
            for (int kq = 0; kq < 4; ++kq) { const int kb = 16 * kq;
                if (kq < 3) {
#pragma unroll
                    for (int i = 0; i < 16; ++i) wv[(kq + 1) & 1][i] = __builtin_nontemporal_load(w + (size_t)(kb + 16 + i) * 6144); }
#pragma unroll
                for (int i4 = 0; i4 < 4; ++i4)
#pragma unroll
                    for (int r = 0; r < 9; ++r) { const f32x4 sv = *(const LAS f32x4*)(sc + r * 1024 + kg * 64 + kb + 4 * i4);
                        acc[r] += (sv[0] * wv[kq & 1][4 * i4] + sv[1] * wv[kq & 1][4 * i4 + 1]) + (sv[2] * wv[kq & 1][4 * i4 + 2] + sv[3] * wv[kq & 1][4 * i4 + 3]); } }
#pragma unroll
            for (int r = 0; r < 9; ++r) red[(kg * 9 + r) * 32 + cl] = acc[r];
            __syncthreads();
            for (int o = F.tid; o < 9 * 32; o += NWAVES * 64) { const int r = o >> 5, c = o & 31; float sum = 0.f;
#pragma unroll
                for (int g = 0; g < 16; ++g) sum += red[(g * 9 + r) * 32 + c];
                MOD[(size_t)(li * 9 + r) * 6144 + nb * 32 + c] = sum + a.in[5][li * 6144 + nb * 32 + c]; }
            __syncthreads();
        }
    }
    {
        const int gt = F.bid * (NWAVES * 64) + F.tid, NT = F.G * NWAVES * 64;
        if (gt < 1024) { const int pos = gt >> 4, i = gt & 15; const float ang = (float)pos * INVF[i]; double s, c; sincos_d((double)ang, s, c);
            float* rp = (float*)(a.ws + WS_ROPE) + gt * 2; rp[0] = (float)c; rp[1] = (float)s; }
        bf16* wsb = (bf16*)(a.ws + WS_WSB);
        for (int i = gt; i < 2 * 8 * 128 * 128 / 2; i += NT) { const float2 v = *(const float2*)(a.in[11] + 2 * i); *(unsigned*)(wsb + 2 * i) = pkbf(v.x, v.y); }
    }
    __syncthreads();
    { TailPlan tp; tail_plan(F.G, 1152, tp); const int tot = moe_items(0), lo = tp.e[4] < tot ? tp.e[4] : tot;
      conv_run(a, 2 * 4864, 0, 0, lo, tot, gw, NGW, (LAS float*)(F.lds + F.wave * 16640), F.lane); }
}

__device__ __forceinline__ void norm_row_core(const float* xsrc32, const bf16* xsrc16, bf16* xdst, const bf16* ys, const float* g2p, const float* gn, const float* scp, const float* shp, bf16* hdst, int lane, f32x4 (&h)[4],
                                              const float* pbp = nullptr, int nS = 0, const float* pgp = nullptr, bool h8 = false) {
    f32x4 v[4];
    if (xsrc32) {
#pragma unroll
        for (int j = 0; j < 4; ++j) v[j] = __builtin_nontemporal_load((const GAS f32x4*)(xsrc32 + 4 * lane + 256 * j));
    } else {
#pragma unroll
        for (int j = 0; j < 4; ++j) { const v2u x = *(const GAS v2u*)(xsrc16 + 4 * lane + 256 * j); v[j] = (f32x4){bflo(x.x), bfhi(x.x), bflo(x.y), bfhi(x.y)}; }
    }
    if (pbp) {
        f32x4 ps[4];
#pragma unroll
        for (int j = 0; j < 4; ++j) ps[j] = (f32x4){0.f, 0.f, 0.f, 0.f};
        for (int q = 0; q < nS; ++q) {
#pragma unroll
            for (int j = 0; j < 4; ++j) { const v2u pp = *(const GAS v2u*)((const bf16*)pbp + (size_t)q * 2048 * 1024 + 4 * lane + 256 * j); ps[j] = ps[j] + (f32x4){bflo(pp.x), bfhi(pp.x), bflo(pp.y), bfhi(pp.y)}; } }
#pragma unroll
        for (int j = 0; j < 4; ++j) v[j] = v[j] + *(const GAS f32x4*)(pgp + 4 * lane + 256 * j) * ps[j];
    }
    if (ys) {
#pragma unroll
        for (int j = 0; j < 4; ++j) { const v2u y0 = *(const GAS v2u*)(ys + 4 * lane + 256 * j), y1 = *(const GAS v2u*)(ys + 1024 + 4 * lane + 256 * j); const f32x4 g = *(const GAS f32x4*)(g2p + 4 * lane + 256 * j);
            v[j].x += g.x * (bflo(y0.x) + bflo(y1.x)); v[j].y += g.y * (bfhi(y0.x) + bfhi(y1.x)); v[j].z += g.z * (bflo(y0.y) + bflo(y1.y)); v[j].w += g.w * (bfhi(y0.y) + bfhi(y1.y)); }
    }
    if (xdst) {
#pragma unroll
        for (int j = 0; j < 4; ++j) { v2u o; o.x = pkbf(v[j].x, v[j].y); o.y = pkbf(v[j].z, v[j].w); *(GAS v2u*)(xdst + 4 * lane + 256 * j) = o; }
    }
    float ss = 0.f;
#pragma unroll
    for (int j = 0; j < 4; ++j) ss += (v[j].x * v[j].x + v[j].y * v[j].y) + (v[j].z * v[j].z + v[j].w * v[j].w);
    const float r = 1.0f / sqrtf(wave_sum(ss) * (1.0f / 1024.0f) + EPS);
#pragma unroll
    for (int j = 0; j < 4; ++j) { const f32x4 g = *(const GAS f32x4*)(gn + 4 * lane + 256 * j), sc = *(const GAS f32x4*)(scp + 4 * lane + 256 * j), sh = *(const GAS f32x4*)(shp + 4 * lane + 256 * j);
        h[j] = (v[j] * r) * g * (sc + 1.0f) + sh;
        if (h8) { *(GAS unsigned*)((unsigned char*)hdst + 4 * lane + 256 * j) = pk4f8(h[j].x, h[j].y, h[j].z, h[j].w); }
        else { v2u o; o.x = pkbf(h[j].x, h[j].y); o.y = pkbf(h[j].z, h[j].w); *(GAS v2u*)(hdst + 4 * lane + 256 * j) = o; } }
}
__device__ __forceinline__ void norm_phase(const Args& a, Frame& F, int li, int which, int nrows, bool src_in, int pend_li, int nS = 0, int rs0 = 0, const float* pgate = nullptr, bool h8 = false) {
    const int gw = F.bid * NWAVES + F.wave, NGW = F.G * NWAVES;
    bf16* X = (bf16*)(a.ws + WS_X); bf16* H = (bf16*)(a.ws + WS_H); const float* MOD = (const float*)(a.ws + WS_MOD); const bf16* YS = (const bf16*)(a.ws + WS_YS);
    const float* gn = (which == 0 ? a.in[6] : a.in[7]) + li * 1024;
    for (int row = gw; row < nrows; row += NGW) {
        const int mr = (row < ML) ? (row >> 11) : 8;
        const float* mp = MOD + (size_t)(li * 9 + mr) * 6144 + (which ? 3 * 1024 : 0);
        const float* xs = src_in ? ((row < ML) ? a.in[0] + (size_t)row * 1024 : a.in[2] + (size_t)(row - ML) * 1024) : nullptr;
        const bool part = (nS > 0) && (row >= rs0);
        const bool wx = src_in || (pend_li >= 0) || part;
        f32x4 h[4];
        norm_row_core(xs, X + (size_t)row * 1024, wx ? X + (size_t)row * 1024 : nullptr, (pend_li >= 0) ? YS + (size_t)row * 2048 : nullptr, MOD + (size_t)((pend_li >= 0 ? pend_li : 0) * 9 + mr) * 6144 + 5 * 1024,
                      gn, mp + 1024, mp, h8 ? (bf16*)((unsigned char*)H + (size_t)row * 1024) : H + (size_t)row * 1024, F.lane, h, part ? (const float*)((const bf16*)(a.ws + WS_PB) + (size_t)(row - rs0) * 1024) : nullptr, nS, part ? pgate + (size_t)mr * 6144 : nullptr, h8);
    }
}
__device__ __forceinline__ void norm_router_phase(const Args& a, Frame& F, int li, int nrows, int nS, int rs0, const float* pgate) {
    constexpr int RPW = 72;
    bf16* X = (bf16*)(a.ws + WS_X); bf16* H = (bf16*)(a.ws + WS_H); const float* MOD = (const float*)(a.ws + WS_MOD);
    int4* TOKI = (int4*)(a.ws + WS_TOKI); float2* TOKW = (float2*)(a.ws + WS_TOKW); int* TOKLIST = (int*)(a.ws + WS_TOKLIST); float* TOKWT = (float*)(a.ws + WS_TOKWT); unsigned char* HP8 = a.ws + WS_HP;
    const int jm = li >> 1;
    LAS float* Rt = (LAS float*)F.lds;
    LAS int* lcnt = (LAS int*)(F.lds + 32768);
    LAS int* lbase = (LAS int*)(F.lds + 32768 + 64);
    LAS int* rinfo = (LAS int*)(F.lds + 32768 + 128);
    LAS float* rwt = (LAS float*)(F.lds + 32768 + 128 + 72 * 16);
    const float* router = a.in[25] + (size_t)jm * 1024 * 8;
    for (int i = F.tid; i < 8192; i += NWAVES * 64) { const int col = i >> 3, e = i & 7; Rt[e * 1024 + col] = router[i]; }
    if (F.tid < 8) lcnt[F.tid] = 0;
    __syncthreads();
    const float* gn = a.in[7] + li * 1024;
    gu32* CNT = F.ctl + CW_CNT + 16 * jm;
    for (int base = F.bid * RPW; base < nrows; base += F.G * RPW) {
        for (int i = 0; i < 9; ++i) {
            const int lr = F.wave * 9 + i, row = base + lr;
            if (row < nrows) {
                const int mr = (row < ML) ? (row >> 11) : 8; const float* mp = MOD + (size_t)(li * 9 + mr) * 6144 + 3 * 1024;
                f32x4 h[4];
                const bool part = (nS > 0) && (row >= rs0);
                norm_row_core(nullptr, X + (size_t)row * 1024, part ? X + (size_t)row * 1024 : nullptr, nullptr, nullptr, gn, mp + 1024, mp, (bf16*)((unsigned char*)H + (size_t)row * 1024), F.lane, h,
                              part ? (const float*)((const bf16*)(a.ws + WS_PB) + (size_t)(row - rs0) * 1024) : nullptr, nS, part ? pgate + (size_t)mr * 6144 : nullptr, true);
                float lg[8];
#pragma unroll
                for (int e = 0; e < 8; ++e) { float p = 0.f;
#pragma unroll
                    for (int j = 0; j < 4; ++j) { const f32x4 rv = *(const LAS f32x4*)(Rt + e * 1024 + 4 * F.lane + 256 * j); p += (h[j].x * rv.x + h[j].y * rv.y) + (h[j].z * rv.z + h[j].w * rv.w); }
                    lg[e] = wave_sum(p); }
                int i0 = 0; float l0 = lg[0];
#pragma unroll
                for (int e = 1; e < 8; ++e) if (lg[e] > l0) { l0 = lg[e]; i0 = e; }
                int i1 = -1; float l1 = -3.0e38f;
#pragma unroll
                for (int e = 0; e < 8; ++e) if (e != i0 && lg[e] > l1) { l1 = lg[e]; i1 = e; }
                const float w0 = 1.0f / (1.0f + __expf(l1 - l0)), w1 = 1.0f - w0;
                if (F.lane == 0) { const int r0 = __hip_atomic_fetch_add(lcnt + i0, 1, __ATOMIC_RELAXED, __HIP_MEMORY_SCOPE_WORKGROUP), r1 = __hip_atomic_fetch_add(lcnt + i1, 1, __ATOMIC_RELAXED, __HIP_MEMORY_SCOPE_WORKGROUP);
                    rinfo[lr * 4 + 0] = i0; rinfo[lr * 4 + 1] = i1; rinfo[lr * 4 + 2] = r0; rinfo[lr * 4 + 3] = r1; rwt[lr * 2] = w0; rwt[lr * 2 + 1] = w1; }
            }
        }
        __syncthreads();
        if (F.tid < 8) { const int c = lcnt[F.tid]; lbase[F.tid] = (int)__hip_atomic_fetch_add(CNT + F.tid, (unsigned)c, RLX_AGENT); lcnt[F.tid] = 0; }
        __syncthreads();
        if (F.tid < RPW) { const int row = base + F.tid; if (row < nrows) { const int e0 = rinfo[F.tid * 4], e1 = rinfo[F.tid * 4 + 1];
            const int p0 = lbase[e0] + rinfo[F.tid * 4 + 2], p1 = lbase[e1] + rinfo[F.tid * 4 + 3]; const float w0 = rwt[F.tid * 2], w1 = rwt[F.tid * 2 + 1];
            TOKI[row] = make_int4(e0 | (e1 << 8), p0, p1, 0); TOKW[row] = make_float2(w0, w1);
            TOKLIST[e0 * CAP + p0] = row * 2; TOKWT[e0 * CAP + p0] = w0; TOKLIST[e1 * CAP + p1] = row * 2 + 1; TOKWT[e1 * CAP + p1] = w1; } }
        for (int i = 0; i < 9; ++i) { const int lr = F.wave * 9 + i, row = base + lr;
            if (row < nrows) { const int e0 = rinfo[lr * 4], e1 = rinfo[lr * 4 + 1]; const int p0 = lbase[e0] + rinfo[lr * 4 + 2], p1 = lbase[e1] + rinfo[lr * 4 + 3];
                const v4u q = *((const GAS v4u*)((const unsigned char*)H + (size_t)row * 1024) + F.lane);
                *((GAS v4u*)(HP8 + ((size_t)e0 * CAP + p0) * 1024) + F.lane) = q; *((GAS v4u*)(HP8 + ((size_t)e1 * CAP + p1) * 1024) + F.lane) = q; } }
        __syncthreads();
    }
}
struct MoeSeg { int np[8]; int pst[9]; int cnt[8]; };
__device__ __forceinline__ void moe_seg(Frame& F, int jm, MoeSeg& s) {
    gu32* CNT = F.ctl + CW_CNT + 16 * jm; int acc = 0;
#pragma unroll
    for (int e = 0; e < 8; ++e) { const int c = __builtin_amdgcn_readfirstlane((int)__hip_atomic_load(CNT + e, RLX_AGENT)); s.cnt[e] = c; s.np[e] = (c + 255) >> 8; s.pst[e] = acc; acc += s.np[e]; }
    s.pst[8] = acc;
}
__device__ __forceinline__ int seg_start(const MoeSeg& s, int e) { int r = 0;
#pragma unroll
    for (int q = 0; q < 8; ++q) r += (q < e) ? s.np[q] : 0;
    return r; }
struct MoeOrder {
    int pst[9]; int cnt[8]; int nt, G, c, ntk; bool apan;
    int F_, R, S;
    __device__ __forceinline__ void no_split() { F_ = 0x7fffffff; R = 0; S = 1; }
    __device__ __forceinline__ void split_tail() { const int U = pst[8] * nt; F_ = (U / G) * G; R = U - F_; S = 1;
        if (R > 0) { S = (R * 7 <= G) ? 7 : (R * 2 <= G) ? 2 : 1; } if (S == 1) no_split(); }
    __device__ __forceinline__ int ps0() const { return (R > 0) ? (F_ / nt) * 256 : 0x7fffffff; }
    __device__ __forceinline__ int psrows() const { return (R > 0) ? ((R + nt - 1) / nt) * 256 : 0; }
    __device__ __forceinline__ bool next(int i, pg8::Unit& u) const {
        const int vc = (G % 8 == 0) ? (c % 8) * (G / 8) + c / 8 : c;
        const int L = i * G + vc; const int U = pst[8] * nt; const bool full = L < F_; const int q = L - F_;
        if (full ? (L >= U) : (q >= R * S)) return false;
        const int t2 = q / S, sp = q - t2 * S, nts = ntk / S; const int tile = full ? L : F_ + t2;
        const int nig = 8 * nt, grp = tile / nig, rr = tile - grp * nig, fm = grp * 8, gsz = (pst[8] - fm < 8) ? pst[8] - fm : 8;
        const int j = rr / gsz, p = fm + (rr - j * gsz); int e = 0;
#pragma unroll
        for (int q2 = 1; q2 < 8; ++q2) e += (p >= pst[q2]) ? 1 : 0;
        int ps = 0, cn = 0;
#pragma unroll
        for (int q2 = 0; q2 < 8; ++q2) { ps = (q2 == e) ? pst[q2] : ps; cn = (q2 == e) ? cnt[q2] : cn; }
        u.pm = p; u.e = e; u.j = j; u.pn = e * nt + j; u.k0 = full ? 0 : sp * nts * 64; u.nt = full ? ntk : nts; u.s = full ? 0 : sp + 1; u.pl = p - ps; u.cn = cn;
        u.pa = apan ? e * (CAP / 256) + (p - ps) : p; return true;
    }
    __device__ __forceinline__ void a_ready(const pg8::Unit&) const {}
    __device__ __forceinline__ void done(const pg8::Unit&) const {}
};

struct SplitOrder {
    int F_, R, S, ntk, G, vc;
    __device__ __forceinline__ void init(int M, int K, int G_, int c) { const int T = (M >> 8) * 4; G = G_; F_ = (T / G) * G; R = T - F_; ntk = K >> 6; vc = (G % 8 == 0) ? (c % 8) * (G / 8) + c / 8 : c;
        S = 1; if (R > 0) { const int want = (K == 3584 || K == 1792) ? 7 : (K == 2048 ? 8 : 4);   if (R * want <= G) S = want; } }
    __device__ __forceinline__ bool next(int i, pg8::Unit& u) const { const int L = i * G + vc; const bool full = L < F_; const int q = L - F_;
        if (!full && q >= R * S) return false;
        const int t2 = q / S, sp = q - t2 * S, nts = ntk / S; const int tile = full ? L : F_ + t2;
        u.e = full ? 0 : sp + 1; u.nt = full ? ntk : nts; u.k0 = full ? 0 : sp * nts * 64; u.pm = tile >> 2; u.pn = tile & 3; u.j = tile & 3; u.s = 0; u.pa = u.pm; u.pl = 0; u.cn = 0; return true; }
    __device__ __forceinline__ int nsplit() const { return R > 0 ? S : 0; }
    __device__ __forceinline__ int rs0() const { return (F_ >> 2) << 8; }
    __device__ __forceinline__ void a_ready(const pg8::Unit&) const {}
    __device__ __forceinline__ void done(const pg8::Unit&) const {}
};

__device__ __forceinline__ void gate_units(const Args& a, Frame& F, int j, int ubeg, int uend) {
    typedef short s16x4 __attribute__((ext_vector_type(4)));
    LAS float* stat = (LAS float*)F.lds;
    LAS bf16* VL = (LAS bf16*)(F.lds + 1024);
    LAS bf16* WSl = (LAS bf16*)(F.lds + 1024 + 34816);
    const bf16* U = (const bf16*)(a.ws + WS_U); const bf16* V = (const bf16*)(a.ws + WS_V); bf16* YAB = (bf16*)(a.ws + WS_YAB); const bf16* WSB = (const bf16*)(a.ws + WS_WSB);
    const float* STATS = (const float*)(a.ws + WS_STATS);
    const int lane = F.lane, w = F.wave, li15 = lane & 15, lq = lane >> 4, pr = 16 * w + li15;
    if (ubeg >= uend) return;
    v4u raw[4], wsv[4], uu[4]; float bsv; f32x4 lnv[4];
#define GT_LOAD(u_) do { const int n_ = (u_) >> 3, g_ = (u_) & 7, r0_ = n_ * 128; \
        _Pragma("unroll") for (int i = 0; i < 4; ++i) { const int idx = F.tid + 512 * i, p = idx >> 4, c8 = (idx & 15) << 3; \
            wsv[i] = *(const GAS v4u*)(WSB + ((size_t)((j * 8 + g_) * 128 + p)) * 128 + c8); raw[i] = *(const GAS v4u*)(V + (size_t)(r0_ + p) * 1024 + g_ * 128 + c8); } \
        _Pragma("unroll") for (int n2 = 0; n2 < 4; ++n2) uu[n2] = *(const GAS v4u*)(U + (size_t)(r0_ + pr) * 1024 + g_ * 128 + 32 * n2 + 8 * lq); \
        bsv = a.in[12][j * 1024 + g_ * 128 + pr]; \
        { const float* lg_ = a.in[9] + j * 1024 + g_ * 128 + ((F.tid & 15) << 3); const float* lb_ = a.in[10] + j * 1024 + g_ * 128 + ((F.tid & 15) << 3); \
          lnv[0] = *(const GAS f32x4*)lg_; lnv[1] = *(const GAS f32x4*)(lg_ + 4); lnv[2] = *(const GAS f32x4*)lb_; lnv[3] = *(const GAS f32x4*)(lb_ + 4); } } while (0)
    GT_LOAD(ubeg);
    int cur_n = -1;
    for (int u = ubeg; u < uend; ++u) {
        const int n = u >> 3, g = u & 7, r0 = n * 128;
        if (n != cur_n) { cur_n = n;
            if (F.tid < 128) { const float* sp = STATS + (size_t)(r0 + F.tid) * 32; float s1 = 0.f, s2 = 0.f;
#pragma unroll
                for (int i = 0; i < 8; ++i) { const f32x4 v = *(const GAS f32x4*)(sp + 4 * i); s1 += v.x + v.z; s2 += v.y + v.w; }
                const float mean = s1 * (1.0f / 1024.0f), var = s2 * (1.0f / 1024.0f) - mean * mean; stat[2 * F.tid] = mean; stat[2 * F.tid + 1] = 1.0f / sqrtf(fmaxf(var, 0.f) + EPS); } }
#pragma unroll
        for (int i = 0; i < 4; ++i) { const int idx = F.tid + 512 * i, p = idx >> 4, c8 = (idx & 15) << 3; *(LAS v4u*)(WSl + p * 136 + c8) = wsv[i]; }
        __syncthreads();
#pragma unroll
        for (int i = 0; i < 4; ++i) { const int idx = F.tid + 512 * i, p = idx >> 4, c8 = (idx & 15) << 3; const float mean = stat[2 * p], rstd = stat[2 * p + 1];
            const f32x4 ga = lnv[0], gb = lnv[1], ba = lnv[2], bb = lnv[3];
            v4u o; o.x = pkbf((bflo(raw[i].x) - mean) * rstd * ga.x + ba.x, (bfhi(raw[i].x) - mean) * rstd * ga.y + ba.y); o.y = pkbf((bflo(raw[i].y) - mean) * rstd * ga.z + ba.z, (bfhi(raw[i].y) - mean) * rstd * ga.w + ba.w);
            o.z = pkbf((bflo(raw[i].z) - mean) * rstd * gb.x + bb.x, (bfhi(raw[i].z) - mean) * rstd * gb.y + bb.y); o.w = pkbf((bflo(raw[i].w) - mean) * rstd * gb.z + bb.z, (bfhi(raw[i].w) - mean) * rstd * gb.w + bb.w);
            { const int g2 = c8 >> 5, a4 = ((c8 & 31) >> 3) << 2; v2u lo2, hi2; lo2.x = o.x; lo2.y = o.y; hi2.x = o.z; hi2.y = o.w;
              *(LAS v2u*)(VL + p * 136 + 32 * g2 + a4) = lo2; *(LAS v2u*)(VL + p * 136 + 32 * g2 + 16 + a4) = hi2; } }
        v4u cu[4]; const float cb = bsv;
#pragma unroll
        for (int n2 = 0; n2 < 4; ++n2) cu[n2] = uu[n2];
        __syncthreads();
        if (u + 1 < uend) GT_LOAD(u + 1);
        f32x4 acc[8];
#pragma unroll
        for (int nt = 0; nt < 8; ++nt) acc[nt] = (f32x4){0.f, 0.f, 0.f, 0.f};
#pragma unroll
        for (int ks = 0; ks < 4; ++ks) { const bf16x8 wf = *(const LAS bf16x8*)(WSl + pr * 136 + 32 * ks + 8 * lq);
#pragma unroll
            for (int nt = 0; nt < 8; ++nt) { const LAS bf16* vp = VL + (32 * ks + 8 * lq + (li15 >> 2)) * 136 + 16 * nt + 4 * (li15 & 3);
                const s16x4 lo = __builtin_bit_cast(s16x4, __builtin_amdgcn_ds_read_tr16_b64_v4i16((LAS s16x4*)vp));
                const s16x4 hi = __builtin_bit_cast(s16x4, __builtin_amdgcn_ds_read_tr16_b64_v4i16((LAS s16x4*)(vp + 4 * 136)));
                const bf16x8 vf = __builtin_shufflevector(lo, hi, 0, 1, 2, 3, 4, 5, 6, 7);
                acc[nt] = __builtin_amdgcn_mfma_f32_16x16x32_bf16(vf, wf, acc[nt], 0, 0, 0); } }
#pragma unroll
        for (int n2 = 0; n2 < 4; ++n2) { const f32x4 a0 = acc[2 * n2], a1 = acc[2 * n2 + 1]; const v4u uv = cu[n2]; v4u o;
            o.x = pkbf(bflo(uv.x) * (a0[0] + cb), bfhi(uv.x) * (a0[1] + cb)); o.y = pkbf(bflo(uv.y) * (a0[2] + cb), bfhi(uv.y) * (a0[3] + cb));
            o.z = pkbf(bflo(uv.z) * (a1[0] + cb), bfhi(uv.z) * (a1[1] + cb)); o.w = pkbf(bflo(uv.w) * (a1[2] + cb), bfhi(uv.w) * (a1[3] + cb));
            *(GAS v4u*)(YAB + (size_t)(r0 + pr) * 2048 + g * 128 + 32 * n2 + 8 * lq) = o; }
        __syncthreads();
    }
#undef GT_LOAD
}
__device__ __forceinline__ int seq_lo(int r) { return (r < ML) ? (r & ~2047) : (ML + ((r - ML) & ~255)); }
__device__ __forceinline__ void conv_phase(const Args& a, Frame& F, int j) {
    LAS float* wl = (LAS float*)F.lds;
    LAS float* cbl = wl + 32 * 1024;
    LAS float* cgl = cbl + 1024;
    const bf16* G = (const bf16*)(a.ws + WS_G); bf16* YAB = (bf16*)(a.ws + WS_YAB);
    __syncthreads();
    for (int i = F.tid; i < 31 * 256; i += NWAVES * 64) *(LAS f32x4*)(wl + 4 * i) = *(const GAS f32x4*)(a.in[13] + (size_t)j * 31 * 1024 + 4 * i);
    if (F.tid >= 256) *(LAS f32x4*)(wl + 31 * 1024 + 4 * (F.tid - 256)) = (f32x4){0.f, 0.f, 0.f, 0.f};
    if (F.tid < 256) { *(LAS f32x4*)(cbl + 4 * F.tid) = *(const GAS f32x4*)(a.in[14] + j * 1024 + 4 * F.tid); *(LAS f32x4*)(cgl + 4 * F.tid) = *(const GAS f32x4*)(a.in[15] + j * 1024 + 4 * F.tid); }
    __syncthreads();
    const int lane = F.lane, gw = F.bid * NWAVES + F.wave, NGW = F.G * NWAVES;
#define CV_LOAD(dst, ri, cbase) do { const int row_ = r0 - 15 + ((ri) > 33 ? 33 : (ri)); const int rc_ = row_ < lo ? lo : (row_ >= hi ? hi - 1 : row_); dst = *(const GAS v4u*)(G + (size_t)rc_ * 1024 + (cbase)); } while (0)
#define CV_UNPACK(src, ri, d) do { const int row_ = r0 - 15 + (ri); const unsigned mk_ = (row_ >= lo && row_ < hi) ? 0xffffffffu : 0u; const unsigned x0_ = src.x & mk_, x1_ = src.y & mk_, x2_ = src.z & mk_, x3_ = src.w & mk_; \
        d[0] = (f32x4){bflo(x0_), bfhi(x0_), bflo(x1_), bfhi(x1_)}; d[1] = (f32x4){bflo(x2_), bfhi(x2_), bflo(x3_), bfhi(x3_)}; } while (0)
    for (int u = gw; u < MT / 3; u += NGW) {
        const int r0 = 3 * u; const int loA = seq_lo(r0), loB = seq_lo(r0 + 2); const int npass = (loA != loB) ? 2 : 1;
        for (int pass = 0; pass < npass; ++pass) {
            const int lo = pass ? loB : loA, hi = lo + ((lo < ML) ? 2048 : 256);
            f32x4 acc[2][3][2];
#pragma unroll
            for (int h = 0; h < 2; ++h) {
                const int cbase = 512 * h + 8 * lane;
                const f32x4 b0 = *(const LAS f32x4*)(cbl + cbase), b1 = *(const LAS f32x4*)(cbl + cbase + 4);
#pragma unroll
                for (int t = 0; t < 3; ++t) { acc[h][t][0] = b0; acc[h][t][1] = b1; }
                f32x4 ring[4][2]; v4u TA[8], TB[8];
#define CV_TRIP(itv, TT, WB, KREL) _Pragma("unroll") for (int s2 = 0; s2 < 8; ++s2) { const int k = 8 * (itv) + s2; \
                        CV_UNPACK(TT[s2], k + 2, ring[(s2 + 2) % 4]); \
                        CV_LOAD(TT[s2], 8 * ((itv) + 2) + s2 + 2, cbase); __builtin_amdgcn_sched_barrier(0x38F); \
                        const f32x4 w0 = *(const LAS f32x4*)(WB + ((KREL) + s2) * 1024), w1 = *(const LAS f32x4*)(WB + ((KREL) + s2) * 1024 + 4); \
                        _Pragma("unroll") for (int t = 0; t < 3; ++t) { acc[h][t][0] = acc[h][t][0] + ring[(s2 + t) % 4][0] * w0; acc[h][t][1] = acc[h][t][1] + ring[(s2 + t) % 4][1] * w1; } }
                { v4u a0, a1; CV_LOAD(a0, 0, cbase); CV_LOAD(a1, 1, cbase);
#pragma unroll
                  for (int s2 = 0; s2 < 8; ++s2) CV_LOAD(TA[s2], s2 + 2, cbase);
#pragma unroll
                  for (int s2 = 0; s2 < 8; ++s2) CV_LOAD(TB[s2], s2 + 10, cbase);
                  CV_UNPACK(a0, 0, ring[0]); CV_UNPACK(a1, 1, ring[1]); }
#pragma unroll 1
                for (int ip = 0; ip < 2; ++ip) {
                    const LAS float* wb = wl + cbase + 16 * ip * 1024;
                    CV_TRIP(2 * ip, TA, wb, 0)
                    CV_TRIP(2 * ip + 1, TB, wb, 8)
                }
#undef CV_TRIP
            }
#pragma unroll
            for (int t = 0; t < 3; ++t) { float ss = 0.f;
#pragma unroll
                for (int h = 0; h < 2; ++h)
#pragma unroll
                    for (int q = 0; q < 2; ++q) { const f32x4 v = acc[h][t][q]; ss += (v.x * v.x + v.y * v.y) + (v.z * v.z + v.w * v.w); }
                const float r = 1.0f / sqrtf(wave_sum(ss) * (1.0f / 1024.0f) + EPS); const int row = r0 + t;
                if (row >= lo && row < hi) {
#pragma unroll
                    for (int h = 0; h < 2; ++h) { const int cbase = 512 * h + 8 * lane; const f32x4 g0 = *(const LAS f32x4*)(cgl + cbase), g1 = *(const LAS f32x4*)(cgl + cbase + 4);
                        const f32x4 y0 = acc[h][t][0] * r * g0, y1 = acc[h][t][1] * r * g1; v4u o;
                        o.x = pkbf(y0.x * fsigm(y0.x), y0.y * fsigm(y0.y)); o.y = pkbf(y0.z * fsigm(y0.z), y0.w * fsigm(y0.w)); o.z = pkbf(y1.x * fsigm(y1.x), y1.y * fsigm(y1.y)); o.w = pkbf(y1.z * fsigm(y1.z), y1.w * fsigm(y1.w));
                        *(GAS v4u*)(YAB + (size_t)row * 2048 + 1024 + cbase) = o; } } }
        }
    }
#undef CV_LOAD
#undef CV_UNPACK
    __syncthreads();
}
__device__ __forceinline__ void mix_phase(const Args& a, Frame& F, int j) {
#ifndef MK_GATE_REP
#define MK_GATE_REP 1
#endif
#ifndef MK_CONV_REP
#define MK_CONV_REP 1
#endif
    for (int rep = 0; rep < MK_GATE_REP; ++rep)
    gate_units(a, F, j, (int)(((long)F.bid * 1152) / F.G), (int)(((long)(F.bid + 1) * 1152) / F.G));
    for (int rep = 0; rep < MK_CONV_REP; ++rep)
    conv_phase(a, F, j);
}

__device__ __forceinline__ void qkrope_phase(const Args& a, Frame& F, int jm, int nrows) {
    const int gw = F.bid * NWAVES + F.wave, NGW = F.G * NWAVES, lane = F.lane;
    const bf16* QKV = (const bf16*)(a.ws + WS_QKV); bf16* Q = (bf16*)(a.ws + WS_Q); bf16* Kb = (bf16*)(a.ws + WS_K); const float* ROPE = (const float*)(a.ws + WS_ROPE);
    const float* qg = a.in[18] + jm * 64; const float* kg = a.in[19] + jm * 64; const int sub = lane & 15;
    float gq[4], gk[4];
#pragma unroll
    for (int k = 0; k < 4; ++k) { gq[k] = qg[sub + 16 * k]; gk[k] = kg[sub + 16 * k]; }
    for (int row = gw; row < nrows; row += NGW) {
        const bool lat = row < ML; float cr = 1.f, sr = 0.f, cc = 1.f, sc = 0.f;
        if (lat) { const int t = row & 2047, pr = t >> 6, pc = t & 63; const float2 a0 = *(const float2*)(ROPE + (pr * 16 + sub) * 2), a1 = *(const float2*)(ROPE + (pc * 16 + sub) * 2); cr = a0.x; sr = a0.y; cc = a1.x; sc = a1.y; }
#pragma unroll
        for (int hg = 0; hg < 5; ++hg) { const int head = 4 * hg + (lane >> 4); const bf16* src = QKV + (size_t)row * 1536 + head * 64 + sub;
            float x[4];
#pragma unroll
            for (int k = 0; k < 4; ++k) x[k] = bf2f(src[16 * k]);
            float ss = (x[0] * x[0] + x[1] * x[1]) + (x[2] * x[2] + x[3] * x[3]);
            ss += __shfl_xor(ss, 1); ss += __shfl_xor(ss, 2); ss += __shfl_xor(ss, 4); ss += __shfl_xor(ss, 8);
            const float r = 1.0f / sqrtf(ss * (1.0f / 64.0f) + EPS);
            float y[4];
#pragma unroll
            for (int k = 0; k < 4; ++k) y[k] = x[k] * r * (hg < 4 ? gq[k] : gk[k]);
            float o[4]; o[0] = y[0] * cr - y[1] * sr; o[1] = y[1] * cr + y[0] * sr; o[2] = y[2] * cc - y[3] * sc; o[3] = y[3] * cc + y[2] * sc;
            if (hg < 4) { bf16* d = Q + (size_t)row * 1024 + head * 64 + sub;
#pragma unroll
                for (int k = 0; k < 4; ++k) d[16 * k] = (bf16)(pkbf(o[k] * QSCALE, 0.f) & 0xffffu); }
            else { bf16* d = Kb + (size_t)row * 256 + (head - 16) * 64 + sub;
#pragma unroll
                for (int k = 0; k < 4; ++k) d[16 * k] = (bf16)(pkbf(o[k], 0.f) & 0xffffu); } }
    }
}
__device__ __forceinline__ void attn_phase(const Args& a, Frame& F, int jm, int nunits) {
    typedef short s16x4 __attribute__((ext_vector_type(4)));
    const bf16* Q = (const bf16*)(a.ws + WS_Q); const bf16* Kb = (const bf16*)(a.ws + WS_K); const bf16* Vb = (const bf16*)(a.ws + WS_QKV); bf16* O = (bf16*)(a.ws + WS_O);
    LAS bf16* Kl = (LAS bf16*)F.lds;
    LAS bf16* Vl = (LAS bf16*)(F.lds + 18432);
    const int lane = F.lane, w = F.wave, li15 = lane & 15, lq = lane >> 4, hsel = w >> 2, qw = (w & 3) * 32;
    const int lkey = F.tid >> 3, ld8 = (F.tid & 7) << 3;
#define KROW(si) (((si) < nw) ? (b * 2048 + q0 - 128 + 64 * (wlo + (si))) : (ML + b * 256 + 64 * ((si) - nw)))
    const int vcu = (F.G % 8 == 0) ? (F.bid % 8) * (F.G / 8) + F.bid / 8 : F.bid;
    for (int ui = vcu; ui < nunits; ui += F.G) {
        int b, hp, q0, qrow0, wlo, nw;
        if (ui < 1024) { b = ui >> 7; hp = (ui >> 4) & 7; const int qb = ui & 15; q0 = qb * 128; qrow0 = b * 2048 + q0; wlo = (qb == 0) ? 2 : 0; nw = (qb == 0 || qb == 15) ? 4 : 6; }
        else { const int v = ui - 1024; b = v >> 4; hp = (v >> 1) & 7; q0 = (v & 1) * 128; qrow0 = ML + b * 256 + q0; wlo = 0; nw = 0; }
        const int ntile = nw + 4, hq = 2 * hp + hsel, kvh = hp >> 1;
        const bf16* qp = Q + (size_t)(qrow0 + qw + li15) * 1024 + hq * 64 + 8 * lq;
        bf16x8 qf[2][2];
#pragma unroll
        for (int mt = 0; mt < 2; ++mt)
#pragma unroll
            for (int ks = 0; ks < 2; ++ks) qf[mt][ks] = *(const GAS bf16x8*)(qp + (size_t)mt * 16 * 1024 + 32 * ks);
        const float sinkv = a.in[20][jm * 16 + hq] * LOG2E;
        float m[2], l[2]; f32x4 o[2][4];
#pragma unroll
        for (int mt = 0; mt < 2; ++mt) { m[mt] = sinkv; l[mt] = (lq == 0) ? 1.0f : 0.0f;
#pragma unroll
            for (int dt = 0; dt < 4; ++dt) o[mt][dt] = (f32x4){0.f, 0.f, 0.f, 0.f}; }
        v4u kreg[2], vreg[2];
#pragma unroll
        for (int h = 0; h < 2; ++h) { const int kr = KROW(h); kreg[h] = *(const GAS v4u*)(Kb + (size_t)(kr + lkey) * 256 + kvh * 64 + ld8); vreg[h] = *(const GAS v4u*)(Vb + (size_t)(kr + lkey) * 256 + kvh * 64 + ld8); }
        for (int si0 = 0; si0 < ntile; si0 += 2)
#pragma unroll
        for (int h = 0; h < 2; ++h) {
            const int si = si0 + h; const int bo = h * 4608;
            *(LAS v4u*)(Kl + bo + lkey * 72 + ld8) = kreg[h]; *(LAS v4u*)(Vl + bo + lkey * 72 + ld8) = vreg[h];
            if (si + 2 < ntile) { const int kr = KROW(si + 2);
                kreg[h] = *(const GAS v4u*)(Kb + (size_t)(kr + lkey) * 256 + kvh * 64 + ld8); vreg[h] = *(const GAS v4u*)(Vb + (size_t)(kr + lkey) * 256 + kvh * 64 + ld8); }
            __syncthreads();
            f32x4 s[2][4];
#pragma unroll
            for (int kt = 0; kt < 4; ++kt) { const LAS bf16* kp = Kl + bo + (16 * kt + li15) * 72 + 8 * lq; const bf16x8 k0 = *(const LAS bf16x8*)kp, k1 = *(const LAS bf16x8*)(kp + 32);
#pragma unroll
                for (int mt = 0; mt < 2; ++mt) { s[mt][kt] = __builtin_amdgcn_mfma_f32_16x16x32_bf16(k0, qf[mt][0], (f32x4){0.f, 0.f, 0.f, 0.f}, 0, 0, 0);
                    s[mt][kt] = __builtin_amdgcn_mfma_f32_16x16x32_bf16(k1, qf[mt][1], s[mt][kt], 0, 0, 0); } }
            const int tt = wlo + si;
            if (si < nw && (tt < 2 || tt > 3)) { const int kpos0 = q0 - 128 + 64 * tt; asm volatile("; window-edge tile" ::: "memory");
#pragma unroll
                for (int mt = 0; mt < 2; ++mt) { const int qpos = q0 + qw + 16 * mt + li15;
#pragma unroll
                    for (int kt = 0; kt < 4; ++kt)
#pragma unroll
                        for (int jj = 0; jj < 4; ++jj) { const int dlt = qpos - (kpos0 + 16 * kt + 4 * lq + jj); if (dlt > 128 || dlt < -128) s[mt][kt][jj] = -INFINITY; } } }
            bf16x8 pb[2][2]; float lm[2];
#pragma unroll
            for (int mt = 0; mt < 2; ++mt) { const f32x4 mv = (f32x4){m[mt], m[mt], m[mt], m[mt]};
#pragma unroll
                for (int kt = 0; kt < 4; ++kt) s[mt][kt] = s[mt][kt] - mv;
                float tm = fmaxf(fmaxf(s[mt][0][0], s[mt][0][1]), fmaxf(s[mt][0][2], s[mt][0][3]));
#pragma unroll
                for (int kt = 1; kt < 4; ++kt) tm = fmaxf(tm, fmaxf(fmaxf(s[mt][kt][0], s[mt][kt][1]), fmaxf(s[mt][kt][2], s[mt][kt][3])));
                lm[mt] = tm; }
            if (__builtin_amdgcn_ballot_w64(fmaxf(lm[0], lm[1]) > 8.0f) != 0ull) {
                asm volatile("; raise the references" ::: "memory");
#pragma unroll
                for (int mt = 0; mt < 2; ++mt) { float tm = lm[mt]; tm = fmaxf(tm, __shfl_xor(tm, 16)); tm = fmaxf(tm, __shfl_xor(tm, 32));
                    const float dl = fmaxf(tm, 0.f), alpha = __builtin_amdgcn_exp2f(-dl); m[mt] += dl; l[mt] *= alpha; const f32x4 dv = (f32x4){dl, dl, dl, dl};
#pragma unroll
                    for (int kt = 0; kt < 4; ++kt) s[mt][kt] = s[mt][kt] - dv;
#pragma unroll
                    for (int dt = 0; dt < 4; ++dt) o[mt][dt] = o[mt][dt] * alpha; } }
#pragma unroll
            for (int mt = 0; mt < 2; ++mt) {
                f32x4 lsv = (f32x4){0.f, 0.f, 0.f, 0.f};
#pragma unroll
                for (int kt = 0; kt < 4; ++kt) { f32x4 pv;
#pragma unroll
                    for (int jj = 0; jj < 4; ++jj) pv[jj] = __builtin_amdgcn_exp2f(s[mt][kt][jj]);
                    s[mt][kt] = pv; lsv = lsv + pv; }
                l[mt] += (lsv[0] + lsv[1]) + (lsv[2] + lsv[3]);
#pragma unroll
                for (int s2 = 0; s2 < 2; ++s2) { v4u pw; pw.x = pkbf(s[mt][2 * s2][0], s[mt][2 * s2][1]); pw.y = pkbf(s[mt][2 * s2][2], s[mt][2 * s2][3]);
                    pw.z = pkbf(s[mt][2 * s2 + 1][0], s[mt][2 * s2 + 1][1]); pw.w = pkbf(s[mt][2 * s2 + 1][2], s[mt][2 * s2 + 1][3]); pb[mt][s2] = __builtin_bit_cast(bf16x8, pw); }
            }
#pragma unroll
            for (int s2 = 0; s2 < 2; ++s2)
#pragma unroll
                for (int dt = 0; dt < 4; ++dt) { const LAS bf16* vp = Vl + bo + (32 * s2 + 4 * lq + (li15 >> 2)) * 72 + 16 * dt + 4 * (li15 & 3);
                    const s16x4 lo = __builtin_bit_cast(s16x4, __builtin_amdgcn_ds_read_tr16_b64_v4i16((LAS s16x4*)vp));
                    const s16x4 hi = __builtin_bit_cast(s16x4, __builtin_amdgcn_ds_read_tr16_b64_v4i16((LAS s16x4*)(vp + 16 * 72)));
                    const bf16x8 af = __builtin_shufflevector(lo, hi, 0, 1, 2, 3, 4, 5, 6, 7);
#pragma unroll
                    for (int mt = 0; mt < 2; ++mt) o[mt][dt] = __builtin_amdgcn_mfma_f32_16x16x32_bf16(af, pb[mt][s2], o[mt][dt], 0, 0, 0); }
        }
#pragma unroll
        for (int mt = 0; mt < 2; ++mt) { float lt = l[mt]; lt += __shfl_xor(lt, 16); lt += __shfl_xor(lt, 32); const float inv = 1.0f / lt;
            bf16* op = O + (size_t)(qrow0 + qw + 16 * mt + li15) * 1024 + hq * 64 + 4 * lq;
#pragma unroll
            for (int dt = 0; dt < 4; ++dt) { v2u ov; ov.x = pkbf(o[mt][dt][0] * inv, o[mt][dt][1] * inv); ov.y = pkbf(o[mt][dt][2] * inv, o[mt][dt][3] * inv); *(GAS v2u*)(op + 16 * dt) = ov; } }
    }
#undef KROW
}
__device__ __forceinline__ void final_phase(const Args& a, Frame& F) {
    const int gw = F.bid * NWAVES + F.wave, NGW = F.G * NWAVES, lane = F.lane;
    const bf16* X = (const bf16*)(a.ws + WS_X); const bf16* YS = (const bf16*)(a.ws + WS_YS); const float* MOD = (const float*)(a.ws + WS_MOD); const bf16* PB = (const bf16*)(a.ws + WS_PB);
    const int4* TOKI = (const int4*)(a.ws + WS_TOKI); const float2* TOKW = (const float2*)(a.ws + WS_TOKW);
    MoeSeg sg; moe_seg(F, 1, sg); MoeOrder S;
#pragma unroll
    for (int q = 0; q < 9; ++q) S.pst[q] = sg.pst[q];
#pragma unroll
    for (int q = 0; q < 8; ++q) S.cnt[q] = sg.cnt[q];
    S.apan = false; S.nt = 4; S.G = F.G; S.c = 0; S.ntk = 28; S.split_tail();
    const int ps0 = S.ps0(), psrows = S.psrows(), nS = S.S;
    for (int row = gw; row < ML; row += NGW) {
        const float* g2p = MOD + (size_t)(3 * 9 + (row >> 11)) * 6144 + 5 * 1024; const bf16* ys = YS + (size_t)row * 2048;
        const int4 ti = TOKI[row]; const float2 tw = TOKW[row];
        const int p0 = seg_start(sg, ti.x & 255) * 256 + ti.y, p1 = seg_start(sg, ti.x >> 8) * 256 + ti.z;
        f32x4 y[4];
#pragma unroll
        for (int j = 0; j < 4; ++j) y[j] = (f32x4){0.f, 0.f, 0.f, 0.f};
#pragma unroll
        for (int sl = 0; sl < 2; ++sl) { const int pr = sl ? p1 : p0; const float wsl = sl ? tw.y : tw.x;
            if (pr >= ps0) { f32x4 ps[4];
#pragma unroll
                for (int j = 0; j < 4; ++j) ps[j] = (f32x4){0.f, 0.f, 0.f, 0.f};
                for (int q = 0; q < nS; ++q) {
#pragma unroll
                    for (int j = 0; j < 4; ++j) { const v2u pp = *(const GAS v2u*)(PB + ((size_t)q * psrows + (size_t)(pr - ps0)) * 1024 + 4 * lane + 256 * j); ps[j] = ps[j] + (f32x4){bflo(pp.x), bfhi(pp.x), bflo(pp.y), bfhi(pp.y)}; } }
#pragma unroll
                for (int j = 0; j < 4; ++j) y[j] = y[j] + ps[j] * wsl; }
            else {
#pragma unroll
                for (int j = 0; j < 4; ++j) { const v2u yy = *(const GAS v2u*)(ys + sl * 1024 + 4 * lane + 256 * j); y[j] = y[j] + (f32x4){bflo(yy.x), bfhi(yy.x), bflo(yy.y), bfhi(yy.y)}; } } }
#pragma unroll
        for (int j = 0; j < 4; ++j) { const v2u xx = *(const GAS v2u*)(X + (size_t)row * 1024 + 4 * lane + 256 * j); f32x4 v = (f32x4){bflo(xx.x), bfhi(xx.x), bflo(xx.y), bfhi(xx.y)};
            const f32x4 g = *(const GAS f32x4*)(g2p + 4 * lane + 256 * j);
            __builtin_nontemporal_store(v + g * y[j], (GAS f32x4*)(a.out + (size_t)row * 1024 + 4 * lane + 256 * j)); }
    }
}

#define GRID_BAR() do { if (!MK_PER_PHASE) xcd_barrier(bar); } while (0)
#define IN(k) (lo <= (k) && (k) < hi)
#define BOTH(k) (IN(k) && IN((k) + 1))
#ifndef MK_MASK
#define MK_MASK 0xFFFFFFFFu
#endif
#define EN(b) (((MK_MASK) >> (b)) & 1u)
#ifndef MK_DUP_MASK
#define MK_DUP_MASK 0u
#endif
#define REP(b) ((((MK_DUP_MASK) >> (b)) & 1u) ? 3 : 1)
#define FRESH() do { int t_ = threadIdx.x, b_ = blockIdx.x; asm volatile("" : "+v"(t_)); asm volatile("" : "+s"(b_)); F.tid = t_; F.lane = t_ & 63; F.wave = __builtin_amdgcn_readfirstlane(t_ >> 6); F.bid = b_; } while (0)
template <int jp> __device__ __forceinline__ void layer_pair(const Args& args, Frame& F, const XcdBarrier& bar, const int lo, const int hi) {
    unsigned char* ws = args.ws;
    bf16* X = (bf16*)(ws + WS_X); const float* MOD = (const float*)(ws + WS_MOD); bf16* H = (bf16*)(ws + WS_H);
        const int pb = 1 + 16 * jp, le = 2 * jp, lo_ = 2 * jp + 1;
        const int rows_tail = (jp == 1) ? ML : MT;
        if (EN(1) && IN(pb + 0)) { FRESH();
_Pragma("unroll 1") for (int rep_ = 0; rep_ < REP(1); ++rep_) { if (jp == 1) { TailPlan tp; tail_plan(F.G, 1024, tp); conv_moe_all(args, F, 1, 2, 0, F.G, -1, tp.e[4] < moe_items(2) ? tp.e[4] : moe_items(2), moe_items(2)); }
            norm_phase(args, F, le, 0, MT, jp == 0, jp == 1 ? 1 : -1); if (rep_ + 1 < REP(1)) GRID_BAR(); } if (BOTH(pb + 0)) GRID_BAR(); }
        if (EN(2) && IN(pb + 1)) { FRESH();
_Pragma("unroll 1") for (int rep_ = 0; rep_ < REP(2); ++rep_) { pg8::Gemm g{H, (const bf16*)(ws + WS_WIN) + (size_t)jp * 4096 * 1024, MT, 4096, 1024}; pg8::StaticOrder S; S.init(MT, 4096, 1024, F.G, F.bid);
            pg8::EpiWin E{(bf16*)(ws + WS_U), (bf16*)(ws + WS_V), (bf16*)(ws + WS_G), (float*)(ws + WS_STATS)};
            pg8::gemm_phase<pg8::EpiWin, pg8::StaticOrder, true, true, 16>(F.lds + RING_OFF, g, S, E); { TailPlan tp; tail_plan(F.G, (jp == 1) ? 1024 : 1152, tp); tail_fill(args, F, tp, 0, jp, jp == 0 ? 0 : 2); } if (rep_ + 1 < REP(2)) GRID_BAR(); } if (BOTH(pb + 1)) GRID_BAR(); }
        if (EN(3) && IN(pb + 2)) { FRESH();
_Pragma("unroll 1") for (int rep_ = 0; rep_ < REP(3); ++rep_) { mix_phase(args, F, jp); if (rep_ + 1 < REP(3)) GRID_BAR(); } if (BOTH(pb + 2)) GRID_BAR(); }
        if (EN(4) && IN(pb + 3)) { FRESH();
_Pragma("unroll 1") for (int rep_ = 0; rep_ < REP(4); ++rep_) { pg8::Gemm g{(const bf16*)(ws + WS_YAB), (const bf16*)(ws + WS_WOUT) + (size_t)jp * 1024 * 2048, MT, 1024, 2048}; SplitOrder S; S.init(MT, 2048, F.G, F.bid);
            pg8::EpiResid E{X, MOD + (size_t)(le * 9) * 6144 + 2 * 1024, (float*)(ws + WS_PB), S.rs0(), args.gmul};
            pg8::gemm_phase<pg8::EpiResid, SplitOrder, true, true>(F.lds + RING_OFF, g, S, E); if (rep_ + 1 < REP(4)) GRID_BAR(); } if (BOTH(pb + 3)) GRID_BAR(); }
        if (EN(5) && IN(pb + 4)) { FRESH();
_Pragma("unroll 1") for (int rep_ = 0; rep_ < REP(5); ++rep_) { SplitOrder SP; SP.init(MT, 2048, F.G, F.bid); norm_phase(args, F, le, 1, MT, false, -1, SP.nsplit(), SP.rs0(), MOD + (size_t)(le * 9) * 6144 + 2 * 1024, MK_FP8_FFN2 && jp == 1); if (rep_ + 1 < REP(5)) GRID_BAR(); } if (BOTH(pb + 4)) GRID_BAR(); }
        if (EN(6) && IN(pb + 5)) { FRESH();
_Pragma("unroll 1") for (int rep_ = 0; rep_ < REP(6); ++rep_) { if (MK_FP8_FFN2 && jp == 1) { pg8::Gemm g{H, (const bf16*)(ws + WS_FF13) + (size_t)jp * 7168 * 1024, MT, 7168, 512}; pg8::StaticOrder S; S.init(MT, 7168, 512, F.G, F.bid);
            pg8::EpiSwiGLU8 E{(unsigned char*)(ws + WS_T), FF, 1.0f / F8_W13};
            pg8::gemm_phase<pg8::EpiSwiGLU8, pg8::StaticOrder, true, true, 8, true>(F.lds + RING_OFF, g, S, E); } else {
            pg8::Gemm g{H, (const bf16*)(ws + WS_FF13) + (size_t)jp * 7168 * 1024, MT, 7168, 1024}; pg8::StaticOrder S; S.init(MT, 7168, 1024, F.G, F.bid);
            pg8::EpiSwiGLU E{(bf16*)(ws + WS_T), FF, args.gmul};
            pg8::gemm_phase<pg8::EpiSwiGLU, pg8::StaticOrder, true, true, 16>(F.lds + RING_OFF, g, S, E); } { TailPlan tp; tail_plan(F.G, (jp == 1) ? 1024 : 1152, tp); tail_fill(args, F, tp, 1, jp, jp == 0 ? 0 : 2); } if (rep_ + 1 < REP(6)) GRID_BAR(); } if (BOTH(pb + 5)) GRID_BAR(); }
        if (EN(7) && IN(pb + 6)) { FRESH();
_Pragma("unroll 1") for (int rep_ = 0; rep_ < REP(7); ++rep_) { if (MK_FP8_FFN2 && jp == 1) { pg8::Gemm g{(const bf16*)(ws + WS_T), (const bf16*)(ws + WS_FF2) + (size_t)jp * 1024 * 3584, MT, 1024, FF / 2}; SplitOrder S; S.init(MT, FF / 2, F.G, F.bid);
            pg8::EpiResid E{X, MOD + (size_t)(le * 9) * 6144 + 5 * 1024, (float*)(ws + WS_PB), S.rs0(), args.gmul * (1.0f / F8_W2), 1.0f / F8_W2};
            pg8::gemm_phase<pg8::EpiResid, SplitOrder, true, true, 0, true>(F.lds + RING_OFF, g, S, E); } else {
            pg8::Gemm g{(const bf16*)(ws + WS_T), (const bf16*)(ws + WS_FF2) + (size_t)jp * 1024 * 3584, MT, 1024, FF}; SplitOrder S; S.init(MT, FF, F.G, F.bid);
            pg8::EpiResid E{X, MOD + (size_t)(le * 9) * 6144 + 5 * 1024, (float*)(ws + WS_PB), S.rs0(), args.gmul};
            pg8::gemm_phase<pg8::EpiResid, SplitOrder, true, true>(F.lds + RING_OFF, g, S, E); } if (rep_ + 1 < REP(7)) GRID_BAR(); } if (BOTH(pb + 6)) GRID_BAR(); }
        if (EN(8) && IN(pb + 7)) { FRESH();
_Pragma("unroll 1") for (int rep_ = 0; rep_ < REP(8); ++rep_) { SplitOrder SP; SP.init(MT, (MK_FP8_FFN2 && jp == 1) ? FF / 2 : FF, F.G, F.bid); norm_phase(args, F, lo_, 0, MT, false, -1, SP.nsplit(), SP.rs0(), MOD + (size_t)(le * 9) * 6144 + 5 * 1024); if (rep_ + 1 < REP(8)) GRID_BAR(); } if (BOTH(pb + 7)) GRID_BAR(); }
        if (EN(9) && IN(pb + 8)) { FRESH();
_Pragma("unroll 1") for (int rep_ = 0; rep_ < REP(9); ++rep_) { pg8::Gemm g{H, (const bf16*)(ws + WS_WQKV) + (size_t)jp * 1536 * 1024, MT, 1536, 1024}; pg8::StaticOrder S; S.init(MT, 1536, 1024, F.G, F.bid);
            pg8::EpiQKV E{(bf16*)(ws + WS_Q), (bf16*)(ws + WS_K), (bf16*)(ws + WS_QKV), args.in[18] + jp * 64, args.in[19] + jp * 64, (const float*)(ws + WS_ROPE), ML, QSCALE, EPS};
            pg8::gemm_phase<pg8::EpiQKV, pg8::StaticOrder, true, true, 16>(F.lds + RING_OFF, g, S, E); { TailPlan tp; tail_plan(F.G, (jp == 1) ? 1024 : 1152, tp); tail_fill(args, F, tp, 2, jp, jp == 0 ? 0 : 2); } if (rep_ + 1 < REP(9)) GRID_BAR(); } if (BOTH(pb + 8)) GRID_BAR(); }
        if (EN(11) && IN(pb + 10)) { FRESH();
_Pragma("unroll 1") for (int rep_ = 0; rep_ < REP(11); ++rep_) { attn_phase(args, F, jp, (jp == 1) ? 1024 : 1152); { TailPlan tp; tail_plan(F.G, (jp == 1) ? 1024 : 1152, tp); tail_fill(args, F, tp, 3, jp, jp == 0 ? 0 : 2, (F.G % 8 == 0) ? (F.bid % 8) * (F.G / 8) + F.bid / 8 : F.bid); } if (rep_ + 1 < REP(11)) GRID_BAR(); } if (BOTH(pb + 10)) GRID_BAR(); }
        if (EN(12) && IN(pb + 11)) { FRESH();
_Pragma("unroll 1") for (int rep_ = 0; rep_ < REP(12); ++rep_) { pg8::Gemm g{(const bf16*)(ws + WS_O), (const bf16*)(ws + WS_WO) + (size_t)jp * 1024 * 1024, rows_tail, 1024, 1024}; SplitOrder S; S.init(rows_tail, 1024, F.G, F.bid);
            pg8::EpiResid E{X, MOD + (size_t)(lo_ * 9) * 6144 + 2 * 1024, (float*)(ws + WS_PB), S.rs0(), args.gmul};
            pg8::gemm_phase<pg8::EpiResid, SplitOrder, true, true>(F.lds + RING_OFF, g, S, E); if (rep_ + 1 < REP(12)) GRID_BAR(); } if (BOTH(pb + 11)) GRID_BAR(); }
        if (EN(13) && IN(pb + 12)) { FRESH();
_Pragma("unroll 1") for (int rep_ = 0; rep_ < REP(13); ++rep_) { SplitOrder SP; SP.init(rows_tail, 1024, F.G, F.bid); norm_router_phase(args, F, lo_, rows_tail, SP.nsplit(), SP.rs0(), MOD + (size_t)(lo_ * 9) * 6144 + 2 * 1024); if (rep_ + 1 < REP(13)) GRID_BAR(); } if (BOTH(pb + 12)) GRID_BAR(); }
        if (EN(15) && IN(pb + 14)) { FRESH();
_Pragma("unroll 1") for (int rep_ = 0; rep_ < REP(15); ++rep_) { MoeSeg sg; moe_seg(F, jp, sg); MoeOrder S;
#pragma unroll
            for (int q = 0; q < 9; ++q) S.pst[q] = sg.pst[q];
#pragma unroll
            for (int q = 0; q < 8; ++q) S.cnt[q] = sg.cnt[q];
            S.nt = 28; S.G = F.G; S.c = F.bid; S.ntk = 8; S.apan = true; S.no_split();
            pg8::Gemm g{(const bf16*)(ws + WS_HP), (const bf16*)(ws + WS_MOE13), 0, 0, 512};
            pg8::EpiSwiGLU8 E{(unsigned char*)(ws + WS_TP), FF, 1.0f / F8_W13};
            pg8::gemm_phase<pg8::EpiSwiGLU8, MoeOrder, true, true, 8, true>(F.lds + RING_OFF, g, S, E); if (rep_ + 1 < REP(15)) GRID_BAR(); } if (BOTH(pb + 14)) GRID_BAR(); }
        if (EN(16) && IN(pb + 15)) { FRESH();
_Pragma("unroll 1") for (int rep_ = 0; rep_ < REP(16); ++rep_) { MoeSeg sg; moe_seg(F, jp, sg); MoeOrder S;
#pragma unroll
            for (int q = 0; q < 9; ++q) S.pst[q] = sg.pst[q];
#pragma unroll
            for (int q = 0; q < 8; ++q) S.cnt[q] = sg.cnt[q];
            S.apan = false; S.nt = 4; S.G = F.G; S.c = F.bid; S.ntk = 28; if (jp == 1) S.split_tail(); else S.no_split();
            pg8::Gemm g{(const bf16*)(ws + WS_TP), (const bf16*)(ws + WS_MOE2), 0, 0, FF / 2};
            pg8::EpiMoeDown E{(bf16*)(ws + WS_YS), (const int*)(ws + WS_TOKLIST), (const float*)(ws + WS_TOKWT), CAP, (bf16*)(ws + WS_PB), S.ps0(), S.psrows(), 1.0f / F8_W2};
            if (jp == 0) pg8::gemm_phase<pg8::EpiMoeDown, MoeOrder, true, true, 28, true>(F.lds + RING_OFF, g, S, E); else pg8::gemm_phase<pg8::EpiMoeDown, MoeOrder, true, true, 0, true>(F.lds + RING_OFF, g, S, E);
            if (jp == 0) { const int U = sg.pst[8] * 4, busy = (U > 2 * F.G) ? ((U - 2 * F.G < F.G) ? U - 2 * F.G : F.G) : 0;
                const int vcid = (F.G % 8 == 0) ? (F.bid % 8) * (F.G / 8) + F.bid / 8 : F.bid;
                if (busy < F.G) conv_moe_all(args, F, 1, 1, busy, F.G - busy, vcid); else conv_moe_all(args, F, 1, 1, 0, F.G, vcid); } if (rep_ + 1 < REP(16)) GRID_BAR(); } if (BOTH(pb + 15)) GRID_BAR(); }
}

__global__ void __launch_bounds__(NWAVES * 64, 2) mk_fwd(Args args) {
    extern __shared__ __attribute__((aligned(16))) unsigned char lds[];
    Frame F;
    F.lds = (LAS unsigned char*)lds; F.MISC = (volatile LAS unsigned*)(F.lds + MISC_OFF);
    F.tid = threadIdx.x; F.lane = F.tid & 63; F.wave = __builtin_amdgcn_readfirstlane(F.tid >> 6); F.G = gridDim.x; F.bid = blockIdx.x;
    F.ctl = (gu32*)(args.ws + WS_CTL);
    for (int u = F.tid; u < (LDS_BYTES - LDSCTL_OFF) / 4; u += NWAVES * 64) ((LAS unsigned*)(F.lds + LDSCTL_OFF))[u] = 0u;
    __syncthreads();
    XcdBarrier bar; bar.bar = (unsigned*)(F.ctl + CW_BAR); bar.x = 0; bar.st = nullptr;
    if (!MK_PER_PHASE) bar = xcd_barrier_post((unsigned*)(F.ctl + CW_BAR), F.MISC + 8);
    const int lo = args.ph_lo, hi = args.ph_hi;
    unsigned char* ws = args.ws;
    bf16* X = (bf16*)(ws + WS_X); const float* MOD = (const float*)(ws + WS_MOD); bf16* H = (bf16*)(ws + WS_H);

    if (EN(0) && IN(0)) { FRESH(); prologue_phase(args, F); if (BOTH(0)) GRID_BAR(); }

    layer_pair<0>(args, F, bar, lo, hi);
    layer_pair<1>(args, F, bar, lo, hi);
    if (EN(17) && IN(33)) { FRESH(); final_phase(args, F); }
#undef IN
#undef BOTH
}

extern "C" void kernel_launch(void* const* d_in, const int* in_sizes, int n_in, void* d_out, int out_size, void* d_ws, size_t ws_size, hipStream_t stream) {
    static int grid = 0;
    if (grid == 0) {
        if (n_in != 29 || out_size != ML * D || ws_size < WS_END) { fprintf(stderr, "kernel_launch: unexpected shapes (n_in %d out %d ws %zu)\n", n_in, out_size, ws_size); grid = -1; return; }
        int dev = 0, cus = 0;
        if (hipGetDevice(&dev) != hipSuccess || hipDeviceGetAttribute(&cus, hipDeviceAttributeMultiprocessorCount, dev) != hipSuccess) { grid = -1; return; }
        if (hipFuncSetAttribute((const void*)mk_fwd, hipFuncAttributeMaxDynamicSharedMemorySize, LDS_BYTES) != hipSuccess) { grid = -1; return; }
        int per_cu = 0; (void)hipOccupancyMaxActiveBlocksPerMultiprocessor(&per_cu, (const void*)mk_fwd, NWAVES * 64, LDS_BYTES); (void)hipGetLastError();
        grid = cus;
    }
    if (grid < 0) return;
    (void)hipMemsetAsync((char*)d_ws + WS_CTL, 0, CTL_ZERO_BYTES, stream);
    Args a{};
    for (int i = 0; i < 29; ++i) a.in[i] = (const float*)d_in[i];
    a.out = (float*)d_out; a.ws = (unsigned char*)d_ws; a.gmul = 1.f; a.pad = 0;
#if MK_PER_PHASE
#ifndef MK_REP_LIST
#define MK_REP_LIST -1
#endif
    const int reps[] = {MK_REP_LIST};
    for (int p = 0; p < N_PHASES; ++p) { int n = 1; for (int r : reps) if (r == p) n += 2;
        for (int q = 0; q < n; ++q) { a.ph_lo = p; a.ph_hi = p + 1; a.gmul = (q == 0) ? 1.f : 0.f; hipLaunchKernelGGL(mk_fwd, dim3(grid), dim3(NWAVES * 64), LDS_BYTES, stream, a); } }
#else
    a.ph_lo = 0; a.ph_hi = N_PHASES; hipLaunchKernelGGL(mk_fwd, dim3(grid), dim3(NWAVES * 64), LDS_BYTES, stream, a);
#endif
}
```

```cpp
#include <hip/hip_runtime.h>
#include <cstdio>
#include <cstdint>
namespace pg8 {
#define PG8_LAS __attribute__((address_space(3)))
typedef unsigned short bf16_t;
typedef short bf16x8 __attribute__((ext_vector_type(8)));
typedef float f32x4 __attribute__((ext_vector_type(4)));
typedef unsigned u32x4 __attribute__((ext_vector_type(4)));
typedef int v4i32 __attribute__((ext_vector_type(4)));
typedef int v8i32 __attribute__((ext_vector_type(8)));
constexpr int BM = 256, BK = 64, HALF = 128, HTB = HALF * BK * 2  , STAGE_BYTES = 8 * HTB, NXCD = 8, WGM = 8;

__host__ __device__ __forceinline__ int lds_byte(int r, int c) { const int st = (r >> 4) * 2 + (c >> 5), rr = r & 15, cc = c & 31, ob = rr * 64 + cc * 2; return st * 1024 + (ob ^ (((ob >> 9) & 1) << 5)); }
__host__ __device__ __forceinline__ void stage_rc(int b, int& R, int& C) { const int st = b / 1024, sb = b % 1024, swz = sb ^ (((sb >> 9) & 1) << 5); R = (st >> 1) * 16 + swz / 64; C = (st & 1) * 32 + (swz % 64) / 2; }
__host__ __device__ __forceinline__ int perm32(int rho) { const int n = rho >> 4, i = rho & 15; return 8 * (i >> 2) + 4 * n + (i & 3); }

struct Unit { int pm, pn, e, j, k0, nt, s, pa, pl, cn; };
struct Gemm { const bf16_t* A; const bf16_t* Bt; int M, N, K; };

struct StaticOrder {
    int nM, nN, nwg, G, c, ntk;
    __host__ __device__ void init(int M, int N, int K, int G_, int c_) { nM = M / BM; nN = N / BM; nwg = nM * nN; G = G_; c = c_; ntk = K / BK; }
    __host__ __device__ bool next(int i, Unit& u) const {
        const long L = (long)i * G + c; if (L >= nwg) return false;
        int wgid = (int)L; { const int q = nwg / NXCD, r = nwg % NXCD, xcd = wgid % NXCD, off = wgid / NXCD; wgid = (xcd < r ? xcd * (q + 1) : r * (q + 1) + (xcd - r) * q) + off; }
        const int nig = WGM * nN, gid = wgid / nig, fm = gid * WGM, gsz = (nM - fm) < WGM ? (nM - fm) : WGM;
        u.pm = fm + ((wgid % nig) % gsz); u.pn = (wgid % nig) / gsz; u.e = 0; u.j = u.pn; u.k0 = 0; u.nt = ntk; u.s = 0; u.pa = u.pm; u.pl = 0; u.cn = 0; return true;
    }
    __device__ __forceinline__ void a_ready(const Unit&) const {}
    __device__ __forceinline__ void done(const Unit&) const {}
};

__device__ __forceinline__ unsigned cvt_pk_bf16(float lo, float hi) { unsigned r; asm volatile("v_cvt_pk_bf16_f32 %0, %1, %2" : "=v"(r) : "v"(lo), "v"(hi)); return r; }
typedef float f32x2 __attribute__((ext_vector_type(2)));
__device__ __forceinline__ f32x2 gelu_pk(f32x2 v) {
    const f32x2 av = __builtin_elementwise_abs(v), d = av * 0.2316418882f + 1.0f;
    f32x2 t; t.x = __builtin_amdgcn_rcpf(d.x); t.y = __builtin_amdgcn_rcpf(d.y);
    f32x2 q = t * 0.5307027145f + (-0.7265760135f); q = q * t + 0.7107068705f; q = q * t + (-0.142248368f); q = q * t + 0.127414796f; q = q * t;
    const f32x2 s = (v * v) * (-0.72134752044f);
    f32x2 e; e.x = __builtin_amdgcn_exp2f(s.x); e.y = __builtin_amdgcn_exp2f(s.y);
    const f32x2 m = v * (q * e), r = v - m;
    f32x2 o; o.x = v.x < 0.f ? m.x : r.x; o.y = v.y < 0.f ? m.y : r.y; return o;
}

template <int ACT  > struct EpiBf16 {
    static constexpr bool PERM = true, AFTER_DRAIN = false; static_assert(ACT == 0 || ACT == 1, "EpiBf16: ACT is 0 (none) or 1 (gelu_pk)");
    bf16_t* O; int ldc; const float* bias; int split_cols; size_t split_stride; float scale0;
    __device__ __forceinline__ void operator()(const f32x4 (&acc)[2][2][4][2], const Unit& u, int wr, int wc, int fr, int fq) const {
        const int row0 = u.pm * BM + wr * 64 + fr; int colt = u.pn * BM; bf16_t* base = O;
        float sc = 1.f; if (split_cols) { const int t = colt / split_cols; base += (size_t)t * split_stride; colt -= t * split_cols; if (t == 0) sc = scale0; }
        const int col0 = colt + wc * 32 + 8 * fq, bcol0 = u.pn * BM + wc * 32 + 8 * fq;
        f32x4 bv[2][2];
#pragma unroll
        for (int bj = 0; bj < 2; ++bj)
#pragma unroll
            for (int n = 0; n < 2; ++n) bv[bj][n] = bias ? *(const f32x4*)(bias + bcol0 + bj * HALF + 4 * n) : (f32x4){0.f, 0.f, 0.f, 0.f};
#pragma unroll
        for (int ai = 0; ai < 2; ++ai)
#pragma unroll
            for (int m = 0; m < 4; ++m) { bf16_t* rowp = base + (size_t)(row0 + ai * HALF + m * 16) * ldc + col0;
#pragma unroll
                for (int bj = 0; bj < 2; ++bj) { f32x4 v0 = acc[ai][bj][m][0] + bv[bj][0], v1 = acc[ai][bj][m][1] + bv[bj][1];
                    if (ACT == 1) { f32x2 a = gelu_pk((f32x2){v0[0], v0[1]}), b = gelu_pk((f32x2){v0[2], v0[3]}), c = gelu_pk((f32x2){v1[0], v1[1]}), d = gelu_pk((f32x2){v1[2], v1[3]});
                        v0 = (f32x4){a.x, a.y, b.x, b.y}; v1 = (f32x4){c.x, c.y, d.x, d.y}; }
                    v0 = v0 * sc; v1 = v1 * sc; u32x4 w; w.x = cvt_pk_bf16(v0[0], v0[1]); w.y = cvt_pk_bf16(v0[2], v0[3]); w.z = cvt_pk_bf16(v1[0], v1[1]); w.w = cvt_pk_bf16(v1[2], v1[3]);
                    *(u32x4*)(rowp + bj * HALF) = w; } }
    }
};
__device__ __forceinline__ float sigm_f(float x) { return __builtin_amdgcn_rcpf(1.f + __builtin_amdgcn_exp2f(-1.4426950409f * x)); }
__device__ __forceinline__ float silu_f(float x) { return x * sigm_f(x); }
__device__ __forceinline__ f32x4 exp2_v(f32x4 x) { return (f32x4){__builtin_amdgcn_exp2f(x[0]), __builtin_amdgcn_exp2f(x[1]), __builtin_amdgcn_exp2f(x[2]), __builtin_amdgcn_exp2f(x[3])}; }
__device__ __forceinline__ f32x4 rcp_v(f32x4 x) { return (f32x4){__builtin_amdgcn_rcpf(x[0]), __builtin_amdgcn_rcpf(x[1]), __builtin_amdgcn_rcpf(x[2]), __builtin_amdgcn_rcpf(x[3])}; }
__device__ __forceinline__ f32x4 sigm_v(f32x4 x) { return rcp_v(1.f + exp2_v(x * -1.4426950409f)); }
__device__ __forceinline__ f32x4 swiglu_v(f32x4 a, f32x4 g, float sc) { const float k = 1.0f / (sc * sc); const f32x4 r = rcp_v(exp2_v(a * (-1.4426950409f * sc)) * k + k); return (a * g) * r; }
__device__ __forceinline__ f32x4 gelu_tanh_v(f32x4 x) { const f32x4 t = x * (x * x * (-2.3022082f * 0.044715f) + -2.3022082f); return x * rcp_v(1.f + exp2_v(t)); }
__device__ __forceinline__ float gelu_tanh_f(float x) { const float t = x * (1.f + 0.044715f * x * x); return x * __builtin_amdgcn_rcpf(1.f + __builtin_amdgcn_exp2f(-2.3022082f * t)); }

struct EpiWin {
    static constexpr bool PERM = true, AFTER_DRAIN = false;
    bf16_t *U, *V, *G; float* stats;
    __device__ __forceinline__ void operator()(const f32x4 (&acc)[2][2][4][2], const Unit& u, int wr, int wc, int fr, int fq) const {
        const int row0 = u.pm * BM + wr * 64 + fr;
        if (u.pn < 8) {
            bf16_t* base = (u.pn < 4) ? U : V; const int col0 = (u.pn & 3) * 256 + wc * 32 + 8 * fq;
#pragma unroll
            for (int ai = 0; ai < 2; ++ai)
#pragma unroll
                for (int m = 0; m < 4; ++m) { bf16_t* rowp = base + (size_t)(row0 + ai * HALF + m * 16) * 1024 + col0; f32x4 sv1 = (f32x4){0.f, 0.f, 0.f, 0.f}, sv2 = (f32x4){0.f, 0.f, 0.f, 0.f};
#pragma unroll
                    for (int bj = 0; bj < 2; ++bj) { const f32x4 g0 = gelu_tanh_v(acc[ai][bj][m][0]), g1 = gelu_tanh_v(acc[ai][bj][m][1]);
                        sv1 = sv1 + (g0 + g1); sv2 = sv2 + (g0 * g0 + g1 * g1);
                        u32x4 w; w.x = cvt_pk_bf16(g0[0], g0[1]); w.y = cvt_pk_bf16(g0[2], g0[3]); w.z = cvt_pk_bf16(g1[0], g1[1]); w.w = cvt_pk_bf16(g1[2], g1[3]);
                        *(u32x4*)(rowp + bj * HALF) = w; }
                    float s1 = (sv1[0] + sv1[1]) + (sv1[2] + sv1[3]), s2 = (sv2[0] + sv2[1]) + (sv2[2] + sv2[3]);
                    if (u.pn >= 4) { s1 += __shfl_xor(s1, 16); s1 += __shfl_xor(s1, 32); s2 += __shfl_xor(s2, 16); s2 += __shfl_xor(s2, 32);
                        if (fq == 0) { f32x2 sv; sv.x = s1; sv.y = s2; *(f32x2*)(stats + (size_t)(row0 + ai * HALF + m * 16) * 32 + ((u.pn - 4) * 4 + wc) * 2) = sv; } } }
        } else {
            const int col0 = (u.pn - 8) * 128 + wc * 32 + 8 * fq;
#pragma unroll
            for (int ai = 0; ai < 2; ++ai)
#pragma unroll
                for (int m = 0; m < 4; ++m) { bf16_t* rowp = G + (size_t)(row0 + ai * HALF + m * 16) * 1024 + col0;
                    const f32x4 a0 = acc[ai][0][m][0], a1 = acc[ai][0][m][1], g0 = acc[ai][1][m][0], g1 = acc[ai][1][m][1]; u32x4 w;
                    const f32x4 y0 = a0 * sigm_v(g0), y1 = a1 * sigm_v(g1);
                    w.x = cvt_pk_bf16(y0[0], y0[1]); w.y = cvt_pk_bf16(y0[2], y0[3]); w.z = cvt_pk_bf16(y1[0], y1[1]); w.w = cvt_pk_bf16(y1[2], y1[3]);
                    *(u32x4*)rowp = w; }
        }
    }
};
struct EpiSwiGLU {
    static constexpr bool PERM = true, AFTER_DRAIN = false;
    bf16_t* T; int ldc; float gmul;
    __device__ __forceinline__ void operator()(const f32x4 (&acc)[2][2][4][2], const Unit& u, int wr, int wc, int fr, int fq) const {
#ifdef MK_SKIP_EPI
        if (gmul == 0.f) return;
#endif
        const int row0 = u.pm * BM + wr * 64 + fr; const int col0 = u.j * 128 + wc * 32 + 8 * fq;
#pragma unroll
        for (int ai = 0; ai < 2; ++ai)
#pragma unroll
            for (int m = 0; m < 4; ++m) { bf16_t* rowp = T + (size_t)(row0 + ai * HALF + m * 16) * ldc + col0;
                const f32x4 a0 = acc[ai][0][m][0], a1 = acc[ai][0][m][1], g0 = acc[ai][1][m][0], g1 = acc[ai][1][m][1]; u32x4 w;
                const f32x4 y0 = swiglu_v(a0, g0, 1.0f), y1 = swiglu_v(a1, g1, 1.0f);
                w.x = cvt_pk_bf16(y0[0], y0[1]); w.y = cvt_pk_bf16(y0[2], y0[3]); w.z = cvt_pk_bf16(y1[0], y1[1]); w.w = cvt_pk_bf16(y1[2], y1[3]);
                *(u32x4*)rowp = w; }
    }
};
struct EpiSwiGLU8 {
    static constexpr bool PERM = true, AFTER_DRAIN = false;
    unsigned char* T; int ldc; float isc;
    __device__ __forceinline__ void operator()(const f32x4 (&acc)[2][2][4][2], const Unit& u, int wr, int wc, int fr, int fq) const {
        const int row0 = u.pm * BM + wr * 64 + fr; const int col0 = u.j * 128 + wc * 32 + 8 * fq;
#pragma unroll
        for (int ai = 0; ai < 2; ++ai)
#pragma unroll
            for (int m = 0; m < 4; ++m) { unsigned char* rowp = T + (size_t)(row0 + ai * HALF + m * 16) * ldc + col0;
                const f32x4 y0 = swiglu_v(acc[ai][0][m][0], acc[ai][1][m][0], isc), y1 = swiglu_v(acc[ai][0][m][1], acc[ai][1][m][1], isc);
                int p0 = 0, p1 = 0;
                p0 = __builtin_amdgcn_cvt_pk_fp8_f32(y0[0], y0[1], p0, false); p0 = __builtin_amdgcn_cvt_pk_fp8_f32(y0[2], y0[3], p0, true);
                p1 = __builtin_amdgcn_cvt_pk_fp8_f32(y1[0], y1[1], p1, false); p1 = __builtin_amdgcn_cvt_pk_fp8_f32(y1[2], y1[3], p1, true);
                *(unsigned long long*)rowp = (unsigned long long)(unsigned)p0 | ((unsigned long long)(unsigned)p1 << 32); }
    }
};
struct EpiResid {
    static constexpr bool PERM = true, AFTER_DRAIN = false;
    bf16_t* X; const float* gate; float* PB; int rs0; float gmul; float psc = 1.0f;
    __device__ __forceinline__ void operator()(const f32x4 (&acc)[2][2][4][2], const Unit& u, int wr, int wc, int fr, int fq) const {
        const int col0 = u.pn * BM + wc * 32 + 8 * fq;
        if (u.e == 0) {
            const int mr = (u.pm < 64) ? (u.pm >> 3) : 8; const float* gp = gate + (size_t)mr * 6144;
            f32x4 gv[2][2];
#pragma unroll
            for (int bj = 0; bj < 2; ++bj)
#pragma unroll
                for (int n = 0; n < 2; ++n) gv[bj][n] = *(const f32x4*)(gp + col0 + bj * HALF + 4 * n) * gmul;
#pragma unroll
            for (int ai = 0; ai < 2; ++ai) { bf16_t* xb = X + (size_t)(u.pm * BM + ai * HALF + wr * 64 + fr) * 1024 + col0; u32x4 xv[4][2];
#pragma unroll
                for (int m = 0; m < 4; ++m)
#pragma unroll
                    for (int bj = 0; bj < 2; ++bj) xv[m][bj] = *(const u32x4*)(xb + (size_t)m * 16 * 1024 + bj * HALF);
                asm volatile("" ::: "memory");
#pragma unroll
                for (int m = 0; m < 4; ++m)
#pragma unroll
                    for (int bj = 0; bj < 2; ++bj) { const u32x4 x = xv[m][bj]; const f32x4 a0 = acc[ai][bj][m][0] * gv[bj][0], a1 = acc[ai][bj][m][1] * gv[bj][1]; u32x4 w;
                        w.x = cvt_pk_bf16(__uint_as_float(x.x << 16) + a0[0], __uint_as_float(x.x & 0xffff0000u) + a0[1]); w.y = cvt_pk_bf16(__uint_as_float(x.y << 16) + a0[2], __uint_as_float(x.y & 0xffff0000u) + a0[3]);
                        w.z = cvt_pk_bf16(__uint_as_float(x.z << 16) + a1[0], __uint_as_float(x.z & 0xffff0000u) + a1[1]); w.w = cvt_pk_bf16(__uint_as_float(x.w << 16) + a1[2], __uint_as_float(x.w & 0xffff0000u) + a1[3]);
                        *(u32x4*)(xb + (size_t)m * 16 * 1024 + bj * HALF) = w; }
                asm volatile("" ::: "memory"); }
        } else {
            bf16_t* pb = (bf16_t*)PB + (size_t)(u.e - 1) * 2048 * 1024;
#pragma unroll
            for (int ai = 0; ai < 2; ++ai)
#pragma unroll
                for (int m = 0; m < 4; ++m) { bf16_t* xp = pb + (size_t)(u.pm * BM + ai * HALF + wr * 64 + m * 16 + fr - rs0) * 1024 + col0;
#pragma unroll
                    for (int bj = 0; bj < 2; ++bj) { const f32x4 v0 = acc[ai][bj][m][0] * psc, v1 = acc[ai][bj][m][1] * psc; u32x4 w; w.x = cvt_pk_bf16(v0[0], v0[1]); w.y = cvt_pk_bf16(v0[2], v0[3]); w.z = cvt_pk_bf16(v1[0], v1[1]); w.w = cvt_pk_bf16(v1[2], v1[3]);
                        *(u32x4*)(xp + bj * HALF) = w; } }
        }
    }
};
struct EpiMoeDown {
    static constexpr bool PERM = true, AFTER_DRAIN = false;
    bf16_t* YS; const int* toklist; const float* tokwt; int cap; bf16_t* PB; int ps0, psrows; float osc;
    __device__ __forceinline__ void operator()(const f32x4 (&acc)[2][2][4][2], const Unit& u, int wr, int wc, int fr, int fq) const {
        const int col0 = u.j * BM + wc * 32 + 8 * fq;
        if (u.s > 0) {
#pragma unroll
            for (int ai = 0; ai < 2; ++ai)
#pragma unroll
                for (int m = 0; m < 4; ++m) { const int prow = u.pm * BM + ai * HALF + wr * 64 + m * 16 + fr; bf16_t* pp = PB + ((size_t)(u.s - 1) * psrows + (size_t)(prow - ps0)) * 1024 + col0;
#pragma unroll
                    for (int bj = 0; bj < 2; ++bj) { const f32x4 v0 = acc[ai][bj][m][0] * osc, v1 = acc[ai][bj][m][1] * osc; u32x4 w; w.x = cvt_pk_bf16(v0[0], v0[1]); w.y = cvt_pk_bf16(v0[2], v0[3]); w.z = cvt_pk_bf16(v1[0], v1[1]); w.w = cvt_pk_bf16(v1[2], v1[3]);
                        *(u32x4*)(pp + bj * HALF) = w; } }
            return; }
        int tsv[2][4]; float wv[2][4];
#pragma unroll
        for (int ai = 0; ai < 2; ++ai)
#pragma unroll
            for (int m = 0; m < 4; ++m) { const int pos = u.pl * BM + ai * HALF + wr * 64 + m * 16 + fr; const int tl = toklist[u.e * cap + pos]; wv[ai][m] = tokwt[u.e * cap + pos]; tsv[ai][m] = (pos < u.cn) ? tl : -1; }
        asm volatile("" ::: "memory");
#pragma unroll
        for (int ai = 0; ai < 2; ++ai)
#pragma unroll
            for (int m = 0; m < 4; ++m) { const int ts = tsv[ai][m]; const float w = wv[ai][m] * osc;
                if (ts >= 0) { bf16_t* yp = YS + (size_t)ts * 1024 + col0;
#pragma unroll
                    for (int bj = 0; bj < 2; ++bj) { const f32x4 v0 = acc[ai][bj][m][0] * w, v1 = acc[ai][bj][m][1] * w; u32x4 o; o.x = cvt_pk_bf16(v0[0], v0[1]); o.y = cvt_pk_bf16(v0[2], v0[3]); o.z = cvt_pk_bf16(v1[0], v1[1]); o.w = cvt_pk_bf16(v1[2], v1[3]);
                        *(u32x4*)(yp + bj * HALF) = o; } } }
    }
};
struct EpiQKV {
    static constexpr bool PERM = true, AFTER_DRAIN = false;
    bf16_t *Q, *K, *V; const float *qg, *kg, *rope; int nlat; float qsc, eps;
    __device__ __forceinline__ void operator()(const f32x4 (&acc)[2][2][4][2], const Unit& u, int wr, int wc, int fr, int fq) const {
        const int row0 = u.pm * BM + wr * 64 + fr;
        if (u.pn == 5) {
#pragma unroll
            for (int ai = 0; ai < 2; ++ai)
#pragma unroll
                for (int m = 0; m < 4; ++m) { bf16_t* rowp = V + (size_t)(row0 + ai * HALF + m * 16) * 256 + wc * 32 + 8 * fq;
#pragma unroll
                    for (int bj = 0; bj < 2; ++bj) { const f32x4 v0 = acc[ai][bj][m][0], v1 = acc[ai][bj][m][1]; u32x4 w; w.x = cvt_pk_bf16(v0[0], v0[1]); w.y = cvt_pk_bf16(v0[2], v0[3]); w.z = cvt_pk_bf16(v1[0], v1[1]); w.w = cvt_pk_bf16(v1[2], v1[3]);
                        *(u32x4*)(rowp + bj * HALF) = w; } }
        } else {
            const bool isq = u.pn < 4; const float* gp = isq ? qg : kg; const float osc = isq ? qsc : 1.0f;
            f32x4 gv[2][2];
#pragma unroll
            for (int bj = 0; bj < 2; ++bj)
#pragma unroll
                for (int n = 0; n < 2; ++n) gv[bj][n] = *(const f32x4*)(gp + 32 * bj + 16 * n + 4 * fq);
#pragma unroll
            for (int ai = 0; ai < 2; ++ai)
#pragma unroll
                for (int m = 0; m < 4; ++m) { const int row = row0 + ai * HALF + m * 16;
                    float ss = 0.f;
#pragma unroll
                    for (int bj = 0; bj < 2; ++bj)
#pragma unroll
                        for (int n = 0; n < 2; ++n) { const f32x4 x = acc[ai][bj][m][n]; ss += (x[0] * x[0] + x[1] * x[1]) + (x[2] * x[2] + x[3] * x[3]); }
                    ss += __shfl_xor(ss, 16); ss += __shfl_xor(ss, 32);
                    const float r = osc / sqrtf(ss * (1.0f / 64.0f) + eps);
                    f32x4 y[2][2];
#pragma unroll
                    for (int bj = 0; bj < 2; ++bj)
#pragma unroll
                        for (int n = 0; n < 2; ++n) y[bj][n] = acc[ai][bj][m][n] * r * gv[bj][n];
                    if (row < nlat) { const int t = row & 2047;
#pragma unroll
                        for (int bj = 0; bj < 2; ++bj) { const int pos = bj ? (t & 63) : (t >> 6); const float* tp = rope + (pos * 16 + 4 * fq) * 2; const f32x4 c01 = *(const f32x4*)tp, c23 = *(const f32x4*)(tp + 4);
                            const f32x4 cs = (f32x4){c01[0], c01[2], c23[0], c23[2]}, sn = (f32x4){c01[1], c01[3], c23[1], c23[3]};
                            const f32x4 a = y[bj][0], b = y[bj][1]; y[bj][0] = a * cs - b * sn; y[bj][1] = b * cs + a * sn; } }
                    bf16_t* dp = (isq ? Q + (size_t)row * 1024 + (4 * u.pn + wc) * 64 : K + (size_t)row * 256 + wc * 64) + 8 * fq;
#pragma unroll
                    for (int bj = 0; bj < 2; ++bj) { const f32x4 v0 = y[bj][0], v1 = y[bj][1]; u32x4 w; w.x = cvt_pk_bf16(v0[0], v0[1]); w.y = cvt_pk_bf16(v0[2], v0[3]); w.z = cvt_pk_bf16(v1[0], v1[1]); w.w = cvt_pk_bf16(v1[2], v1[3]);
                        *(u32x4*)(dp + 32 * bj) = w; } }
        }
    }
};
template <class Epi, class Sched, bool ALIGN_EPI = false, bool SP2 = false, int NTC = 0, bool FP8 = false>
__device__ __forceinline__ void gemm_phase(PG8_LAS unsigned char* lds, const Gemm g, const Sched& S, const Epi& E) {
    int tid_ = threadIdx.x; asm volatile("" : "+v"(tid_));
    const int tid = tid_, wid = __builtin_amdgcn_readfirstlane(tid >> 6), lane = tid & 63, wr = wid >> 2, wc = wid & 3, fr = lane & 15, fq = lane >> 4;
    const int K = g.K;
    unsigned voffA[2], voffB[2];
#pragma unroll
    for (int i = 0; i < 2; ++i) { int R, C; stage_rc(tid * 16 + i * 8192, R, C); const int Rb = Epi::PERM ? ((R & ~31) + perm32(R & 31)) : R;
        voffA[i] = (unsigned)(R * K + C) * 2u; voffB[i] = (unsigned)(Rb * K + C) * 2u; }
    const size_t kstep = (size_t)(BK * 2);
    const size_t hstep = (size_t)HALF * K * 2;
    const size_t tstep = 2 * hstep;
    const unsigned ldsw = (unsigned)wid * 1024u;
    const int aoff = lds_byte(wr * 64 + fr, fq * 8), boff = lds_byte(wc * 32 + fr, fq * 8);
#define PG8_SA(b, h) (((b) * 2 + (h)) * HTB)
#define PG8_SB(b, h) ((4 + (b) * 2 + (h)) * HTB)
#define PG8_STAGE(bufoff, gbase, voff) do { _Pragma("unroll") for (int _i = 0; _i < 2; ++_i) \
        __builtin_amdgcn_global_load_lds((const unsigned*)((const char*)(gbase) + (voff)[_i]), (PG8_LAS unsigned*)(lds + (bufoff) + ldsw + _i * 8192), 16, 0, 0); } while (0)
#define PG8_LDA(dst, b, h) do { if constexpr (FP8) { _Pragma("unroll") for (int m = 0; m < 4; ++m) { const v4i32 l0_ = *(const PG8_LAS v4i32*)(lds + PG8_SA(b, h) + aoff + m * 2048), l1_ = *(const PG8_LAS v4i32*)(lds + PG8_SA(b, h) + aoff + m * 2048 + 1024); \
            dst##8[m] = __builtin_shufflevector(l0_, l1_, 0, 1, 2, 3, 4, 5, 6, 7); } } \
        else { _Pragma("unroll") for (int m = 0; m < 4; ++m) _Pragma("unroll") for (int k = 0; k < 2; ++k) dst[m][k] = *(const PG8_LAS bf16x8*)(lds + PG8_SA(b, h) + aoff + m * 2048 + k * 1024); } } while (0)
#define PG8_LDB(dst, b, h) do { if constexpr (FP8) { _Pragma("unroll") for (int n = 0; n < 2; ++n) { const v4i32 l0_ = *(const PG8_LAS v4i32*)(lds + PG8_SB(b, h) + boff + n * 2048), l1_ = *(const PG8_LAS v4i32*)(lds + PG8_SB(b, h) + boff + n * 2048 + 1024); \
            dst##8[n] = __builtin_shufflevector(l0_, l1_, 0, 1, 2, 3, 4, 5, 6, 7); } } \
        else { _Pragma("unroll") for (int n = 0; n < 2; ++n) _Pragma("unroll") for (int k = 0; k < 2; ++k) dst[n][k] = *(const PG8_LAS bf16x8*)(lds + PG8_SB(b, h) + boff + n * 2048 + k * 1024); } } while (0)
#define PG8_MMA(ai, bj, At, Bt) do { __builtin_amdgcn_s_setprio(1); \
        if constexpr (FP8) { asm volatile("s_nop 1"); _Pragma("unroll") for (int m = 0; m < 4; ++m) _Pragma("unroll") for (int n = 0; n < 2; ++n) \
            asm volatile("v_mfma_scale_f32_16x16x128_f8f6f4 %0, %1, %2, %0, %3, %3 op_sel_hi:[0,0,0]" : "+v"(acc[ai][bj][m][n]) : "v"(Bt##8[n]), "v"(At##8[m]), "v"(f8one)); } \
        else { _Pragma("unroll") for (int m = 0; m < 4; ++m) _Pragma("unroll") for (int n = 0; n < 2; ++n) _Pragma("unroll") for (int k = 0; k < 2; ++k) \
            acc[ai][bj][m][n] = __builtin_amdgcn_mfma_f32_16x16x32_bf16(Bt[n][k], At[m][k], acc[ai][bj][m][n], 0, 0, 0); } \
        __builtin_amdgcn_s_setprio(0); } while (0)
#define PG8_WAIT_V(n) asm volatile("s_waitcnt vmcnt(" #n ")" ::: "memory")
#define PG8_WAIT_L(n) asm volatile("s_waitcnt lgkmcnt(" #n ")" ::: "memory")
#define PG8_BAR __builtin_amdgcn_s_barrier()
#define PG8_SCHED __builtin_amdgcn_sched_barrier(0)
    Unit cur, nxt; int ui = 0;
    if (!S.next(0, cur)) return;
    f32x4 acc[2][2][4][2];
#pragma unroll
    for (int a = 0; a < 2; ++a)
#pragma unroll
        for (int b = 0; b < 2; ++b)
#pragma unroll
            for (int m = 0; m < 4; ++m)
#pragma unroll
                for (int n = 0; n < 2; ++n) acc[a][b][m][n] = (f32x4){0.f, 0.f, 0.f, 0.f};
    bf16x8 At[4][2], B0[2][2], B1[2][2];
    const int f8one = 0x7f7f7f7f;
    v8i32 At8[4], B08[2], B18[2];
    const char* cA = (const char*)g.A + (size_t)cur.pa * tstep + (size_t)cur.k0 * 2; const char* cB = (const char*)g.Bt + (size_t)cur.pn * tstep + (size_t)cur.k0 * 2;
    S.a_ready(cur);
    if constexpr (SP2) {
        PG8_STAGE(PG8_SB(0, 0), cB, voffB); PG8_STAGE(PG8_SB(0, 1), cB + hstep, voffB); PG8_STAGE(PG8_SA(0, 0), cA, voffA); PG8_STAGE(PG8_SA(0, 1), cA + hstep, voffA);
        if (wr == 1) PG8_BAR;
        PG8_WAIT_V(2); PG8_BAR;
        PG8_STAGE(PG8_SB(1, 0), cB + kstep, voffB); PG8_STAGE(PG8_SA(1, 0), cA + kstep, voffA); PG8_STAGE(PG8_SB(1, 1), cB + hstep + kstep, voffB);
        PG8_WAIT_V(6); PG8_BAR;
    } else {
        PG8_STAGE(PG8_SB(0, 0), cB, voffB); PG8_STAGE(PG8_SA(0, 0), cA, voffA); PG8_STAGE(PG8_SB(0, 1), cB + hstep, voffB); PG8_STAGE(PG8_SA(0, 1), cA + hstep, voffA);
        if (wr == 1) PG8_BAR;
        PG8_WAIT_V(4); PG8_BAR;
        PG8_STAGE(PG8_SB(1, 0), cB + kstep, voffB); PG8_STAGE(PG8_SA(1, 0), cA + kstep, voffA); PG8_STAGE(PG8_SB(1, 1), cB + hstep + kstep, voffB);
        PG8_WAIT_V(6); PG8_BAR;
    }
    for (;;) {
        const bool has_next = S.next(ui + 1, nxt);
        const char* nA = has_next ? (const char*)g.A + (size_t)nxt.pa * tstep + (size_t)nxt.k0 * 2 : cA; const char* nB = has_next ? (const char*)g.Bt + (size_t)nxt.pn * tstep + (size_t)nxt.k0 * 2 : cB;
        const int nt = NTC ? NTC : cur.nt;
#pragma unroll 1
        for (int t = 0; t < nt; t += 2) {
            const bool last = (t == nt - 2);
            const char* a1 = cA + (size_t)(t + 1) * kstep;
            const char* a2 = last ? nA : cA + (size_t)(t + 2) * kstep; const char* b2 = last ? nB : cB + (size_t)(t + 2) * kstep;
            const char* a3 = a2 + kstep; const char* b3 = b2 + kstep;
            if (last && has_next) S.a_ready(nxt);
            if constexpr (SP2) {
            PG8_LDB(B0, 0, 0); PG8_LDB(B1, 0, 1); PG8_SCHED; PG8_LDA(At, 0, 0); PG8_STAGE(PG8_SA(1, 1), a1 + hstep, voffA);
            PG8_WAIT_V(8); PG8_WAIT_L(0); PG8_BAR; PG8_MMA(0, 0, At, B0); PG8_MMA(0, 1, At, B1); PG8_BAR; PG8_SCHED;
            PG8_LDA(At, 0, 1); PG8_STAGE(PG8_SB(0, 0), b2, voffB); PG8_STAGE(PG8_SB(0, 1), b2 + hstep, voffB); PG8_STAGE(PG8_SA(0, 0), a2, voffA);
            PG8_WAIT_V(8); PG8_WAIT_L(0); PG8_BAR; PG8_MMA(1, 0, At, B0); PG8_MMA(1, 1, At, B1); PG8_BAR; PG8_SCHED;
            PG8_LDB(B0, 1, 0); PG8_LDB(B1, 1, 1); PG8_SCHED; PG8_LDA(At, 1, 0); PG8_STAGE(PG8_SA(0, 1), a2 + hstep, voffA);
            PG8_WAIT_V(8); PG8_WAIT_L(0); PG8_BAR; PG8_MMA(0, 0, At, B0); PG8_MMA(0, 1, At, B1); PG8_BAR; PG8_SCHED;
            PG8_LDA(At, 1, 1); PG8_STAGE(PG8_SB(1, 0), b3, voffB); PG8_STAGE(PG8_SB(1, 1), b3 + hstep, voffB); PG8_STAGE(PG8_SA(1, 0), a3, voffA);
            PG8_WAIT_V(8); PG8_WAIT_L(0); PG8_BAR; PG8_MMA(1, 0, At, B0); PG8_MMA(1, 1, At, B1); PG8_BAR; PG8_SCHED;
            } else {
            PG8_LDB(B0, 0, 0); PG8_SCHED; PG8_LDA(At, 0, 0); PG8_STAGE(PG8_SA(1, 1), a1 + hstep, voffA);
            PG8_WAIT_L(8); PG8_BAR; PG8_WAIT_L(0); PG8_MMA(0, 0, At, B0); PG8_BAR; PG8_SCHED;
            PG8_LDB(B1, 0, 1); PG8_STAGE(PG8_SB(0, 0), b2, voffB);
            PG8_BAR; PG8_WAIT_L(0); PG8_MMA(0, 1, At, B1); PG8_BAR;
            PG8_LDA(At, 0, 1); PG8_STAGE(PG8_SA(0, 0), a2, voffA);
            PG8_BAR; PG8_WAIT_L(0); PG8_MMA(1, 0, At, B0); PG8_BAR; PG8_SCHED;
            PG8_STAGE(PG8_SB(0, 1), b2 + hstep, voffB);
            PG8_WAIT_V(6); PG8_BAR; PG8_MMA(1, 1, At, B1); PG8_BAR;
            PG8_LDB(B0, 1, 0); PG8_SCHED; PG8_LDA(At, 1, 0); PG8_STAGE(PG8_SA(0, 1), a2 + hstep, voffA);
            PG8_WAIT_L(8); PG8_BAR; PG8_WAIT_L(0); PG8_MMA(0, 0, At, B0); PG8_BAR; PG8_SCHED;
            PG8_LDB(B1, 1, 1); PG8_STAGE(PG8_SB(1, 0), b3, voffB);
            PG8_BAR; PG8_WAIT_L(0); PG8_MMA(0, 1, At, B1); PG8_BAR;
            PG8_LDA(At, 1, 1); PG8_STAGE(PG8_SA(1, 0), a3, voffA);
            PG8_BAR; PG8_WAIT_L(0); PG8_MMA(1, 0, At, B0); PG8_BAR; PG8_SCHED;
            PG8_STAGE(PG8_SB(1, 1), b3 + hstep, voffB);
            PG8_WAIT_V(6); PG8_BAR; PG8_MMA(1, 1, At, B1); PG8_BAR;
            }
        }
        if constexpr (ALIGN_EPI) { if (wr == 0) PG8_BAR; }
        if constexpr (FP8) { asm volatile("s_nop 15\n\ts_nop 15\n\ts_nop 15\n\ts_nop 15" ::: "memory"); }
        if constexpr (!Epi::AFTER_DRAIN) { E(acc, cur, wr, wc, fr, fq); S.done(cur); }
        if (!has_next) break;
#pragma unroll
        for (int a = 0; a < 2; ++a)
#pragma unroll
            for (int b = 0; b < 2; ++b)
#pragma unroll
                for (int m = 0; m < 4; ++m)
#pragma unroll
                    for (int n = 0; n < 2; ++n) acc[a][b][m][n] = (f32x4){0.f, 0.f, 0.f, 0.f};
        cur = nxt; cA = nA; cB = nB; ++ui;
        if constexpr (ALIGN_EPI) { if (wr == 1) PG8_BAR; }
    }
    PG8_WAIT_V(0);
    if constexpr (!ALIGN_EPI) { if (wr == 0) PG8_BAR; }
    PG8_BAR;
    if constexpr (Epi::AFTER_DRAIN) { E.fused(acc, cur, wr, wc, fr, fq, lds, wid, lane); S.done(cur); }
#undef PG8_SA
#undef PG8_SB
#undef PG8_STAGE
#undef PG8_LDA
#undef PG8_LDB
#undef PG8_MMA
#undef PG8_WAIT_V
#undef PG8_WAIT_L
#undef PG8_BAR
#undef PG8_SCHED
}
}
#define GAS __attribute__((address_space(1)))
#define LAS __attribute__((address_space(3)))
typedef unsigned short bf16;
typedef unsigned v4u __attribute__((ext_vector_type(4)));
typedef float f32x4 __attribute__((ext_vector_type(4)));
typedef short bf16x8 __attribute__((ext_vector_type(8)));
typedef GAS unsigned gu32;
typedef GAS unsigned long long gu64;
#define RLX_AGENT __ATOMIC_RELAXED, __HIP_MEMORY_SCOPE_AGENT
#define LDS_WAIT() asm volatile("s_waitcnt lgkmcnt(0)" ::: "memory")
#define VM_WAIT() asm volatile("s_waitcnt vmcnt(0)" ::: "memory")
__device__ __forceinline__ unsigned long long rt() { return __builtin_amdgcn_s_memrealtime(); }
__device__ __forceinline__ unsigned f2bf(float f) { unsigned u = __builtin_bit_cast(unsigned, f); return (u + 0x7fffu + ((u >> 16) & 1u)) >> 16; }
__device__ __forceinline__ unsigned pk2(float lo, float hi) { return f2bf(lo) | (f2bf(hi) << 16); }

#define XB_TMO      128
#define XB_XCNT(j)  (256  + 64 * (j))
#define XB_XSUB(j)  (1280 + 64 * (j))
#define XB_XGEN(j)  (2304 + 64 * (j))
#define XB_TOP      3328
#define XB_TOPGEN   3392
#define XCD_BAR_WORDS 3456
#define XB_SPIN_CAP (1u << 18)

__device__ __forceinline__ unsigned xb_ld(unsigned* p)              { return __hip_atomic_load(p, __ATOMIC_RELAXED, __HIP_MEMORY_SCOPE_AGENT); }
__device__ __forceinline__ unsigned xb_add(unsigned* p, unsigned v) { return __hip_atomic_fetch_add(p, v, __ATOMIC_RELAXED, __HIP_MEMORY_SCOPE_AGENT); }
__device__ __forceinline__ unsigned xb_xcc_id() { return (unsigned)__builtin_amdgcn_s_getreg((3 << 11) | 20) & 0xFu; }
#define XB_SPIN(cond, bar) do { unsigned _sp = 0; while (cond) { __builtin_amdgcn_s_sleep(1); \
    if ((++_sp & 255u) == 0u) { if (xb_ld(&(bar)[XB_TMO])) break; if (_sp > XB_SPIN_CAP) { atomicAdd(&(bar)[XB_TMO], 1u); break; } } } } while (0)

struct XcdBarrier {
    unsigned* bar; unsigned x;
    volatile LAS unsigned* st;
};

__device__ __forceinline__ XcdBarrier xcd_barrier_post(unsigned* bar, volatile LAS unsigned* st) {
    XcdBarrier b; b.bar = bar; b.x = xb_xcc_id(); b.st = st;
    if (threadIdx.x == 0) (void)xb_add(&bar[XB_XCNT(b.x)], 1u);
    return b;
}
__device__ __forceinline__ void xcd_barrier_complete(unsigned* bar, unsigned x, unsigned& nloc, unsigned& nx) {
    const unsigned G = gridDim.x * gridDim.y * gridDim.z;
    unsigned sum, cnt, mine, sp = 0u;
    for (;;) {
        sum = 0u; cnt = 0u; mine = 0u;
#pragma unroll
        for (unsigned j = 0; j < 16; ++j) { const unsigned c = xb_ld(&bar[XB_XCNT(j)]); sum += c; cnt += (c > 0u) ? 1u : 0u; mine = (j == x) ? c : mine; }
        if (sum == G) break;
        __builtin_amdgcn_s_sleep(1);
        if ((++sp & 255u) == 0u) { if (xb_ld(&bar[XB_TMO])) break; if (sp > XB_SPIN_CAP) { atomicAdd(&bar[XB_TMO], 1u); break; } }
    }
    nloc = mine > 0u ? mine : 1u; nx = cnt > 0u ? cnt : 1u;
}

__device__ __forceinline__ void xcd_barrier(const XcdBarrier& b) {
    asm volatile("s_waitcnt vmcnt(0)" ::: "memory");
    __syncthreads();
    if (threadIdx.x == 0) {
        unsigned* bar = b.bar;
        __builtin_amdgcn_s_waitcnt(0);
        unsigned nloc = b.st[0], nx = b.st[1];
        if (nloc == 0u) { xcd_barrier_complete(bar, b.x, nloc, nx); b.st[0] = nloc; b.st[1] = nx; }
        const unsigned old = xb_add(&bar[XB_XSUB(b.x)], 1u);
        const unsigned gen = old / nloc;
        if (old + 1u == (gen + 1u) * nloc) {
            __builtin_amdgcn_fence(__ATOMIC_RELEASE, "agent");
            asm volatile("s_waitcnt vmcnt(0)" ::: "memory");
            const unsigned og = xb_add(&bar[XB_TOP], 1u);
            const unsigned tg = og / nx;
            if (og + 1u == (tg + 1u) * nx) xb_add(&bar[XB_TOPGEN], 1u);
            else XB_SPIN(xb_ld(&bar[XB_TOPGEN]) == tg, bar);
            __builtin_amdgcn_fence(__ATOMIC_ACQUIRE, "agent");
            xb_add(&bar[XB_XGEN(b.x)], 1u);
            asm volatile("s_waitcnt vmcnt(0)" ::: "memory");
        } else {
            XB_SPIN(xb_ld(&bar[XB_XGEN(b.x)]) == gen, bar);
            __builtin_amdgcn_fence(__ATOMIC_ACQUIRE, "agent");
            asm volatile("s_waitcnt vmcnt(0)" ::: "memory");
        }
    }
    __syncthreads();
}
constexpr int NWAVES = 8;
#ifndef MK_PER_PHASE
#define MK_PER_PHASE 0
#endif
constexpr int D = 1024, NB = 8, SEQ = 2048, CTXL = 256, ML = NB * SEQ, MC = NB * CTXL, MT = ML + MC;
constexpr int FF = 3584, NE = 8;
constexpr float EPS = 1e-6f;
constexpr float LOG2E = 1.4426950408889634f;
constexpr float QSCALE = 0.125f * LOG2E;
#ifndef MK_FP8_FFN2
#define MK_FP8_FFN2 1
#endif
constexpr float F8_W13 = 32.0f, F8_W2 = 64.0f;
constexpr int N_PHASES = 34;
constexpr size_t MiB = 1u << 20;
constexpr size_t WS_CTL = 0, CTL_ZERO_BYTES = 1 * MiB;
constexpr size_t WS_MOD = 1 * MiB;
constexpr size_t WS_ROPE = 2 * MiB;
constexpr size_t WS_WSB = 2 * MiB + 65536;
constexpr size_t WS_TOKI = 3 * MiB;
constexpr size_t WS_TOKW = 3 * MiB + 524288;
constexpr int CAP = MT;
constexpr size_t WS_TOKLIST = 4 * MiB;
constexpr size_t WS_TOKWT = 4 * MiB + 655360;
constexpr size_t WS_STATS = 5 * MiB + 524288;
constexpr size_t WS_WIN = 8 * MiB, WS_WOUT = 24 * MiB, WS_WQKV = 32 * MiB, WS_WO = 38 * MiB, WS_FF13 = 42 * MiB, WS_FF2 = 70 * MiB;
constexpr size_t WS_MOE13 = 84 * MiB, WS_MOE2 = 196 * MiB;
constexpr size_t WS_X = 252 * MiB;
constexpr size_t WS_H = 324 * MiB;
constexpr size_t WS_R = 360 * MiB;
constexpr size_t WS_U = WS_R, WS_V = WS_R + 36 * MiB, WS_G = WS_R + 72 * MiB, WS_YAB = WS_R + 108 * MiB;
constexpr size_t WS_QKV = WS_R, WS_Q = WS_R + 54 * MiB, WS_K = WS_R + 90 * MiB, WS_O = WS_R + 99 * MiB;
constexpr size_t WS_T = WS_R;
constexpr size_t WS_HP = WS_R, WS_TP = WS_R + 144 * MiB, WS_YS = WS_R + 342 * MiB;
constexpr size_t WS_PB = WS_R + 414 * MiB;
constexpr size_t WS_END = WS_PB + 64 * MiB;
constexpr int CW_TMO = 0, CW_CODE = 1, CW_CNT = 64, CW_BAR = 4096;
constexpr int RING_OFF = 0;
constexpr int LDSCTL_OFF = 143360, MISC_OFF = LDSCTL_OFF + 64;
constexpr int LDS_BYTES = 147456;
__constant__ float INVF[16] = {1.0f, 0.5623413324356079f, 0.3162277638912201f, 0.17782793939113617f, 0.10000000149011612f, 0.05623413249850273f, 0.03162277489900589f, 0.017782794311642647f,
    0.009999999776482582f, 0.005623413249850273f, 0.003162277629598975f, 0.0017782794311642647f, 0.0010000000474974513f, 0.000562341301701963f, 0.0003162277571391314f, 0.00017782794020604342f};

typedef unsigned v2u __attribute__((ext_vector_type(2)));
struct Args { const float* in[29]; float* out; unsigned char* ws; int ph_lo, ph_hi; float gmul; int pad; };
struct Frame { LAS unsigned char* lds; volatile LAS unsigned* MISC; gu32* ctl; int tid, lane, wave, G, bid; };

__device__ __forceinline__ float wave_sum(float v) {
#pragma unroll
    for (int o = 1; o < 64; o <<= 1) v += __shfl_xor(v, o);
    return v;
}
__device__ __forceinline__ float bf2f(unsigned short b) { return __uint_as_float((unsigned)b << 16); }
__device__ __forceinline__ float bflo(unsigned w) { return __uint_as_float(w << 16); }
__device__ __forceinline__ float bfhi(unsigned w) { return __uint_as_float(w & 0xffff0000u); }
__device__ __forceinline__ unsigned pkbf(float lo, float hi) { return pg8::cvt_pk_bf16(lo, hi); }
__device__ __forceinline__ float fsigm(float x) { return pg8::sigm_f(x); }
__device__ __forceinline__ unsigned pk4f8(float a, float b, float c, float d) { int p = 0; p = __builtin_amdgcn_cvt_pk_fp8_f32(a, b, p, false); p = __builtin_amdgcn_cvt_pk_fp8_f32(c, d, p, true); return (unsigned)p; }

__device__ __forceinline__ int dst_row(int mode, int n) {
    if (mode == 0) return n;
    if (mode == 1) return ((n >> 7) << 8) + (n & 127);
    if (mode == 2) return ((n >> 7) << 8) + 128 + (n & 127);
    if (mode == 4) { if (n >= 1280) return n;
        const int tile = n >> 8, r = n & 255, wc = r >> 6, d = r & 63, bj = d >> 5, dh = d & 31, nn = dh >> 4, fq = (dh & 15) >> 2, e = dh & 3; return (tile << 8) + 128 * bj + 32 * wc + 8 * fq + 4 * nn + e; }
    if (n < 2048) return n;
    if (n < 3072) { const int j = n - 2048; return 2048 + ((j >> 7) << 8) + (j & 127); }
    { const int j = n - 3072; return 2048 + ((j >> 7) << 8) + 128 + (j & 127); }
}
struct ConvDesc { const float* W; bf16* WT; int N, K, mode, item; float f8s; };
__device__ __forceinline__ void conv_ld(const ConvDesc& d, int lane, f32x4 (&r)[16]) {
    const int nblk = d.N >> 6, kb = d.item / nblk, nb = d.item - kb * nblk, k0 = kb << 6, n0 = nb << 6; const int c4 = (lane & 15) << 2, kr = lane >> 4;
#pragma unroll
    for (int i = 0; i < 16; ++i) r[i] = __builtin_nontemporal_load((const GAS f32x4*)(d.W + (size_t)(k0 + 4 * i + kr) * d.N + n0 + c4));
}
__device__ __forceinline__ void conv_st(const ConvDesc& d, LAS float* scr, int lane, const f32x4 (&r)[16]) {
    const int nblk = d.N >> 6, kb = d.item / nblk, nb = d.item - kb * nblk, k0 = kb << 6, n0 = nb << 6; const int c4 = (lane & 15) << 2, kr = lane >> 4;
#pragma unroll
    for (int i = 0; i < 16; ++i) { LAS float* s = scr + (4 * i + kr) * 65 + c4; s[0] = r[i].x; s[1] = r[i].y; s[2] = r[i].z; s[3] = r[i].w; }
    LDS_WAIT(); asm volatile("" ::: "memory");
    if (d.f8s != 0.f) {
        const float sc = d.f8s; unsigned char* W8 = (unsigned char*)d.WT;
#pragma unroll
        for (int jj = 0; jj < 4; ++jj) { const int id = lane + 64 * jj, n = id >> 2, c = id & 3; const LAS float* s = scr + (16 * c) * 65 + n; v4u o;
            o.x = pk4f8(s[0] * sc, s[65] * sc, s[130] * sc, s[195] * sc); o.y = pk4f8(s[260] * sc, s[325] * sc, s[390] * sc, s[455] * sc);
            o.z = pk4f8(s[520] * sc, s[585] * sc, s[650] * sc, s[715] * sc); o.w = pk4f8(s[780] * sc, s[845] * sc, s[910] * sc, s[975] * sc);
            *(GAS v4u*)(W8 + (size_t)dst_row(d.mode, n0 + n) * d.K + k0 + 16 * c) = o; }
    } else {
    const int c = lane & 7;
#pragma unroll
    for (int jj = 0; jj < 8; ++jj) { const int n = (lane >> 3) + 8 * jj; const LAS float* s = scr + (8 * c) * 65 + n;
        v4u o; o.x = pkbf(s[0], s[65]); o.y = pkbf(s[130], s[195]); o.z = pkbf(s[260], s[325]); o.w = pkbf(s[390], s[455]);
        *(GAS v4u*)(d.WT + (size_t)dst_row(d.mode, n0 + n) * d.K + k0 + 8 * c) = o; }
    }
    LDS_WAIT(); asm volatile("" ::: "memory");
}
__device__ __forceinline__ ConvDesc dec_nonmoe(const Args& a, int it) {
    ConvDesc d; d.f8s = 0.f; const int j = it / 4864; int r = it - j * 4864; const bool f8 = MK_FP8_FFN2 && (j == 1);
    if (r < 1024) { d.W = a.in[8] + (size_t)j * 1024 * 4096; d.N = 4096; d.K = 1024; d.mode = 3; d.WT = (bf16*)(a.ws + WS_WIN) + (size_t)j * 4096 * 1024; }
    else if ((r -= 1024) < 512) { d.W = a.in[16] + (size_t)j * 2048 * 1024; d.N = 1024; d.K = 2048; d.mode = 0; d.WT = (bf16*)(a.ws + WS_WOUT) + (size_t)j * 1024 * 2048; }
    else if ((r -= 512) < 384) { d.W = a.in[17] + (size_t)j * 1024 * 1536; d.N = 1536; d.K = 1024; d.mode = 4; d.WT = (bf16*)(a.ws + WS_WQKV) + (size_t)j * 1536 * 1024; }
    else if ((r -= 384) < 256) { d.W = a.in[21] + (size_t)j * 1024 * 1024; d.N = 1024; d.K = 1024; d.mode = 0; d.WT = (bf16*)(a.ws + WS_WO) + (size_t)j * 1024 * 1024; }
    else if ((r -= 256) < 896) { d.W = a.in[22] + (size_t)j * 1024 * 3584; d.N = 3584; d.K = 1024; d.mode = 1; d.WT = (bf16*)(a.ws + WS_FF13) + (size_t)j * 7168 * 1024; if (f8) d.f8s = F8_W13; }
    else if ((r -= 896) < 896) { d.W = a.in[23] + (size_t)j * 1024 * 3584; d.N = 3584; d.K = 1024; d.mode = 2; d.WT = (bf16*)(a.ws + WS_FF13) + (size_t)j * 7168 * 1024; if (f8) d.f8s = F8_W13; }
    else { r -= 896; d.W = a.in[24] + (size_t)j * 3584 * 1024; d.N = 1024; d.K = 3584; d.mode = 0; d.WT = (bf16*)(a.ws + WS_FF2) + (size_t)j * 1024 * 3584; if (f8) d.f8s = F8_W2; }
    d.item = r; return d;
}
__device__ __forceinline__ ConvDesc dec_moe(const Args& a, int jm, int sel, int it) {
    ConvDesc d; const int per = (sel == 0) ? 2688 : (sel == 1 ? 1792 : 896);
    const int e = it / per; int r = it - e * per; if (sel == 2) r += 1792;
    const size_t eo = (size_t)(jm * 8 + e);
    unsigned char* m13 = a.ws + WS_MOE13 + (size_t)e * 7168 * 1024; unsigned char* m2 = a.ws + WS_MOE2 + (size_t)e * 1024 * 3584;
    if (r < 896) { d.W = a.in[26] + eo * 1024 * 3584; d.N = 3584; d.K = 1024; d.mode = 1; d.WT = (bf16*)m13; d.f8s = F8_W13; }
    else if ((r -= 896) < 896) { d.W = a.in[27] + eo * 1024 * 3584; d.N = 3584; d.K = 1024; d.mode = 2; d.WT = (bf16*)m13; d.f8s = F8_W13; }
    else { r -= 896; d.W = a.in[28] + eo * 3584 * 1024; d.N = 1024; d.K = 3584; d.mode = 0; d.WT = (bf16*)m2; d.f8s = F8_W2; }
    d.item = r; return d;
}
__device__ __forceinline__ void conv_run(const Args& a, int n_non, int jm, int sel, int moe_lo, int moe_hi, int gw, int NGW, LAS float* scr, int lane) {
    const int total = n_non + ((moe_hi > moe_lo) ? moe_hi - moe_lo : 0);
    if (gw >= total) return;
    ConvDesc cur = (gw < n_non) ? dec_nonmoe(a, gw) : dec_moe(a, jm, sel, gw - n_non + moe_lo);
    f32x4 r[16]; conv_ld(cur, lane, r);
    for (int it = gw; it < total; it += NGW) {
        const int nx = it + NGW; ConvDesc nxt = cur; f32x4 rn[16];
        if (nx < total) { nxt = (nx < n_non) ? dec_nonmoe(a, nx) : dec_moe(a, jm, sel, nx - n_non + moe_lo); conv_ld(nxt, lane, rn); }
        conv_st(cur, scr, lane, r);
        if (nx < total) {
#pragma unroll
            for (int i = 0; i < 16; ++i) r[i] = rn[i];
            cur = nxt; }
    }
}
__device__ __forceinline__ int moe_items(int sel) { return 8 * ((sel == 0) ? 2688 : (sel == 1 ? 1792 : 896)); }
struct TailPlan { int nl[4]; int e[5]; };
__device__ __forceinline__ int last_round_units(int n, int G) { const int r = n % G; return r == 0 ? G : r; }
__device__ __forceinline__ void tail_plan(int G, int att_units, TailPlan& t) {
    t.nl[0] = last_round_units((MT / 256) * 16, G); t.nl[1] = last_round_units((MT / 256) * 28, G); t.nl[2] = last_round_units((MT / 256) * 6, G); t.nl[3] = last_round_units(att_units, G);
    const int quota[4] = {2, 2, 3, 1}; t.e[0] = 0;
#pragma unroll
    for (int k = 0; k < 4; ++k) t.e[k + 1] = t.e[k] + (G - t.nl[k]) * NWAVES * quota[k];
}
__device__ __forceinline__ void tail_fill(const Args& a, Frame& F, const TailPlan& t, int k, int jm, int sel, int wid = -1) {
    const int me = (wid >= 0) ? wid : F.bid;
    const int nl = t.nl[k]; if (me < nl || nl >= F.G) return;
    const int tot = moe_items(sel), lo = t.e[k] < tot ? t.e[k] : tot, hi = t.e[k + 1] < tot ? t.e[k + 1] : tot;
    __syncthreads();
    conv_run(a, 0, jm, sel, lo, hi, (me - nl) * NWAVES + F.wave, (F.G - nl) * NWAVES, (LAS float*)(F.lds + F.wave * 16640), F.lane);
}
__device__ __forceinline__ void conv_moe_all(const Args& a, Frame& F, int jm, int sel, int w0, int nw, int wid = -1, int lo = 0, int hi = -1) {
    const int me = (wid >= 0) ? wid : F.bid;
    if (me < w0 || me >= w0 + nw) return;
    conv_run(a, 0, jm, sel, lo, (hi < 0) ? moe_items(sel) : hi, (me - w0) * NWAVES + F.wave, nw * NWAVES, (LAS float*)(F.lds + F.wave * 16640), F.lane);
}
__device__ __forceinline__ void sincos_d(double x, double& s, double& c) {
    const double TWO_PI = 6.283185307179586476925286766559;
    const double k = __builtin_rint(x / TWO_PI); const double r = x - k * TWO_PI, r2 = r * r;
    double ts = r, ss = r, tc = 1.0, cs = 1.0;
#pragma unroll 1
    for (int n = 1; n <= 14; ++n) { tc = -tc * r2 / (double)((2 * n - 1) * (2 * n)); cs += tc; ts = -ts * r2 / (double)((2 * n) * (2 * n + 1)); ss += ts; }
    s = ss; c = cs;
}
__device__ __forceinline__ void prologue_phase(const Args& a, Frame& F) {
    const int gw = F.bid * NWAVES + F.wave, NGW = F.G * NWAVES;
    {
        LAS float* sc = (LAS float*)F.lds; LAS float* red = sc + 9 * 1024;
        for (int i = F.tid; i < 9 * 1024; i += NWAVES * 64) { const float v = (i < 8192) ? a.in[1][i] : a.in[3][i - 8192]; sc[i] = v * fsigm(v); }
        __syncthreads();
        float* MOD = (float*)(a.ws + WS_MOD);
        for (int job = F.bid; job < 768; job += F.G) {
            const int li = job / 192, nb = job - li * 192; const int cl = F.tid & 31, kg = F.tid >> 5;
            const float* w = a.in[4] + (size_t)li * 1024 * 6144 + (size_t)(kg * 64) * 6144 + nb * 32 + cl;
            float acc[9];
#pragma unroll
            for (int r = 0; r < 9; ++r) acc[r] = 0.f;
            float wv[2][16];
#pragma unroll
            for (int i = 0; i < 16; ++i) wv[0][i] = __builtin_nontemporal_load(w + (size_t)i * 6144);
#pragma unroll
            for (int kq = 0; kq < 4; ++kq) { const int kb = 16 * kq;
                if (kq < 3) {
#pragma unroll
                    for (int i = 0; i < 16; ++i) wv[(kq + 1) & 1][i] = __builtin_nontemporal_load(w + (size_t)(kb + 16 + i) * 6144); }
#pragma unroll
                for (int i4 = 0; i4 < 4; ++i4)
#pragma unroll
                    for (int r = 0; r < 9; ++r) { const f32x4 sv = *(const LAS f32x4*)(sc + r * 1024 + kg * 64 + kb + 4 * i4);
                        acc[r] += (sv[0] * wv[kq & 1][4 * i4] + sv[1] * wv[kq & 1][4 * i4 + 1]) + (sv[2] * wv[kq & 1][4 * i4 + 2] + sv[3] * wv[kq & 1][4 * i4 + 3]); } }
#pragma unroll
            for (int r = 0; r < 9; ++r) red[(kg * 9 + r) * 32 + cl] = acc[r];
            __syncthreads();
            for (int o = F.tid; o < 9 * 32; o += NWAVES * 64) { const int r = o >> 5, c = o & 31; float sum = 0.f;
#pragma unroll
                for (int g = 0; g < 16; ++g) sum += red[(g * 9 + r) * 32 + c];
                MOD[(size_t)(li * 9 + r) * 6144 + nb * 32 + c] = sum + a.in[5][li * 6144 + nb * 32 + c]; }
            __syncthreads();
        }
    }
    {
        const int gt = F.bid * (NWAVES * 64) + F.tid, NT = F.G * NWAVES * 64;
        if (gt < 1024) { const int pos = gt >> 4, i = gt & 15; const float ang = (float)pos * INVF[i]; double s, c; sincos_d((double)ang, s, c);
            float* rp = (float*)(a.ws + WS_ROPE) + gt * 2; rp[0] = (float)c; rp[1] = (float)s; }
        bf16* wsb = (bf16*)(a.ws + WS_WSB);
        for (int i = gt; i < 2 * 8 * 128 * 128 / 2; i += NT) { const float2 v = *(const float2*)(a.in[11] + 2 * i); *(unsigned*)(wsb + 2 * i) = pkbf(v.x, v.y); }
    }
    __syncthreads();
    { TailPlan tp; tail_plan(F.G, 1152, tp); const int tot = moe_items(0), lo = tp.e[4] < tot ? tp.e[4] : tot;
      conv_run(a, 2 * 4864, 0, 0, lo, tot, gw, NGW, (LAS float*)(F.lds + F.wave * 16640), F.lane); }
}

__device__ __forceinline__ void norm_row_core(const float* xsrc32, const bf16* xsrc16, bf16* xdst, const bf16* ys, const float* g2p, const float* gn, const float* scp, const float* shp, bf16* hdst, int lane, f32x4 (&h)[4],
                                              const float* pbp = nullptr, int nS = 0, const float* pgp = nullptr, bool h8 = false) {
    f32x4 v[4];
    if (xsrc32) {
#pragma unroll
        for (int j = 0; j < 4; ++j) v[j] = __builtin_nontemporal_load((const GAS f32x4*)(xsrc32 + 4 * lane + 256 * j));
    } else {
#pragma unroll
        for (int j = 0; j < 4; ++j) { const v2u x = *(const GAS v2u*)(xsrc16 + 4 * lane + 256 * j); v[j] = (f32x4){bflo(x.x), bfhi(x.x), bflo(x.y), bfhi(x.y)}; }
    }
    if (pbp) {
        f32x4 ps[4];
#pragma unroll
        for (int j = 0; j < 4; ++j) ps[j] = (f32x4){0.f, 0.f, 0.f, 0.f};
        for (int q = 0; q < nS; ++q) {
#pragma unroll
            for (int j = 0; j < 4; ++j) { const v2u pp = *(const GAS v2u*)((const bf16*)pbp + (size_t)q * 2048 * 1024 + 4 * lane + 256 * j); ps[j] = ps[j] + (f32x4){bflo(pp.x), bfhi(pp.x), bflo(pp.y), bfhi(pp.y)}; } }
#pragma unroll
        for (int j = 0; j < 4; ++j) v[j] = v[j] + *(const GAS f32x4*)(pgp + 4 * lane + 256 * j) * ps[j];
    }
    if (ys) {
#pragma unroll
        for (int j = 0; j < 4; ++j) { const v2u y0 = *(const GAS v2u*)(ys + 4 * lane + 256 * j), y1 = *(const GAS v2u*)(ys + 1024 + 4 * lane + 256 * j); const f32x4 g = *(const GAS f32x4*)(g2p + 4 * lane + 256 * j);
            v[j].x += g.x * (bflo(y0.x) + bflo(y1.x)); v[j].y += g.y * (bfhi(y0.x) + bfhi(y1.x)); v[j].z += g.z * (bflo(y0.y) + bflo(y1.y)); v[j].w += g.w * (bfhi(y0.y) + bfhi(y1.y)); }
    }
    if (xdst) {
#pragma unroll
        for (int j = 0; j < 4; ++j) { v2u o; o.x = pkbf(v[j].x, v[j].y); o.y = pkbf(v[j].z, v[j].w); *(GAS v2u*)(xdst + 4 * lane + 256 * j) = o; }
    }
    float ss = 0.f;
#pragma unroll
    for (int j = 0; j < 4; ++j) ss += (v[j].x * v[j].x + v[j].y * v[j].y) + (v[j].z * v[j].z + v[j].w * v[j].w);
    const float r = 1.0f / sqrtf(wave_sum(ss) * (1.0f / 1024.0f) + EPS);
#pragma unroll
    for (int j = 0; j < 4; ++j) { const f32x4 g = *(const GAS f32x4*)(gn + 4 * lane + 256 * j), sc = *(const GAS f32x4*)(scp + 4 * lane + 256 * j), sh = *(const GAS f32x4*)(shp + 4 * lane + 256 * j);
        h[j] = (v[j] * r) * g * (sc + 1.0f) + sh;
        if (h8) { *(GAS unsigned*)((unsigned char*)hdst + 4 * lane + 256 * j) = pk4f8(h[j].x, h[j].y, h[j].z, h[j].w); }
        else { v2u o; o.x = pkbf(h[j].x, h[j].y); o.y = pkbf(h[j].z, h[j].w); *(GAS v2u*)(hdst + 4 * lane + 256 * j) = o; } }
}
__device__ __forceinline__ void norm_phase(const Args& a, Frame& F, int li, int which, int nrows, bool src_in, int pend_li, int nS = 0, int rs0 = 0, const float* pgate = nullptr, bool h8 = false) {
    const int gw = F.bid * NWAVES + F.wave, NGW = F.G * NWAVES;
    bf16* X = (bf16*)(a.ws + WS_X); bf16* H = (bf16*)(a.ws + WS_H); const float* MOD = (const float*)(a.ws + WS_MOD); const bf16* YS = (const bf16*)(a.ws + WS_YS);
    const float* gn = (which == 0 ? a.in[6] : a.in[7]) + li * 1024;
    for (int row = gw; row < nrows; row += NGW) {
        const int mr = (row < ML) ? (row >> 11) : 8;
        const float* mp = MOD + (size_t)(li * 9 + mr) * 6144 + (which ? 3 * 1024 : 0);
        const float* xs = src_in ? ((row < ML) ? a.in[0] + (size_t)row * 1024 : a.in[2] + (size_t)(row - ML) * 1024) : nullptr;
        const bool part = (nS > 0) && (row >= rs0);
        const bool wx = src_in || (pend_li >= 0) || part;
        f32x4 h[4];
        norm_row_core(xs, X + (size_t)row * 1024, wx ? X + (size_t)row * 1024 : nullptr, (pend_li >= 0) ? YS + (size_t)row * 2048 : nullptr, MOD + (size_t)((pend_li >= 0 ? pend_li : 0) * 9 + mr) * 6144 + 5 * 1024,
                      gn, mp + 1024, mp, h8 ? (bf16*)((unsigned char*)H + (size_t)row * 1024) : H + (size_t)row * 1024, F.lane, h, part ? (const float*)((const bf16*)(a.ws + WS_PB) + (size_t)(row - rs0) * 1024) : nullptr, nS, part ? pgate + (size_t)mr * 6144 : nullptr, h8);
    }
}
__device__ __forceinline__ void norm_router_phase(const Args& a, Frame& F, int li, int nrows, int nS, int rs0, const float* pgate) {
    constexpr int RPW = 72;
    bf16* X = (bf16*)(a.ws + WS_X); bf16* H = (bf16*)(a.ws + WS_H); const float* MOD = (const float*)(a.ws + WS_MOD);
    int4* TOKI = (int4*)(a.ws + WS_TOKI); float2* TOKW = (float2*)(a.ws + WS_TOKW); int* TOKLIST = (int*)(a.ws + WS_TOKLIST); float* TOKWT = (float*)(a.ws + WS_TOKWT); unsigned char* HP8 = a.ws + WS_HP;
    const int jm = li >> 1;
    LAS float* Rt = (LAS float*)F.lds;
    LAS int* lcnt = (LAS int*)(F.lds + 32768);
    LAS int* lbase = (LAS int*)(F.lds + 32768 + 64);
    LAS int* rinfo = (LAS int*)(F.lds + 32768 + 128);
    LAS float* rwt = (LAS float*)(F.lds + 32768 + 128 + 72 * 16);
    const float* router = a.in[25] + (size_t)jm * 1024 * 8;
    for (int i = F.tid; i < 8192; i += NWAVES * 64) { const int col = i >> 3, e = i & 7; Rt[e * 1024 + col] = router[i]; }
    if (F.tid < 8) lcnt[F.tid] = 0;
    __syncthreads();
    const float* gn = a.in[7] + li * 1024;
    gu32* CNT = F.ctl + CW_CNT + 16 * jm;
    for (int base = F.bid * RPW; base < nrows; base += F.G * RPW) {
        for (int i = 0; i < 9; ++i) {
            const int lr = F.wave * 9 + i, row = base + lr;
            if (row < nrows) {
                const int mr = (row < ML) ? (row >> 11) : 8; const float* mp = MOD + (size_t)(li * 9 + mr) * 6144 + 3 * 1024;
                f32x4 h[4];
                const bool part = (nS > 0) && (row >= rs0);
                norm_row_core(nullptr, X + (size_t)row * 1024, part ? X + (size_t)row * 1024 : nullptr, nullptr, nullptr, gn, mp + 1024, mp, (bf16*)((unsigned char*)H + (size_t)row * 1024), F.lane, h,
                              part ? (const float*)((const bf16*)(a.ws + WS_PB) + (size_t)(row - rs0) * 1024) : nullptr, nS, part ? pgate + (size_t)mr * 6144 : nullptr, true);
                float lg[8];
#pragma unroll
                for (int e = 0; e < 8; ++e) { float p = 0.f;
#pragma unroll
                    for (int j = 0; j < 4; ++j) { const f32x4 rv = *(const LAS f32x4*)(Rt + e * 1024 + 4 * F.lane + 256 * j); p += (h[j].x * rv.x + h[j].y * rv.y) + (h[j].z * rv.z + h[j].w * rv.w); }
                    lg[e] = wave_sum(p); }
                int i0 = 0; float l0 = lg[0];
#pragma unroll
                for (int e = 1; e < 8; ++e) if (lg[e] > l0) { l0 = lg[e]; i0 = e; }
                int i1 = -1; float l1 = -3.0e38f;
#pragma unroll
                for (int e = 0; e < 8; ++e) if (e != i0 && lg[e] > l1) { l1 = lg[e]; i1 = e; }
                const float w0 = 1.0f / (1.0f + __expf(l1 - l0)), w1 = 1.0f - w0;
                if (F.lane == 0) { const int r0 = __hip_atomic_fetch_add(lcnt + i0, 1, __ATOMIC_RELAXED, __HIP_MEMORY_SCOPE_WORKGROUP), r1 = __hip_atomic_fetch_add(lcnt + i1, 1, __ATOMIC_RELAXED, __HIP_MEMORY_SCOPE_WORKGROUP);
                    rinfo[lr * 4 + 0] = i0; rinfo[lr * 4 + 1] = i1; rinfo[lr * 4 + 2] = r0; rinfo[lr * 4 + 3] = r1; rwt[lr * 2] = w0; rwt[lr * 2 + 1] = w1; }
            }
        }
        __syncthreads();
        if (F.tid < 8) { const int c = lcnt[F.tid]; lbase[F.tid] = (int)__hip_atomic_fetch_add(CNT + F.tid, (unsigned)c, RLX_AGENT); lcnt[F.tid] = 0; }
        __syncthreads();
        if (F.tid < RPW) { const int row = base + F.tid; if (row < nrows) { const int e0 = rinfo[F.tid * 4], e1 = rinfo[F.tid * 4 + 1];
            const int p0 = lbase[e0] + rinfo[F.tid * 4 + 2], p1 = lbase[e1] + rinfo[F.tid * 4 + 3]; const float w0 = rwt[F.tid * 2], w1 = rwt[F.tid * 2 + 1];
            TOKI[row] = make_int4(e0 | (e1 << 8), p0, p1, 0); TOKW[row] = make_float2(w0, w1);
            TOKLIST[e0 * CAP + p0] = row * 2; TOKWT[e0 * CAP + p0] = w0; TOKLIST[e1 * CAP + p1] = row * 2 + 1; TOKWT[e1 * CAP + p1] = w1; } }
        for (int i = 0; i < 9; ++i) { const int lr = F.wave * 9 + i, row = base + lr;
            if (row < nrows) { const int e0 = rinfo[lr * 4], e1 = rinfo[lr * 4 + 1]; const int p0 = lbase[e0] + rinfo[lr * 4 + 2], p1 = lbase[e1] + rinfo[lr * 4 + 3];
                const v4u q = *((const GAS v4u*)((const unsigned char*)H + (size_t)row * 1024) + F.lane);
                *((GAS v4u*)(HP8 + ((size_t)e0 * CAP + p0) * 1024) + F.lane) = q; *((GAS v4u*)(HP8 + ((size_t)e1 * CAP + p1) * 1024) + F.lane) = q; } }
        __syncthreads();
    }
}
struct MoeSeg { int np[8]; int pst[9]; int cnt[8]; };
__device__ __forceinline__ void moe_seg(Frame& F, int jm, MoeSeg& s) {
    gu32* CNT = F.ctl + CW_CNT + 16 * jm; int acc = 0;
#pragma unroll
    for (int e = 0; e < 8; ++e) { const int c = __builtin_amdgcn_readfirstlane((int)__hip_atomic_load(CNT + e, RLX_AGENT)); s.cnt[e] = c; s.np[e] = (c + 255) >> 8; s.pst[e] = acc; acc += s.np[e]; }
    s.pst[8] = acc;
}
__device__ __forceinline__ int seg_start(const MoeSeg& s, int e) { int r = 0;
#pragma unroll
    for (int q = 0; q < 8; ++q) r += (q < e) ? s.np[q] : 0;
    return r; }
struct MoeOrder {
    int pst[9]; int cnt[8]; int nt, G, c, ntk; bool apan;
    int F_, R, S;
    __device__ __forceinline__ void no_split() { F_ = 0x7fffffff; R = 0; S = 1; }
    __device__ __forceinline__ void split_tail() { const int U = pst[8] * nt; F_ = (U / G) * G; R = U - F_; S = 1;
        if (R > 0) { S = (R * 7 <= G) ? 7 : (R * 2 <= G) ? 2 : 1; } if (S == 1) no_split(); }
    __device__ __forceinline__ int ps0() const { return (R > 0) ? (F_ / nt) * 256 : 0x7fffffff; }
    __device__ __forceinline__ int psrows() const { return (R > 0) ? ((R + nt - 1) / nt) * 256 : 0; }
    __device__ __forceinline__ bool next(int i, pg8::Unit& u) const {
        const int vc = (G % 8 == 0) ? (c % 8) * (G / 8) + c / 8 : c;
        const int L = i * G + vc; const int U = pst[8] * nt; const bool full = L < F_; const int q = L - F_;
        if (full ? (L >= U) : (q >= R * S)) return false;
        const int t2 = q / S, sp = q - t2 * S, nts = ntk / S; const int tile = full ? L : F_ + t2;
        const int nig = 8 * nt, grp = tile / nig, rr = tile - grp * nig, fm = grp * 8, gsz = (pst[8] - fm < 8) ? pst[8] - fm : 8;
        const int j = rr / gsz, p = fm + (rr - j * gsz); int e = 0;
#pragma unroll
        for (int q2 = 1; q2 < 8; ++q2) e += (p >= pst[q2]) ? 1 : 0;
        int ps = 0, cn = 0;
#pragma unroll
        for (int q2 = 0; q2 < 8; ++q2) { ps = (q2 == e) ? pst[q2] : ps; cn = (q2 == e) ? cnt[q2] : cn; }
        u.pm = p; u.e = e; u.j = j; u.pn = e * nt + j; u.k0 = full ? 0 : sp * nts * 64; u.nt = full ? ntk : nts; u.s = full ? 0 : sp + 1; u.pl = p - ps; u.cn = cn;
        u.pa = apan ? e * (CAP / 256) + (p - ps) : p; return true;
    }
    __device__ __forceinline__ void a_ready(const pg8::Unit&) const {}
    __device__ __forceinline__ void done(const pg8::Unit&) const {}
};

struct SplitOrder {
    int F_, R, S, ntk, G, vc;
    __device__ __forceinline__ void init(int M, int K, int G_, int c) { const int T = (M >> 8) * 4; G = G_; F_ = (T / G) * G; R = T - F_; ntk = K >> 6; vc = (G % 8 == 0) ? (c % 8) * (G / 8) + c / 8 : c;
        S = 1; if (R > 0) { const int want = (K == 3584 || K == 1792) ? 7 : (K == 2048 ? 8 : 4);   if (R * want <= G) S = want; } }
    __device__ __forceinline__ bool next(int i, pg8::Unit& u) const { const int L = i * G + vc; const bool full = L < F_; const int q = L - F_;
        if (!full && q >= R * S) return false;
        const int t2 = q / S, sp = q - t2 * S, nts = ntk / S; const int tile = full ? L : F_ + t2;
        u.e = full ? 0 : sp + 1; u.nt = full ? ntk : nts; u.k0 = full ? 0 : sp * nts * 64; u.pm = tile >> 2; u.pn = tile & 3; u.j = tile & 3; u.s = 0; u.pa = u.pm; u.pl = 0; u.cn = 0; return true; }
    __device__ __forceinline__ int nsplit() const { return R > 0 ? S : 0; }
    __device__ __forceinline__ int rs0() const { return (F_ >> 2) << 8; }
    __device__ __forceinline__ void a_ready(const pg8::Unit&) const {}
    __device__ __forceinline__ void done(const pg8::Unit&) const {}
};

__device__ __forceinline__ void gate_units(const Args& a, Frame& F, int j, int ubeg, int uend) {
    typedef short s16x4 __attribute__((ext_vector_type(4)));
    LAS float* stat = (LAS float*)F.lds;
    LAS bf16* VL = (LAS bf16*)(F.lds + 1024);
    LAS bf16* WSl = (LAS bf16*)(F.lds + 1024 + 34816);
    const bf16* U = (const bf16*)(a.ws + WS_U); const bf16* V = (const bf16*)(a.ws + WS_V); bf16* YAB = (bf16*)(a.ws + WS_YAB); const bf16* WSB = (const bf16*)(a.ws + WS_WSB);
    const float* STATS = (const float*)(a.ws + WS_STATS);
    const int lane = F.lane, w = F.wave, li15 = lane & 15, lq = lane >> 4, pr = 16 * w + li15;
    if (ubeg >= uend) return;
    v4u raw[4], wsv[4], uu[4]; float bsv; f32x4 lnv[4];
#define GT_LOAD(u_) do { const int n_ = (u_) >> 3, g_ = (u_) & 7, r0_ = n_ * 128; \
        _Pragma("unroll") for (int i = 0; i < 4; ++i) { const int idx = F.tid + 512 * i, p = idx >> 4, c8 = (idx & 15) << 3; \
            wsv[i] = *(const GAS v4u*)(WSB + ((size_t)((j * 8 + g_) * 128 + p)) * 128 + c8); raw[i] = *(const GAS v4u*)(V + (size_t)(r0_ + p) * 1024 + g_ * 128 + c8); } \
        _Pragma("unroll") for (int n2 = 0; n2 < 4; ++n2) uu[n2] = *(const GAS v4u*)(U + (size_t)(r0_ + pr) * 1024 + g_ * 128 + 32 * n2 + 8 * lq); \
        bsv = a.in[12][j * 1024 + g_ * 128 + pr]; \
        { const float* lg_ = a.in[9] + j * 1024 + g_ * 128 + ((F.tid & 15) << 3); const float* lb_ = a.in[10] + j * 1024 + g_ * 128 + ((F.tid & 15) << 3); \
          lnv[0] = *(const GAS f32x4*)lg_; lnv[1] = *(const GAS f32x4*)(lg_ + 4); lnv[2] = *(const GAS f32x4*)lb_; lnv[3] = *(const GAS f32x4*)(lb_ + 4); } } while (0)
    GT_LOAD(ubeg);
    int cur_n = -1;
    for (int u = ubeg; u < uend; ++u) {
        const int n = u >> 3, g = u & 7, r0 = n * 128;
        if (n != cur_n) { cur_n = n;
            if (F.tid < 128) { const float* sp = STATS + (size_t)(r0 + F.tid) * 32; float s1 = 0.f, s2 = 0.f;
#pragma unroll
                for (int i = 0; i < 8; ++i) { const f32x4 v = *(const GAS f32x4*)(sp + 4 * i); s1 += v.x + v.z; s2 += v.y + v.w; }
                const float mean = s1 * (1.0f / 1024.0f), var = s2 * (1.0f / 1024.0f) - mean * mean; stat[2 * F.tid] = mean; stat[2 * F.tid + 1] = 1.0f / sqrtf(fmaxf(var, 0.f) + EPS); } }
#pragma unroll
        for (int i = 0; i < 4; ++i) { const int idx = F.tid + 512 * i, p = idx >> 4, c8 = (idx & 15) << 3; *(LAS v4u*)(WSl + p * 136 + c8) = wsv[i]; }
        __syncthreads();
#pragma unroll
        for (int i = 0; i < 4; ++i) { const int idx = F.tid + 512 * i, p = idx >> 4, c8 = (idx & 15) << 3; const float mean = stat[2 * p], rstd = stat[2 * p + 1];
            const f32x4 ga = lnv[0], gb = lnv[1], ba = lnv[2], bb = lnv[3];
            v4u o; o.x = pkbf((bflo(raw[i].x) - mean) * rstd * ga.x + ba.x, (bfhi(raw[i].x) - mean) * rstd * ga.y + ba.y); o.y = pkbf((bflo(raw[i].y) - mean) * rstd * ga.z + ba.z, (bfhi(raw[i].y) - mean) * rstd * ga.w + ba.w);
            o.z = pkbf((bflo(raw[i].z) - mean) * rstd * gb.x + bb.x, (bfhi(raw[i].z) - mean) * rstd * gb.y + bb.y); o.w = pkbf((bflo(raw[i].w) - mean) * rstd * gb.z + bb.z, (bfhi(raw[i].w) - mean) * rstd * gb.w + bb.w);
            { const int g2 = c8 >> 5, a4 = ((c8 & 31) >> 3) << 2; v2u lo2, hi2; lo2.x = o.x; lo2.y = o.y; hi2.x = o.z; hi2.y = o.w;
              *(LAS v2u*)(VL + p * 136 + 32 * g2 + a4) = lo2; *(LAS v2u*)(VL + p * 136 + 32 * g2 + 16 + a4) = hi2; } }
        v4u cu[4]; const float cb = bsv;
#pragma unroll
        for (int n2 = 0; n2 < 4; ++n2) cu[n2] = uu[n2];
        __syncthreads();
        if (u + 1 < uend) GT_LOAD(u + 1);
        f32x4 acc[8];
#pragma unroll
        for (int nt = 0; nt < 8; ++nt) acc[nt] = (f32x4){0.f, 0.f, 0.f, 0.f};
#pragma unroll
        for (int ks = 0; ks < 4; ++ks) { const bf16x8 wf = *(const LAS bf16x8*)(WSl + pr * 136 + 32 * ks + 8 * lq);
#pragma unroll
            for (int nt = 0; nt < 8; ++nt) { const LAS bf16* vp = VL + (32 * ks + 8 * lq + (li15 >> 2)) * 136 + 16 * nt + 4 * (li15 & 3);
                const s16x4 lo = __builtin_bit_cast(s16x4, __builtin_amdgcn_ds_read_tr16_b64_v4i16((LAS s16x4*)vp));
                const s16x4 hi = __builtin_bit_cast(s16x4, __builtin_amdgcn_ds_read_tr16_b64_v4i16((LAS s16x4*)(vp + 4 * 136)));
                const bf16x8 vf = __builtin_shufflevector(lo, hi, 0, 1, 2, 3, 4, 5, 6, 7);
                acc[nt] = __builtin_amdgcn_mfma_f32_16x16x32_bf16(vf, wf, acc[nt], 0, 0, 0); } }
#pragma unroll
        for (int n2 = 0; n2 < 4; ++n2) { const f32x4 a0 = acc[2 * n2], a1 = acc[2 * n2 + 1]; const v4u uv = cu[n2]; v4u o;
            o.x = pkbf(bflo(uv.x) * (a0[0] + cb), bfhi(uv.x) * (a0[1] + cb)); o.y = pkbf(bflo(uv.y) * (a0[2] + cb), bfhi(uv.y) * (a0[3] + cb));
            o.z = pkbf(bflo(uv.z) * (a1[0] + cb), bfhi(uv.z) * (a1[1] + cb)); o.w = pkbf(bflo(uv.w) * (a1[2] + cb), bfhi(uv.w) * (a1[3] + cb));
            *(GAS v4u*)(YAB + (size_t)(r0 + pr) * 2048 + g * 128 + 32 * n2 + 8 * lq) = o; }
        __syncthreads();
    }
#undef GT_LOAD
}
__device__ __forceinline__ int seq_lo(int r) { return (r < ML) ? (r & ~2047) : (ML + ((r - ML) & ~255)); }
__device__ __forceinline__ void conv_phase(const Args& a, Frame& F, int j) {
    LAS float* wl = (LAS float*)F.lds;
    LAS float* cbl = wl + 31 * 1024;
    LAS float* cgl = cbl + 1024;
    const bf16* G = (const bf16*)(a.ws + WS_G); bf16* YAB = (bf16*)(a.ws + WS_YAB);
    __syncthreads();
    for (int i = F.tid; i < 31 * 256; i += NWAVES * 64) *(LAS f32x4*)(wl + 4 * i) = *(const GAS f32x4*)(a.in[13] + (size_t)j * 31 * 1024 + 4 * i);
    if (F.tid < 256) { *(LAS f32x4*)(cbl + 4 * F.tid) = *(const GAS f32x4*)(a.in[14] + j * 1024 + 4 * F.tid); *(LAS f32x4*)(cgl + 4 * F.tid) = *(const GAS f32x4*)(a.in[15] + j * 1024 + 4 * F.tid); }
    __syncthreads();
    const int lane = F.lane, gw = F.bid * NWAVES + F.wave, NGW = F.G * NWAVES;
#define CV_LOAD(dst, ri, cbase) do { const int row_ = r0 - 15 + (ri); const int rc_ = row_ < lo ? lo : (row_ >= hi ? hi - 1 : row_); dst = *(const GAS v4u*)((const GAS char*)G + (size_t)rc_ * 2048 + (unsigned)((cbase) * 2)); } while (0)
#define CV_UNPACK(src, ri, d) do { const int row_ = r0 - 15 + (ri); const unsigned mk_ = (row_ >= lo && row_ < hi) ? 0xffffffffu : 0u; const unsigned x0_ = src.x & mk_, x1_ = src.y & mk_, x2_ = src.z & mk_, x3_ = src.w & mk_; \
        d[0] = (f32x4){bflo(x0_), bfhi(x0_), bflo(x1_), bfhi(x1_)}; d[1] = (f32x4){bflo(x2_), bfhi(x2_), bflo(x3_), bfhi(x3_)}; } while (0)
    for (int u = gw; u < MT / 6; u += NGW) {
        const int r0 = 6 * u; const int loA = seq_lo(r0), loB = seq_lo(r0 + 5); const int npass = (loA != loB) ? 2 : 1;
        for (int pass = 0; pass < npass; ++pass) {
            const int lo = pass ? loB : loA, hi = lo + ((lo < ML) ? 2048 : 256);
            f32x4 acc[2][6][2];
#pragma unroll
            for (int h = 0; h < 2; ++h) {
                int cbase = 512 * h + 8 * lane; asm volatile("" : "+v"(cbase));
                const f32x4 b0 = *(const LAS f32x4*)(cbl + cbase), b1 = *(const LAS f32x4*)(cbl + cbase + 4);
#pragma unroll
                for (int t = 0; t < 6; ++t) { acc[h][t][0] = b0; acc[h][t][1] = b1; }
                f32x4 ring[6][2]; v4u T[6];
                { v4u a[5];
#pragma unroll
                  for (int i = 0; i < 5; ++i) CV_LOAD(a[i], i, cbase);
#pragma unroll
                  for (int s2 = 0; s2 < 6; ++s2) CV_LOAD(T[s2], s2 + 5, cbase);
#pragma unroll
                  for (int i = 0; i < 5; ++i) CV_UNPACK(a[i], i, ring[i]); }
#pragma unroll 1
                for (int it = 0; it < 5; ++it) {
#pragma unroll
                    for (int s2 = 0; s2 < 6; ++s2) { const int k = 6 * it + s2;
                        CV_UNPACK(T[s2], k + 5, ring[(s2 + 5) % 6]);
                        CV_LOAD(T[s2], 6 * (it + 1) + s2 + 5, cbase);
                        const f32x4 w0 = *(const LAS f32x4*)(wl + k * 1024 + cbase), w1 = *(const LAS f32x4*)(wl + k * 1024 + cbase + 4);
#pragma unroll
                        for (int t = 0; t < 6; ++t) { acc[h][t][0] = acc[h][t][0] + ring[(s2 + t) % 6][0] * w0; acc[h][t][1] = acc[h][t][1] + ring[(s2 + t) % 6][1] * w1; }
                        __builtin_amdgcn_sched_barrier(0); }
                }
                { CV_UNPACK(T[0], 35, ring[5]);
                  const f32x4 w0 = *(const LAS f32x4*)(wl + 30 * 1024 + cbase), w1 = *(const LAS f32x4*)(wl + 30 * 1024 + cbase + 4);
#pragma unroll
                  for (int t = 0; t < 6; ++t) { acc[h][t][0] = acc[h][t][0] + ring[t][0] * w0; acc[h][t][1] = acc[h][t][1] + ring[t][1] * w1; } }
            }
#pragma unroll
            for (int t = 0; t < 6; ++t) { float ss = 0.f;
#pragma unroll
                for (int h = 0; h < 2; ++h)
#pragma unroll
                    for (int q = 0; q < 2; ++q) { const f32x4 v = acc[h][t][q]; ss += (v.x * v.x + v.y * v.y) + (v.z * v.z + v.w * v.w); }
                const float r = 1.0f / sqrtf(wave_sum(ss) * (1.0f / 1024.0f) + EPS); const int row = r0 + t;
                if (row >= lo && row < hi) {
#pragma unroll
                    for (int h = 0; h < 2; ++h) { int cbase = 512 * h + 8 * lane; asm volatile("" : "+v"(cbase)); const f32x4 g0 = *(const LAS f32x4*)(cgl + cbase), g1 = *(const LAS f32x4*)(cgl + cbase + 4);
                        const f32x4 y0 = acc[h][t][0] * r * g0, y1 = acc[h][t][1] * r * g1; v4u o;
                        o.x = pkbf(y0.x * fsigm(y0.x), y0.y * fsigm(y0.y)); o.y = pkbf(y0.z * fsigm(y0.z), y0.w * fsigm(y0.w)); o.z = pkbf(y1.x * fsigm(y1.x), y1.y * fsigm(y1.y)); o.w = pkbf(y1.z * fsigm(y1.z), y1.w * fsigm(y1.w));
                        *(GAS v4u*)(YAB + (size_t)row * 2048 + 1024 + cbase) = o; } } }
        }
    }
#undef CV_LOAD
#undef CV_UNPACK
    __syncthreads();
}
__device__ __forceinline__ void mix_phase(const Args& a, Frame& F, int j) {
#ifndef MK_GATE_REP
#define MK_GATE_REP 1
#endif
#ifndef MK_CONV_REP
#define MK_CONV_REP 1
#endif
    for (int rep = 0; rep < MK_GATE_REP; ++rep)
    gate_units(a, F, j, (int)(((long)F.bid * 1152) / F.G), (int)(((long)(F.bid + 1) * 1152) / F.G));
    for (int rep = 0; rep < MK_CONV_REP; ++rep)
    conv_phase(a, F, j);
}

__device__ __forceinline__ void qkrope_phase(const Args& a, Frame& F, int jm, int nrows) {
    const int gw = F.bid * NWAVES + F.wave, NGW = F.G * NWAVES, lane = F.lane;
    const bf16* QKV = (const bf16*)(a.ws + WS_QKV); bf16* Q = (bf16*)(a.ws + WS_Q); bf16* Kb = (bf16*)(a.ws + WS_K); const float* ROPE = (const float*)(a.ws + WS_ROPE);
    const float* qg = a.in[18] + jm * 64; const float* kg = a.in[19] + jm * 64; const int sub = lane & 15;
    float gq[4], gk[4];
#pragma unroll
    for (int k = 0; k < 4; ++k) { gq[k] = qg[sub + 16 * k]; gk[k] = kg[sub + 16 * k]; }
    for (int row = gw; row < nrows; row += NGW) {
        const bool lat = row < ML; float cr = 1.f, sr = 0.f, cc = 1.f, sc = 0.f;
        if (lat) { const int t = row & 2047, pr = t >> 6, pc = t & 63; const float2 a0 = *(const float2*)(ROPE + (pr * 16 + sub) * 2), a1 = *(const float2*)(ROPE + (pc * 16 + sub) * 2); cr = a0.x; sr = a0.y; cc = a1.x; sc = a1.y; }
#pragma unroll
        for (int hg = 0; hg < 5; ++hg) { const int head = 4 * hg + (lane >> 4); const bf16* src = QKV + (size_t)row * 1536 + head * 64 + sub;
            float x[4];
#pragma unroll
            for (int k = 0; k < 4; ++k) x[k] = bf2f(src[16 * k]);
            float ss = (x[0] * x[0] + x[1] * x[1]) + (x[2] * x[2] + x[3] * x[3]);
            ss += __shfl_xor(ss, 1); ss += __shfl_xor(ss, 2); ss += __shfl_xor(ss, 4); ss += __shfl_xor(ss, 8);
            const float r = 1.0f / sqrtf(ss * (1.0f / 64.0f) + EPS);
            float y[4];
#pragma unroll
            for (int k = 0; k < 4; ++k) y[k] = x[k] * r * (hg < 4 ? gq[k] : gk[k]);
            float o[4]; o[0] = y[0] * cr - y[1] * sr; o[1] = y[1] * cr + y[0] * sr; o[2] = y[2] * cc - y[3] * sc; o[3] = y[3] * cc + y[2] * sc;
            if (hg < 4) { bf16* d = Q + (size_t)row * 1024 + head * 64 + sub;
#pragma unroll
                for (int k = 0; k < 4; ++k) d[16 * k] = (bf16)(pkbf(o[k] * QSCALE, 0.f) & 0xffffu); }
            else { bf16* d = Kb + (size_t)row * 256 + (head - 16) * 64 + sub;
#pragma unroll
                for (int k = 0; k < 4; ++k) d[16 * k] = (bf16)(pkbf(o[k], 0.f) & 0xffffu); } }
    }
}
__device__ __forceinline__ void attn_phase(const Args& a, Frame& F, int jm, int nunits) {
    typedef short s16x4 __attribute__((ext_vector_type(4)));
    const bf16* Q = (const bf16*)(a.ws + WS_Q); const bf16* Kb = (const bf16*)(a.ws + WS_K); const bf16* Vb = (const bf16*)(a.ws + WS_QKV); bf16* O = (bf16*)(a.ws + WS_O);
    LAS bf16* Kl = (LAS bf16*)F.lds;
    LAS bf16* Vl = (LAS bf16*)(F.lds + 18432);
    const int lane = F.lane, w = F.wave, li15 = lane & 15, lq = lane >> 4, hsel = w >> 2, qw = (w & 3) * 32;
    const int lkey = F.tid >> 3, ld8 = (F.tid & 7) << 3;
#define KROW(si) (((si) < nw) ? (b * 2048 + q0 - 128 + 64 * (wlo + (si))) : (ML + b * 256 + 64 * ((si) - nw)))
    const int vcu = (F.G % 8 == 0) ? (F.bid % 8) * (F.G / 8) + F.bid / 8 : F.bid;
    for (int ui = vcu; ui < nunits; ui += F.G) {
        int b, hp, q0, qrow0, wlo, nw;
        if (ui < 1024) { b = ui >> 7; hp = (ui >> 4) & 7; const int qb = ui & 15; q0 = qb * 128; qrow0 = b * 2048 + q0; wlo = (qb == 0) ? 2 : 0; nw = (qb == 0 || qb == 15) ? 4 : 6; }
        else { const int v = ui - 1024; b = v >> 4; hp = (v >> 1) & 7; q0 = (v & 1) * 128; qrow0 = ML + b * 256 + q0; wlo = 0; nw = 0; }
        const int ntile = nw + 4, hq = 2 * hp + hsel, kvh = hp >> 1;
        const bf16* qp = Q + (size_t)(qrow0 + qw + li15) * 1024 + hq * 64 + 8 * lq;
        bf16x8 qf[2][2];
#pragma unroll
        for (int mt = 0; mt < 2; ++mt)
#pragma unroll
            for (int ks = 0; ks < 2; ++ks) qf[mt][ks] = *(const GAS bf16x8*)(qp + (size_t)mt * 16 * 1024 + 32 * ks);
        const float sinkv = a.in[20][jm * 16 + hq] * LOG2E;
        float m[2], l[2]; f32x4 o[2][4];
#pragma unroll
        for (int mt = 0; mt < 2; ++mt) { m[mt] = sinkv; l[mt] = (lq == 0) ? 1.0f : 0.0f;
#pragma unroll
            for (int dt = 0; dt < 4; ++dt) o[mt][dt] = (f32x4){0.f, 0.f, 0.f, 0.f}; }
        v4u kreg[2], vreg[2];
#pragma unroll
        for (int h = 0; h < 2; ++h) { const int kr = KROW(h); kreg[h] = *(const GAS v4u*)(Kb + (size_t)(kr + lkey) * 256 + kvh * 64 + ld8); vreg[h] = *(const GAS v4u*)(Vb + (size_t)(kr + lkey) * 256 + kvh * 64 + ld8); }
        for (int si0 = 0; si0 < ntile; si0 += 2)
#pragma unroll
        for (int h = 0; h < 2; ++h) {
            const int si = si0 + h; const int bo = h * 4608;
            *(LAS v4u*)(Kl + bo + lkey * 72 + ld8) = kreg[h]; *(LAS v4u*)(Vl + bo + lkey * 72 + ld8) = vreg[h];
            if (si + 2 < ntile) { const int kr = KROW(si + 2);
                kreg[h] = *(const GAS v4u*)(Kb + (size_t)(kr + lkey) * 256 + kvh * 64 + ld8); vreg[h] = *(const GAS v4u*)(Vb + (size_t)(kr + lkey) * 256 + kvh * 64 + ld8); }
            __syncthreads();
            f32x4 s[2][4];
#pragma unroll
            for (int kt = 0; kt < 4; ++kt) { const LAS bf16* kp = Kl + bo + (16 * kt + li15) * 72 + 8 * lq; const bf16x8 k0 = *(const LAS bf16x8*)kp, k1 = *(const LAS bf16x8*)(kp + 32);
#pragma unroll
                for (int mt = 0; mt < 2; ++mt) { s[mt][kt] = __builtin_amdgcn_mfma_f32_16x16x32_bf16(k0, qf[mt][0], (f32x4){0.f, 0.f, 0.f, 0.f}, 0, 0, 0);
                    s[mt][kt] = __builtin_amdgcn_mfma_f32_16x16x32_bf16(k1, qf[mt][1], s[mt][kt], 0, 0, 0); } }
            const int tt = wlo + si;
            if (si < nw && (tt < 2 || tt > 3)) { const int kpos0 = q0 - 128 + 64 * tt; asm volatile("; window-edge tile" ::: "memory");
#pragma unroll
                for (int mt = 0; mt < 2; ++mt) { const int qpos = q0 + qw + 16 * mt + li15;
#pragma unroll
                    for (int kt = 0; kt < 4; ++kt)
#pragma unroll
                        for (int jj = 0; jj < 4; ++jj) { const int dlt = qpos - (kpos0 + 16 * kt + 4 * lq + jj); if (dlt > 128 || dlt < -128) s[mt][kt][jj] = -INFINITY; } } }
            bf16x8 pb[2][2]; float lm[2];
#pragma unroll
            for (int mt = 0; mt < 2; ++mt) { const f32x4 mv = (f32x4){m[mt], m[mt], m[mt], m[mt]};
#pragma unroll
                for (int kt = 0; kt < 4; ++kt) s[mt][kt] = s[mt][kt] - mv;
                float tm = fmaxf(fmaxf(s[mt][0][0], s[mt][0][1]), fmaxf(s[mt][0][2], s[mt][0][3]));
#pragma unroll
                for (int kt = 1; kt < 4; ++kt) tm = fmaxf(tm, fmaxf(fmaxf(s[mt][kt][0], s[mt][kt][1]), fmaxf(s[mt][kt][2], s[mt][kt][3])));
                lm[mt] = tm; }
            if (__builtin_amdgcn_ballot_w64(fmaxf(lm[0], lm[1]) > 8.0f) != 0ull) {
                asm volatile("; raise the references" ::: "memory");
#pragma unroll
                for (int mt = 0; mt < 2; ++mt) { float tm = lm[mt]; tm = fmaxf(tm, __shfl_xor(tm, 16)); tm = fmaxf(tm, __shfl_xor(tm, 32));
                    const float dl = fmaxf(tm, 0.f), alpha = __builtin_amdgcn_exp2f(-dl); m[mt] += dl; l[mt] *= alpha; const f32x4 dv = (f32x4){dl, dl, dl, dl};
#pragma unroll
                    for (int kt = 0; kt < 4; ++kt) s[mt][kt] = s[mt][kt] - dv;
#pragma unroll
                    for (int dt = 0; dt < 4; ++dt) o[mt][dt] = o[mt][dt] * alpha; } }
#pragma unroll
            for (int mt = 0; mt < 2; ++mt) {
                f32x4 lsv = (f32x4){0.f, 0.f, 0.f, 0.f};
#pragma unroll
                for (int kt = 0; kt < 4; ++kt) { f32x4 pv;
#pragma unroll
                    for (int jj = 0; jj < 4; ++jj) pv[jj] = __builtin_amdgcn_exp2f(s[mt][kt][jj]);
                    s[mt][kt] = pv; lsv = lsv + pv; }
                l[mt] += (lsv[0] + lsv[1]) + (lsv[2] + lsv[3]);
#pragma unroll
                for (int s2 = 0; s2 < 2; ++s2) { v4u pw; pw.x = pkbf(s[mt][2 * s2][0], s[mt][2 * s2][1]); pw.y = pkbf(s[mt][2 * s2][2], s[mt][2 * s2][3]);
                    pw.z = pkbf(s[mt][2 * s2 + 1][0], s[mt][2 * s2 + 1][1]); pw.w = pkbf(s[mt][2 * s2 + 1][2], s[mt][2 * s2 + 1][3]); pb[mt][s2] = __builtin_bit_cast(bf16x8, pw); }
            }
#pragma unroll
            for (int s2 = 0; s2 < 2; ++s2)
#pragma unroll
                for (int dt = 0; dt < 4; ++dt) { const LAS bf16* vp = Vl + bo + (32 * s2 + 4 * lq + (li15 >> 2)) * 72 + 16 * dt + 4 * (li15 & 3);
                    const s16x4 lo = __builtin_bit_cast(s16x4, __builtin_amdgcn_ds_read_tr16_b64_v4i16((LAS s16x4*)vp));
                    const s16x4 hi = __builtin_bit_cast(s16x4, __builtin_amdgcn_ds_read_tr16_b64_v4i16((LAS s16x4*)(vp + 16 * 72)));
                    const bf16x8 af = __builtin_shufflevector(lo, hi, 0, 1, 2, 3, 4, 5, 6, 7);
#pragma unroll
                    for (int mt = 0; mt < 2; ++mt) o[mt][dt] = __builtin_amdgcn_mfma_f32_16x16x32_bf16(af, pb[mt][s2], o[mt][dt], 0, 0, 0); }
        }
#pragma unroll
        for (int mt = 0; mt < 2; ++mt) { float lt = l[mt]; lt += __shfl_xor(lt, 16); lt += __shfl_xor(lt, 32); const float inv = 1.0f / lt;
            bf16* op = O + (size_t)(qrow0 + qw + 16 * mt + li15) * 1024 + hq * 64 + 4 * lq;
#pragma unroll
            for (int dt = 0; dt < 4; ++dt) { v2u ov; ov.x = pkbf(o[mt][dt][0] * inv, o[mt][dt][1] * inv); ov.y = pkbf(o[mt][dt][2] * inv, o[mt][dt][3] * inv); *(GAS v2u*)(op + 16 * dt) = ov; } }
    }
#undef KROW
}
__device__ __forceinline__ void final_phase(const Args& a, Frame& F) {
    const int gw = F.bid * NWAVES + F.wave, NGW = F.G * NWAVES, lane = F.lane;
    const bf16* X = (const bf16*)(a.ws + WS_X); const bf16* YS = (const bf16*)(a.ws + WS_YS); const float* MOD = (const float*)(a.ws + WS_MOD); const bf16* PB = (const bf16*)(a.ws + WS_PB);
    const int4* TOKI = (const int4*)(a.ws + WS_TOKI); const float2* TOKW = (const float2*)(a.ws + WS_TOKW);
    MoeSeg sg; moe_seg(F, 1, sg); MoeOrder S;
#pragma unroll
    for (int q = 0; q < 9; ++q) S.pst[q] = sg.pst[q];
#pragma unroll
    for (int q = 0; q < 8; ++q) S.cnt[q] = sg.cnt[q];
    S.apan = false; S.nt = 4; S.G = F.G; S.c = 0; S.ntk = 28; S.split_tail();
    const int ps0 = S.ps0(), psrows = S.psrows(), nS = S.S;
    for (int row = gw; row < ML; row += NGW) {
        const float* g2p = MOD + (size_t)(3 * 9 + (row >> 11)) * 6144 + 5 * 1024; const bf16* ys = YS + (size_t)row * 2048;
        const int4 ti = TOKI[row]; const float2 tw = TOKW[row];
        const int p0 = seg_start(sg, ti.x & 255) * 256 + ti.y, p1 = seg_start(sg, ti.x >> 8) * 256 + ti.z;
        f32x4 y[4];
#pragma unroll
        for (int j = 0; j < 4; ++j) y[j] = (f32x4){0.f, 0.f, 0.f, 0.f};
#pragma unroll
        for (int sl = 0; sl < 2; ++sl) { const int pr = sl ? p1 : p0; const float wsl = sl ? tw.y : tw.x;
            if (pr >= ps0) { f32x4 ps[4];
#pragma unroll
                for (int j = 0; j < 4; ++j) ps[j] = (f32x4){0.f, 0.f, 0.f, 0.f};
                for (int q = 0; q < nS; ++q) {
#pragma unroll
                    for (int j = 0; j < 4; ++j) { const v2u pp = *(const GAS v2u*)(PB + ((size_t)q * psrows + (size_t)(pr - ps0)) * 1024 + 4 * lane + 256 * j); ps[j] = ps[j] + (f32x4){bflo(pp.x), bfhi(pp.x), bflo(pp.y), bfhi(pp.y)}; } }
#pragma unroll
                for (int j = 0; j < 4; ++j) y[j] = y[j] + ps[j] * wsl; }
            else {
#pragma unroll
                for (int j = 0; j < 4; ++j) { const v2u yy = *(const GAS v2u*)(ys + sl * 1024 + 4 * lane + 256 * j); y[j] = y[j] + (f32x4){bflo(yy.x), bfhi(yy.x), bflo(yy.y), bfhi(yy.y)}; } } }
#pragma unroll
        for (int j = 0; j < 4; ++j) { const v2u xx = *(const GAS v2u*)(X + (size_t)row * 1024 + 4 * lane + 256 * j); f32x4 v = (f32x4){bflo(xx.x), bfhi(xx.x), bflo(xx.y), bfhi(xx.y)};
            const f32x4 g = *(const GAS f32x4*)(g2p + 4 * lane + 256 * j);
            __builtin_nontemporal_store(v + g * y[j], (GAS f32x4*)(a.out + (size_t)row * 1024 + 4 * lane + 256 * j)); }
    }
}

#define GRID_BAR() do { if (!MK_PER_PHASE) xcd_barrier(bar); } while (0)
#define IN(k) (lo <= (k) && (k) < hi)
#define BOTH(k) (IN(k) && IN((k) + 1))
#ifndef MK_MASK
#define MK_MASK 0xFFFFFFFFu
#endif
#define EN(b) (((MK_MASK) >> (b)) & 1u)
#ifndef MK_DUP_MASK
#define MK_DUP_MASK 0u
#endif
#define REP(b) ((((MK_DUP_MASK) >> (b)) & 1u) ? 3 : 1)
#define FRESH() do { int t_ = threadIdx.x, b_ = blockIdx.x; asm volatile("" : "+v"(t_)); asm volatile("" : "+s"(b_)); F.tid = t_; F.lane = t_ & 63; F.wave = __builtin_amdgcn_readfirstlane(t_ >> 6); F.bid = b_; } while (0)
template <int jp> __device__ __forceinline__ void layer_pair(const Args& args, Frame& F, const XcdBarrier& bar, const int lo, const int hi) {
    unsigned char* ws = args.ws;
    bf16* X = (bf16*)(ws + WS_X); const float* MOD = (const float*)(ws + WS_MOD); bf16* H = (bf16*)(ws + WS_H);
        const int pb = 1 + 16 * jp, le = 2 * jp, lo_ = 2 * jp + 1;
        const int rows_tail = (jp == 1) ? ML : MT;
        if (EN(1) && IN(pb + 0)) { FRESH();
_Pragma("unroll 1") for (int rep_ = 0; rep_ < REP(1); ++rep_) { if (jp == 1) { TailPlan tp; tail_plan(F.G, 1024, tp); conv_moe_all(args, F, 1, 2, 0, F.G, -1, tp.e[4] < moe_items(2) ? tp.e[4] : moe_items(2), moe_items(2)); }
            norm_phase(args, F, le, 0, MT, jp == 0, jp == 1 ? 1 : -1); if (rep_ + 1 < REP(1)) GRID_BAR(); } if (BOTH(pb + 0)) GRID_BAR(); }
        if (EN(2) && IN(pb + 1)) { FRESH();
_Pragma("unroll 1") for (int rep_ = 0; rep_ < REP(2); ++rep_) { pg8::Gemm g{H, (const bf16*)(ws + WS_WIN) + (size_t)jp * 4096 * 1024, MT, 4096, 1024}; pg8::StaticOrder S; S.init(MT, 4096, 1024, F.G, F.bid);
            pg8::EpiWin E{(bf16*)(ws + WS_U), (bf16*)(ws + WS_V), (bf16*)(ws + WS_G), (float*)(ws + WS_STATS)};
            pg8::gemm_phase<pg8::EpiWin, pg8::StaticOrder, true, true, 16>(F.lds + RING_OFF, g, S, E); { TailPlan tp; tail_plan(F.G, (jp == 1) ? 1024 : 1152, tp); tail_fill(args, F, tp, 0, jp, jp == 0 ? 0 : 2); } if (rep_ + 1 < REP(2)) GRID_BAR(); } if (BOTH(pb + 1)) GRID_BAR(); }
        if (EN(3) && IN(pb + 2)) { FRESH();
_Pragma("unroll 1") for (int rep_ = 0; rep_ < REP(3); ++rep_) { mix_phase(args, F, jp); if (rep_ + 1 < REP(3)) GRID_BAR(); } if (BOTH(pb + 2)) GRID_BAR(); }
        if (EN(4) && IN(pb + 3)) { FRESH();
_Pragma("unroll 1") for (int rep_ = 0; rep_ < REP(4); ++rep_) { pg8::Gemm g{(const bf16*)(ws + WS_YAB), (const bf16*)(ws + WS_WOUT) + (size_t)jp * 1024 * 2048, MT, 1024, 2048}; SplitOrder S; S.init(MT, 2048, F.G, F.bid);
            pg8::EpiResid E{X, MOD + (size_t)(le * 9) * 6144 + 2 * 1024, (float*)(ws + WS_PB), S.rs0(), args.gmul};
            pg8::gemm_phase<pg8::EpiResid, SplitOrder, true, true>(F.lds + RING_OFF, g, S, E); if (rep_ + 1 < REP(4)) GRID_BAR(); } if (BOTH(pb + 3)) GRID_BAR(); }
        if (EN(5) && IN(pb + 4)) { FRESH();
_Pragma("unroll 1") for (int rep_ = 0; rep_ < REP(5); ++rep_) { SplitOrder SP; SP.init(MT, 2048, F.G, F.bid); norm_phase(args, F, le, 1, MT, false, -1, SP.nsplit(), SP.rs0(), MOD + (size_t)(le * 9) * 6144 + 2 * 1024, MK_FP8_FFN2 && jp == 1); if (rep_ + 1 < REP(5)) GRID_BAR(); } if (BOTH(pb + 4)) GRID_BAR(); }
        if (EN(6) && IN(pb + 5)) { FRESH();
_Pragma("unroll 1") for (int rep_ = 0; rep_ < REP(6); ++rep_) { if (MK_FP8_FFN2 && jp == 1) { pg8::Gemm g{H, (const bf16*)(ws + WS_FF13) + (size_t)jp * 7168 * 1024, MT, 7168, 512}; pg8::StaticOrder S; S.init(MT, 7168, 512, F.G, F.bid);
            pg8::EpiSwiGLU8 E{(unsigned char*)(ws + WS_T), FF, 1.0f / F8_W13};
            pg8::gemm_phase<pg8::EpiSwiGLU8, pg8::StaticOrder, true, true, 8, true>(F.lds + RING_OFF, g, S, E); } else {
            pg8::Gemm g{H, (const bf16*)(ws + WS_FF13) + (size_t)jp * 7168 * 1024, MT, 7168, 1024}; pg8::StaticOrder S; S.init(MT, 7168, 1024, F.G, F.bid);
            pg8::EpiSwiGLU E{(bf16*)(ws + WS_T), FF, args.gmul};
            pg8::gemm_phase<pg8::EpiSwiGLU, pg8::StaticOrder, true, true, 16>(F.lds + RING_OFF, g, S, E); } { TailPlan tp; tail_plan(F.G, (jp == 1) ? 1024 : 1152, tp); tail_fill(args, F, tp, 1, jp, jp == 0 ? 0 : 2); } if (rep_ + 1 < REP(6)) GRID_BAR(); } if (BOTH(pb + 5)) GRID_BAR(); }
        if (EN(7) && IN(pb + 6)) { FRESH();
_Pragma("unroll 1") for (int rep_ = 0; rep_ < REP(7); ++rep_) { if (MK_FP8_FFN2 && jp == 1) { pg8::Gemm g{(const bf16*)(ws + WS_T), (const bf16*)(ws + WS_FF2) + (size_t)jp * 1024 * 3584, MT, 1024, FF / 2}; SplitOrder S; S.init(MT, FF / 2, F.G, F.bid);
            pg8::EpiResid E{X, MOD + (size_t)(le * 9) * 6144 + 5 * 1024, (float*)(ws + WS_PB), S.rs0(), args.gmul * (1.0f / F8_W2), 1.0f / F8_W2};
            pg8::gemm_phase<pg8::EpiResid, SplitOrder, true, true, 0, true>(F.lds + RING_OFF, g, S, E); } else {
            pg8::Gemm g{(const bf16*)(ws + WS_T), (const bf16*)(ws + WS_FF2) + (size_t)jp * 1024 * 3584, MT, 1024, FF}; SplitOrder S; S.init(MT, FF, F.G, F.bid);
            pg8::EpiResid E{X, MOD + (size_t)(le * 9) * 6144 + 5 * 1024, (float*)(ws + WS_PB), S.rs0(), args.gmul};
            pg8::gemm_phase<pg8::EpiResid, SplitOrder, true, true>(F.lds + RING_OFF, g, S, E); } if (rep_ + 1 < REP(7)) GRID_BAR(); } if (BOTH(pb + 6)) GRID_BAR(); }
        if (EN(8) && IN(pb + 7)) { FRESH();
_Pragma("unroll 1") for (int rep_ = 0; rep_ < REP(8); ++rep_) { SplitOrder SP; SP.init(MT, (MK_FP8_FFN2 && jp == 1) ? FF / 2 : FF, F.G, F.bid); norm_phase(args, F, lo_, 0, MT, false, -1, SP.nsplit(), SP.rs0(), MOD + (size_t)(le * 9) * 6144 + 5 * 1024); if (rep_ + 1 < REP(8)) GRID_BAR(); } if (BOTH(pb + 7)) GRID_BAR(); }
        if (EN(9) && IN(pb + 8)) { FRESH();
_Pragma("unroll 1") for (int rep_ = 0; rep_ < REP(9); ++rep_) { pg8::Gemm g{H, (const bf16*)(ws + WS_WQKV) + (size_t)jp * 1536 * 1024, MT, 1536, 1024}; pg8::StaticOrder S; S.init(MT, 1536, 1024, F.G, F.bid);
            pg8::EpiQKV E{(bf16*)(ws + WS_Q), (bf16*)(ws + WS_K), (bf16*)(ws + WS_QKV), args.in[18] + jp * 64, args.in[19] + jp * 64, (const float*)(ws + WS_ROPE), ML, QSCALE, EPS};
            pg8::gemm_phase<pg8::EpiQKV, pg8::StaticOrder, true, true, 16>(F.lds + RING_OFF, g, S, E); { TailPlan tp; tail_plan(F.G, (jp == 1) ? 1024 : 1152, tp); tail_fill(args, F, tp, 2, jp, jp == 0 ? 0 : 2); } if (rep_ + 1 < REP(9)) GRID_BAR(); } if (BOTH(pb + 8)) GRID_BAR(); }
        if (EN(11) && IN(pb + 10)) { FRESH();
_Pragma("unroll 1") for (int rep_ = 0; rep_ < REP(11); ++rep_) { attn_phase(args, F, jp, (jp == 1) ? 1024 : 1152); { TailPlan tp; tail_plan(F.G, (jp == 1) ? 1024 : 1152, tp); tail_fill(args, F, tp, 3, jp, jp == 0 ? 0 : 2, (F.G % 8 == 0) ? (F.bid % 8) * (F.G / 8) + F.bid / 8 : F.bid); } if (rep_ + 1 < REP(11)) GRID_BAR(); } if (BOTH(pb + 10)) GRID_BAR(); }
        if (EN(12) && IN(pb + 11)) { FRESH();
_Pragma("unroll 1") for (int rep_ = 0; rep_ < REP(12); ++rep_) { pg8::Gemm g{(const bf16*)(ws + WS_O), (const bf16*)(ws + WS_WO) + (size_t)jp * 1024 * 1024, rows_tail, 1024, 1024}; SplitOrder S; S.init(rows_tail, 1024, F.G, F.bid);
            pg8::EpiResid E{X, MOD + (size_t)(lo_ * 9) * 6144 + 2 * 1024, (float*)(ws + WS_PB), S.rs0(), args.gmul};
            pg8::gemm_phase<pg8::EpiResid, SplitOrder, true, true>(F.lds + RING_OFF, g, S, E); if (rep_ + 1 < REP(12)) GRID_BAR(); } if (BOTH(pb + 11)) GRID_BAR(); }
        if (EN(13) && IN(pb + 12)) { FRESH();
_Pragma("unroll 1") for (int rep_ = 0; rep_ < REP(13); ++rep_) { SplitOrder SP; SP.init(rows_tail, 1024, F.G, F.bid); norm_router_phase(args, F, lo_, rows_tail, SP.nsplit(), SP.rs0(), MOD + (size_t)(lo_ * 9) * 6144 + 2 * 1024); if (rep_ + 1 < REP(13)) GRID_BAR(); } if (BOTH(pb + 12)) GRID_BAR(); }
        if (EN(15) && IN(pb + 14)) { FRESH();
_Pragma("unroll 1") for (int rep_ = 0; rep_ < REP(15); ++rep_) { MoeSeg sg; moe_seg(F, jp, sg); MoeOrder S;
#pragma unroll
            for (int q = 0; q < 9; ++q) S.pst[q] = sg.pst[q];
#pragma unroll
            for (int q = 0; q < 8; ++q) S.cnt[q] = sg.cnt[q];
            S.nt = 28; S.G = F.G; S.c = F.bid; S.ntk = 8; S.apan = true; S.no_split();
            pg8::Gemm g{(const bf16*)(ws + WS_HP), (const bf16*)(ws + WS_MOE13), 0, 0, 512};
            pg8::EpiSwiGLU8 E{(unsigned char*)(ws + WS_TP), FF, 1.0f / F8_W13};
            pg8::gemm_phase<pg8::EpiSwiGLU8, MoeOrder, true, true, 8, true>(F.lds + RING_OFF, g, S, E); if (rep_ + 1 < REP(15)) GRID_BAR(); } if (BOTH(pb + 14)) GRID_BAR(); }
        if (EN(16) && IN(pb + 15)) { FRESH();
_Pragma("unroll 1") for (int rep_ = 0; rep_ < REP(16); ++rep_) { MoeSeg sg; moe_seg(F, jp, sg); MoeOrder S;
#pragma unroll
            for (int q = 0; q < 9; ++q) S.pst[q] = sg.pst[q];
#pragma unroll
            for (int q = 0; q < 8; ++q) S.cnt[q] = sg.cnt[q];
            S.apan = false; S.nt = 4; S.G = F.G; S.c = F.bid; S.ntk = 28; if (jp == 1) S.split_tail(); else S.no_split();
            pg8::Gemm g{(const bf16*)(ws + WS_TP), (const bf16*)(ws + WS_MOE2), 0, 0, FF / 2};
            pg8::EpiMoeDown E{(bf16*)(ws + WS_YS), (const int*)(ws + WS_TOKLIST), (const float*)(ws + WS_TOKWT), CAP, (bf16*)(ws + WS_PB), S.ps0(), S.psrows(), 1.0f / F8_W2};
            if (jp == 0) pg8::gemm_phase<pg8::EpiMoeDown, MoeOrder, true, true, 28, true>(F.lds + RING_OFF, g, S, E); else pg8::gemm_phase<pg8::EpiMoeDown, MoeOrder, true, true, 0, true>(F.lds + RING_OFF, g, S, E);
            if (jp == 0) { const int U = sg.pst[8] * 4, busy = (U > 2 * F.G) ? ((U - 2 * F.G < F.G) ? U - 2 * F.G : F.G) : 0;
                const int vcid = (F.G % 8 == 0) ? (F.bid % 8) * (F.G / 8) + F.bid / 8 : F.bid;
                if (busy < F.G) conv_moe_all(args, F, 1, 1, busy, F.G - busy, vcid); else conv_moe_all(args, F, 1, 1, 0, F.G, vcid); } if (rep_ + 1 < REP(16)) GRID_BAR(); } if (BOTH(pb + 15)) GRID_BAR(); }
}

__global__ void __launch_bounds__(NWAVES * 64, 2) mk_fwd(Args args) {
    extern __shared__ __attribute__((aligned(16))) unsigned char lds[];
    Frame F;
    F.lds = (LAS unsigned char*)lds; F.MISC = (volatile LAS unsigned*)(F.lds + MISC_OFF);
    F.tid = threadIdx.x; F.lane = F.tid & 63; F.wave = __builtin_amdgcn_readfirstlane(F.tid >> 6); F.G = gridDim.x; F.bid = blockIdx.x;
    F.ctl = (gu32*)(args.ws + WS_CTL);
    for (int u = F.tid; u < (LDS_BYTES - LDSCTL_OFF) / 4; u += NWAVES * 64) ((LAS unsigned*)(F.lds + LDSCTL_OFF))[u] = 0u;
    __syncthreads();
    XcdBarrier bar; bar.bar = (unsigned*)(F.ctl + CW_BAR); bar.x = 0; bar.st = nullptr;
    if (!MK_PER_PHASE) bar = xcd_barrier_post((unsigned*)(F.ctl + CW_BAR), F.MISC + 8);
    const int lo = args.ph_lo, hi = args.ph_hi;
    unsigned char* ws = args.ws;
    bf16* X = (bf16*)(ws + WS_X); const float* MOD = (const float*)(ws + WS_MOD); bf16* H = (bf16*)(ws + WS_H);

    if (EN(0) && IN(0)) { FRESH(); prologue_phase(args, F); if (BOTH(0)) GRID_BAR(); }

    layer_pair<0>(args, F, bar, lo, hi);
    layer_pair<1>(args, F, bar, lo, hi);
    if (EN(17) && IN(33)) { FRESH(); final_phase(args, F); }
#undef IN
#undef BOTH
}

extern "C" void kernel_launch(void* const* d_in, const int* in_sizes, int n_in, void* d_out, int out_size, void* d_ws, size_t ws_size, hipStream_t stream) {
    static int grid = 0;
    if (grid == 0) {
        if (n_in != 29 || out_size != ML * D || ws_size < WS_END) { fprintf(stderr, "kernel_launch: unexpected shapes (n_in %d out %d ws %zu)\n", n_in, out_size, ws_size); grid = -1; return; }
        int dev = 0, cus = 0;
        if (hipGetDevice(&dev) != hipSuccess || hipDeviceGetAttribute(&cus, hipDeviceAttributeMultiprocessorCount, dev) != hipSuccess) { grid = -1; return; }
        if (hipFuncSetAttribute((const void*)mk_fwd, hipFuncAttributeMaxDynamicSharedMemorySize, LDS_BYTES) != hipSuccess) { grid = -1; return; }
        int per_cu = 0; (void)hipOccupancyMaxActiveBlocksPerMultiprocessor(&per_cu, (const void*)mk_fwd, NWAVES * 64, LDS_BYTES); (void)hipGetLastError();
        grid = cus;
    }
    if (grid < 0) return;
    (void)hipMemsetAsync((char*)d_ws + WS_CTL, 0, CTL_ZERO_BYTES, stream);
    Args a{};
    for (int i = 0; i < 29; ++i) a.in[i] = (const float*)d_in[i];
    a.out = (float*)d_out; a.ws = (unsigned char*)d_ws; a.gmul = 1.f; a.pad = 0;
#if MK_PER_PHASE
#ifndef MK_REP_LIST
#define MK_REP_LIST -1
#endif
    const int reps[] = {MK_REP_LIST};
    for (int p = 0; p < N_PHASES; ++p) { int n = 1; for (int r : reps) if (r == p) n += 2;
        for (int q = 0; q < n; ++q) { a.ph_lo = p; a.ph_hi = p + 1; a.gmul = (q == 0) ? 1.f : 0.f; hipLaunchKernelGGL(mk_fwd, dim3(grid), dim3(NWAVES * 64), LDS_BYTES, stream, a); } }
#else
    a.ph_lo = 0; a.ph_hi = N_PHASES; hipLaunchKernelGGL(mk_fwd, dim3(grid), dim3(NWAVES * 64), LDS_BYTES, stream, a);
#endif
}
```

```cpp
#include <hip/hip_runtime.h>
#include <cstdio>
#include <cstdint>
namespace pg8 {
#define PG8_LAS __attribute__((address_space(3)))
typedef unsigned short bf16_t;
typedef short bf16x8 __attribute__((ext_vector_type(8)));
typedef float f32x4 __attribute__((ext_vector_type(4)));
typedef unsigned u32x4 __attribute__((ext_vector_type(4)));
typedef int v4i32 __attribute__((ext_vector_type(4)));
typedef int v8i32 __attribute__((ext_vector_type(8)));
constexpr int BM = 256, BK = 64, HALF = 128, HTB = HALF * BK * 2  , STAGE_BYTES = 8 * HTB, NXCD = 8, WGM = 8;

__host__ __device__ __forceinline__ int lds_byte(int r, int c) { const int st = (r >> 4) * 2 + (c >> 5), rr = r & 15, cc = c & 31, ob = rr * 64 + cc * 2; return st * 1024 + (ob ^ (((ob >> 9) & 1) << 5)); }
__host__ __device__ __forceinline__ void stage_rc(int b, int& R, int& C) { const int st = b / 1024, sb = b % 1024, swz = sb ^ (((sb >> 9) & 1) << 5); R = (st >> 1) * 16 + swz / 64; C = (st & 1) * 32 + (swz % 64) / 2; }
__host__ __device__ __forceinline__ int perm32(int rho) { const int n = rho >> 4, i = rho & 15; return 8 * (i >> 2) + 4 * n + (i & 3); }

struct Unit { int pm, pn, e, j, k0, nt, s, pa, pl, cn; };
struct Gemm { const bf16_t* A; const bf16_t* Bt; int M, N, K; };

struct StaticOrder {
    int nM, nN, nwg, G, c, ntk;
    __host__ __device__ void init(int M, int N, int K, int G_, int c_) { nM = M / BM; nN = N / BM; nwg = nM * nN; G = G_; c = c_; ntk = K / BK; }
    __host__ __device__ bool next(int i, Unit& u) const {
        const long L = (long)i * G + c; if (L >= nwg) return false;
        int wgid = (int)L; { const int q = nwg / NXCD, r = nwg % NXCD, xcd = wgid % NXCD, off = wgid / NXCD; wgid = (xcd < r ? xcd * (q + 1) : r * (q + 1) + (xcd - r) * q) + off; }
        const int nig = WGM * nN, gid = wgid / nig, fm = gid * WGM, gsz = (nM - fm) < WGM ? (nM - fm) : WGM;
        u.pm = fm + ((wgid % nig) % gsz); u.pn = (wgid % nig) / gsz; u.e = 0; u.j = u.pn; u.k0 = 0; u.nt = ntk; u.s = 0; u.pa = u.pm; u.pl = 0; u.cn = 0; return true;
    }
    __device__ __forceinline__ void a_ready(const Unit&) const {}
    __device__ __forceinline__ void done(const Unit&) const {}
};

__device__ __forceinline__ unsigned cvt_pk_bf16(float lo, float hi) { unsigned r; asm volatile("v_cvt_pk_bf16_f32 %0, %1, %2" : "=v"(r) : "v"(lo), "v"(hi)); return r; }
typedef float f32x2 __attribute__((ext_vector_type(2)));
__device__ __forceinline__ f32x2 gelu_pk(f32x2 v) {
    const f32x2 av = __builtin_elementwise_abs(v), d = av * 0.2316418882f + 1.0f;
    f32x2 t; t.x = __builtin_amdgcn_rcpf(d.x); t.y = __builtin_amdgcn_rcpf(d.y);
    f32x2 q = t * 0.5307027145f + (-0.7265760135f); q = q * t + 0.7107068705f; q = q * t + (-0.142248368f); q = q * t + 0.127414796f; q = q * t;
    const f32x2 s = (v * v) * (-0.72134752044f);
    f32x2 e; e.x = __builtin_amdgcn_exp2f(s.x); e.y = __builtin_amdgcn_exp2f(s.y);
    const f32x2 m = v * (q * e), r = v - m;
    f32x2 o; o.x = v.x < 0.f ? m.x : r.x; o.y = v.y < 0.f ? m.y : r.y; return o;
}

template <int ACT  > struct EpiBf16 {
    static constexpr bool PERM = true, AFTER_DRAIN = false; static_assert(ACT == 0 || ACT == 1, "EpiBf16: ACT is 0 (none) or 1 (gelu_pk)");
    bf16_t* O; int ldc; const float* bias; int split_cols; size_t split_stride; float scale0;
    __device__ __forceinline__ void operator()(const f32x4 (&acc)[2][2][4][2], const Unit& u, int wr, int wc, int fr, int fq) const {
        const int row0 = u.pm * BM + wr * 64 + fr; int colt = u.pn * BM; bf16_t* base = O;
        float sc = 1.f; if (split_cols) { const int t = colt / split_cols; base += (size_t)t * split_stride; colt -= t * split_cols; if (t == 0) sc = scale0; }
        const int col0 = colt + wc * 32 + 8 * fq, bcol0 = u.pn * BM + wc * 32 + 8 * fq;
        f32x4 bv[2][2];
#pragma unroll
        for (int bj = 0; bj < 2; ++bj)
#pragma unroll
            for (int n = 0; n < 2; ++n) bv[bj][n] = bias ? *(const f32x4*)(bias + bcol0 + bj * HALF + 4 * n) : (f32x4){0.f, 0.f, 0.f, 0.f};
#pragma unroll
        for (int ai = 0; ai < 2; ++ai)
#pragma unroll
            for (int m = 0; m < 4; ++m) { bf16_t* rowp = base + (size_t)(row0 + ai * HALF + m * 16) * ldc + col0;
#pragma unroll
                for (int bj = 0; bj < 2; ++bj) { f32x4 v0 = acc[ai][bj][m][0] + bv[bj][0], v1 = acc[ai][bj][m][1] + bv[bj][1];
                    if (ACT == 1) { f32x2 a = gelu_pk((f32x2){v0[0], v0[1]}), b = gelu_pk((f32x2){v0[2], v0[3]}), c = gelu_pk((f32x2){v1[0], v1[1]}), d = gelu_pk((f32x2){v1[2], v1[3]});
                        v0 = (f32x4){a.x, a.y, b.x, b.y}; v1 = (f32x4){c.x, c.y, d.x, d.y}; }
                    v0 = v0 * sc; v1 = v1 * sc; u32x4 w; w.x = cvt_pk_bf16(v0[0], v0[1]); w.y = cvt_pk_bf16(v0[2], v0[3]); w.z = cvt_pk_bf16(v1[0], v1[1]); w.w = cvt_pk_bf16(v1[2], v1[3]);
                    *(u32x4*)(rowp + bj * HALF) = w; } }
    }
};
__device__ __forceinline__ float sigm_f(float x) { return __builtin_amdgcn_rcpf(1.f + __builtin_amdgcn_exp2f(-1.4426950409f * x)); }
__device__ __forceinline__ float silu_f(float x) { return x * sigm_f(x); }
__device__ __forceinline__ f32x4 exp2_v(f32x4 x) { return (f32x4){__builtin_amdgcn_exp2f(x[0]), __builtin_amdgcn_exp2f(x[1]), __builtin_amdgcn_exp2f(x[2]), __builtin_amdgcn_exp2f(x[3])}; }
__device__ __forceinline__ f32x4 rcp_v(f32x4 x) { return (f32x4){__builtin_amdgcn_rcpf(x[0]), __builtin_amdgcn_rcpf(x[1]), __builtin_amdgcn_rcpf(x[2]), __builtin_amdgcn_rcpf(x[3])}; }
__device__ __forceinline__ f32x4 sigm_v(f32x4 x) { return rcp_v(1.f + exp2_v(x * -1.4426950409f)); }
__device__ __forceinline__ f32x4 swiglu_v(f32x4 a, f32x4 g, float sc) { const float k = 1.0f / (sc * sc); const f32x4 r = rcp_v(exp2_v(a * (-1.4426950409f * sc)) * k + k); return (a * g) * r; }
__device__ __forceinline__ f32x4 gelu_tanh_v(f32x4 x) { const f32x4 t = x * (x * x * (-2.3022082f * 0.044715f) + -2.3022082f); return x * rcp_v(1.f + exp2_v(t)); }
__device__ __forceinline__ float gelu_tanh_f(float x) { const float t = x * (1.f + 0.044715f * x * x); return x * __builtin_amdgcn_rcpf(1.f + __builtin_amdgcn_exp2f(-2.3022082f * t)); }

struct EpiWin {
    static constexpr bool PERM = true, AFTER_DRAIN = false;
    bf16_t *U, *V, *G; float* stats;
    __device__ __forceinline__ void operator()(const f32x4 (&acc)[2][2][4][2], const Unit& u, int wr, int wc, int fr, int fq) const {
        const int row0 = u.pm * BM + wr * 64 + fr;
        if (u.pn < 8) {
            bf16_t* base = (u.pn < 4) ? U : V; const int col0 = (u.pn & 3) * 256 + wc * 32 + 8 * fq;
#pragma unroll
            for (int ai = 0; ai < 2; ++ai)
#pragma unroll
                for (int m = 0; m < 4; ++m) { bf16_t* rowp = base + (size_t)(row0 + ai * HALF + m * 16) * 1024 + col0; f32x4 sv1 = (f32x4){0.f, 0.f, 0.f, 0.f}, sv2 = (f32x4){0.f, 0.f, 0.f, 0.f};
#pragma unroll
                    for (int bj = 0; bj < 2; ++bj) { const f32x4 g0 = gelu_tanh_v(acc[ai][bj][m][0]), g1 = gelu_tanh_v(acc[ai][bj][m][1]);
                        sv1 = sv1 + (g0 + g1); sv2 = sv2 + (g0 * g0 + g1 * g1);
                        u32x4 w; w.x = cvt_pk_bf16(g0[0], g0[1]); w.y = cvt_pk_bf16(g0[2], g0[3]); w.z = cvt_pk_bf16(g1[0], g1[1]); w.w = cvt_pk_bf16(g1[2], g1[3]);
                        *(u32x4*)(rowp + bj * HALF) = w; }
                    float s1 = (sv1[0] + sv1[1]) + (sv1[2] + sv1[3]), s2 = (sv2[0] + sv2[1]) + (sv2[2] + sv2[3]);
                    if (u.pn >= 4) { s1 += __shfl_xor(s1, 16); s1 += __shfl_xor(s1, 32); s2 += __shfl_xor(s2, 16); s2 += __shfl_xor(s2, 32);
                        if (fq == 0) { f32x2 sv; sv.x = s1; sv.y = s2; *(f32x2*)(stats + (size_t)(row0 + ai * HALF + m * 16) * 32 + ((u.pn - 4) * 4 + wc) * 2) = sv; } } }
        } else {
            const int col0 = (u.pn - 8) * 128 + wc * 32 + 8 * fq;
#pragma unroll
            for (int ai = 0; ai < 2; ++ai)
#pragma unroll
                for (int m = 0; m < 4; ++m) { bf16_t* rowp = G + (size_t)(row0 + ai * HALF + m * 16) * 1024 + col0;
                    const f32x4 a0 = acc[ai][0][m][0], a1 = acc[ai][0][m][1], g0 = acc[ai][1][m][0], g1 = acc[ai][1][m][1]; u32x4 w;
                    const f32x4 y0 = a0 * sigm_v(g0), y1 = a1 * sigm_v(g1);
                    w.x = cvt_pk_bf16(y0[0], y0[1]); w.y = cvt_pk_bf16(y0[2], y0[3]); w.z = cvt_pk_bf16(y1[0], y1[1]); w.w = cvt_pk_bf16(y1[2], y1[3]);
                    *(u32x4*)rowp = w; }
        }
    }
};
struct EpiSwiGLU {
    static constexpr bool PERM = true, AFTER_DRAIN = false;
    bf16_t* T; int ldc; float gmul;
    __device__ __forceinline__ void operator()(const f32x4 (&acc)[2][2][4][2], const Unit& u, int wr, int wc, int fr, int fq) const {
#ifdef MK_SKIP_EPI
        if (gmul == 0.f) return;
#endif
        const int row0 = u.pm * BM + wr * 64 + fr; const int col0 = u.j * 128 + wc * 32 + 8 * fq;
#pragma unroll
        for (int ai = 0; ai < 2; ++ai)
#pragma unroll
            for (int m = 0; m < 4; ++m) { bf16_t* rowp = T + (size_t)(row0 + ai * HALF + m * 16) * ldc + col0;
                const f32x4 a0 = acc[ai][0][m][0], a1 = acc[ai][0][m][1], g0 = acc[ai][1][m][0], g1 = acc[ai][1][m][1]; u32x4 w;
                const f32x4 y0 = swiglu_v(a0, g0, 1.0f), y1 = swiglu_v(a1, g1, 1.0f);
                w.x = cvt_pk_bf16(y0[0], y0[1]); w.y = cvt_pk_bf16(y0[2], y0[3]); w.z = cvt_pk_bf16(y1[0], y1[1]); w.w = cvt_pk_bf16(y1[2], y1[3]);
                *(u32x4*)rowp = w; }
    }
};
struct EpiSwiGLU8 {
    static constexpr bool PERM = true, AFTER_DRAIN = false;
    unsigned char* T; int ldc; float isc;
    __device__ __forceinline__ void operator()(const f32x4 (&acc)[2][2][4][2], const Unit& u, int wr, int wc, int fr, int fq) const {
        const int row0 = u.pm * BM + wr * 64 + fr; const int col0 = u.j * 128 + wc * 32 + 8 * fq;
#pragma unroll
        for (int ai = 0; ai < 2; ++ai)
#pragma unroll
            for (int m = 0; m < 4; ++m) { unsigned char* rowp = T + (size_t)(row0 + ai * HALF + m * 16) * ldc + col0;
                const f32x4 y0 = swiglu_v(acc[ai][0][m][0], acc[ai][1][m][0], isc), y1 = swiglu_v(acc[ai][0][m][1], acc[ai][1][m][1], isc);
                int p0 = 0, p1 = 0;
                p0 = __builtin_amdgcn_cvt_pk_fp8_f32(y0[0], y0[1], p0, false); p0 = __builtin_amdgcn_cvt_pk_fp8_f32(y0[2], y0[3], p0, true);
                p1 = __builtin_amdgcn_cvt_pk_fp8_f32(y1[0], y1[1], p1, false); p1 = __builtin_amdgcn_cvt_pk_fp8_f32(y1[2], y1[3], p1, true);
                *(unsigned long long*)rowp = (unsigned long long)(unsigned)p0 | ((unsigned long long)(unsigned)p1 << 32); }
    }
};
struct EpiResid {
    static constexpr bool PERM = true, AFTER_DRAIN = false;
    bf16_t* X; const float* gate; float* PB; int rs0; float gmul; float psc = 1.0f;
    __device__ __forceinline__ void operator()(const f32x4 (&acc)[2][2][4][2], const Unit& u, int wr, int wc, int fr, int fq) const {
        const int col0 = u.pn * BM + wc * 32 + 8 * fq;
        if (u.e == 0) {
            const int mr = (u.pm < 64) ? (u.pm >> 3) : 8; const float* gp = gate + (size_t)mr * 6144;
            f32x4 gv[2][2];
#pragma unroll
            for (int bj = 0; bj < 2; ++bj)
#pragma unroll
                for (int n = 0; n < 2; ++n) gv[bj][n] = *(const f32x4*)(gp + col0 + bj * HALF + 4 * n) * gmul;
#pragma unroll
            for (int ai = 0; ai < 2; ++ai) { bf16_t* xb = X + (size_t)(u.pm * BM + ai * HALF + wr * 64 + fr) * 1024 + col0; u32x4 xv[4][2];
#pragma unroll
                for (int m = 0; m < 4; ++m)
#pragma unroll
                    for (int bj = 0; bj < 2; ++bj) xv[m][bj] = *(const u32x4*)(xb + (size_t)m * 16 * 1024 + bj * HALF);
                asm volatile("" ::: "memory");
#pragma unroll
                for (int m = 0; m < 4; ++m)
#pragma unroll
                    for (int bj = 0; bj < 2; ++bj) { const u32x4 x = xv[m][bj]; const f32x4 a0 = acc[ai][bj][m][0] * gv[bj][0], a1 = acc[ai][bj][m][1] * gv[bj][1]; u32x4 w;
                        w.x = cvt_pk_bf16(__uint_as_float(x.x << 16) + a0[0], __uint_as_float(x.x & 0xffff0000u) + a0[1]); w.y = cvt_pk_bf16(__uint_as_float(x.y << 16) + a0[2], __uint_as_float(x.y & 0xffff0000u) + a0[3]);
                        w.z = cvt_pk_bf16(__uint_as_float(x.z << 16) + a1[0], __uint_as_float(x.z & 0xffff0000u) + a1[1]); w.w = cvt_pk_bf16(__uint_as_float(x.w << 16) + a1[2], __uint_as_float(x.w & 0xffff0000u) + a1[3]);
                        *(u32x4*)(xb + (size_t)m * 16 * 1024 + bj * HALF) = w; }
                asm volatile("" ::: "memory"); }
        } else {
            bf16_t* pb = (bf16_t*)PB + (size_t)(u.e - 1) * 2048 * 1024;
#pragma unroll
            for (int ai = 0; ai < 2; ++ai)
#pragma unroll
                for (int m = 0; m < 4; ++m) { bf16_t* xp = pb + (size_t)(u.pm * BM + ai * HALF + wr * 64 + m * 16 + fr - rs0) * 1024 + col0;
#pragma unroll
                    for (int bj = 0; bj < 2; ++bj) { const f32x4 v0 = acc[ai][bj][m][0] * psc, v1 = acc[ai][bj][m][1] * psc; u32x4 w; w.x = cvt_pk_bf16(v0[0], v0[1]); w.y = cvt_pk_bf16(v0[2], v0[3]); w.z = cvt_pk_bf16(v1[0], v1[1]); w.w = cvt_pk_bf16(v1[2], v1[3]);
                        *(u32x4*)(xp + bj * HALF) = w; } }
        }
    }
};
struct EpiMoeDown {
    static constexpr bool PERM = true, AFTER_DRAIN = false;
    bf16_t* YS; const int* toklist; const float* tokwt; int cap; bf16_t* PB; int ps0, psrows; float osc;
    __device__ __forceinline__ void operator()(const f32x4 (&acc)[2][2][4][2], const Unit& u, int wr, int wc, int fr, int fq) const {
        const int col0 = u.j * BM + wc * 32 + 8 * fq;
        if (u.s > 0) {
#pragma unroll
            for (int ai = 0; ai < 2; ++ai)
#pragma unroll
                for (int m = 0; m < 4; ++m) { const int prow = u.pm * BM + ai * HALF + wr * 64 + m * 16 + fr; bf16_t* pp = PB + ((size_t)(u.s - 1) * psrows + (size_t)(prow - ps0)) * 1024 + col0;
#pragma unroll
                    for (int bj = 0; bj < 2; ++bj) { const f32x4 v0 = acc[ai][bj][m][0] * osc, v1 = acc[ai][bj][m][1] * osc; u32x4 w; w.x = cvt_pk_bf16(v0[0], v0[1]); w.y = cvt_pk_bf16(v0[2], v0[3]); w.z = cvt_pk_bf16(v1[0], v1[1]); w.w = cvt_pk_bf16(v1[2], v1[3]);
                        *(u32x4*)(pp + bj * HALF) = w; } }
            return; }
        int tsv[2][4]; float wv[2][4];
#pragma unroll
        for (int ai = 0; ai < 2; ++ai)
#pragma unroll
            for (int m = 0; m < 4; ++m) { const int pos = u.pl * BM + ai * HALF + wr * 64 + m * 16 + fr; const int tl = toklist[u.e * cap + pos]; wv[ai][m] = tokwt[u.e * cap + pos]; tsv[ai][m] = (pos < u.cn) ? tl : -1; }
        asm volatile("" ::: "memory");
#pragma unroll
        for (int ai = 0; ai < 2; ++ai)
#pragma unroll
            for (int m = 0; m < 4; ++m) { const int ts = tsv[ai][m]; const float w = wv[ai][m] * osc;
                if (ts >= 0) { bf16_t* yp = YS + (size_t)ts * 1024 + col0;
#pragma unroll
                    for (int bj = 0; bj < 2; ++bj) { const f32x4 v0 = acc[ai][bj][m][0] * w, v1 = acc[ai][bj][m][1] * w; u32x4 o; o.x = cvt_pk_bf16(v0[0], v0[1]); o.y = cvt_pk_bf16(v0[2], v0[3]); o.z = cvt_pk_bf16(v1[0], v1[1]); o.w = cvt_pk_bf16(v1[2], v1[3]);
                        *(u32x4*)(yp + bj * HALF) = o; } } }
    }
};
struct EpiQKV {
    static constexpr bool PERM = true, AFTER_DRAIN = false;
    bf16_t *Q, *K, *V; const float *qg, *kg, *rope; int nlat; float qsc, eps;
    __device__ __forceinline__ void operator()(const f32x4 (&acc)[2][2][4][2], const Unit& u, int wr, int wc, int fr, int fq) const {
        const int row0 = u.pm * BM + wr * 64 + fr;
        if (u.pn == 5) {
#pragma unroll
            for (int ai = 0; ai < 2; ++ai)
#pragma unroll
                for (int m = 0; m < 4; ++m) { bf16_t* rowp = V + (size_t)(row0 + ai * HALF + m * 16) * 256 + wc * 32 + 8 * fq;
#pragma unroll
                    for (int bj = 0; bj < 2; ++bj) { const f32x4 v0 = acc[ai][bj][m][0], v1 = acc[ai][bj][m][1]; u32x4 w; w.x = cvt_pk_bf16(v0[0], v0[1]); w.y = cvt_pk_bf16(v0[2], v0[3]); w.z = cvt_pk_bf16(v1[0], v1[1]); w.w = cvt_pk_bf16(v1[2], v1[3]);
                        *(u32x4*)(rowp + bj * HALF) = w; } }
        } else {
            const bool isq = u.pn < 4; const float* gp = isq ? qg : kg; const float osc = isq ? qsc : 1.0f;
            f32x4 gv[2][2];
#pragma unroll
            for (int bj = 0; bj < 2; ++bj)
#pragma unroll
                for (int n = 0; n < 2; ++n) gv[bj][n] = *(const f32x4*)(gp + 32 * bj + 16 * n + 4 * fq);
#pragma unroll
            for (int ai = 0; ai < 2; ++ai)
#pragma unroll
                for (int m = 0; m < 4; ++m) { const int row = row0 + ai * HALF + m * 16;
                    float ss = 0.f;
#pragma unroll
                    for (int bj = 0; bj < 2; ++bj)
#pragma unroll
                        for (int n = 0; n < 2; ++n) { const f32x4 x = acc[ai][bj][m][n]; ss += (x[0] * x[0] + x[1] * x[1]) + (x[2] * x[2] + x[3] * x[3]); }
                    ss += __shfl_xor(ss, 16); ss += __shfl_xor(ss, 32);
                    const float r = osc / sqrtf(ss * (1.0f / 64.0f) + eps);
                    f32x4 y[2][2];
#pragma unroll
                    for (int bj = 0; bj < 2; ++bj)
#pragma unroll
                        for (int n = 0; n < 2; ++n) y[bj][n] = acc[ai][bj][m][n] * r * gv[bj][n];
                    if (row < nlat) { const int t = row & 2047;
#pragma unroll
                        for (int bj = 0; bj < 2; ++bj) { const int pos = bj ? (t & 63) : (t >> 6); const float* tp = rope + (pos * 16 + 4 * fq) * 2; const f32x4 c01 = *(const f32x4*)tp, c23 = *(const f32x4*)(tp + 4);
                            const f32x4 cs = (f32x4){c01[0], c01[2], c23[0], c23[2]}, sn = (f32x4){c01[1], c01[3], c23[1], c23[3]};
                            const f32x4 a = y[bj][0], b = y[bj][1]; y[bj][0] = a * cs - b * sn; y[bj][1] = b * cs + a * sn; } }
                    bf16_t* dp = (isq ? Q + (size_t)row * 1024 + (4 * u.pn + wc) * 64 : K + (size_t)row * 256 + wc * 64) + 8 * fq;
#pragma unroll
                    for (int bj = 0; bj < 2; ++bj) { const f32x4 v0 = y[bj][0], v1 = y[bj][1]; u32x4 w; w.x = cvt_pk_bf16(v0[0], v0[1]); w.y = cvt_pk_bf16(v0[2], v0[3]); w.z = cvt_pk_bf16(v1[0], v1[1]); w.w = cvt_pk_bf16(v1[2], v1[3]);
                        *(u32x4*)(dp + 32 * bj) = w; } }
        }
    }
};
template <class Epi, class Sched, bool ALIGN_EPI = false, bool SP2 = false, int NTC = 0, bool FP8 = false>
__device__ __forceinline__ void gemm_phase(PG8_LAS unsigned char* lds, const Gemm g, const Sched& S, const Epi& E) {
    int tid_ = threadIdx.x; asm volatile("" : "+v"(tid_));
    const int tid = tid_, wid = __builtin_amdgcn_readfirstlane(tid >> 6), lane = tid & 63, wr = wid >> 2, wc = wid & 3, fr = lane & 15, fq = lane >> 4;
    const int K = g.K;
    unsigned voffA[2], voffB[2];
#pragma unroll
    for (int i = 0; i < 2; ++i) { int R, C; stage_rc(tid * 16 + i * 8192, R, C); const int Rb = Epi::PERM ? ((R & ~31) + perm32(R & 31)) : R;
        voffA[i] = (unsigned)(R * K + C) * 2u; voffB[i] = (unsigned)(Rb * K + C) * 2u; }
    const size_t kstep = (size_t)(BK * 2);
    const size_t hstep = (size_t)HALF * K * 2;
    const size_t tstep = 2 * hstep;
    const unsigned ldsw = (unsigned)wid * 1024u;
    const int aoff = lds_byte(wr * 64 + fr, fq * 8), boff = lds_byte(wc * 32 + fr, fq * 8);
#define PG8_SA(b, h) (((b) * 2 + (h)) * HTB)
#define PG8_SB(b, h) ((4 + (b) * 2 + (h)) * HTB)
#define PG8_STAGE(bufoff, gbase, voff) do { _Pragma("unroll") for (int _i = 0; _i < 2; ++_i) \
        __builtin_amdgcn_global_load_lds((const unsigned*)((const char*)(gbase) + (voff)[_i]), (PG8_LAS unsigned*)(lds + (bufoff) + ldsw + _i * 8192), 16, 0, 0); } while (0)
#define PG8_LDA(dst, b, h) do { if constexpr (FP8) { _Pragma("unroll") for (int m = 0; m < 4; ++m) { const v4i32 l0_ = *(const PG8_LAS v4i32*)(lds + PG8_SA(b, h) + aoff + m * 2048), l1_ = *(const PG8_LAS v4i32*)(lds + PG8_SA(b, h) + aoff + m * 2048 + 1024); \
            dst##8[m] = __builtin_shufflevector(l0_, l1_, 0, 1, 2, 3, 4, 5, 6, 7); } } \
        else { _Pragma("unroll") for (int m = 0; m < 4; ++m) _Pragma("unroll") for (int k = 0; k < 2; ++k) dst[m][k] = *(const PG8_LAS bf16x8*)(lds + PG8_SA(b, h) + aoff + m * 2048 + k * 1024); } } while (0)
#define PG8_LDB(dst, b, h) do { if constexpr (FP8) { _Pragma("unroll") for (int n = 0; n < 2; ++n) { const v4i32 l0_ = *(const PG8_LAS v4i32*)(lds + PG8_SB(b, h) + boff + n * 2048), l1_ = *(const PG8_LAS v4i32*)(lds + PG8_SB(b, h) + boff + n * 2048 + 1024); \
            dst##8[n] = __builtin_shufflevector(l0_, l1_, 0, 1, 2, 3, 4, 5, 6, 7); } } \
        else { _Pragma("unroll") for (int n = 0; n < 2; ++n) _Pragma("unroll") for (int k = 0; k < 2; ++k) dst[n][k] = *(const PG8_LAS bf16x8*)(lds + PG8_SB(b, h) + boff + n * 2048 + k * 1024); } } while (0)
#define PG8_MMA(ai, bj, At, Bt) do { __builtin_amdgcn_s_setprio(1); \
        if constexpr (FP8) { asm volatile("s_nop 1"); _Pragma("unroll") for (int m = 0; m < 4; ++m) _Pragma("unroll") for (int n = 0; n < 2; ++n) \
            asm volatile("v_mfma_scale_f32_16x16x128_f8f6f4 %0, %1, %2, %0, %3, %3 op_sel_hi:[0,0,0]" : "+v"(acc[ai][bj][m][n]) : "v"(Bt##8[n]), "v"(At##8[m]), "v"(f8one)); } \
        else { _Pragma("unroll") for (int m = 0; m < 4; ++m) _Pragma("unroll") for (int n = 0; n < 2; ++n) _Pragma("unroll") for (int k = 0; k < 2; ++k) \
            acc[ai][bj][m][n] = __builtin_amdgcn_mfma_f32_16x16x32_bf16(Bt[n][k], At[m][k], acc[ai][bj][m][n], 0, 0, 0); } \
        __builtin_amdgcn_s_setprio(0); } while (0)
#define PG8_WAIT_V(n) asm volatile("s_waitcnt vmcnt(" #n ")" ::: "memory")
#define PG8_WAIT_L(n) asm volatile("s_waitcnt lgkmcnt(" #n ")" ::: "memory")
#define PG8_BAR __builtin_amdgcn_s_barrier()
#define PG8_SCHED __builtin_amdgcn_sched_barrier(0)
    Unit cur, nxt; int ui = 0;
    if (!S.next(0, cur)) return;
    f32x4 acc[2][2][4][2];
#pragma unroll
    for (int a = 0; a < 2; ++a)
#pragma unroll
        for (int b = 0; b < 2; ++b)
#pragma unroll
            for (int m = 0; m < 4; ++m)
#pragma unroll
                for (int n = 0; n < 2; ++n) acc[a][b][m][n] = (f32x4){0.f, 0.f, 0.f, 0.f};
    bf16x8 At[4][2], B0[2][2], B1[2][2];
    const int f8one = 0x7f7f7f7f;
    v8i32 At8[4], B08[2], B18[2];
    const char* cA = (const char*)g.A + (size_t)cur.pa * tstep + (size_t)cur.k0 * 2; const char* cB = (const char*)g.Bt + (size_t)cur.pn * tstep + (size_t)cur.k0 * 2;
    S.a_ready(cur);
    if constexpr (SP2) {
        PG8_STAGE(PG8_SB(0, 0), cB, voffB); PG8_STAGE(PG8_SB(0, 1), cB + hstep, voffB); PG8_STAGE(PG8_SA(0, 0), cA, voffA); PG8_STAGE(PG8_SA(0, 1), cA + hstep, voffA);
        if (wr == 1) PG8_BAR;
        PG8_WAIT_V(2); PG8_BAR;
        PG8_STAGE(PG8_SB(1, 0), cB + kstep, voffB); PG8_STAGE(PG8_SA(1, 0), cA + kstep, voffA); PG8_STAGE(PG8_SB(1, 1), cB + hstep + kstep, voffB);
        PG8_WAIT_V(6); PG8_BAR;
    } else {
        PG8_STAGE(PG8_SB(0, 0), cB, voffB); PG8_STAGE(PG8_SA(0, 0), cA, voffA); PG8_STAGE(PG8_SB(0, 1), cB + hstep, voffB); PG8_STAGE(PG8_SA(0, 1), cA + hstep, voffA);
        if (wr == 1) PG8_BAR;
        PG8_WAIT_V(4); PG8_BAR;
        PG8_STAGE(PG8_SB(1, 0), cB + kstep, voffB); PG8_STAGE(PG8_SA(1, 0), cA + kstep, voffA); PG8_STAGE(PG8_SB(1, 1), cB + hstep + kstep, voffB);
        PG8_WAIT_V(6); PG8_BAR;
    }
    for (;;) {
        const bool has_next = S.next(ui + 1, nxt);
        const char* nA = has_next ? (const char*)g.A + (size_t)nxt.pa * tstep + (size_t)nxt.k0 * 2 : cA; const char* nB = has_next ? (const char*)g.Bt + (size_t)nxt.pn * tstep + (size_t)nxt.k0 * 2 : cB;
        const int nt = NTC ? NTC : cur.nt;
#pragma unroll 1
        for (int t = 0; t < nt; t += 2) {
            const bool last = (t == nt - 2);
            const char* a1 = cA + (size_t)(t + 1) * kstep;
            const char* a2 = last ? nA : cA + (size_t)(t + 2) * kstep; const char* b2 = last ? nB : cB + (size_t)(t + 2) * kstep;
            const char* a3 = a2 + kstep; const char* b3 = b2 + kstep;
            if (last && has_next) S.a_ready(nxt);
            if constexpr (SP2) {
            PG8_LDB(B0, 0, 0); PG8_LDB(B1, 0, 1); PG8_SCHED; PG8_LDA(At, 0, 0); PG8_STAGE(PG8_SA(1, 1), a1 + hstep, voffA);
            PG8_WAIT_V(8); PG8_WAIT_L(0); PG8_BAR; PG8_MMA(0, 0, At, B0); PG8_MMA(0, 1, At, B1); PG8_BAR; PG8_SCHED;
            PG8_LDA(At, 0, 1); PG8_STAGE(PG8_SB(0, 0), b2, voffB); PG8_STAGE(PG8_SB(0, 1), b2 + hstep, voffB); PG8_STAGE(PG8_SA(0, 0), a2, voffA);
            PG8_WAIT_V(8); PG8_WAIT_L(0); PG8_BAR; PG8_MMA(1, 0, At, B0); PG8_MMA(1, 1, At, B1); PG8_BAR; PG8_SCHED;
            PG8_LDB(B0, 1, 0); PG8_LDB(B1, 1, 1); PG8_SCHED; PG8_LDA(At, 1, 0); PG8_STAGE(PG8_SA(0, 1), a2 + hstep, voffA);
            PG8_WAIT_V(8); PG8_WAIT_L(0); PG8_BAR; PG8_MMA(0, 0, At, B0); PG8_MMA(0, 1, At, B1); PG8_BAR; PG8_SCHED;
            PG8_LDA(At, 1, 1); PG8_STAGE(PG8_SB(1, 0), b3, voffB); PG8_STAGE(PG8_SB(1, 1), b3 + hstep, voffB); PG8_STAGE(PG8_SA(1, 0), a3, voffA);
            PG8_WAIT_V(8); PG8_WAIT_L(0); PG8_BAR; PG8_MMA(1, 0, At, B0); PG8_MMA(1, 1, At, B1); PG8_BAR; PG8_SCHED;
            } else {
            PG8_LDB(B0, 0, 0); PG8_SCHED; PG8_LDA(At, 0, 0); PG8_STAGE(PG8_SA(1, 1), a1 + hstep, voffA);
            PG8_WAIT_L(8); PG8_BAR; PG8_WAIT_L(0); PG8_MMA(0, 0, At, B0); PG8_BAR; PG8_SCHED;
            PG8_LDB(B1, 0, 1); PG8_STAGE(PG8_SB(0, 0), b2, voffB);
            PG8_BAR; PG8_WAIT_L(0); PG8_MMA(0, 1, At, B1); PG8_BAR;
            PG8_LDA(At, 0, 1); PG8_STAGE(PG8_SA(0, 0), a2, voffA);
            PG8_BAR; PG8_WAIT_L(0); PG8_MMA(1, 0, At, B0); PG8_BAR; PG8_SCHED;
            PG8_STAGE(PG8_SB(0, 1), b2 + hstep, voffB);
            PG8_WAIT_V(6); PG8_BAR; PG8_MMA(1, 1, At, B1); PG8_BAR;
            PG8_LDB(B0, 1, 0); PG8_SCHED; PG8_LDA(At, 1, 0); PG8_STAGE(PG8_SA(0, 1), a2 + hstep, voffA);
            PG8_WAIT_L(8); PG8_BAR; PG8_WAIT_L(0); PG8_MMA(0, 0, At, B0); PG8_BAR; PG8_SCHED;
            PG8_LDB(B1, 1, 1); PG8_STAGE(PG8_SB(1, 0), b3, voffB);
            PG8_BAR; PG8_WAIT_L(0); PG8_MMA(0, 1, At, B1); PG8_BAR;
            PG8_LDA(At, 1, 1); PG8_STAGE(PG8_SA(1, 0), a3, voffA);
            PG8_BAR; PG8_WAIT_L(0); PG8_MMA(1, 0, At, B0); PG8_BAR; PG8_SCHED;
            PG8_STAGE(PG8_SB(1, 1), b3 + hstep, voffB);
            PG8_WAIT_V(6); PG8_BAR; PG8_MMA(1, 1, At, B1); PG8_BAR;
            }
        }
        if constexpr (ALIGN_EPI) { if (wr == 0) PG8_BAR; }
        if constexpr (FP8) { asm volatile("s_nop 15\n\ts_nop 15\n\ts_nop 15\n\ts_nop 15" ::: "memory"); }
        if constexpr (!Epi::AFTER_DRAIN) { E(acc, cur, wr, wc, fr, fq); S.done(cur); }
        if (!has_next) break;
#pragma unroll
        for (int a = 0; a < 2; ++a)
#pragma unroll
            for (int b = 0; b < 2; ++b)
#pragma unroll
                for (int m = 0; m < 4; ++m)
#pragma unroll
                    for (int n = 0; n < 2; ++n) acc[a][b][m][n] = (f32x4){0.f, 0.f, 0.f, 0.f};
        cur = nxt; cA = nA; cB = nB; ++ui;
        if constexpr (ALIGN_EPI) { if (wr == 1) PG8_BAR; }
    }
    PG8_WAIT_V(0);
    if constexpr (!ALIGN_EPI) { if (wr == 0) PG8_BAR; }
    PG8_BAR;
    if constexpr (Epi::AFTER_DRAIN) { E.fused(acc, cur, wr, wc, fr, fq, lds, wid, lane); S.done(cur); }
#undef PG8_SA
#undef PG8_SB
#undef PG8_STAGE
#undef PG8_LDA
#undef PG8_LDB
#undef PG8_MMA
#undef PG8_WAIT_V
#undef PG8_WAIT_L
#undef PG8_BAR
#undef PG8_SCHED
}
}
#define GAS __attribute__((address_space(1)))
#define LAS __attribute__((address_space(3)))
typedef unsigned short bf16;
typedef unsigned v4u __attribute__((ext_vector_type(4)));
typedef float f32x4 __attribute__((ext_vector_type(4)));
typedef short bf16x8 __attribute__((ext_vector_type(8)));
typedef GAS unsigned gu32;
typedef GAS unsigned long long gu64;
#define RLX_AGENT __ATOMIC_RELAXED, __HIP_MEMORY_SCOPE_AGENT
#define LDS_WAIT() asm volatile("s_waitcnt lgkmcnt(0)" ::: "memory")
#define VM_WAIT() asm volatile("s_waitcnt vmcnt(0)" ::: "memory")
__device__ __forceinline__ unsigned long long rt() { return __builtin_amdgcn_s_memrealtime(); }
__device__ __forceinline__ unsigned f2bf(float f) { unsigned u = __builtin_bit_cast(unsigned, f); return (u + 0x7fffu + ((u >> 16) & 1u)) >> 16; }
__device__ __forceinline__ unsigned pk2(float lo, float hi) { return f2bf(lo) | (f2bf(hi) << 16); }

#define XB_TMO      128
#define XB_XCNT(j)  (256  + 64 * (j))
#define XB_XSUB(j)  (1280 + 64 * (j))
#define XB_XGEN(j)  (2304 + 64 * (j))
#define XB_TOP      3328
#define XB_TOPGEN   3392
#define XCD_BAR_WORDS 3456
#define XB_SPIN_CAP (1u << 18)

__device__ __forceinline__ unsigned xb_ld(unsigned* p)              { return __hip_atomic_load(p, __ATOMIC_RELAXED, __HIP_MEMORY_SCOPE_AGENT); }
__device__ __forceinline__ unsigned xb_add(unsigned* p, unsigned v) { return __hip_atomic_fetch_add(p, v, __ATOMIC_RELAXED, __HIP_MEMORY_SCOPE_AGENT); }
__device__ __forceinline__ unsigned xb_xcc_id() { return (unsigned)__builtin_amdgcn_s_getreg((3 << 11) | 20) & 0xFu; }
#define XB_SPIN(cond, bar) do { unsigned _sp = 0; while (cond) { __builtin_amdgcn_s_sleep(1); \
    if ((++_sp & 255u) == 0u) { if (xb_ld(&(bar)[XB_TMO])) break; if (_sp > XB_SPIN_CAP) { atomicAdd(&(bar)[XB_TMO], 1u); break; } } } } while (0)

struct XcdBarrier {
    unsigned* bar; unsigned x;
    volatile LAS unsigned* st;
};

__device__ __forceinline__ XcdBarrier xcd_barrier_post(unsigned* bar, volatile LAS unsigned* st) {
    XcdBarrier b; b.bar = bar; b.x = xb_xcc_id(); b.st = st;
    if (threadIdx.x == 0) (void)xb_add(&bar[XB_XCNT(b.x)], 1u);
    return b;
}
__device__ __forceinline__ void xcd_barrier_complete(unsigned* bar, unsigned x, unsigned& nloc, unsigned& nx) {
    const unsigned G = gridDim.x * gridDim.y * gridDim.z;
    unsigned sum, cnt, mine, sp = 0u;
    for (;;) {
        sum = 0u; cnt = 0u; mine = 0u;
#pragma unroll
        for (unsigned j = 0; j < 16; ++j) { const unsigned c = xb_ld(&bar[XB_XCNT(j)]); sum += c; cnt += (c > 0u) ? 1u : 0u; mine = (j == x) ? c : mine; }
        if (sum == G) break;
        __builtin_amdgcn_s_sleep(1);
        if ((++sp & 255u) == 0u) { if (xb_ld(&bar[XB_TMO])) break; if (sp > XB_SPIN_CAP) { atomicAdd(&bar[XB_TMO], 1u); break; } }
    }
    nloc = mine > 0u ? mine : 1u; nx = cnt > 0u ? cnt : 1u;
}

__device__ __forceinline__ void xcd_barrier(const XcdBarrier& b) {
    asm volatile("s_waitcnt vmcnt(0)" ::: "memory");
    __syncthreads();
    if (threadIdx.x == 0) {
        unsigned* bar = b.bar;
        __builtin_amdgcn_s_waitcnt(0);
        unsigned nloc = b.st[0], nx = b.st[1];
        if (nloc == 0u) { xcd_barrier_complete(bar, b.x, nloc, nx); b.st[0] = nloc; b.st[1] = nx; }
        const unsigned old = xb_add(&bar[XB_XSUB(b.x)], 1u);
        const unsigned gen = old / nloc;
        if (old + 1u == (gen + 1u) * nloc) {
            __builtin_amdgcn_fence(__ATOMIC_RELEASE, "agent");
            asm volatile("s_waitcnt vmcnt(0)" ::: "memory");
            const unsigned og = xb_add(&bar[XB_TOP], 1u);
            const unsigned tg = og / nx;
            if (og + 1u == (tg + 1u) * nx) xb_add(&bar[XB_TOPGEN], 1u);
            else XB_SPIN(xb_ld(&bar[XB_TOPGEN]) == tg, bar);
            __builtin_amdgcn_fence(__ATOMIC_ACQUIRE, "agent");
            xb_add(&bar[XB_XGEN(b.x)], 1u);
            asm volatile("s_waitcnt vmcnt(0)" ::: "memory");
        } else {
            XB_SPIN(xb_ld(&bar[XB_XGEN(b.x)]) == gen, bar);
            __builtin_amdgcn_fence(__ATOMIC_ACQUIRE, "agent");
            asm volatile("s_waitcnt vmcnt(0)" ::: "memory");
        }
    }
    __syncthreads();
}
constexpr int NWAVES = 8;
#ifndef MK_PER_PHASE
#define MK_PER_PHASE 0
#endif
constexpr int D = 1024, NB = 8, SEQ = 2048, CTXL = 256, ML = NB * SEQ, MC = NB * CTXL, MT = ML + MC;
constexpr int FF = 3584, NE = 8;
constexpr float EPS = 1e-6f;
constexpr float LOG2E = 1.4426950408889634f;
constexpr float QSCALE = 0.125f * LOG2E;
#ifndef MK_FP8_FFN2
#define MK_FP8_FFN2 1
#endif
constexpr float F8_W13 = 32.0f, F8_W2 = 64.0f;
constexpr int N_PHASES = 34;
constexpr size_t MiB = 1u << 20;
constexpr size_t WS_CTL = 0, CTL_ZERO_BYTES = 1 * MiB;
constexpr size_t WS_MOD = 1 * MiB;
constexpr size_t WS_ROPE = 2 * MiB;
constexpr size_t WS_WSB = 2 * MiB + 65536;
constexpr size_t WS_TOKI = 3 * MiB;
constexpr size_t WS_TOKW = 3 * MiB + 524288;
constexpr int CAP = MT;
constexpr size_t WS_TOKLIST = 4 * MiB;
constexpr size_t WS_TOKWT = 4 * MiB + 655360;
constexpr size_t WS_STATS = 5 * MiB + 524288;
constexpr size_t WS_WIN = 8 * MiB, WS_WOUT = 24 * MiB, WS_WQKV = 32 * MiB, WS_WO = 38 * MiB, WS_FF13 = 42 * MiB, WS_FF2 = 70 * MiB;
constexpr size_t WS_MOE13 = 84 * MiB, WS_MOE2 = 196 * MiB;
constexpr size_t WS_X = 252 * MiB;
constexpr size_t WS_H = 324 * MiB;
constexpr size_t WS_R = 360 * MiB;
constexpr size_t WS_U = WS_R, WS_V = WS_R + 36 * MiB, WS_G = WS_R + 72 * MiB, WS_YAB = WS_R + 108 * MiB;
constexpr size_t WS_QKV = WS_R, WS_Q = WS_R + 54 * MiB, WS_K = WS_R + 90 * MiB, WS_O = WS_R + 99 * MiB;
constexpr size_t WS_T = WS_R;
constexpr size_t WS_HP = WS_R, WS_TP = WS_R + 144 * MiB, WS_YS = WS_R + 342 * MiB;
constexpr size_t WS_PB = WS_R + 414 * MiB;
constexpr size_t WS_END = WS_PB + 64 * MiB;
constexpr int CW_TMO = 0, CW_CODE = 1, CW_CNT = 64, CW_BAR = 4096;
constexpr int RING_OFF = 0;
constexpr int LDSCTL_OFF = 143360, MISC_OFF = LDSCTL_OFF + 64;
constexpr int LDS_BYTES = 147456;
__constant__ float INVF[16] = {1.0f, 0.5623413324356079f, 0.3162277638912201f, 0.17782793939113617f, 0.10000000149011612f, 0.05623413249850273f, 0.03162277489900589f, 0.017782794311642647f,
    0.009999999776482582f, 0.005623413249850273f, 0.003162277629598975f, 0.0017782794311642647f, 0.0010000000474974513f, 0.000562341301701963f, 0.0003162277571391314f, 0.00017782794020604342f};

typedef unsigned v2u __attribute__((ext_vector_type(2)));
struct Args { const float* in[29]; float* out; unsigned char* ws; int ph_lo, ph_hi; float gmul; int pad; };
struct Frame { LAS unsigned char* lds; volatile LAS unsigned* MISC; gu32* ctl; int tid, lane, wave, G, bid; };

__device__ __forceinline__ float wave_sum(float v) {
#pragma unroll
    for (int o = 1; o < 64; o <<= 1) v += __shfl_xor(v, o);
    return v;
}
__device__ __forceinline__ float bf2f(unsigned short b) { return __uint_as_float((unsigned)b << 16); }
__device__ __forceinline__ float bflo(unsigned w) { return __uint_as_float(w << 16); }
__device__ __forceinline__ float bfhi(unsigned w) { return __uint_as_float(w & 0xffff0000u); }
__device__ __forceinline__ unsigned pkbf(float lo, float hi) { return pg8::cvt_pk_bf16(lo, hi); }
__device__ __forceinline__ float fsigm(float x) { return pg8::sigm_f(x); }
__device__ __forceinline__ unsigned pk4f8(float a, float b, float c, float d) { int p = 0; p = __builtin_amdgcn_cvt_pk_fp8_f32(a, b, p, false); p = __builtin_amdgcn_cvt_pk_fp8_f32(c, d, p, true); return (unsigned)p; }

__device__ __forceinline__ int dst_row(int mode, int n) {
    if (mode == 0) return n;
    if (mode == 1) return ((n >> 7) << 8) + (n & 127);
    if (mode == 2) return ((n >> 7) << 8) + 128 + (n & 127);
    if (mode == 4) { if (n >= 1280) return n;
        const int tile = n >> 8, r = n & 255, wc = r >> 6, d = r & 63, bj = d >> 5, dh = d & 31, nn = dh >> 4, fq = (dh & 15) >> 2, e = dh & 3; return (tile << 8) + 128 * bj + 32 * wc + 8 * fq + 4 * nn + e; }
    if (n < 2048) return n;
    if (n < 3072) { const int j = n - 2048; return 2048 + ((j >> 7) << 8) + (j & 127); }
    { const int j = n - 3072; return 2048 + ((j >> 7) << 8) + 128 + (j & 127); }
}
struct ConvDesc { const float* W; bf16* WT; int N, K, mode, item; float f8s; };
__device__ __forceinline__ void conv_ld(const ConvDesc& d, int lane, f32x4 (&r)[16]) {
    const int nblk = d.N >> 6, kb = d.item / nblk, nb = d.item - kb * nblk, k0 = kb << 6, n0 = nb << 6; const int c4 = (lane & 15) << 2, kr = lane >> 4;
#pragma unroll
    for (int i = 0; i < 16; ++i) r[i] = __builtin_nontemporal_load((const GAS f32x4*)(d.W + (size_t)(k0 + 4 * i + kr) * d.N + n0 + c4));
}
__device__ __forceinline__ void conv_st(const ConvDesc& d, LAS float* scr, int lane, const f32x4 (&r)[16]) {
    const int nblk = d.N >> 6, kb = d.item / nblk, nb = d.item - kb * nblk, k0 = kb << 6, n0 = nb << 6; const int c4 = (lane & 15) << 2, kr = lane >> 4;
#pragma unroll
    for (int i = 0; i < 16; ++i) { LAS float* s = scr + (4 * i + kr) * 65 + c4; s[0] = r[i].x; s[1] = r[i].y; s[2] = r[i].z; s[3] = r[i].w; }
    LDS_WAIT(); asm volatile("" ::: "memory");
    if (d.f8s != 0.f) {
        const float sc = d.f8s; unsigned char* W8 = (unsigned char*)d.WT;
#pragma unroll
        for (int jj = 0; jj < 4; ++jj) { const int id = lane + 64 * jj, n = id >> 2, c = id & 3; const LAS float* s = scr + (16 * c) * 65 + n; v4u o;
            o.x = pk4f8(s[0] * sc, s[65] * sc, s[130] * sc, s[195] * sc); o.y = pk4f8(s[260] * sc, s[325] * sc, s[390] * sc, s[455] * sc);
            o.z = pk4f8(s[520] * sc, s[585] * sc, s[650] * sc, s[715] * sc); o.w = pk4f8(s[780] * sc, s[845] * sc, s[910] * sc, s[975] * sc);
            *(GAS v4u*)(W8 + (size_t)dst_row(d.mode, n0 + n) * d.K + k0 + 16 * c) = o; }
    } else {
    const int c = lane & 7;
#pragma unroll
    for (int jj = 0; jj < 8; ++jj) { const int n = (lane >> 3) + 8 * jj; const LAS float* s = scr + (8 * c) * 65 + n;
        v4u o; o.x = pkbf(s[0], s[65]); o.y = pkbf(s[130], s[195]); o.z = pkbf(s[260], s[325]); o.w = pkbf(s[390], s[455]);
        *(GAS v4u*)(d.WT + (size_t)dst_row(d.mode, n0 + n) * d.K + k0 + 8 * c) = o; }
    }
    LDS_WAIT(); asm volatile("" ::: "memory");
}
__device__ __forceinline__ ConvDesc dec_nonmoe(const Args& a, int it) {
    ConvDesc d; d.f8s = 0.f; const int j = it / 4864; int r = it - j * 4864; const bool f8 = MK_FP8_FFN2 && (j == 1);
    if (r < 1024) { d.W = a.in[8] + (size_t)j * 1024 * 4096; d.N = 4096; d.K = 1024; d.mode = 3; d.WT = (bf16*)(a.ws + WS_WIN) + (size_t)j * 4096 * 1024; }
    else if ((r -= 1024) < 512) { d.W = a.in[16] + (size_t)j * 2048 * 1024; d.N = 1024; d.K = 2048; d.mode = 0; d.WT = (bf16*)(a.ws + WS_WOUT) + (size_t)j * 1024 * 2048; }
    else if ((r -= 512) < 384) { d.W = a.in[17] + (size_t)j * 1024 * 1536; d.N = 1536; d.K = 1024; d.mode = 4; d.WT = (bf16*)(a.ws + WS_WQKV) + (size_t)j * 1536 * 1024; }
    else if ((r -= 384) < 256) { d.W = a.in[21] + (size_t)j * 1024 * 1024; d.N = 1024; d.K = 1024; d.mode = 0; d.WT = (bf16*)(a.ws + WS_WO) + (size_t)j * 1024 * 1024; }
    else if ((r -= 256) < 896) { d.W = a.in[22] + (size_t)j * 1024 * 3584; d.N = 3584; d.K = 1024; d.mode = 1; d.WT = (bf16*)(a.ws + WS_FF13) + (size_t)j * 7168 * 1024; if (f8) d.f8s = F8_W13; }
    else if ((r -= 896) < 896) { d.W = a.in[23] + (size_t)j * 1024 * 3584; d.N = 3584; d.K = 1024; d.mode = 2; d.WT = (bf16*)(a.ws + WS_FF13) + (size_t)j * 7168 * 1024; if (f8) d.f8s = F8_W13; }
    else { r -= 896; d.W = a.in[24] + (size_t)j * 3584 * 1024; d.N = 1024; d.K = 3584; d.mode = 0; d.WT = (bf16*)(a.ws + WS_FF2) + (size_t)j * 1024 * 3584; if (f8) d.f8s = F8_W2; }
    d.item = r; return d;
}
__device__ __forceinline__ ConvDesc dec_moe(const Args& a, int jm, int sel, int it) {
    ConvDesc d; const int per = (sel == 0) ? 2688 : (sel == 1 ? 1792 : 896);
    const int e = it / per; int r = it - e * per; if (sel == 2) r += 1792;
    const size_t eo = (size_t)(jm * 8 + e);
    unsigned char* m13 = a.ws + WS_MOE13 + (size_t)e * 7168 * 1024; unsigned char* m2 = a.ws + WS_MOE2 + (size_t)e * 1024 * 3584;
    if (r < 896) { d.W = a.in[26] + eo * 1024 * 3584; d.N = 3584; d.K = 1024; d.mode = 1; d.WT = (bf16*)m13; d.f8s = F8_W13; }
    else if ((r -= 896) < 896) { d.W = a.in[27] + eo * 1024 * 3584; d.N = 3584; d.K = 1024; d.mode = 2; d.WT = (bf16*)m13; d.f8s = F8_W13; }
    else { r -= 896; d.W = a.in[28] + eo * 3584 * 1024; d.N = 1024; d.K = 3584; d.mode = 0; d.WT = (bf16*)m2; d.f8s = F8_W2; }
    d.item = r; return d;
}
__device__ __forceinline__ void conv_run(const Args& a, int n_non, int jm, int sel, int moe_lo, int moe_hi, int gw, int NGW, LAS float* scr, int lane) {
    const int total = n_non + ((moe_hi > moe_lo) ? moe_hi - moe_lo : 0);
    if (gw >= total) return;
    ConvDesc cur = (gw < n_non) ? dec_nonmoe(a, gw) : dec_moe(a, jm, sel, gw - n_non + moe_lo);
    f32x4 r[16]; conv_ld(cur, lane, r);
    for (int it = gw; it < total; it += NGW) {
        const int nx = it + NGW; ConvDesc nxt = cur; f32x4 rn[16];
        if (nx < total) { nxt = (nx < n_non) ? dec_nonmoe(a, nx) : dec_moe(a, jm, sel, nx - n_non + moe_lo); conv_ld(nxt, lane, rn); }
        conv_st(cur, scr, lane, r);
        if (nx < total) {
#pragma unroll
            for (int i = 0; i < 16; ++i) r[i] = rn[i];
            cur = nxt; }
    }
}
__device__ __forceinline__ int moe_items(int sel) { return 8 * ((sel == 0) ? 2688 : (sel == 1 ? 1792 : 896)); }
struct TailPlan { int nl[4]; int e[5]; };
__device__ __forceinline__ int last_round_units(int n, int G) { const int r = n % G; return r == 0 ? G : r; }
__device__ __forceinline__ void tail_plan(int G, int att_units, TailPlan& t) {
    t.nl[0] = last_round_units((MT / 256) * 16, G); t.nl[1] = last_round_units((MT / 256) * 28, G); t.nl[2] = last_round_units((MT / 256) * 6, G); t.nl[3] = last_round_units(att_units, G);
    const int quota[4] = {2, 2, 3, 1}; t.e[0] = 0;
#pragma unroll
    for (int k = 0; k < 4; ++k) t.e[k + 1] = t.e[k] + (G - t.nl[k]) * NWAVES * quota[k];
}
__device__ __forceinline__ void tail_fill(const Args& a, Frame& F, const TailPlan& t, int k, int jm, int sel, int wid = -1) {
    const int me = (wid >= 0) ? wid : F.bid;
    const int nl = t.nl[k]; if (me < nl || nl >= F.G) return;
    const int tot = moe_items(sel), lo = t.e[k] < tot ? t.e[k] : tot, hi = t.e[k + 1] < tot ? t.e[k + 1] : tot;
    __syncthreads();
    conv_run(a, 0, jm, sel, lo, hi, (me - nl) * NWAVES + F.wave, (F.G - nl) * NWAVES, (LAS float*)(F.lds + F.wave * 16640), F.lane);
}
__device__ __forceinline__ void conv_moe_all(const Args& a, Frame& F, int jm, int sel, int w0, int nw, int wid = -1, int lo = 0, int hi = -1) {
    const int me = (wid >= 0) ? wid : F.bid;
    if (me < w0 || me >= w0 + nw) return;
    conv_run(a, 0, jm, sel, lo, (hi < 0) ? moe_items(sel) : hi, (me - w0) * NWAVES + F.wave, nw * NWAVES, (LAS float*)(F.lds + F.wave * 16640), F.lane);
}
__device__ __forceinline__ void sincos_d(double x, double& s, double& c) {
    const double TWO_PI = 6.283185307179586476925286766559;
    const double k = __builtin_rint(x / TWO_PI); const double r = x - k * TWO_PI, r2 = r * r;
    double ts = r, ss = r, tc = 1.0, cs = 1.0;
#pragma unroll 1
    for (int n = 1; n <= 14; ++n) { tc = -tc * r2 / (double)((2 * n - 1) * (2 * n)); cs += tc; ts = -ts * r2 / (double)((2 * n) * (2 * n + 1)); ss += ts; }
    s = ss; c = cs;
}
__device__ __forceinline__ void prologue_phase(const Args& a, Frame& F) {
    const int gw = F.bid * NWAVES + F.wave, NGW = F.G * NWAVES;
    {
        LAS float* sc = (LAS float*)F.lds; LAS float* red = sc + 9 * 1024;
        { float cv[18];
#pragma unroll
          for (int q = 0; q < 18; ++q) { const int i = F.tid + q * (NWAVES * 64); cv[q] = (q < 16) ? a.in[1][i] : a.in[3][i - 8192]; }
#pragma unroll
          for (int q = 0; q < 18; ++q) { const int i = F.tid + q * (NWAVES * 64); sc[i] = cv[q] * fsigm(cv[q]); } }
        __syncthreads();
        float* MOD = (float*)(a.ws + WS_MOD);
        for (int job = F.bid; job < 768; job += F.G) {
            const int li = job / 192, nb = job - li * 192; const int cl = F.tid & 31, kg = F.tid >> 5;
            const float* w = a.in[4] + (size_t)li * 1024 * 6144 + (size_t)(kg * 64) * 6144 + nb * 32 + cl;
            float acc[9];
#pragma unroll
            for (int r = 0; r < 9; ++r) acc[r] = 0.f;
            float wv[2][16];
#pragma unroll
            for (int i = 0; i < 16; ++i) wv[0][i] = __builtin_nontemporal_load(w + (size_t)i * 6144);
#pragma unroll
            for (int kq = 0; kq < 4; ++kq) { const int kb = 16 * kq;
                if (kq < 3) {
#pragma unroll
                    for (int i = 0; i < 16; ++i) wv[(kq + 1) & 1][i] = __builtin_nontemporal_load(w + (size_t)(kb + 16 + i) * 6144); }
#pragma unroll
                for (int i4 = 0; i4 < 4; ++i4)
#pragma unroll
                    for (int r = 0; r < 9; ++r) { const f32x4 sv = *(const LAS f32x4*)(sc + r * 1024 + kg * 64 + kb + 4 * i4);
                        acc[r] += (sv[0] * wv[kq & 1][4 * i4] + sv[1] * wv[kq & 1][4 * i4 + 1]) + (sv[2] * wv[kq & 1][4 * i4 + 2] + sv[3] * wv[kq & 1][4 * i4 + 3]); } }
#pragma unroll
            for (int r = 0; r < 9; ++r) red[(kg * 9 + r) * 32 + cl] = acc[r];
            __syncthreads();
            for (int o = F.tid; o < 9 * 32; o += NWAVES * 64) { const int r = o >> 5, c = o & 31; float sum = 0.f;
#pragma unroll
                for (int g = 0; g < 16; ++g) sum += red[(g * 9 + r) * 32 + c];
                MOD[(size_t)(li * 9 + r) * 6144 + nb * 32 + c] = sum + a.in[5][li * 6144 + nb * 32 + c]; }
            __syncthreads();
        }
    }
    {
        const int gt = F.bid * (NWAVES * 64) + F.tid, NT = F.G * NWAVES * 64;
        if (gt < 1024) { const int pos = gt >> 4, i = gt & 15; const float ang = (float)pos * INVF[i]; double s, c; sincos_d((double)ang, s, c);
            float* rp = (float*)(a.ws + WS_ROPE) + gt * 2; rp[0] = (float)c; rp[1] = (float)s; }
        bf16* wsb = (bf16*)(a.ws + WS_WSB);
        for (int i = gt; i < 2 * 8 * 128 * 128 / 2; i += NT) { const float2 v = *(const float2*)(a.in[11] + 2 * i); *(unsigned*)(wsb + 2 * i) = pkbf(v.x, v.y); }
    }
    __syncthreads();
    { TailPlan tp; tail_plan(F.G, 1152, tp); const int tot = moe_items(0), lo = tp.e[4] < tot ? tp.e[4] : tot;
      conv_run(a, 2 * 4864, 0, 0, lo, tot, gw, NGW, (LAS float*)(F.lds + F.wave * 16640), F.lane); }
}

__device__ __forceinline__ void norm_row_core(const float* xsrc32, const bf16* xsrc16, bf16* xdst, const bf16* ys, const float* g2p, const float* gn, const float* scp, const float* shp, bf16* hdst, int lane, f32x4 (&h)[4],
                                              const float* pbp = nullptr, int nS = 0, const float* pgp = nullptr, bool h8 = false) {
    f32x4 v[4];
    if (xsrc32) {
#pragma unroll
        for (int j = 0; j < 4; ++j) v[j] = __builtin_nontemporal_load((const GAS f32x4*)(xsrc32 + 4 * lane + 256 * j));
    } else {
#pragma unroll
        for (int j = 0; j < 4; ++j) { const v2u x = *(const GAS v2u*)(xsrc16 + 4 * lane + 256 * j); v[j] = (f32x4){bflo(x.x), bfhi(x.x), bflo(x.y), bfhi(x.y)}; }
    }
    if (pbp) {
        f32x4 ps[4];
#pragma unroll
        for (int j = 0; j < 4; ++j) ps[j] = (f32x4){0.f, 0.f, 0.f, 0.f};
        for (int q = 0; q < nS; ++q) {
#pragma unroll
            for (int j = 0; j < 4; ++j) { const v2u pp = *(const GAS v2u*)((const bf16*)pbp + (size_t)q * 2048 * 1024 + 4 * lane + 256 * j); ps[j] = ps[j] + (f32x4){bflo(pp.x), bfhi(pp.x), bflo(pp.y), bfhi(pp.y)}; } }
#pragma unroll
        for (int j = 0; j < 4; ++j) v[j] = v[j] + *(const GAS f32x4*)(pgp + 4 * lane + 256 * j) * ps[j];
    }
    if (ys) {
#pragma unroll
        for (int j = 0; j < 4; ++j) { const v2u y0 = *(const GAS v2u*)(ys + 4 * lane + 256 * j), y1 = *(const GAS v2u*)(ys + 1024 + 4 * lane + 256 * j); const f32x4 g = *(const GAS f32x4*)(g2p + 4 * lane + 256 * j);
            v[j].x += g.x * (bflo(y0.x) + bflo(y1.x)); v[j].y += g.y * (bfhi(y0.x) + bfhi(y1.x)); v[j].z += g.z * (bflo(y0.y) + bflo(y1.y)); v[j].w += g.w * (bfhi(y0.y) + bfhi(y1.y)); }
    }
    if (xdst) {
#pragma unroll
        for (int j = 0; j < 4; ++j) { v2u o; o.x = pkbf(v[j].x, v[j].y); o.y = pkbf(v[j].z, v[j].w); *(GAS v2u*)(xdst + 4 * lane + 256 * j) = o; }
    }
    float ss = 0.f;
#pragma unroll
    for (int j = 0; j < 4; ++j) ss += (v[j].x * v[j].x + v[j].y * v[j].y) + (v[j].z * v[j].z + v[j].w * v[j].w);
    const float r = 1.0f / sqrtf(wave_sum(ss) * (1.0f / 1024.0f) + EPS);
#pragma unroll
    for (int j = 0; j < 4; ++j) { const f32x4 g = *(const GAS f32x4*)(gn + 4 * lane + 256 * j), sc = *(const GAS f32x4*)(scp + 4 * lane + 256 * j), sh = *(const GAS f32x4*)(shp + 4 * lane + 256 * j);
        h[j] = (v[j] * r) * g * (sc + 1.0f) + sh;
        if (h8) { *(GAS unsigned*)((unsigned char*)hdst + 4 * lane + 256 * j) = pk4f8(h[j].x, h[j].y, h[j].z, h[j].w); }
        else { v2u o; o.x = pkbf(h[j].x, h[j].y); o.y = pkbf(h[j].z, h[j].w); *(GAS v2u*)(hdst + 4 * lane + 256 * j) = o; } }
}
__device__ __forceinline__ void norm_phase(const Args& a, Frame& F, int li, int which, int nrows, bool src_in, int pend_li, int nS = 0, int rs0 = 0, const float* pgate = nullptr, bool h8 = false) {
    const int gw = F.bid * NWAVES + F.wave, NGW = F.G * NWAVES;
    bf16* X = (bf16*)(a.ws + WS_X); bf16* H = (bf16*)(a.ws + WS_H); const float* MOD = (const float*)(a.ws + WS_MOD); const bf16* YS = (const bf16*)(a.ws + WS_YS);
    const float* gn = (which == 0 ? a.in[6] : a.in[7]) + li * 1024;
    for (int row = gw; row < nrows; row += NGW) {
        const int mr = (row < ML) ? (row >> 11) : 8;
        const float* mp = MOD + (size_t)(li * 9 + mr) * 6144 + (which ? 3 * 1024 : 0);
        const float* xs = src_in ? ((row < ML) ? a.in[0] + (size_t)row * 1024 : a.in[2] + (size_t)(row - ML) * 1024) : nullptr;
        const bool part = (nS > 0) && (row >= rs0);
        const bool wx = src_in || (pend_li >= 0) || part;
        f32x4 h[4];
        norm_row_core(xs, X + (size_t)row * 1024, wx ? X + (size_t)row * 1024 : nullptr, (pend_li >= 0) ? YS + (size_t)row * 2048 : nullptr, MOD + (size_t)((pend_li >= 0 ? pend_li : 0) * 9 + mr) * 6144 + 5 * 1024,
                      gn, mp + 1024, mp, h8 ? (bf16*)((unsigned char*)H + (size_t)row * 1024) : H + (size_t)row * 1024, F.lane, h, part ? (const float*)((const bf16*)(a.ws + WS_PB) + (size_t)(row - rs0) * 1024) : nullptr, nS, part ? pgate + (size_t)mr * 6144 : nullptr, h8);
    }
}
__device__ __forceinline__ void norm_router_phase(const Args& a, Frame& F, int li, int nrows, int nS, int rs0, const float* pgate) {
    constexpr int RPW = 72;
    bf16* X = (bf16*)(a.ws + WS_X); bf16* H = (bf16*)(a.ws + WS_H); const float* MOD = (const float*)(a.ws + WS_MOD);
    int4* TOKI = (int4*)(a.ws + WS_TOKI); float2* TOKW = (float2*)(a.ws + WS_TOKW); int* TOKLIST = (int*)(a.ws + WS_TOKLIST); float* TOKWT = (float*)(a.ws + WS_TOKWT); unsigned char* HP8 = a.ws + WS_HP;
    const int jm = li >> 1;
    LAS float* Rt = (LAS float*)F.lds;
    LAS int* lcnt = (LAS int*)(F.lds + 32768);
    LAS int* lbase = (LAS int*)(F.lds + 32768 + 64);
    LAS int* rinfo = (LAS int*)(F.lds + 32768 + 128);
    LAS float* rwt = (LAS float*)(F.lds + 32768 + 128 + 72 * 16);
    const float* router = a.in[25] + (size_t)jm * 1024 * 8;
    for (int i = F.tid; i < 8192; i += NWAVES * 64) { const int col = i >> 3, e = i & 7; Rt[e * 1024 + col] = router[i]; }
    if (F.tid < 8) lcnt[F.tid] = 0;
    __syncthreads();
    const float* gn = a.in[7] + li * 1024;
    gu32* CNT = F.ctl + CW_CNT + 16 * jm;
    for (int base = F.bid * RPW; base < nrows; base += F.G * RPW) {
        for (int i = 0; i < 9; ++i) {
            const int lr = F.wave * 9 + i, row = base + lr;
            if (row < nrows) {
                const int mr = (row < ML) ? (row >> 11) : 8; const float* mp = MOD + (size_t)(li * 9 + mr) * 6144 + 3 * 1024;
                f32x4 h[4];
                const bool part = (nS > 0) && (row >= rs0);
                norm_row_core(nullptr, X + (size_t)row * 1024, part ? X + (size_t)row * 1024 : nullptr, nullptr, nullptr, gn, mp + 1024, mp, (bf16*)((unsigned char*)H + (size_t)row * 1024), F.lane, h,
                              part ? (const float*)((const bf16*)(a.ws + WS_PB) + (size_t)(row - rs0) * 1024) : nullptr, nS, part ? pgate + (size_t)mr * 6144 : nullptr, true);
                float lg[8];
#pragma unroll
                for (int e = 0; e < 8; ++e) { float p = 0.f;
#pragma unroll
                    for (int j = 0; j < 4; ++j) { const f32x4 rv = *(const LAS f32x4*)(Rt + e * 1024 + 4 * F.lane + 256 * j); p += (h[j].x * rv.x + h[j].y * rv.y) + (h[j].z * rv.z + h[j].w * rv.w); }
                    lg[e] = wave_sum(p); }
                int i0 = 0; float l0 = lg[0];
#pragma unroll
                for (int e = 1; e < 8; ++e) if (lg[e] > l0) { l0 = lg[e]; i0 = e; }
                int i1 = -1; float l1 = -3.0e38f;
#pragma unroll
                for (int e = 0; e < 8; ++e) if (e != i0 && lg[e] > l1) { l1 = lg[e]; i1 = e; }
                const float w0 = 1.0f / (1.0f + __expf(l1 - l0)), w1 = 1.0f - w0;
                if (F.lane == 0) { const int r0 = __hip_atomic_fetch_add(lcnt + i0, 1, __ATOMIC_RELAXED, __HIP_MEMORY_SCOPE_WORKGROUP), r1 = __hip_atomic_fetch_add(lcnt + i1, 1, __ATOMIC_RELAXED, __HIP_MEMORY_SCOPE_WORKGROUP);
                    rinfo[lr * 4 + 0] = i0; rinfo[lr * 4 + 1] = i1; rinfo[lr * 4 + 2] = r0; rinfo[lr * 4 + 3] = r1; rwt[lr * 2] = w0; rwt[lr * 2 + 1] = w1; }
            }
        }
        __syncthreads();
        if (F.tid < 8) { const int c = lcnt[F.tid]; lbase[F.tid] = (int)__hip_atomic_fetch_add(CNT + F.tid, (unsigned)c, RLX_AGENT); lcnt[F.tid] = 0; }
        __syncthreads();
        if (F.tid < RPW) { const int row = base + F.tid; if (row < nrows) { const int e0 = rinfo[F.tid * 4], e1 = rinfo[F.tid * 4 + 1];
            const int p0 = lbase[e0] + rinfo[F.tid * 4 + 2], p1 = lbase[e1] + rinfo[F.tid * 4 + 3]; const float w0 = rwt[F.tid * 2], w1 = rwt[F.tid * 2 + 1];
            TOKI[row] = make_int4(e0 | (e1 << 8), p0, p1, 0); TOKW[row] = make_float2(w0, w1);
            TOKLIST[e0 * CAP + p0] = row * 2; TOKWT[e0 * CAP + p0] = w0; TOKLIST[e1 * CAP + p1] = row * 2 + 1; TOKWT[e1 * CAP + p1] = w1; } }
        for (int i = 0; i < 9; ++i) { const int lr = F.wave * 9 + i, row = base + lr;
            if (row < nrows) { const int e0 = rinfo[lr * 4], e1 = rinfo[lr * 4 + 1]; const int p0 = lbase[e0] + rinfo[lr * 4 + 2], p1 = lbase[e1] + rinfo[lr * 4 + 3];
                const v4u q = *((const GAS v4u*)((const unsigned char*)H + (size_t)row * 1024) + F.lane);
                *((GAS v4u*)(HP8 + ((size_t)e0 * CAP + p0) * 1024) + F.lane) = q; *((GAS v4u*)(HP8 + ((size_t)e1 * CAP + p1) * 1024) + F.lane) = q; } }
        __syncthreads();
    }
}
struct MoeSeg { int np[8]; int pst[9]; int cnt[8]; };
__device__ __forceinline__ void moe_seg(Frame& F, int jm, MoeSeg& s) {
    gu32* CNT = F.ctl + CW_CNT + 16 * jm; int acc = 0;
#pragma unroll
    for (int e = 0; e < 8; ++e) { const int c = __builtin_amdgcn_readfirstlane((int)__hip_atomic_load(CNT + e, RLX_AGENT)); s.cnt[e] = c; s.np[e] = (c + 255) >> 8; s.pst[e] = acc; acc += s.np[e]; }
    s.pst[8] = acc;
}
__device__ __forceinline__ int seg_start(const MoeSeg& s, int e) { int r = 0;
#pragma unroll
    for (int q = 0; q < 8; ++q) r += (q < e) ? s.np[q] : 0;
    return r; }
struct MoeOrder {
    int pst[9]; int cnt[8]; int nt, G, c, ntk; bool apan;
    int F_, R, S;
    __device__ __forceinline__ void no_split() { F_ = 0x7fffffff; R = 0; S = 1; }
    __device__ __forceinline__ void split_tail() { const int U = pst[8] * nt; F_ = (U / G) * G; R = U - F_; S = 1;
        if (R > 0) { S = (R * 7 <= G) ? 7 : (R * 2 <= G) ? 2 : 1; } if (S == 1) no_split(); }
    __device__ __forceinline__ int ps0() const { return (R > 0) ? (F_ / nt) * 256 : 0x7fffffff; }
    __device__ __forceinline__ int psrows() const { return (R > 0) ? ((R + nt - 1) / nt) * 256 : 0; }
    __device__ __forceinline__ bool next(int i, pg8::Unit& u) const {
        const int vc = (G % 8 == 0) ? (c % 8) * (G / 8) + c / 8 : c;
        const int L = i * G + vc; const int U = pst[8] * nt; const bool full = L < F_; const int q = L - F_;
        if (full ? (L >= U) : (q >= R * S)) return false;
        const int t2 = q / S, sp = q - t2 * S, nts = ntk / S; const int tile = full ? L : F_ + t2;
        const int nig = 8 * nt, grp = tile / nig, rr = tile - grp * nig, fm = grp * 8, gsz = (pst[8] - fm < 8) ? pst[8] - fm : 8;
        const int j = rr / gsz, p = fm + (rr - j * gsz); int e = 0;
#pragma unroll
        for (int q2 = 1; q2 < 8; ++q2) e += (p >= pst[q2]) ? 1 : 0;
        int ps = 0, cn = 0;
#pragma unroll
        for (int q2 = 0; q2 < 8; ++q2) { ps = (q2 == e) ? pst[q2] : ps; cn = (q2 == e) ? cnt[q2] : cn; }
        u.pm = p; u.e = e; u.j = j; u.pn = e * nt + j; u.k0 = full ? 0 : sp * nts * 64; u.nt = full ? ntk : nts; u.s = full ? 0 : sp + 1; u.pl = p - ps; u.cn = cn;
        u.pa = apan ? e * (CAP / 256) + (p - ps) : p; return true;
    }
    __device__ __forceinline__ void a_ready(const pg8::Unit&) const {}
    __device__ __forceinline__ void done(const pg8::Unit&) const {}
};

struct SplitOrder {
    int F_, R, S, ntk, G, vc;
    __device__ __forceinline__ void init(int M, int K, int G_, int c) { const int T = (M >> 8) * 4; G = G_; F_ = (T / G) * G; R = T - F_; ntk = K >> 6; vc = (G % 8 == 0) ? (c % 8) * (G / 8) + c / 8 : c;
        S = 1; if (R > 0) { const int want = (K == 3584 || K == 1792) ? 7 : (K == 2048 ? 8 : 4);   if (R * want <= G) S = want; } }
    __device__ __forceinline__ bool next(int i, pg8::Unit& u) const { const int L = i * G + vc; const bool full = L < F_; const int q = L - F_;
        if (!full && q >= R * S) return false;
        const int t2 = q / S, sp = q - t2 * S, nts = ntk / S; const int tile = full ? L : F_ + t2;
        u.e = full ? 0 : sp + 1; u.nt = full ? ntk : nts; u.k0 = full ? 0 : sp * nts * 64; u.pm = tile >> 2; u.pn = tile & 3; u.j = tile & 3; u.s = 0; u.pa = u.pm; u.pl = 0; u.cn = 0; return true; }
    __device__ __forceinline__ int nsplit() const { return R > 0 ? S : 0; }
    __device__ __forceinline__ int rs0() const { return (F_ >> 2) << 8; }
    __device__ __forceinline__ void a_ready(const pg8::Unit&) const {}
    __device__ __forceinline__ void done(const pg8::Unit&) const {}
};

__device__ __forceinline__ void gate_units(const Args& a, Frame& F, int j, int ubeg, int uend) {
    typedef short s16x4 __attribute__((ext_vector_type(4)));
    LAS float* stat = (LAS float*)F.lds;
    LAS bf16* VL = (LAS bf16*)(F.lds + 1024);
    LAS bf16* WSl = (LAS bf16*)(F.lds + 1024 + 34816);
    const bf16* U = (const bf16*)(a.ws + WS_U); const bf16* V = (const bf16*)(a.ws + WS_V); bf16* YAB = (bf16*)(a.ws + WS_YAB); const bf16* WSB = (const bf16*)(a.ws + WS_WSB);
    const float* STATS = (const float*)(a.ws + WS_STATS);
    const int lane = F.lane, w = F.wave, li15 = lane & 15, lq = lane >> 4, pr = 16 * w + li15;
    if (ubeg >= uend) return;
    v4u raw[4], wsv[4], uu[4]; float bsv; f32x4 lnv[4];
#define GT_LOAD(u_) do { const int n_ = (u_) >> 3, g_ = (u_) & 7, r0_ = n_ * 128; \
        _Pragma("unroll") for (int i = 0; i < 4; ++i) { const int idx = F.tid + 512 * i, p = idx >> 4, c8 = (idx & 15) << 3; \
            wsv[i] = *(const GAS v4u*)(WSB + ((size_t)((j * 8 + g_) * 128 + p)) * 128 + c8); raw[i] = *(const GAS v4u*)(V + (size_t)(r0_ + p) * 1024 + g_ * 128 + c8); } \
        _Pragma("unroll") for (int n2 = 0; n2 < 4; ++n2) uu[n2] = *(const GAS v4u*)(U + (size_t)(r0_ + pr) * 1024 + g_ * 128 + 32 * n2 + 8 * lq); \
        bsv = a.in[12][j * 1024 + g_ * 128 + pr]; \
        { const float* lg_ = a.in[9] + j * 1024 + g_ * 128 + ((F.tid & 15) << 3); const float* lb_ = a.in[10] + j * 1024 + g_ * 128 + ((F.tid & 15) << 3); \
          lnv[0] = *(const GAS f32x4*)lg_; lnv[1] = *(const GAS f32x4*)(lg_ + 4); lnv[2] = *(const GAS f32x4*)lb_; lnv[3] = *(const GAS f32x4*)(lb_ + 4); } } while (0)
    GT_LOAD(ubeg);
    int cur_n = -1;
    for (int u = ubeg; u < uend; ++u) {
        const int n = u >> 3, g = u & 7, r0 = n * 128;
        if (n != cur_n) { cur_n = n;
            if (F.tid < 128) { const float* sp = STATS + (size_t)(r0 + F.tid) * 32; float s1 = 0.f, s2 = 0.f;
#pragma unroll
                for (int i = 0; i < 8; ++i) { const f32x4 v = *(const GAS f32x4*)(sp + 4 * i); s1 += v.x + v.z; s2 += v.y + v.w; }
                const float mean = s1 * (1.0f / 1024.0f), var = s2 * (1.0f / 1024.0f) - mean * mean; stat[2 * F.tid] = mean; stat[2 * F.tid + 1] = 1.0f / sqrtf(fmaxf(var, 0.f) + EPS); } }
#pragma unroll
        for (int i = 0; i < 4; ++i) { const int idx = F.tid + 512 * i, p = idx >> 4, c8 = (idx & 15) << 3; *(LAS v4u*)(WSl + p * 136 + c8) = wsv[i]; }
        __syncthreads();
#pragma unroll
        for (int i = 0; i < 4; ++i) { const int idx = F.tid + 512 * i, p = idx >> 4, c8 = (idx & 15) << 3; const float mean = stat[2 * p], rstd = stat[2 * p + 1];
            const f32x4 ga = lnv[0], gb = lnv[1], ba = lnv[2], bb = lnv[3];
            v4u o; o.x = pkbf((bflo(raw[i].x) - mean) * rstd * ga.x + ba.x, (bfhi(raw[i].x) - mean) * rstd * ga.y + ba.y); o.y = pkbf((bflo(raw[i].y) - mean) * rstd * ga.z + ba.z, (bfhi(raw[i].y) - mean) * rstd * ga.w + ba.w);
            o.z = pkbf((bflo(raw[i].z) - mean) * rstd * gb.x + bb.x, (bfhi(raw[i].z) - mean) * rstd * gb.y + bb.y); o.w = pkbf((bflo(raw[i].w) - mean) * rstd * gb.z + bb.z, (bfhi(raw[i].w) - mean) * rstd * gb.w + bb.w);
            { const int g2 = c8 >> 5, a4 = ((c8 & 31) >> 3) << 2; v2u lo2, hi2; lo2.x = o.x; lo2.y = o.y; hi2.x = o.z; hi2.y = o.w;
              *(LAS v2u*)(VL + p * 136 + 32 * g2 + a4) = lo2; *(LAS v2u*)(VL + p * 136 + 32 * g2 + 16 + a4) = hi2; } }
        v4u cu[4]; const float cb = bsv;
#pragma unroll
        for (int n2 = 0; n2 < 4; ++n2) cu[n2] = uu[n2];
        __syncthreads();
        if (u + 1 < uend) GT_LOAD(u + 1);
        f32x4 acc[8];
#pragma unroll
        for (int nt = 0; nt < 8; ++nt) acc[nt] = (f32x4){0.f, 0.f, 0.f, 0.f};
#pragma unroll
        for (int ks = 0; ks < 4; ++ks) { const bf16x8 wf = *(const LAS bf16x8*)(WSl + pr * 136 + 32 * ks + 8 * lq);
#pragma unroll
            for (int nt = 0; nt < 8; ++nt) { const LAS bf16* vp = VL + (32 * ks + 8 * lq + (li15 >> 2)) * 136 + 16 * nt + 4 * (li15 & 3);
                const s16x4 lo = __builtin_bit_cast(s16x4, __builtin_amdgcn_ds_read_tr16_b64_v4i16((LAS s16x4*)vp));
                const s16x4 hi = __builtin_bit_cast(s16x4, __builtin_amdgcn_ds_read_tr16_b64_v4i16((LAS s16x4*)(vp + 4 * 136)));
                const bf16x8 vf = __builtin_shufflevector(lo, hi, 0, 1, 2, 3, 4, 5, 6, 7);
                acc[nt] = __builtin_amdgcn_mfma_f32_16x16x32_bf16(vf, wf, acc[nt], 0, 0, 0); } }
#pragma unroll
        for (int n2 = 0; n2 < 4; ++n2) { const f32x4 a0 = acc[2 * n2], a1 = acc[2 * n2 + 1]; const v4u uv = cu[n2]; v4u o;
            o.x = pkbf(bflo(uv.x) * (a0[0] + cb), bfhi(uv.x) * (a0[1] + cb)); o.y = pkbf(bflo(uv.y) * (a0[2] + cb), bfhi(uv.y) * (a0[3] + cb));
            o.z = pkbf(bflo(uv.z) * (a1[0] + cb), bfhi(uv.z) * (a1[1] + cb)); o.w = pkbf(bflo(uv.w) * (a1[2] + cb), bfhi(uv.w) * (a1[3] + cb));
            *(GAS v4u*)(YAB + (size_t)(r0 + pr) * 2048 + g * 128 + 32 * n2 + 8 * lq) = o; }
        __syncthreads();
    }
#undef GT_LOAD
}
__device__ __forceinline__ int seq_lo(int r) { return (r < ML) ? (r & ~2047) : (ML + ((r - ML) & ~255)); }
__device__ __forceinline__ void conv_phase(const Args& a, Frame& F, int j) {
    LAS float* wl = (LAS float*)F.lds;
    LAS float* cbl = wl + 31 * 1024;
    LAS float* cgl = cbl + 1024;
    const bf16* G = (const bf16*)(a.ws + WS_G); bf16* YAB = (bf16*)(a.ws + WS_YAB);
    __syncthreads();
    { f32x4 wv[16];
#pragma unroll
      for (int q = 0; q < 16; ++q) { const int i = F.tid + q * (NWAVES * 64); wv[q] = *(const GAS f32x4*)(a.in[13] + (size_t)j * 31 * 1024 + 4 * (i < 31 * 256 ? i : 31 * 256 - 1)); }
#pragma unroll
      for (int q = 0; q < 16; ++q) { const int i = F.tid + q * (NWAVES * 64); if (i < 31 * 256) *(LAS f32x4*)(wl + 4 * i) = wv[q]; } }
    if (F.tid < 256) { *(LAS f32x4*)(cbl + 4 * F.tid) = *(const GAS f32x4*)(a.in[14] + j * 1024 + 4 * F.tid); *(LAS f32x4*)(cgl + 4 * F.tid) = *(const GAS f32x4*)(a.in[15] + j * 1024 + 4 * F.tid); }
    __syncthreads();
    const int lane = F.lane, gw = F.bid * NWAVES + F.wave, NGW = F.G * NWAVES;
#define CV_LOAD(dst, ri, cbase) do { const int row_ = r0 - 15 + (ri); const int rc_ = row_ < lo ? lo : (row_ >= hi ? hi - 1 : row_); dst = *(const GAS v4u*)((const GAS char*)G + (size_t)rc_ * 2048 + (unsigned)((cbase) * 2)); } while (0)
#define CV_UNPACK(src, ri, d) do { const int row_ = r0 - 15 + (ri); const unsigned mk_ = (row_ >= lo && row_ < hi) ? 0xffffffffu : 0u; const unsigned x0_ = src.x & mk_, x1_ = src.y & mk_, x2_ = src.z & mk_, x3_ = src.w & mk_; \
        d[0] = (f32x4){bflo(x0_), bfhi(x0_), bflo(x1_), bfhi(x1_)}; d[1] = (f32x4){bflo(x2_), bfhi(x2_), bflo(x3_), bfhi(x3_)}; } while (0)
    for (int u = gw; u < MT / 6; u += NGW) {
        const int r0 = 6 * u; const int loA = seq_lo(r0), loB = seq_lo(r0 + 5); const int npass = (loA != loB) ? 2 : 1;
        for (int pass = 0; pass < npass; ++pass) {
            const int lo = pass ? loB : loA, hi = lo + ((lo < ML) ? 2048 : 256);
            f32x4 acc[2][6][2];
#pragma unroll
            for (int h = 0; h < 2; ++h) {
                int cbase = 512 * h + 8 * lane; asm volatile("" : "+v"(cbase));
                const f32x4 b0 = *(const LAS f32x4*)(cbl + cbase), b1 = *(const LAS f32x4*)(cbl + cbase + 4);
#pragma unroll
                for (int t = 0; t < 6; ++t) { acc[h][t][0] = b0; acc[h][t][1] = b1; }
                f32x4 ring[6][2]; v4u T[6];
                { v4u a[5];
#pragma unroll
                  for (int i = 0; i < 5; ++i) CV_LOAD(a[i], i, cbase);
#pragma unroll
                  for (int s2 = 0; s2 < 6; ++s2) CV_LOAD(T[s2], s2 + 5, cbase);
#pragma unroll
                  for (int i = 0; i < 5; ++i) CV_UNPACK(a[i], i, ring[i]); }
#pragma unroll 1
                for (int it = 0; it < 5; ++it) {
#pragma unroll
                    for (int s2 = 0; s2 < 6; ++s2) { const int k = 6 * it + s2;
                        CV_UNPACK(T[s2], k + 5, ring[(s2 + 5) % 6]);
                        CV_LOAD(T[s2], 6 * (it + 1) + s2 + 5, cbase);
                        const f32x4 w0 = *(const LAS f32x4*)(wl + k * 1024 + cbase), w1 = *(const LAS f32x4*)(wl + k * 1024 + cbase + 4);
#pragma unroll
                        for (int t = 0; t < 6; ++t) { acc[h][t][0] = acc[h][t][0] + ring[(s2 + t) % 6][0] * w0; acc[h][t][1] = acc[h][t][1] + ring[(s2 + t) % 6][1] * w1; }
                        __builtin_amdgcn_sched_barrier(0); }
                }
                { CV_UNPACK(T[0], 35, ring[5]);
                  const f32x4 w0 = *(const LAS f32x4*)(wl + 30 * 1024 + cbase), w1 = *(const LAS f32x4*)(wl + 30 * 1024 + cbase + 4);
#pragma unroll
                  for (int t = 0; t < 6; ++t) { acc[h][t][0] = acc[h][t][0] + ring[t][0] * w0; acc[h][t][1] = acc[h][t][1] + ring[t][1] * w1; } }
            }
#pragma unroll
            for (int t = 0; t < 6; ++t) { float ss = 0.f;
#pragma unroll
                for (int h = 0; h < 2; ++h)
#pragma unroll
                    for (int q = 0; q < 2; ++q) { const f32x4 v = acc[h][t][q]; ss += (v.x * v.x + v.y * v.y) + (v.z * v.z + v.w * v.w); }
                const float r = 1.0f / sqrtf(wave_sum(ss) * (1.0f / 1024.0f) + EPS); const int row = r0 + t;
                if (row >= lo && row < hi) {
#pragma unroll
                    for (int h = 0; h < 2; ++h) { int cbase = 512 * h + 8 * lane; asm volatile("" : "+v"(cbase)); const f32x4 g0 = *(const LAS f32x4*)(cgl + cbase), g1 = *(const LAS f32x4*)(cgl + cbase + 4);
                        const f32x4 y0 = acc[h][t][0] * r * g0, y1 = acc[h][t][1] * r * g1; v4u o;
                        o.x = pkbf(y0.x * fsigm(y0.x), y0.y * fsigm(y0.y)); o.y = pkbf(y0.z * fsigm(y0.z), y0.w * fsigm(y0.w)); o.z = pkbf(y1.x * fsigm(y1.x), y1.y * fsigm(y1.y)); o.w = pkbf(y1.z * fsigm(y1.z), y1.w * fsigm(y1.w));
                        *(GAS v4u*)(YAB + (size_t)row * 2048 + 1024 + cbase) = o; } } }
        }
    }
#undef CV_LOAD
#undef CV_UNPACK
    __syncthreads();
}
__device__ __forceinline__ void mix_phase(const Args& a, Frame& F, int j) {
#ifndef MK_GATE_REP
#define MK_GATE_REP 1
#endif
#ifndef MK_CONV_REP
#define MK_CONV_REP 1
#endif
    for (int rep = 0; rep < MK_GATE_REP; ++rep)
    gate_units(a, F, j, (int)(((long)F.bid * 1152) / F.G), (int)(((long)(F.bid + 1) * 1152) / F.G));
    for (int rep = 0; rep < MK_CONV_REP; ++rep)
    conv_phase(a, F, j);
}

__device__ __forceinline__ void qkrope_phase(const Args& a, Frame& F, int jm, int nrows) {
    const int gw = F.bid * NWAVES + F.wave, NGW = F.G * NWAVES, lane = F.lane;
    const bf16* QKV = (const bf16*)(a.ws + WS_QKV); bf16* Q = (bf16*)(a.ws + WS_Q); bf16* Kb = (bf16*)(a.ws + WS_K); const float* ROPE = (const float*)(a.ws + WS_ROPE);
    const float* qg = a.in[18] + jm * 64; const float* kg = a.in[19] + jm * 64; const int sub = lane & 15;
    float gq[4], gk[4];
#pragma unroll
    for (int k = 0; k < 4; ++k) { gq[k] = qg[sub + 16 * k]; gk[k] = kg[sub + 16 * k]; }
    for (int row = gw; row < nrows; row += NGW) {
        const bool lat = row < ML; float cr = 1.f, sr = 0.f, cc = 1.f, sc = 0.f;
        if (lat) { const int t = row & 2047, pr = t >> 6, pc = t & 63; const float2 a0 = *(const float2*)(ROPE + (pr * 16 + sub) * 2), a1 = *(const float2*)(ROPE + (pc * 16 + sub) * 2); cr = a0.x; sr = a0.y; cc = a1.x; sc = a1.y; }
#pragma unroll
        for (int hg = 0; hg < 5; ++hg) { const int head = 4 * hg + (lane >> 4); const bf16* src = QKV + (size_t)row * 1536 + head * 64 + sub;
            float x[4];
#pragma unroll
            for (int k = 0; k < 4; ++k) x[k] = bf2f(src[16 * k]);
            float ss = (x[0] * x[0] + x[1] * x[1]) + (x[2] * x[2] + x[3] * x[3]);
            ss += __shfl_xor(ss, 1); ss += __shfl_xor(ss, 2); ss += __shfl_xor(ss, 4); ss += __shfl_xor(ss, 8);
            const float r = 1.0f / sqrtf(ss * (1.0f / 64.0f) + EPS);
            float y[4];
#pragma unroll
            for (int k = 0; k < 4; ++k) y[k] = x[k] * r * (hg < 4 ? gq[k] : gk[k]);
            float o[4]; o[0] = y[0] * cr - y[1] * sr; o[1] = y[1] * cr + y[0] * sr; o[2] = y[2] * cc - y[3] * sc; o[3] = y[3] * cc + y[2] * sc;
            if (hg < 4) { bf16* d = Q + (size_t)row * 1024 + head * 64 + sub;
#pragma unroll
                for (int k = 0; k < 4; ++k) d[16 * k] = (bf16)(pkbf(o[k] * QSCALE, 0.f) & 0xffffu); }
            else { bf16* d = Kb + (size_t)row * 256 + (head - 16) * 64 + sub;
#pragma unroll
                for (int k = 0; k < 4; ++k) d[16 * k] = (bf16)(pkbf(o[k], 0.f) & 0xffffu); } }
    }
}
__device__ __forceinline__ void attn_phase(const Args& a, Frame& F, int jm, int nunits) {
    typedef short s16x4 __attribute__((ext_vector_type(4)));
    const bf16* Q = (const bf16*)(a.ws + WS_Q); const bf16* Kb = (const bf16*)(a.ws + WS_K); const bf16* Vb = (const bf16*)(a.ws + WS_QKV); bf16* O = (bf16*)(a.ws + WS_O);
    LAS bf16* Kl = (LAS bf16*)F.lds;
    LAS bf16* Vl = (LAS bf16*)(F.lds + 18432);
    const int lane = F.lane, w = F.wave, li15 = lane & 15, lq = lane >> 4, hsel = w >> 2, qw = (w & 3) * 32;
    const int lkey = F.tid >> 3, ld8 = (F.tid & 7) << 3;
#define KROW(si) (((si) < nw) ? (b * 2048 + q0 - 128 + 64 * (wlo + (si))) : (ML + b * 256 + 64 * ((si) - nw)))
    const int vcu = (F.G % 8 == 0) ? (F.bid % 8) * (F.G / 8) + F.bid / 8 : F.bid;
    for (int ui = vcu; ui < nunits; ui += F.G) {
        int b, hp, q0, qrow0, wlo, nw;
        if (ui < 1024) { b = ui >> 7; hp = (ui >> 4) & 7; const int qb = ui & 15; q0 = qb * 128; qrow0 = b * 2048 + q0; wlo = (qb == 0) ? 2 : 0; nw = (qb == 0 || qb == 15) ? 4 : 6; }
        else { const int v = ui - 1024; b = v >> 4; hp = (v >> 1) & 7; q0 = (v & 1) * 128; qrow0 = ML + b * 256 + q0; wlo = 0; nw = 0; }
        const int ntile = nw + 4, hq = 2 * hp + hsel, kvh = hp >> 1;
        const bf16* qp = Q + (size_t)(qrow0 + qw + li15) * 1024 + hq * 64 + 8 * lq;
        bf16x8 qf[2][2];
#pragma unroll
        for (int mt = 0; mt < 2; ++mt)
#pragma unroll
            for (int ks = 0; ks < 2; ++ks) qf[mt][ks] = *(const GAS bf16x8*)(qp + (size_t)mt * 16 * 1024 + 32 * ks);
        const float sinkv = a.in[20][jm * 16 + hq] * LOG2E;
        float m[2], l[2]; f32x4 o[2][4];
#pragma unroll
        for (int mt = 0; mt < 2; ++mt) { m[mt] = sinkv; l[mt] = (lq == 0) ? 1.0f : 0.0f;
#pragma unroll
            for (int dt = 0; dt < 4; ++dt) o[mt][dt] = (f32x4){0.f, 0.f, 0.f, 0.f}; }
        v4u kreg[2], vreg[2];
#pragma unroll
        for (int h = 0; h < 2; ++h) { const int kr = KROW(h); kreg[h] = *(const GAS v4u*)(Kb + (size_t)(kr + lkey) * 256 + kvh * 64 + ld8); vreg[h] = *(const GAS v4u*)(Vb + (size_t)(kr + lkey) * 256 + kvh * 64 + ld8); }
        for (int si0 = 0; si0 < ntile; si0 += 2)
#pragma unroll
        for (int h = 0; h < 2; ++h) {
            const int si = si0 + h; const int bo = h * 4608;
            *(LAS v4u*)(Kl + bo + lkey * 72 + ld8) = kreg[h]; *(LAS v4u*)(Vl + bo + lkey * 72 + ld8) = vreg[h];
            if (si + 2 < ntile) { const int kr = KROW(si + 2);
                kreg[h] = *(const GAS v4u*)(Kb + (size_t)(kr + lkey) * 256 + kvh * 64 + ld8); vreg[h] = *(const GAS v4u*)(Vb + (size_t)(kr + lkey) * 256 + kvh * 64 + ld8); }
            __syncthreads();
            f32x4 s[2][4];
#pragma unroll
            for (int kt = 0; kt < 4; ++kt) { const LAS bf16* kp = Kl + bo + (16 * kt + li15) * 72 + 8 * lq; const bf16x8 k0 = *(const LAS bf16x8*)kp, k1 = *(const LAS bf16x8*)(kp + 32);
#pragma unroll
                for (int mt = 0; mt < 2; ++mt) { s[mt][kt] = __builtin_amdgcn_mfma_f32_16x16x32_bf16(k0, qf[mt][0], (f32x4){0.f, 0.f, 0.f, 0.f}, 0, 0, 0);
                    s[mt][kt] = __builtin_amdgcn_mfma_f32_16x16x32_bf16(k1, qf[mt][1], s[mt][kt], 0, 0, 0); } }
            const int tt = wlo + si;
            if (si < nw && (tt < 2 || tt > 3)) { const int kpos0 = q0 - 128 + 64 * tt; asm volatile("; window-edge tile" ::: "memory");
#pragma unroll
                for (int mt = 0; mt < 2; ++mt) { const int qpos = q0 + qw + 16 * mt + li15;
#pragma unroll
                    for (int kt = 0; kt < 4; ++kt)
#pragma unroll
                        for (int jj = 0; jj < 4; ++jj) { const int dlt = qpos - (kpos0 + 16 * kt + 4 * lq + jj); if (dlt > 128 || dlt < -128) s[mt][kt][jj] = -INFINITY; } } }
            bf16x8 pb[2][2]; float lm[2];
#pragma unroll
            for (int mt = 0; mt < 2; ++mt) { const f32x4 mv = (f32x4){m[mt], m[mt], m[mt], m[mt]};
#pragma unroll
                for (int kt = 0; kt < 4; ++kt) s[mt][kt] = s[mt][kt] - mv;
                float tm = fmaxf(fmaxf(s[mt][0][0], s[mt][0][1]), fmaxf(s[mt][0][2], s[mt][0][3]));
#pragma unroll
                for (int kt = 1; kt < 4; ++kt) tm = fmaxf(tm, fmaxf(fmaxf(s[mt][kt][0], s[mt][kt][1]), fmaxf(s[mt][kt][2], s[mt][kt][3])));
                lm[mt] = tm; }
            if (__builtin_amdgcn_ballot_w64(fmaxf(lm[0], lm[1]) > 8.0f) != 0ull) {
                asm volatile("; raise the references" ::: "memory");
#pragma unroll
                for (int mt = 0; mt < 2; ++mt) { float tm = lm[mt]; tm = fmaxf(tm, __shfl_xor(tm, 16)); tm = fmaxf(tm, __shfl_xor(tm, 32));
                    const float dl = fmaxf(tm, 0.f), alpha = __builtin_amdgcn_exp2f(-dl); m[mt] += dl; l[mt] *= alpha; const f32x4 dv = (f32x4){dl, dl, dl, dl};
#pragma unroll
                    for (int kt = 0; kt < 4; ++kt) s[mt][kt] = s[mt][kt] - dv;
#pragma unroll
                    for (int dt = 0; dt < 4; ++dt) o[mt][dt] = o[mt][dt] * alpha; } }
#pragma unroll
            for (int mt = 0; mt < 2; ++mt) {
                f32x4 lsv = (f32x4){0.f, 0.f, 0.f, 0.f};
#pragma unroll
                for (int kt = 0; kt < 4; ++kt) { f32x4 pv;
#pragma unroll
                    for (int jj = 0; jj < 4; ++jj) pv[jj] = __builtin_amdgcn_exp2f(s[mt][kt][jj]);
                    s[mt][kt] = pv; lsv = lsv + pv; }
                l[mt] += (lsv[0] + lsv[1]) + (lsv[2] + lsv[3]);
#pragma unroll
                for (int s2 = 0; s2 < 2; ++s2) { v4u pw; pw.x = pkbf(s[mt][2 * s2][0], s[mt][2 * s2][1]); pw.y = pkbf(s[mt][2 * s2][2], s[mt][2 * s2][3]);
                    pw.z = pkbf(s[mt][2 * s2 + 1][0], s[mt][2 * s2 + 1][1]); pw.w = pkbf(s[mt][2 * s2 + 1][2], s[mt][2 * s2 + 1][3]); pb[mt][s2] = __builtin_bit_cast(bf16x8, pw); }
            }
#pragma unroll
            for (int s2 = 0; s2 < 2; ++s2)
#pragma unroll
                for (int dt = 0; dt < 4; ++dt) { const LAS bf16* vp = Vl + bo + (32 * s2 + 4 * lq + (li15 >> 2)) * 72 + 16 * dt + 4 * (li15 & 3);
                    const s16x4 lo = __builtin_bit_cast(s16x4, __builtin_amdgcn_ds_read_tr16_b64_v4i16((LAS s16x4*)vp));
                    const s16x4 hi = __builtin_bit_cast(s16x4, __builtin_amdgcn_ds_read_tr16_b64_v4i16((LAS s16x4*)(vp + 16 * 72)));
                    const bf16x8 af = __builtin_shufflevector(lo, hi, 0, 1, 2, 3, 4, 5, 6, 7);
#pragma unroll
                    for (int mt = 0; mt < 2; ++mt) o[mt][dt] = __builtin_amdgcn_mfma_f32_16x16x32_bf16(af, pb[mt][s2], o[mt][dt], 0, 0, 0); }
        }
#pragma unroll
        for (int mt = 0; mt < 2; ++mt) { float lt = l[mt]; lt += __shfl_xor(lt, 16); lt += __shfl_xor(lt, 32); const float inv = 1.0f / lt;
            bf16* op = O + (size_t)(qrow0 + qw + 16 * mt + li15) * 1024 + hq * 64 + 4 * lq;
#pragma unroll
            for (int dt = 0; dt < 4; ++dt) { v2u ov; ov.x = pkbf(o[mt][dt][0] * inv, o[mt][dt][1] * inv); ov.y = pkbf(o[mt][dt][2] * inv, o[mt][dt][3] * inv); *(GAS v2u*)(op + 16 * dt) = ov; } }
    }
#undef KROW
}
__device__ __forceinline__ void final_phase(const Args& a, Frame& F) {
    const int gw = F.bid * NWAVES + F.wave, NGW = F.G * NWAVES, lane = F.lane;
    const bf16* X = (const bf16*)(a.ws + WS_X); const bf16* YS = (const bf16*)(a.ws + WS_YS); const float* MOD = (const float*)(a.ws + WS_MOD); const bf16* PB = (const bf16*)(a.ws + WS_PB);
    const int4* TOKI = (const int4*)(a.ws + WS_TOKI); const float2* TOKW = (const float2*)(a.ws + WS_TOKW);
    MoeSeg sg; moe_seg(F, 1, sg); MoeOrder S;
#pragma unroll
    for (int q = 0; q < 9; ++q) S.pst[q] = sg.pst[q];
#pragma unroll
    for (int q = 0; q < 8; ++q) S.cnt[q] = sg.cnt[q];
    S.apan = false; S.nt = 4; S.G = F.G; S.c = 0; S.ntk = 28; S.split_tail();
    const int ps0 = S.ps0(), psrows = S.psrows(), nS = S.S;
    for (int row = gw; row < ML; row += NGW) {
        const float* g2p = MOD + (size_t)(3 * 9 + (row >> 11)) * 6144 + 5 * 1024; const bf16* ys = YS + (size_t)row * 2048;
        const int4 ti = TOKI[row]; const float2 tw = TOKW[row];
        const int p0 = seg_start(sg, ti.x & 255) * 256 + ti.y, p1 = seg_start(sg, ti.x >> 8) * 256 + ti.z;
        f32x4 y[4];
#pragma unroll
        for (int j = 0; j < 4; ++j) y[j] = (f32x4){0.f, 0.f, 0.f, 0.f};
#pragma unroll
        for (int sl = 0; sl < 2; ++sl) { const int pr = sl ? p1 : p0; const float wsl = sl ? tw.y : tw.x;
            if (pr >= ps0) { f32x4 ps[4];
#pragma unroll
                for (int j = 0; j < 4; ++j) ps[j] = (f32x4){0.f, 0.f, 0.f, 0.f};
                for (int q = 0; q < nS; ++q) {
#pragma unroll
                    for (int j = 0; j < 4; ++j) { const v2u pp = *(const GAS v2u*)(PB + ((size_t)q * psrows + (size_t)(pr - ps0)) * 1024 + 4 * lane + 256 * j); ps[j] = ps[j] + (f32x4){bflo(pp.x), bfhi(pp.x), bflo(pp.y), bfhi(pp.y)}; } }
#pragma unroll
                for (int j = 0; j < 4; ++j) y[j] = y[j] + ps[j] * wsl; }
            else {
#pragma unroll
                for (int j = 0; j < 4; ++j) { const v2u yy = *(const GAS v2u*)(ys + sl * 1024 + 4 * lane + 256 * j); y[j] = y[j] + (f32x4){bflo(yy.x), bfhi(yy.x), bflo(yy.y), bfhi(yy.y)}; } } }
#pragma unroll
        for (int j = 0; j < 4; ++j) { const v2u xx = *(const GAS v2u*)(X + (size_t)row * 1024 + 4 * lane + 256 * j); f32x4 v = (f32x4){bflo(xx.x), bfhi(xx.x), bflo(xx.y), bfhi(xx.y)};
            const f32x4 g = *(const GAS f32x4*)(g2p + 4 * lane + 256 * j);
            __builtin_nontemporal_store(v + g * y[j], (GAS f32x4*)(a.out + (size_t)row * 1024 + 4 * lane + 256 * j)); }
    }
}

#define GRID_BAR() do { if (!MK_PER_PHASE) xcd_barrier(bar); } while (0)
#define IN(k) (lo <= (k) && (k) < hi)
#define BOTH(k) (IN(k) && IN((k) + 1))
#ifndef MK_MASK
#define MK_MASK 0xFFFFFFFFu
#endif
#define EN(b) (((MK_MASK) >> (b)) & 1u)
#ifndef MK_DUP_MASK
#define MK_DUP_MASK 0u
#endif
#define REP(b) ((((MK_DUP_MASK) >> (b)) & 1u) ? 3 : 1)
#define FRESH() do { int t_ = threadIdx.x, b_ = blockIdx.x; asm volatile("" : "+v"(t_)); asm volatile("" : "+s"(b_)); F.tid = t_; F.lane = t_ & 63; F.wave = __builtin_amdgcn_readfirstlane(t_ >> 6); F.bid = b_; } while (0)
template <int jp> __device__ __forceinline__ void layer_pair(const Args& args, Frame& F, const XcdBarrier& bar, const int lo, const int hi) {
    unsigned char* ws = args.ws;
    bf16* X = (bf16*)(ws + WS_X); const float* MOD = (const float*)(ws + WS_MOD); bf16* H = (bf16*)(ws + WS_H);
        const int pb = 1 + 16 * jp, le = 2 * jp, lo_ = 2 * jp + 1;
        const int rows_tail = (jp == 1) ? ML : MT;
        if (EN(1) && IN(pb + 0)) { FRESH();
_Pragma("unroll 1") for (int rep_ = 0; rep_ < REP(1); ++rep_) { if (jp == 1) { TailPlan tp; tail_plan(F.G, 1024, tp); conv_moe_all(args, F, 1, 2, 0, F.G, -1, tp.e[4] < moe_items(2) ? tp.e[4] : moe_items(2), moe_items(2)); }
            norm_phase(args, F, le, 0, MT, jp == 0, jp == 1 ? 1 : -1); if (rep_ + 1 < REP(1)) GRID_BAR(); } if (BOTH(pb + 0)) GRID_BAR(); }
        if (EN(2) && IN(pb + 1)) { FRESH();
_Pragma("unroll 1") for (int rep_ = 0; rep_ < REP(2); ++rep_) { pg8::Gemm g{H, (const bf16*)(ws + WS_WIN) + (size_t)jp * 4096 * 1024, MT, 4096, 1024}; pg8::StaticOrder S; S.init(MT, 4096, 1024, F.G, F.bid);
            pg8::EpiWin E{(bf16*)(ws + WS_U), (bf16*)(ws + WS_V), (bf16*)(ws + WS_G), (float*)(ws + WS_STATS)};
            pg8::gemm_phase<pg8::EpiWin, pg8::StaticOrder, true, true, 16>(F.lds + RING_OFF, g, S, E); { TailPlan tp; tail_plan(F.G, (jp == 1) ? 1024 : 1152, tp); tail_fill(args, F, tp, 0, jp, jp == 0 ? 0 : 2); } if (rep_ + 1 < REP(2)) GRID_BAR(); } if (BOTH(pb + 1)) GRID_BAR(); }
        if (EN(3) && IN(pb + 2)) { FRESH();
_Pragma("unroll 1") for (int rep_ = 0; rep_ < REP(3); ++rep_) { mix_phase(args, F, jp); if (rep_ + 1 < REP(3)) GRID_BAR(); } if (BOTH(pb + 2)) GRID_BAR(); }
        if (EN(4) && IN(pb + 3)) { FRESH();
_Pragma("unroll 1") for (int rep_ = 0; rep_ < REP(4); ++rep_) { pg8::Gemm g{(const bf16*)(ws + WS_YAB), (const bf16*)(ws + WS_WOUT) + (size_t)jp * 1024 * 2048, MT, 1024, 2048}; SplitOrder S; S.init(MT, 2048, F.G, F.bid);
            pg8::EpiResid E{X, MOD + (size_t)(le * 9) * 6144 + 2 * 1024, (float*)(ws + WS_PB), S.rs0(), args.gmul};
            pg8::gemm_phase<pg8::EpiResid, SplitOrder, true, true>(F.lds + RING_OFF, g, S, E); if (rep_ + 1 < REP(4)) GRID_BAR(); } if (BOTH(pb + 3)) GRID_BAR(); }
        if (EN(5) && IN(pb + 4)) { FRESH();
_Pragma("unroll 1") for (int rep_ = 0; rep_ < REP(5); ++rep_) { SplitOrder SP; SP.init(MT, 2048, F.G, F.bid); norm_phase(args, F, le, 1, MT, false, -1, SP.nsplit(), SP.rs0(), MOD + (size_t)(le * 9) * 6144 + 2 * 1024, MK_FP8_FFN2 && jp == 1); if (rep_ + 1 < REP(5)) GRID_BAR(); } if (BOTH(pb + 4)) GRID_BAR(); }
        if (EN(6) && IN(pb + 5)) { FRESH();
_Pragma("unroll 1") for (int rep_ = 0; rep_ < REP(6); ++rep_) { if (MK_FP8_FFN2 && jp == 1) { pg8::Gemm g{H, (const bf16*)(ws + WS_FF13) + (size_t)jp * 7168 * 1024, MT, 7168, 512}; pg8::StaticOrder S; S.init(MT, 7168, 512, F.G, F.bid);
            pg8::EpiSwiGLU8 E{(unsigned char*)(ws + WS_T), FF, 1.0f / F8_W13};
            pg8::gemm_phase<pg8::EpiSwiGLU8, pg8::StaticOrder, true, true, 8, true>(F.lds + RING_OFF, g, S, E); } else {
            pg8::Gemm g{H, (const bf16*)(ws + WS_FF13) + (size_t)jp * 7168 * 1024, MT, 7168, 1024}; pg8::StaticOrder S; S.init(MT, 7168, 1024, F.G, F.bid);
            pg8::EpiSwiGLU E{(bf16*)(ws + WS_T), FF, args.gmul};
            pg8::gemm_phase<pg8::EpiSwiGLU, pg8::StaticOrder, true, true, 16>(F.lds + RING_OFF, g, S, E); } { TailPlan tp; tail_plan(F.G, (jp == 1) ? 1024 : 1152, tp); tail_fill(args, F, tp, 1, jp, jp == 0 ? 0 : 2); } if (rep_ + 1 < REP(6)) GRID_BAR(); } if (BOTH(pb + 5)) GRID_BAR(); }
        if (EN(7) && IN(pb + 6)) { FRESH();
_Pragma("unroll 1") for (int rep_ = 0; rep_ < REP(7); ++rep_) { if (MK_FP8_FFN2 && jp == 1) { pg8::Gemm g{(const bf16*)(ws + WS_T), (const bf16*)(ws + WS_FF2) + (size_t)jp * 1024 * 3584, MT, 1024, FF / 2}; SplitOrder S; S.init(MT, FF / 2, F.G, F.bid);
            pg8::EpiResid E{X, MOD + (size_t)(le * 9) * 6144 + 5 * 1024, (float*)(ws + WS_PB), S.rs0(), args.gmul * (1.0f / F8_W2), 1.0f / F8_W2};
            pg8::gemm_phase<pg8::EpiResid, SplitOrder, true, true, 0, true>(F.lds + RING_OFF, g, S, E); } else {
            pg8::Gemm g{(const bf16*)(ws + WS_T), (const bf16*)(ws + WS_FF2) + (size_t)jp * 1024 * 3584, MT, 1024, FF}; SplitOrder S; S.init(MT, FF, F.G, F.bid);
            pg8::EpiResid E{X, MOD + (size_t)(le * 9) * 6144 + 5 * 1024, (float*)(ws + WS_PB), S.rs0(), args.gmul};
            pg8::gemm_phase<pg8::EpiResid, SplitOrder, true, true>(F.lds + RING_OFF, g, S, E); } if (rep_ + 1 < REP(7)) GRID_BAR(); } if (BOTH(pb + 6)) GRID_BAR(); }
        if (EN(8) && IN(pb + 7)) { FRESH();
_Pragma("unroll 1") for (int rep_ = 0; rep_ < REP(8); ++rep_) { SplitOrder SP; SP.init(MT, (MK_FP8_FFN2 && jp == 1) ? FF / 2 : FF, F.G, F.bid); norm_phase(args, F, lo_, 0, MT, false, -1, SP.nsplit(), SP.rs0(), MOD + (size_t)(le * 9) * 6144 + 5 * 1024); if (rep_ + 1 < REP(8)) GRID_BAR(); } if (BOTH(pb + 7)) GRID_BAR(); }
        if (EN(9) && IN(pb + 8)) { FRESH();
_Pragma("unroll 1") for (int rep_ = 0; rep_ < REP(9); ++rep_) { pg8::Gemm g{H, (const bf16*)(ws + WS_WQKV) + (size_t)jp * 1536 * 1024, MT, 1536, 1024}; pg8::StaticOrder S; S.init(MT, 1536, 1024, F.G, F.bid);
            pg8::EpiQKV E{(bf16*)(ws + WS_Q), (bf16*)(ws + WS_K), (bf16*)(ws + WS_QKV), args.in[18] + jp * 64, args.in[19] + jp * 64, (const float*)(ws + WS_ROPE), ML, QSCALE, EPS};
            pg8::gemm_phase<pg8::EpiQKV, pg8::StaticOrder, true, true, 16>(F.lds + RING_OFF, g, S, E); { TailPlan tp; tail_plan(F.G, (jp == 1) ? 1024 : 1152, tp); tail_fill(args, F, tp, 2, jp, jp == 0 ? 0 : 2); } if (rep_ + 1 < REP(9)) GRID_BAR(); } if (BOTH(pb + 8)) GRID_BAR(); }
        if (EN(11) && IN(pb + 10)) { FRESH();
_Pragma("unroll 1") for (int rep_ = 0; rep_ < REP(11); ++rep_) { attn_phase(args, F, jp, (jp == 1) ? 1024 : 1152); { TailPlan tp; tail_plan(F.G, (jp == 1) ? 1024 : 1152, tp); tail_fill(args, F, tp, 3, jp, jp == 0 ? 0 : 2, (F.G % 8 == 0) ? (F.bid % 8) * (F.G / 8) + F.bid / 8 : F.bid); } if (rep_ + 1 < REP(11)) GRID_BAR(); } if (BOTH(pb + 10)) GRID_BAR(); }
        if (EN(12) && IN(pb + 11)) { FRESH();
_Pragma("unroll 1") for (int rep_ = 0; rep_ < REP(12); ++rep_) { pg8::Gemm g{(const bf16*)(ws + WS_O), (const bf16*)(ws + WS_WO) + (size_t)jp * 1024 * 1024, rows_tail, 1024, 1024}; SplitOrder S; S.init(rows_tail, 1024, F.G, F.bid);
            pg8::EpiResid E{X, MOD + (size_t)(lo_ * 9) * 6144 + 2 * 1024, (float*)(ws + WS_PB), S.rs0(), args.gmul};
            pg8::gemm_phase<pg8::EpiResid, SplitOrder, true, true>(F.lds + RING_OFF, g, S, E); if (rep_ + 1 < REP(12)) GRID_BAR(); } if (BOTH(pb + 11)) GRID_BAR(); }
        if (EN(13) && IN(pb + 12)) { FRESH();
_Pragma("unroll 1") for (int rep_ = 0; rep_ < REP(13); ++rep_) { SplitOrder SP; SP.init(rows_tail, 1024, F.G, F.bid); norm_router_phase(args, F, lo_, rows_tail, SP.nsplit(), SP.rs0(), MOD + (size_t)(lo_ * 9) * 6144 + 2 * 1024); if (rep_ + 1 < REP(13)) GRID_BAR(); } if (BOTH(pb + 12)) GRID_BAR(); }
        if (EN(15) && IN(pb + 14)) { FRESH();
_Pragma("unroll 1") for (int rep_ = 0; rep_ < REP(15); ++rep_) { MoeSeg sg; moe_seg(F, jp, sg); MoeOrder S;
#pragma unroll
            for (int q = 0; q < 9; ++q) S.pst[q] = sg.pst[q];
#pragma unroll
            for (int q = 0; q < 8; ++q) S.cnt[q] = sg.cnt[q];
            S.nt = 28; S.G = F.G; S.c = F.bid; S.ntk = 8; S.apan = true; S.no_split();
            pg8::Gemm g{(const bf16*)(ws + WS_HP), (const bf16*)(ws + WS_MOE13), 0, 0, 512};
            pg8::EpiSwiGLU8 E{(unsigned char*)(ws + WS_TP), FF, 1.0f / F8_W13};
            pg8::gemm_phase<pg8::EpiSwiGLU8, MoeOrder, true, true, 8, true>(F.lds + RING_OFF, g, S, E); if (rep_ + 1 < REP(15)) GRID_BAR(); } if (BOTH(pb + 14)) GRID_BAR(); }
        if (EN(16) && IN(pb + 15)) { FRESH();
_Pragma("unroll 1") for (int rep_ = 0; rep_ < REP(16); ++rep_) { MoeSeg sg; moe_seg(F, jp, sg); MoeOrder S;
#pragma unroll
            for (int q = 0; q < 9; ++q) S.pst[q] = sg.pst[q];
#pragma unroll
            for (int q = 0; q < 8; ++q) S.cnt[q] = sg.cnt[q];
            S.apan = false; S.nt = 4; S.G = F.G; S.c = F.bid; S.ntk = 28; if (jp == 1) S.split_tail(); else S.no_split();
            pg8::Gemm g{(const bf16*)(ws + WS_TP), (const bf16*)(ws + WS_MOE2), 0, 0, FF / 2};
            pg8::EpiMoeDown E{(bf16*)(ws + WS_YS), (const int*)(ws + WS_TOKLIST), (const float*)(ws + WS_TOKWT), CAP, (bf16*)(ws + WS_PB), S.ps0(), S.psrows(), 1.0f / F8_W2};
            if (jp == 0) pg8::gemm_phase<pg8::EpiMoeDown, MoeOrder, true, true, 28, true>(F.lds + RING_OFF, g, S, E); else pg8::gemm_phase<pg8::EpiMoeDown, MoeOrder, true, true, 0, true>(F.lds + RING_OFF, g, S, E);
            if (jp == 0) { const int U = sg.pst[8] * 4, busy = (U > 2 * F.G) ? ((U - 2 * F.G < F.G) ? U - 2 * F.G : F.G) : 0;
                const int vcid = (F.G % 8 == 0) ? (F.bid % 8) * (F.G / 8) + F.bid / 8 : F.bid;
                if (busy < F.G) conv_moe_all(args, F, 1, 1, busy, F.G - busy, vcid); else conv_moe_all(args, F, 1, 1, 0, F.G, vcid); } if (rep_ + 1 < REP(16)) GRID_BAR(); } if (BOTH(pb + 15)) GRID_BAR(); }
}

__global__ void __launch_bounds__(NWAVES * 64, 2) mk_fwd(Args args) {
    extern __shared__ __attribute__((aligned(16))) unsigned char lds[];
    Frame F;
    F.lds = (LAS unsigned char*)lds; F.MISC = (volatile LAS unsigned*)(F.lds + MISC_OFF);
    F.tid = threadIdx.x; F.lane = F.tid & 63; F.wave = __builtin_amdgcn_readfirstlane(F.tid >> 6); F.G = gridDim.x; F.bid = blockIdx.x;
    F.ctl = (gu32*)(args.ws + WS_CTL);
    for (int u = F.tid; u < (LDS_BYTES - LDSCTL_OFF) / 4; u += NWAVES * 64) ((LAS unsigned*)(F.lds + LDSCTL_OFF))[u] = 0u;
    __syncthreads();
    XcdBarrier bar; bar.bar = (unsigned*)(F.ctl + CW_BAR); bar.x = 0; bar.st = nullptr;
    if (!MK_PER_PHASE) bar = xcd_barrier_post((unsigned*)(F.ctl + CW_BAR), F.MISC + 8);
    const int lo = args.ph_lo, hi = args.ph_hi;
    unsigned char* ws = args.ws;
    bf16* X = (bf16*)(ws + WS_X); const float* MOD = (const float*)(ws + WS_MOD); bf16* H = (bf16*)(ws + WS_H);

    if (EN(0) && IN(0)) { FRESH(); prologue_phase(args, F); if (BOTH(0)) GRID_BAR(); }

    layer_pair<0>(args, F, bar, lo, hi);
    layer_pair<1>(args, F, bar, lo, hi);
    if (EN(17) && IN(33)) { FRESH(); final_phase(args, F); }
#undef IN
#undef BOTH
}

extern "C" void kernel_launch(void* const* d_in, const int* in_sizes, int n_in, void* d_out, int out_size, void* d_ws, size_t ws_size, hipStream_t stream) {
    static int grid = 0;
    if (grid == 0) {
        if (n_in != 29 || out_size != ML * D || ws_size < WS_END) { fprintf(stderr, "kernel_launch: unexpected shapes (n_in %d out %d ws %zu)\n", n_in, out_size, ws_size); grid = -1; return; }
        int dev = 0, cus = 0;
        if (hipGetDevice(&dev) != hipSuccess || hipDeviceGetAttribute(&cus, hipDeviceAttributeMultiprocessorCount, dev) != hipSuccess) { grid = -1; return; }
        if (hipFuncSetAttribute((const void*)mk_fwd, hipFuncAttributeMaxDynamicSharedMemorySize, LDS_BYTES) != hipSuccess) { grid = -1; return; }
        int per_cu = 0; (void)hipOccupancyMaxActiveBlocksPerMultiprocessor(&per_cu, (const void*)mk_fwd, NWAVES * 64, LDS_BYTES); (void)hipGetLastError();
        grid = cus;
    }
    if (grid < 0) return;
    (void)hipMemsetAsync((char*)d_ws + WS_CTL, 0, CTL_ZERO_BYTES, stream);
    Args a{};
    for (int i = 0; i < 29; ++i) a.in[i] = (const float*)d_in[i];
    a.out = (float*)d_out; a.ws = (unsigned char*)d_ws; a.gmul = 1.f; a.pad = 0;
#if MK_PER_PHASE
#ifndef MK_REP_LIST
#define MK_REP_LIST -1
#endif
    const int reps[] = {MK_REP_LIST};
    for (int p = 0; p < N_PHASES; ++p) { int n = 1; for (int r : reps) if (r == p) n += 2;
        for (int q = 0; q < n; ++q) { a.ph_lo = p; a.ph_hi = p + 1; a.gmul = (q == 0) ? 1.f : 0.f; hipLaunchKernelGGL(mk_fwd, dim3(grid), dim3(NWAVES * 64), LDS_BYTES, stream, a); } }
#else
    a.ph_lo = 0; a.ph_hi = N_PHASES; hipLaunchKernelGGL(mk_fwd, dim3(grid), dim3(NWAVES * 64), LDS_BYTES, stream, a);
#endif
}
```

```cpp
#include <hip/hip_runtime.h>
#include <cstdio>
#include <cstdint>
namespace pg8 {
#define PG8_LAS __attribute__((address_space(3)))
typedef unsigned short bf16_t;
typedef short bf16x8 __attribute__((ext_vector_type(8)));
typedef float f32x4 __attribute__((ext_vector_type(4)));
typedef unsigned u32x4 __attribute__((ext_vector_type(4)));
typedef int v4i32 __attribute__((ext_vector_type(4)));
typedef int v8i32 __attribute__((ext_vector_type(8)));
constexpr int BM = 256, BK = 64, HALF = 128, HTB = HALF * BK * 2  , STAGE_BYTES = 8 * HTB, NXCD = 8, WGM = 8;

__host__ __device__ __forceinline__ int lds_byte(int r, int c) { const int st = (r >> 4) * 2 + (c >> 5), rr = r & 15, cc = c & 31, ob = rr * 64 + cc * 2; return st * 1024 + (ob ^ (((ob >> 9) & 1) << 5)); }
__host__ __device__ __forceinline__ void stage_rc(int b, int& R, int& C) { const int st = b / 1024, sb = b % 1024, swz = sb ^ (((sb >> 9) & 1) << 5); R = (st >> 1) * 16 + swz / 64; C = (st & 1) * 32 + (swz % 64) / 2; }
__host__ __device__ __forceinline__ int perm32(int rho) { const int n = rho >> 4, i = rho & 15; return 8 * (i >> 2) + 4 * n + (i & 3); }

struct Unit { int pm, pn, e, j, k0, nt, s, pa, pl, cn; };
struct Gemm { const bf16_t* A; const bf16_t* Bt; int M, N, K; };

struct StaticOrder {
    int nM, nN, nwg, G, c, ntk;
    __host__ __device__ void init(int M, int N, int K, int G_, int c_) { nM = M / BM; nN = N / BM; nwg = nM * nN; G = G_; c = c_; ntk = K / BK; }
    __host__ __device__ bool next(int i, Unit& u) const {
        const long L = (long)i * G + c; if (L >= nwg) return false;
        int wgid = (int)L; { const int q = nwg / NXCD, r = nwg % NXCD, xcd = wgid % NXCD, off = wgid / NXCD; wgid = (xcd < r ? xcd * (q + 1) : r * (q + 1) + (xcd - r) * q) + off; }
        const int nig = WGM * nN, gid = wgid / nig, fm = gid * WGM, gsz = (nM - fm) < WGM ? (nM - fm) : WGM;
        u.pm = fm + ((wgid % nig) % gsz); u.pn = (wgid % nig) / gsz; u.e = 0; u.j = u.pn; u.k0 = 0; u.nt = ntk; u.s = 0; u.pa = u.pm; u.pl = 0; u.cn = 0; return true;
    }
    __device__ __forceinline__ void a_ready(const Unit&) const {}
    __device__ __forceinline__ void done(const Unit&) const {}
};

__device__ __forceinline__ unsigned cvt_pk_bf16(float lo, float hi) { unsigned r; asm volatile("v_cvt_pk_bf16_f32 %0, %1, %2" : "=v"(r) : "v"(lo), "v"(hi)); return r; }
typedef float f32x2 __attribute__((ext_vector_type(2)));
__device__ __forceinline__ f32x2 gelu_pk(f32x2 v) {
    const f32x2 av = __builtin_elementwise_abs(v), d = av * 0.2316418882f + 1.0f;
    f32x2 t; t.x = __builtin_amdgcn_rcpf(d.x); t.y = __builtin_amdgcn_rcpf(d.y);
    f32x2 q = t * 0.5307027145f + (-0.7265760135f); q = q * t + 0.7107068705f; q = q * t + (-0.142248368f); q = q * t + 0.127414796f; q = q * t;
    const f32x2 s = (v * v) * (-0.72134752044f);
    f32x2 e; e.x = __builtin_amdgcn_exp2f(s.x); e.y = __builtin_amdgcn_exp2f(s.y);
    const f32x2 m = v * (q * e), r = v - m;
    f32x2 o; o.x = v.x < 0.f ? m.x : r.x; o.y = v.y < 0.f ? m.y : r.y; return o;
}

template <int ACT  > struct EpiBf16 {
    static constexpr bool PERM = true, AFTER_DRAIN = false; static_assert(ACT == 0 || ACT == 1, "EpiBf16: ACT is 0 (none) or 1 (gelu_pk)");
    bf16_t* O; int ldc; const float* bias; int split_cols; size_t split_stride; float scale0;
    __device__ __forceinline__ void operator()(const f32x4 (&acc)[2][2][4][2], const Unit& u, int wr, int wc, int fr, int fq) const {
        const int row0 = u.pm * BM + wr * 64 + fr; int colt = u.pn * BM; bf16_t* base = O;
        float sc = 1.f; if (split_cols) { const int t = colt / split_cols; base += (size_t)t * split_stride; colt -= t * split_cols; if (t == 0) sc = scale0; }
        const int col0 = colt + wc * 32 + 8 * fq, bcol0 = u.pn * BM + wc * 32 + 8 * fq;
        f32x4 bv[2][2];
#pragma unroll
        for (int bj = 0; bj < 2; ++bj)
#pragma unroll
            for (int n = 0; n < 2; ++n) bv[bj][n] = bias ? *(const f32x4*)(bias + bcol0 + bj * HALF + 4 * n) : (f32x4){0.f, 0.f, 0.f, 0.f};
#pragma unroll
        for (int ai = 0; ai < 2; ++ai)
#pragma unroll
            for (int m = 0; m < 4; ++m) { bf16_t* rowp = base + (size_t)(row0 + ai * HALF + m * 16) * ldc + col0;
#pragma unroll
                for (int bj = 0; bj < 2; ++bj) { f32x4 v0 = acc[ai][bj][m][0] + bv[bj][0], v1 = acc[ai][bj][m][1] + bv[bj][1];
                    if (ACT == 1) { f32x2 a = gelu_pk((f32x2){v0[0], v0[1]}), b = gelu_pk((f32x2){v0[2], v0[3]}), c = gelu_pk((f32x2){v1[0], v1[1]}), d = gelu_pk((f32x2){v1[2], v1[3]});
                        v0 = (f32x4){a.x, a.y, b.x, b.y}; v1 = (f32x4){c.x, c.y, d.x, d.y}; }
                    v0 = v0 * sc; v1 = v1 * sc; u32x4 w; w.x = cvt_pk_bf16(v0[0], v0[1]); w.y = cvt_pk_bf16(v0[2], v0[3]); w.z = cvt_pk_bf16(v1[0], v1[1]); w.w = cvt_pk_bf16(v1[2], v1[3]);
                    *(u32x4*)(rowp + bj * HALF) = w; } }
    }
};
__device__ __forceinline__ float sigm_f(float x) { return __builtin_amdgcn_rcpf(1.f + __builtin_amdgcn_exp2f(-1.4426950409f * x)); }
__device__ __forceinline__ float silu_f(float x) { return x * sigm_f(x); }
__device__ __forceinline__ f32x4 exp2_v(f32x4 x) { return (f32x4){__builtin_amdgcn_exp2f(x[0]), __builtin_amdgcn_exp2f(x[1]), __builtin_amdgcn_exp2f(x[2]), __builtin_amdgcn_exp2f(x[3])}; }
__device__ __forceinline__ f32x4 rcp_v(f32x4 x) { return (f32x4){__builtin_amdgcn_rcpf(x[0]), __builtin_amdgcn_rcpf(x[1]), __builtin_amdgcn_rcpf(x[2]), __builtin_amdgcn_rcpf(x[3])}; }
__device__ __forceinline__ f32x4 sigm_v(f32x4 x) { return rcp_v(1.f + exp2_v(x * -1.4426950409f)); }
__device__ __forceinline__ f32x4 swiglu_v(f32x4 a, f32x4 g, float sc) { const float k = 1.0f / (sc * sc); const f32x4 r = rcp_v(exp2_v(a * (-1.4426950409f * sc)) * k + k); return (a * g) * r; }
__device__ __forceinline__ f32x4 gelu_tanh_v(f32x4 x) { const f32x4 t = x * (x * x * (-2.3022082f * 0.044715f) + -2.3022082f); return x * rcp_v(1.f + exp2_v(t)); }
__device__ __forceinline__ float gelu_tanh_f(float x) { const float t = x * (1.f + 0.044715f * x * x); return x * __builtin_amdgcn_rcpf(1.f + __builtin_amdgcn_exp2f(-2.3022082f * t)); }

struct EpiWin {
    static constexpr bool PERM = true, AFTER_DRAIN = false;
    bf16_t *U, *V, *G; float* stats;
    __device__ __forceinline__ void operator()(const f32x4 (&acc)[2][2][4][2], const Unit& u, int wr, int wc, int fr, int fq) const {
        const int row0 = u.pm * BM + wr * 64 + fr;
        if (u.pn < 8) {
            bf16_t* base = (u.pn < 4) ? U : V; const int col0 = (u.pn & 3) * 256 + wc * 32 + 8 * fq;
#pragma unroll
            for (int ai = 0; ai < 2; ++ai)
#pragma unroll
                for (int m = 0; m < 4; ++m) { bf16_t* rowp = base + (size_t)(row0 + ai * HALF + m * 16) * 1024 + col0; f32x4 sv1 = (f32x4){0.f, 0.f, 0.f, 0.f}, sv2 = (f32x4){0.f, 0.f, 0.f, 0.f};
#pragma unroll
                    for (int bj = 0; bj < 2; ++bj) { const f32x4 g0 = gelu_tanh_v(acc[ai][bj][m][0]), g1 = gelu_tanh_v(acc[ai][bj][m][1]);
                        sv1 = sv1 + (g0 + g1); sv2 = sv2 + (g0 * g0 + g1 * g1);
                        u32x4 w; w.x = cvt_pk_bf16(g0[0], g0[1]); w.y = cvt_pk_bf16(g0[2], g0[3]); w.z = cvt_pk_bf16(g1[0], g1[1]); w.w = cvt_pk_bf16(g1[2], g1[3]);
                        *(u32x4*)(rowp + bj * HALF) = w; }
                    float s1 = (sv1[0] + sv1[1]) + (sv1[2] + sv1[3]), s2 = (sv2[0] + sv2[1]) + (sv2[2] + sv2[3]);
                    if (u.pn >= 4) { s1 += __shfl_xor(s1, 16); s1 += __shfl_xor(s1, 32); s2 += __shfl_xor(s2, 16); s2 += __shfl_xor(s2, 32);
                        if (fq == 0) { f32x2 sv; sv.x = s1; sv.y = s2; *(f32x2*)(stats + (size_t)(row0 + ai * HALF + m * 16) * 32 + ((u.pn - 4) * 4 + wc) * 2) = sv; } } }
        } else {
            const int col0 = (u.pn - 8) * 128 + wc * 32 + 8 * fq;
#pragma unroll
            for (int ai = 0; ai < 2; ++ai)
#pragma unroll
                for (int m = 0; m < 4; ++m) { bf16_t* rowp = G + (size_t)(row0 + ai * HALF + m * 16) * 1024 + col0;
                    const f32x4 a0 = acc[ai][0][m][0], a1 = acc[ai][0][m][1], g0 = acc[ai][1][m][0], g1 = acc[ai][1][m][1]; u32x4 w;
                    const f32x4 y0 = a0 * sigm_v(g0), y1 = a1 * sigm_v(g1);
                    w.x = cvt_pk_bf16(y0[0], y0[1]); w.y = cvt_pk_bf16(y0[2], y0[3]); w.z = cvt_pk_bf16(y1[0], y1[1]); w.w = cvt_pk_bf16(y1[2], y1[3]);
                    *(u32x4*)rowp = w; }
        }
    }
};
struct EpiSwiGLU {
    static constexpr bool PERM = true, AFTER_DRAIN = false;
    bf16_t* T; int ldc; float gmul;
    __device__ __forceinline__ void operator()(const f32x4 (&acc)[2][2][4][2], const Unit& u, int wr, int wc, int fr, int fq) const {
#ifdef MK_SKIP_EPI
        if (gmul == 0.f) return;
#endif
        const int row0 = u.pm * BM + wr * 64 + fr; const int col0 = u.j * 128 + wc * 32 + 8 * fq;
#pragma unroll
        for (int ai = 0; ai < 2; ++ai)
#pragma unroll
            for (int m = 0; m < 4; ++m) { bf16_t* rowp = T + (size_t)(row0 + ai * HALF + m * 16) * ldc + col0;
                const f32x4 a0 = acc[ai][0][m][0], a1 = acc[ai][0][m][1], g0 = acc[ai][1][m][0], g1 = acc[ai][1][m][1]; u32x4 w;
                const f32x4 y0 = swiglu_v(a0, g0, 1.0f), y1 = swiglu_v(a1, g1, 1.0f);
                w.x = cvt_pk_bf16(y0[0], y0[1]); w.y = cvt_pk_bf16(y0[2], y0[3]); w.z = cvt_pk_bf16(y1[0], y1[1]); w.w = cvt_pk_bf16(y1[2], y1[3]);
                *(u32x4*)rowp = w; }
    }
};
struct EpiSwiGLU8 {
    static constexpr bool PERM = true, AFTER_DRAIN = false;
    unsigned char* T; int ldc; float isc;
    __device__ __forceinline__ void operator()(const f32x4 (&acc)[2][2][4][2], const Unit& u, int wr, int wc, int fr, int fq) const {
        const int row0 = u.pm * BM + wr * 64 + fr; const int col0 = u.j * 128 + wc * 32 + 8 * fq;
#pragma unroll
        for (int ai = 0; ai < 2; ++ai)
#pragma unroll
            for (int m = 0; m < 4; ++m) { unsigned char* rowp = T + (size_t)(row0 + ai * HALF + m * 16) * ldc + col0;
                const f32x4 y0 = swiglu_v(acc[ai][0][m][0], acc[ai][1][m][0], isc), y1 = swiglu_v(acc[ai][0][m][1], acc[ai][1][m][1], isc);
                int p0 = 0, p1 = 0;
                p0 = __builtin_amdgcn_cvt_pk_fp8_f32(y0[0], y0[1], p0, false); p0 = __builtin_amdgcn_cvt_pk_fp8_f32(y0[2], y0[3], p0, true);
                p1 = __builtin_amdgcn_cvt_pk_fp8_f32(y1[0], y1[1], p1, false); p1 = __builtin_amdgcn_cvt_pk_fp8_f32(y1[2], y1[3], p1, true);
                *(unsigned long long*)rowp = (unsigned long long)(unsigned)p0 | ((unsigned long long)(unsigned)p1 << 32); }
    }
};
struct EpiResid {
    static constexpr bool PERM = true, AFTER_DRAIN = false;
    bf16_t* X; const float* gate; float* PB; int rs0; float gmul; float psc = 1.0f;
    __device__ __forceinline__ void operator()(const f32x4 (&acc)[2][2][4][2], const Unit& u, int wr, int wc, int fr, int fq) const {
        const int col0 = u.pn * BM + wc * 32 + 8 * fq;
        if (u.e == 0) {
            const int mr = (u.pm < 64) ? (u.pm >> 3) : 8; const float* gp = gate + (size_t)mr * 6144;
            f32x4 gv[2][2];
#pragma unroll
            for (int bj = 0; bj < 2; ++bj)
#pragma unroll
                for (int n = 0; n < 2; ++n) gv[bj][n] = *(const f32x4*)(gp + col0 + bj * HALF + 4 * n) * gmul;
#pragma unroll
            for (int ai = 0; ai < 2; ++ai) { bf16_t* xb = X + (size_t)(u.pm * BM + ai * HALF + wr * 64 + fr) * 1024 + col0; u32x4 xv[4][2];
#pragma unroll
                for (int m = 0; m < 4; ++m)
#pragma unroll
                    for (int bj = 0; bj < 2; ++bj) xv[m][bj] = *(const u32x4*)(xb + (size_t)m * 16 * 1024 + bj * HALF);
                asm volatile("" ::: "memory");
#pragma unroll
                for (int m = 0; m < 4; ++m)
#pragma unroll
                    for (int bj = 0; bj < 2; ++bj) { const u32x4 x = xv[m][bj]; const f32x4 a0 = acc[ai][bj][m][0] * gv[bj][0], a1 = acc[ai][bj][m][1] * gv[bj][1]; u32x4 w;
                        w.x = cvt_pk_bf16(__uint_as_float(x.x << 16) + a0[0], __uint_as_float(x.x & 0xffff0000u) + a0[1]); w.y = cvt_pk_bf16(__uint_as_float(x.y << 16) + a0[2], __uint_as_float(x.y & 0xffff0000u) + a0[3]);
                        w.z = cvt_pk_bf16(__uint_as_float(x.z << 16) + a1[0], __uint_as_float(x.z & 0xffff0000u) + a1[1]); w.w = cvt_pk_bf16(__uint_as_float(x.w << 16) + a1[2], __uint_as_float(x.w & 0xffff0000u) + a1[3]);
                        *(u32x4*)(xb + (size_t)m * 16 * 1024 + bj * HALF) = w; }
                asm volatile("" ::: "memory"); }
        } else {
            bf16_t* pb = (bf16_t*)PB + (size_t)(u.e - 1) * 2048 * 1024;
#pragma unroll
            for (int ai = 0; ai < 2; ++ai)
#pragma unroll
                for (int m = 0; m < 4; ++m) { bf16_t* xp = pb + (size_t)(u.pm * BM + ai * HALF + wr * 64 + m * 16 + fr - rs0) * 1024 + col0;
#pragma unroll
                    for (int bj = 0; bj < 2; ++bj) { const f32x4 v0 = acc[ai][bj][m][0] * psc, v1 = acc[ai][bj][m][1] * psc; u32x4 w; w.x = cvt_pk_bf16(v0[0], v0[1]); w.y = cvt_pk_bf16(v0[2], v0[3]); w.z = cvt_pk_bf16(v1[0], v1[1]); w.w = cvt_pk_bf16(v1[2], v1[3]);
                        *(u32x4*)(xp + bj * HALF) = w; } }
        }
    }
};
struct EpiMoeDown {
    static constexpr bool PERM = true, AFTER_DRAIN = false;
    bf16_t* YS; const int* toklist; const float* tokwt; int cap; bf16_t* PB; int ps0, psrows; float osc;
    __device__ __forceinline__ void operator()(const f32x4 (&acc)[2][2][4][2], const Unit& u, int wr, int wc, int fr, int fq) const {
        const int col0 = u.j * BM + wc * 32 + 8 * fq;
        if (u.s > 0) {
#pragma unroll
            for (int ai = 0; ai < 2; ++ai)
#pragma unroll
                for (int m = 0; m < 4; ++m) { const int prow = u.pm * BM + ai * HALF + wr * 64 + m * 16 + fr; bf16_t* pp = PB + ((size_t)(u.s - 1) * psrows + (size_t)(prow - ps0)) * 1024 + col0;
#pragma unroll
                    for (int bj = 0; bj < 2; ++bj) { const f32x4 v0 = acc[ai][bj][m][0] * osc, v1 = acc[ai][bj][m][1] * osc; u32x4 w; w.x = cvt_pk_bf16(v0[0], v0[1]); w.y = cvt_pk_bf16(v0[2], v0[3]); w.z = cvt_pk_bf16(v1[0], v1[1]); w.w = cvt_pk_bf16(v1[2], v1[3]);
                        *(u32x4*)(pp + bj * HALF) = w; } }
            return; }
        int tsv[2][4]; float wv[2][4];
#pragma unroll
        for (int ai = 0; ai < 2; ++ai)
#pragma unroll
            for (int m = 0; m < 4; ++m) { const int pos = u.pl * BM + ai * HALF + wr * 64 + m * 16 + fr; const int tl = toklist[u.e * cap + pos]; wv[ai][m] = tokwt[u.e * cap + pos]; tsv[ai][m] = (pos < u.cn) ? tl : -1; }
        asm volatile("" ::: "memory");
#pragma unroll
        for (int ai = 0; ai < 2; ++ai)
#pragma unroll
            for (int m = 0; m < 4; ++m) { const int ts = tsv[ai][m]; const float w = wv[ai][m] * osc;
                if (ts >= 0) { bf16_t* yp = YS + (size_t)ts * 1024 + col0;
#pragma unroll
                    for (int bj = 0; bj < 2; ++bj) { const f32x4 v0 = acc[ai][bj][m][0] * w, v1 = acc[ai][bj][m][1] * w; u32x4 o; o.x = cvt_pk_bf16(v0[0], v0[1]); o.y = cvt_pk_bf16(v0[2], v0[3]); o.z = cvt_pk_bf16(v1[0], v1[1]); o.w = cvt_pk_bf16(v1[2], v1[3]);
                        *(u32x4*)(yp + bj * HALF) = o; } } }
    }
};
struct EpiQKV {
    static constexpr bool PERM = true, AFTER_DRAIN = false;
    bf16_t *Q, *K, *V; const float *qg, *kg, *rope; int nlat; float qsc, eps;
    __device__ __forceinline__ void operator()(const f32x4 (&acc)[2][2][4][2], const Unit& u, int wr, int wc, int fr, int fq) const {
        const int row0 = u.pm * BM + wr * 64 + fr;
        if (u.pn == 5) {
#pragma unroll
            for (int ai = 0; ai < 2; ++ai)
#pragma unroll
                for (int m = 0; m < 4; ++m) { bf16_t* rowp = V + (size_t)(row0 + ai * HALF + m * 16) * 256 + wc * 32 + 8 * fq;
#pragma unroll
                    for (int bj = 0; bj < 2; ++bj) { const f32x4 v0 = acc[ai][bj][m][0], v1 = acc[ai][bj][m][1]; u32x4 w; w.x = cvt_pk_bf16(v0[0], v0[1]); w.y = cvt_pk_bf16(v0[2], v0[3]); w.z = cvt_pk_bf16(v1[0], v1[1]); w.w = cvt_pk_bf16(v1[2], v1[3]);
                        *(u32x4*)(rowp + bj * HALF) = w; } }
        } else {
            const bool isq = u.pn < 4; const float* gp = isq ? qg : kg; const float osc = isq ? qsc : 1.0f;
            f32x4 gv[2][2];
#pragma unroll
            for (int bj = 0; bj < 2; ++bj)
#pragma unroll
                for (int n = 0; n < 2; ++n) gv[bj][n] = *(const f32x4*)(gp + 32 * bj + 16 * n + 4 * fq);
#pragma unroll
            for (int ai = 0; ai < 2; ++ai)
#pragma unroll
                for (int m = 0; m < 4; ++m) { const int row = row0 + ai * HALF + m * 16;
                    float ss = 0.f;
#pragma unroll
                    for (int bj = 0; bj < 2; ++bj)
#pragma unroll
                        for (int n = 0; n < 2; ++n) { const f32x4 x = acc[ai][bj][m][n]; ss += (x[0] * x[0] + x[1] * x[1]) + (x[2] * x[2] + x[3] * x[3]); }
                    ss += __shfl_xor(ss, 16); ss += __shfl_xor(ss, 32);
                    const float r = osc / sqrtf(ss * (1.0f / 64.0f) + eps);
                    f32x4 y[2][2];
#pragma unroll
                    for (int bj = 0; bj < 2; ++bj)
#pragma unroll
                        for (int n = 0; n < 2; ++n) y[bj][n] = acc[ai][bj][m][n] * r * gv[bj][n];
                    if (row < nlat) { const int t = row & 2047;
#pragma unroll
                        for (int bj = 0; bj < 2; ++bj) { const int pos = bj ? (t & 63) : (t >> 6); const float* tp = rope + (pos * 16 + 4 * fq) * 2; const f32x4 c01 = *(const f32x4*)tp, c23 = *(const f32x4*)(tp + 4);
                            const f32x4 cs = (f32x4){c01[0], c01[2], c23[0], c23[2]}, sn = (f32x4){c01[1], c01[3], c23[1], c23[3]};
                            const f32x4 a = y[bj][0], b = y[bj][1]; y[bj][0] = a * cs - b * sn; y[bj][1] = b * cs + a * sn; } }
                    bf16_t* dp = (isq ? Q + (size_t)row * 1024 + (4 * u.pn + wc) * 64 : K + (size_t)row * 256 + wc * 64) + 8 * fq;
#pragma unroll
                    for (int bj = 0; bj < 2; ++bj) { const f32x4 v0 = y[bj][0], v1 = y[bj][1]; u32x4 w; w.x = cvt_pk_bf16(v0[0], v0[1]); w.y = cvt_pk_bf16(v0[2], v0[3]); w.z = cvt_pk_bf16(v1[0], v1[1]); w.w = cvt_pk_bf16(v1[2], v1[3]);
                        *(u32x4*)(dp + 32 * bj) = w; } }
        }
    }
};
template <class Epi, class Sched, bool ALIGN_EPI = false, bool SP2 = false, int NTC = 0, bool FP8 = false>
__device__ __forceinline__ void gemm_phase(PG8_LAS unsigned char* lds, const Gemm g, const Sched& S, const Epi& E) {
    int tid_ = threadIdx.x; asm volatile("" : "+v"(tid_));
    const int tid = tid_, wid = __builtin_amdgcn_readfirstlane(tid >> 6), lane = tid & 63, wr = wid >> 2, wc = wid & 3, fr = lane & 15, fq = lane >> 4;
    const int K = g.K;
    unsigned voffA[2], voffB[2];
#pragma unroll
    for (int i = 0; i < 2; ++i) { int R, C; stage_rc(tid * 16 + i * 8192, R, C); const int Rb = Epi::PERM ? ((R & ~31) + perm32(R & 31)) : R;
        voffA[i] = (unsigned)(R * K + C) * 2u; voffB[i] = (unsigned)(Rb * K + C) * 2u; }
    const size_t kstep = (size_t)(BK * 2);
    const size_t hstep = (size_t)HALF * K * 2;
    const size_t tstep = 2 * hstep;
    const unsigned ldsw = (unsigned)wid * 1024u;
    const int aoff = lds_byte(wr * 64 + fr, fq * 8), boff = lds_byte(wc * 32 + fr, fq * 8);
#define PG8_SA(b, h) (((b) * 2 + (h)) * HTB)
#define PG8_SB(b, h) ((4 + (b) * 2 + (h)) * HTB)
#define PG8_STAGE(bufoff, gbase, voff) do { _Pragma("unroll") for (int _i = 0; _i < 2; ++_i) \
        __builtin_amdgcn_global_load_lds((const unsigned*)((const char*)(gbase) + (voff)[_i]), (PG8_LAS unsigned*)(lds + (bufoff) + ldsw + _i * 8192), 16, 0, 0); } while (0)
#define PG8_LDA(dst, b, h) do { if constexpr (FP8) { _Pragma("unroll") for (int m = 0; m < 4; ++m) { const v4i32 l0_ = *(const PG8_LAS v4i32*)(lds + PG8_SA(b, h) + aoff + m * 2048), l1_ = *(const PG8_LAS v4i32*)(lds + PG8_SA(b, h) + aoff + m * 2048 + 1024); \
            dst##8[m] = __builtin_shufflevector(l0_, l1_, 0, 1, 2, 3, 4, 5, 6, 7); } } \
        else { _Pragma("unroll") for (int m = 0; m < 4; ++m) _Pragma("unroll") for (int k = 0; k < 2; ++k) dst[m][k] = *(const PG8_LAS bf16x8*)(lds + PG8_SA(b, h) + aoff + m * 2048 + k * 1024); } } while (0)
#define PG8_LDB(dst, b, h) do { if constexpr (FP8) { _Pragma("unroll") for (int n = 0; n < 2; ++n) { const v4i32 l0_ = *(const PG8_LAS v4i32*)(lds + PG8_SB(b, h) + boff + n * 2048), l1_ = *(const PG8_LAS v4i32*)(lds + PG8_SB(b, h) + boff + n * 2048 + 1024); \
            dst##8[n] = __builtin_shufflevector(l0_, l1_, 0, 1, 2, 3, 4, 5, 6, 7); } } \
        else { _Pragma("unroll") for (int n = 0; n < 2; ++n) _Pragma("unroll") for (int k = 0; k < 2; ++k) dst[n][k] = *(const PG8_LAS bf16x8*)(lds + PG8_SB(b, h) + boff + n * 2048 + k * 1024); } } while (0)
#define PG8_MMA(ai, bj, At, Bt) do { __builtin_amdgcn_s_setprio(1); \
        if constexpr (FP8) { asm volatile("s_nop 1"); _Pragma("unroll") for (int m = 0; m < 4; ++m) _Pragma("unroll") for (int n = 0; n < 2; ++n) \
            asm volatile("v_mfma_scale_f32_16x16x128_f8f6f4 %0, %1, %2, %0, %3, %3 op_sel_hi:[0,0,0]" : "+v"(acc[ai][bj][m][n]) : "v"(Bt##8[n]), "v"(At##8[m]), "v"(f8one)); } \
        else { _Pragma("unroll") for (int m = 0; m < 4; ++m) _Pragma("unroll") for (int n = 0; n < 2; ++n) _Pragma("unroll") for (int k = 0; k < 2; ++k) \
            acc[ai][bj][m][n] = __builtin_amdgcn_mfma_f32_16x16x32_bf16(Bt[n][k], At[m][k], acc[ai][bj][m][n], 0, 0, 0); } \
        __builtin_amdgcn_s_setprio(0); } while (0)
#define PG8_WAIT_V(n) asm volatile("s_waitcnt vmcnt(" #n ")" ::: "memory")
#define PG8_WAIT_L(n) asm volatile("s_waitcnt lgkmcnt(" #n ")" ::: "memory")
#define PG8_BAR __builtin_amdgcn_s_barrier()
#define PG8_SCHED __builtin_amdgcn_sched_barrier(0)
    Unit cur, nxt; int ui = 0;
    if (!S.next(0, cur)) return;
    f32x4 acc[2][2][4][2];
#pragma unroll
    for (int a = 0; a < 2; ++a)
#pragma unroll
        for (int b = 0; b < 2; ++b)
#pragma unroll
            for (int m = 0; m < 4; ++m)
#pragma unroll
                for (int n = 0; n < 2; ++n) acc[a][b][m][n] = (f32x4){0.f, 0.f, 0.f, 0.f};
    bf16x8 At[4][2], B0[2][2], B1[2][2];
    const int f8one = 0x7f7f7f7f;
    v8i32 At8[4], B08[2], B18[2];
    const char* cA = (const char*)g.A + (size_t)cur.pa * tstep + (size_t)cur.k0 * 2; const char* cB = (const char*)g.Bt + (size_t)cur.pn * tstep + (size_t)cur.k0 * 2;
    S.a_ready(cur);
    if constexpr (SP2) {
        PG8_STAGE(PG8_SB(0, 0), cB, voffB); PG8_STAGE(PG8_SB(0, 1), cB + hstep, voffB); PG8_STAGE(PG8_SA(0, 0), cA, voffA); PG8_STAGE(PG8_SA(0, 1), cA + hstep, voffA);
        if (wr == 1) PG8_BAR;
        PG8_WAIT_V(2); PG8_BAR;
        PG8_STAGE(PG8_SB(1, 0), cB + kstep, voffB); PG8_STAGE(PG8_SA(1, 0), cA + kstep, voffA); PG8_STAGE(PG8_SB(1, 1), cB + hstep + kstep, voffB);
        PG8_WAIT_V(6); PG8_BAR;
    } else {
        PG8_STAGE(PG8_SB(0, 0), cB, voffB); PG8_STAGE(PG8_SA(0, 0), cA, voffA); PG8_STAGE(PG8_SB(0, 1), cB + hstep, voffB); PG8_STAGE(PG8_SA(0, 1), cA + hstep, voffA);
        if (wr == 1) PG8_BAR;
        PG8_WAIT_V(4); PG8_BAR;
        PG8_STAGE(PG8_SB(1, 0), cB + kstep, voffB); PG8_STAGE(PG8_SA(1, 0), cA + kstep, voffA); PG8_STAGE(PG8_SB(1, 1), cB + hstep + kstep, voffB);
        PG8_WAIT_V(6); PG8_BAR;
    }
    for (;;) {
        const bool has_next = S.next(ui + 1, nxt);
        const char* nA = has_next ? (const char*)g.A + (size_t)nxt.pa * tstep + (size_t)nxt.k0 * 2 : cA; const char* nB = has_next ? (const char*)g.Bt + (size_t)nxt.pn * tstep + (size_t)nxt.k0 * 2 : cB;
        const int nt = NTC ? NTC : cur.nt;
#pragma unroll 1
        for (int t = 0; t < nt; t += 2) {
            const bool last = (t == nt - 2);
            const char* a1 = cA + (size_t)(t + 1) * kstep;
            const char* a2 = last ? nA : cA + (size_t)(t + 2) * kstep; const char* b2 = last ? nB : cB + (size_t)(t + 2) * kstep;
            const char* a3 = a2 + kstep; const char* b3 = b2 + kstep;
            if (last && has_next) S.a_ready(nxt);
            if constexpr (SP2) {
            PG8_LDB(B0, 0, 0); PG8_LDB(B1, 0, 1); PG8_SCHED; PG8_LDA(At, 0, 0); PG8_STAGE(PG8_SA(1, 1), a1 + hstep, voffA);
            PG8_WAIT_V(8); PG8_WAIT_L(0); PG8_BAR; PG8_MMA(0, 0, At, B0); PG8_MMA(0, 1, At, B1); PG8_BAR; PG8_SCHED;
            PG8_LDA(At, 0, 1); PG8_STAGE(PG8_SB(0, 0), b2, voffB); PG8_STAGE(PG8_SB(0, 1), b2 + hstep, voffB); PG8_STAGE(PG8_SA(0, 0), a2, voffA);
            PG8_WAIT_V(8); PG8_WAIT_L(0); PG8_BAR; PG8_MMA(1, 0, At, B0); PG8_MMA(1, 1, At, B1); PG8_BAR; PG8_SCHED;
            PG8_LDB(B0, 1, 0); PG8_LDB(B1, 1, 1); PG8_SCHED; PG8_LDA(At, 1, 0); PG8_STAGE(PG8_SA(0, 1), a2 + hstep, voffA);
            PG8_WAIT_V(8); PG8_WAIT_L(0); PG8_BAR; PG8_MMA(0, 0, At, B0); PG8_MMA(0, 1, At, B1); PG8_BAR; PG8_SCHED;
            PG8_LDA(At, 1, 1); PG8_STAGE(PG8_SB(1, 0), b3, voffB); PG8_STAGE(PG8_SB(1, 1), b3 + hstep, voffB); PG8_STAGE(PG8_SA(1, 0), a3, voffA);
            PG8_WAIT_V(8); PG8_WAIT_L(0); PG8_BAR; PG8_MMA(1, 0, At, B0); PG8_MMA(1, 1, At, B1); PG8_BAR; PG8_SCHED;
            } else {
            PG8_LDB(B0, 0, 0); PG8_SCHED; PG8_LDA(At, 0, 0); PG8_STAGE(PG8_SA(1, 1), a1 + hstep, voffA);
            PG8_WAIT_L(8); PG8_BAR; PG8_WAIT_L(0); PG8_MMA(0, 0, At, B0); PG8_BAR; PG8_SCHED;
            PG8_LDB(B1, 0, 1); PG8_STAGE(PG8_SB(0, 0), b2, voffB);
            PG8_BAR; PG8_WAIT_L(0); PG8_MMA(0, 1, At, B1); PG8_BAR;
            PG8_LDA(At, 0, 1); PG8_STAGE(PG8_SA(0, 0), a2, voffA);
            PG8_BAR; PG8_WAIT_L(0); PG8_MMA(1, 0, At, B0); PG8_BAR; PG8_SCHED;
            PG8_STAGE(PG8_SB(0, 1), b2 + hstep, voffB);
            PG8_WAIT_V(6); PG8_BAR; PG8_MMA(1, 1, At, B1); PG8_BAR;
            PG8_LDB(B0, 1, 0); PG8_SCHED; PG8_LDA(At, 1, 0); PG8_STAGE(PG8_SA(0, 1), a2 + hstep, voffA);
            PG8_WAIT_L(8); PG8_BAR; PG8_WAIT_L(0); PG8_MMA(0, 0, At, B0); PG8_BAR; PG8_SCHED;
            PG8_LDB(B1, 1, 1); PG8_STAGE(PG8_SB(1, 0), b3, voffB);
            PG8_BAR; PG8_WAIT_L(0); PG8_MMA(0, 1, At, B1); PG8_BAR;
            PG8_LDA(At, 1, 1); PG8_STAGE(PG8_SA(1, 0), a3, voffA);
            PG8_BAR; PG8_WAIT_L(0); PG8_MMA(1, 0, At, B0); PG8_BAR; PG8_SCHED;
            PG8_STAGE(PG8_SB(1, 1), b3 + hstep, voffB);
            PG8_WAIT_V(6); PG8_BAR; PG8_MMA(1, 1, At, B1); PG8_BAR;
            }
        }
        if constexpr (ALIGN_EPI) { if (wr == 0) PG8_BAR; }
        if constexpr (FP8) { asm volatile("s_nop 15\n\ts_nop 15\n\ts_nop 15\n\ts_nop 15" ::: "memory"); }
        if constexpr (!Epi::AFTER_DRAIN) { E(acc, cur, wr, wc, fr, fq); S.done(cur); }
        if (!has_next) break;
#pragma unroll
        for (int a = 0; a < 2; ++a)
#pragma unroll
            for (int b = 0; b < 2; ++b)
#pragma unroll
                for (int m = 0; m < 4; ++m)
#pragma unroll
                    for (int n = 0; n < 2; ++n) acc[a][b][m][n] = (f32x4){0.f, 0.f, 0.f, 0.f};
        cur = nxt; cA = nA; cB = nB; ++ui;
        if constexpr (ALIGN_EPI) { if (wr == 1) PG8_BAR; }
    }
    PG8_WAIT_V(0);
    if constexpr (!ALIGN_EPI) { if (wr == 0) PG8_BAR; }
    PG8_BAR;
    if constexpr (Epi::AFTER_DRAIN) { E.fused(acc, cur, wr, wc, fr, fq, lds, wid, lane); S.done(cur); }
#undef PG8_SA
#undef PG8_SB
#undef PG8_STAGE
#undef PG8_LDA
#undef PG8_LDB
#undef PG8_MMA
#undef PG8_WAIT_V
#undef PG8_WAIT_L
#undef PG8_BAR
#undef PG8_SCHED
}
}
#define GAS __attribute__((address_space(1)))
#define LAS __attribute__((address_space(3)))
typedef unsigned short bf16;
typedef unsigned v4u __attribute__((ext_vector_type(4)));
typedef float f32x4 __attribute__((ext_vector_type(4)));
typedef short bf16x8 __attribute__((ext_vector_type(8)));
typedef GAS unsigned gu32;
typedef GAS unsigned long long gu64;
#define RLX_AGENT __ATOMIC_RELAXED, __HIP_MEMORY_SCOPE_AGENT
#define LDS_WAIT() asm volatile("s_waitcnt lgkmcnt(0)" ::: "memory")
#define VM_WAIT() asm volatile("s_waitcnt vmcnt(0)" ::: "memory")
__device__ __forceinline__ unsigned long long rt() { return __builtin_amdgcn_s_memrealtime(); }
__device__ __forceinline__ unsigned f2bf(float f) { unsigned u = __builtin_bit_cast(unsigned, f); return (u + 0x7fffu + ((u >> 16) & 1u)) >> 16; }
__device__ __forceinline__ unsigned pk2(float lo, float hi) { return f2bf(lo) | (f2bf(hi) << 16); }

#define XB_TMO      128
#define XB_XCNT(j)  (256  + 64 * (j))
#define XB_XSUB(j)  (1280 + 64 * (j))
#define XB_XGEN(j)  (2304 + 64 * (j))
#define XB_TOP      3328
#define XB_TOPGEN   3392
#define XCD_BAR_WORDS 3456
#define XB_SPIN_CAP (1u << 18)

__device__ __forceinline__ unsigned xb_ld(unsigned* p)              { return __hip_atomic_load(p, __ATOMIC_RELAXED, __HIP_MEMORY_SCOPE_AGENT); }
__device__ __forceinline__ unsigned xb_add(unsigned* p, unsigned v) { return __hip_atomic_fetch_add(p, v, __ATOMIC_RELAXED, __HIP_MEMORY_SCOPE_AGENT); }
__device__ __forceinline__ unsigned xb_xcc_id() { return (unsigned)__builtin_amdgcn_s_getreg((3 << 11) | 20) & 0xFu; }
#define XB_SPIN(cond, bar) do { unsigned _sp = 0; while (cond) { __builtin_amdgcn_s_sleep(1); \
    if ((++_sp & 255u) == 0u) { if (xb_ld(&(bar)[XB_TMO])) break; if (_sp > XB_SPIN_CAP) { atomicAdd(&(bar)[XB_TMO], 1u); break; } } } } while (0)

struct XcdBarrier {
    unsigned* bar; unsigned x;
    volatile LAS unsigned* st;
};

__device__ __forceinline__ XcdBarrier xcd_barrier_post(unsigned* bar, volatile LAS unsigned* st) {
    XcdBarrier b; b.bar = bar; b.x = xb_xcc_id(); b.st = st;
    if (threadIdx.x == 0) (void)xb_add(&bar[XB_XCNT(b.x)], 1u);
    return b;
}
__device__ __forceinline__ void xcd_barrier_complete(unsigned* bar, unsigned x, unsigned& nloc, unsigned& nx) {
    const unsigned G = gridDim.x * gridDim.y * gridDim.z;
    unsigned sum, cnt, mine, sp = 0u;
    for (;;) {
        sum = 0u; cnt = 0u; mine = 0u;
#pragma unroll
        for (unsigned j = 0; j < 16; ++j) { const unsigned c = xb_ld(&bar[XB_XCNT(j)]); sum += c; cnt += (c > 0u) ? 1u : 0u; mine = (j == x) ? c : mine; }
        if (sum == G) break;
        __builtin_amdgcn_s_sleep(1);
        if ((++sp & 255u) == 0u) { if (xb_ld(&bar[XB_TMO])) break; if (sp > XB_SPIN_CAP) { atomicAdd(&bar[XB_TMO], 1u); break; } }
    }
    nloc = mine > 0u ? mine : 1u; nx = cnt > 0u ? cnt : 1u;
}

__device__ __forceinline__ void xcd_barrier(const XcdBarrier& b) {
    asm volatile("s_waitcnt vmcnt(0)" ::: "memory");
    __syncthreads();
    if (threadIdx.x == 0) {
        unsigned* bar = b.bar;
        __builtin_amdgcn_s_waitcnt(0);
        unsigned nloc = b.st[0], nx = b.st[1];
        if (nloc == 0u) { xcd_barrier_complete(bar, b.x, nloc, nx); b.st[0] = nloc; b.st[1] = nx; }
        const unsigned old = xb_add(&bar[XB_XSUB(b.x)], 1u);
        const unsigned gen = old / nloc;
        if (old + 1u == (gen + 1u) * nloc) {
            __builtin_amdgcn_fence(__ATOMIC_RELEASE, "agent");
            asm volatile("s_waitcnt vmcnt(0)" ::: "memory");
            const unsigned og = xb_add(&bar[XB_TOP], 1u);
            const unsigned tg = og / nx;
            if (og + 1u == (tg + 1u) * nx) xb_add(&bar[XB_TOPGEN], 1u);
            else XB_SPIN(xb_ld(&bar[XB_TOPGEN]) == tg, bar);
            __builtin_amdgcn_fence(__ATOMIC_ACQUIRE, "agent");
            xb_add(&bar[XB_XGEN(b.x)], 1u);
            asm volatile("s_waitcnt vmcnt(0)" ::: "memory");
        } else {
            XB_SPIN(xb_ld(&bar[XB_XGEN(b.x)]) == gen, bar);
            __builtin_amdgcn_fence(__ATOMIC_ACQUIRE, "agent");
            asm volatile("s_waitcnt vmcnt(0)" ::: "memory");
        }
    }
    __syncthreads();
}
constexpr int NWAVES = 8;
#ifndef MK_PER_PHASE
#define MK_PER_PHASE 0
#endif
constexpr int D = 1024, NB = 8, SEQ = 2048, CTXL = 256, ML = NB * SEQ, MC = NB * CTXL, MT = ML + MC;
constexpr int FF = 3584, NE = 8;
constexpr float EPS = 1e-6f;
constexpr float LOG2E = 1.4426950408889634f;
constexpr float QSCALE = 0.125f * LOG2E;
#ifndef MK_FP8_FFN2
#define MK_FP8_FFN2 1
#endif
constexpr float F8_W13 = 32.0f, F8_W2 = 64.0f;
constexpr int N_PHASES = 34;
constexpr size_t MiB = 1u << 20;
constexpr size_t WS_CTL = 0, CTL_ZERO_BYTES = 1 * MiB;
constexpr size_t WS_MOD = 1 * MiB;
constexpr size_t WS_ROPE = 2 * MiB;
constexpr size_t WS_WSB = 2 * MiB + 65536;
constexpr size_t WS_TOKI = 3 * MiB;
constexpr size_t WS_TOKW = 3 * MiB + 524288;
constexpr int CAP = MT;
constexpr size_t WS_TOKLIST = 4 * MiB;
constexpr size_t WS_TOKWT = 4 * MiB + 655360;
constexpr size_t WS_STATS = 5 * MiB + 524288;
constexpr size_t WS_WIN = 8 * MiB, WS_WOUT = 24 * MiB, WS_WQKV = 32 * MiB, WS_WO = 38 * MiB, WS_FF13 = 42 * MiB, WS_FF2 = 70 * MiB;
constexpr size_t WS_MOE13 = 84 * MiB, WS_MOE2 = 196 * MiB;
constexpr size_t WS_X = 252 * MiB;
constexpr size_t WS_H = 324 * MiB;
constexpr size_t WS_R = 360 * MiB;
constexpr size_t WS_U = WS_R, WS_V = WS_R + 36 * MiB, WS_G = WS_R + 72 * MiB, WS_YAB = WS_R + 108 * MiB;
constexpr size_t WS_QKV = WS_R, WS_Q = WS_R + 54 * MiB, WS_K = WS_R + 90 * MiB, WS_O = WS_R + 99 * MiB;
constexpr size_t WS_T = WS_R;
constexpr size_t WS_HP = WS_R, WS_TP = WS_R + 144 * MiB, WS_YS = WS_R + 342 * MiB;
constexpr size_t WS_PB = WS_R + 414 * MiB;
constexpr size_t WS_END = WS_PB + 64 * MiB;
constexpr int CW_TMO = 0, CW_CODE = 1, CW_CNT = 64, CW_BAR = 4096;
constexpr int RING_OFF = 0;
constexpr int LDSCTL_OFF = 143360, MISC_OFF = LDSCTL_OFF + 64;
constexpr int LDS_BYTES = 147456;
__constant__ float INVF[16] = {1.0f, 0.5623413324356079f, 0.3162277638912201f, 0.17782793939113617f, 0.10000000149011612f, 0.05623413249850273f, 0.03162277489900589f, 0.017782794311642647f,
    0.009999999776482582f, 0.005623413249850273f, 0.003162277629598975f, 0.0017782794311642647f, 0.0010000000474974513f, 0.000562341301701963f, 0.0003162277571391314f, 0.00017782794020604342f};

typedef unsigned v2u __attribute__((ext_vector_type(2)));
struct Args { const float* in[29]; float* out; unsigned char* ws; int ph_lo, ph_hi; float gmul; int pad; };
struct Frame { LAS unsigned char* lds; volatile LAS unsigned* MISC; gu32* ctl; int tid, lane, wave, G, bid; };

__device__ __forceinline__ float wave_sum(float v) {
#pragma unroll
    for (int o = 1; o < 64; o <<= 1) v += __shfl_xor(v, o);
    return v;
}
__device__ __forceinline__ float bf2f(unsigned short b) { return __uint_as_float((unsigned)b << 16); }
__device__ __forceinline__ float bflo(unsigned w) { return __uint_as_float(w << 16); }
__device__ __forceinline__ float bfhi(unsigned w) { return __uint_as_float(w & 0xffff0000u); }
__device__ __forceinline__ unsigned pkbf(float lo, float hi) { return pg8::cvt_pk_bf16(lo, hi); }
__device__ __forceinline__ float fsigm(float x) { return pg8::sigm_f(x); }
__device__ __forceinline__ unsigned pk4f8(float a, float b, float c, float d) { int p = 0; p = __builtin_amdgcn_cvt_pk_fp8_f32(a, b, p, false); p = __builtin_amdgcn_cvt_pk_fp8_f32(c, d, p, true); return (unsigned)p; }

__device__ __forceinline__ int dst_row(int mode, int n) {
    if (mode == 0) return n;
    if (mode == 1) return ((n >> 7) << 8) + (n & 127);
    if (mode == 2) return ((n >> 7) << 8) + 128 + (n & 127);
    if (mode == 4) { if (n >= 1280) return n;
        const int tile = n >> 8, r = n & 255, wc = r >> 6, d = r & 63, bj = d >> 5, dh = d & 31, nn = dh >> 4, fq = (dh & 15) >> 2, e = dh & 3; return (tile << 8) + 128 * bj + 32 * wc + 8 * fq + 4 * nn + e; }
    if (n < 2048) return n;
    if (n < 3072) { const int j = n - 2048; return 2048 + ((j >> 7) << 8) + (j & 127); }
    { const int j = n - 3072; return 2048 + ((j >> 7) << 8) + 128 + (j & 127); }
}
struct ConvDesc { const float* W; bf16* WT; int N, K, mode, item; float f8s; };
__device__ __forceinline__ void conv_ld(const ConvDesc& d, int lane, f32x4 (&r)[16]) {
    const int nblk = d.N >> 6, kb = d.item / nblk, nb = d.item - kb * nblk, k0 = kb << 6, n0 = nb << 6; const int c4 = (lane & 15) << 2, kr = lane >> 4;
#pragma unroll
    for (int i = 0; i < 16; ++i) r[i] = __builtin_nontemporal_load((const GAS f32x4*)(d.W + (size_t)(k0 + 4 * i + kr) * d.N + n0 + c4));
}
__device__ __forceinline__ void conv_st(const ConvDesc& d, LAS float* scr, int lane, const f32x4 (&r)[16]) {
    const int nblk = d.N >> 6, kb = d.item / nblk, nb = d.item - kb * nblk, k0 = kb << 6, n0 = nb << 6; const int c4 = (lane & 15) << 2, kr = lane >> 4;
#pragma unroll
    for (int i = 0; i < 16; ++i) { LAS float* s = scr + (4 * i + kr) * 65 + c4; s[0] = r[i].x; s[1] = r[i].y; s[2] = r[i].z; s[3] = r[i].w; }
    LDS_WAIT(); asm volatile("" ::: "memory");
    if (d.f8s != 0.f) {
        const float sc = d.f8s; unsigned char* W8 = (unsigned char*)d.WT;
#pragma unroll
        for (int jj = 0; jj < 4; ++jj) { const int id = lane + 64 * jj, n = id >> 2, c = id & 3; const LAS float* s = scr + (16 * c) * 65 + n; v4u o;
            o.x = pk4f8(s[0] * sc, s[65] * sc, s[130] * sc, s[195] * sc); o.y = pk4f8(s[260] * sc, s[325] * sc, s[390] * sc, s[455] * sc);
            o.z = pk4f8(s[520] * sc, s[585] * sc, s[650] * sc, s[715] * sc); o.w = pk4f8(s[780] * sc, s[845] * sc, s[910] * sc, s[975] * sc);
            *(GAS v4u*)(W8 + (size_t)dst_row(d.mode, n0 + n) * d.K + k0 + 16 * c) = o; }
    } else {
    const int c = lane & 7;
#pragma unroll
    for (int jj = 0; jj < 8; ++jj) { const int n = (lane >> 3) + 8 * jj; const LAS float* s = scr + (8 * c) * 65 + n;
        v4u o; o.x = pkbf(s[0], s[65]); o.y = pkbf(s[130], s[195]); o.z = pkbf(s[260], s[325]); o.w = pkbf(s[390], s[455]);
        *(GAS v4u*)(d.WT + (size_t)dst_row(d.mode, n0 + n) * d.K + k0 + 8 * c) = o; }
    }
    LDS_WAIT(); asm volatile("" ::: "memory");
}
__device__ __forceinline__ ConvDesc dec_nonmoe(const Args& a, int it) {
    ConvDesc d; d.f8s = 0.f; const int j = it / 4864; int r = it - j * 4864; const bool f8 = MK_FP8_FFN2 && (j == 1);
    if (r < 1024) { d.W = a.in[8] + (size_t)j * 1024 * 4096; d.N = 4096; d.K = 1024; d.mode = 3; d.WT = (bf16*)(a.ws + WS_WIN) + (size_t)j * 4096 * 1024; }
    else if ((r -= 1024) < 512) { d.W = a.in[16] + (size_t)j * 2048 * 1024; d.N = 1024; d.K = 2048; d.mode = 0; d.WT = (bf16*)(a.ws + WS_WOUT) + (size_t)j * 1024 * 2048; }
    else if ((r -= 512) < 384) { d.W = a.in[17] + (size_t)j * 1024 * 1536; d.N = 1536; d.K = 1024; d.mode = 4; d.WT = (bf16*)(a.ws + WS_WQKV) + (size_t)j * 1536 * 1024; }
    else if ((r -= 384) < 256) { d.W = a.in[21] + (size_t)j * 1024 * 1024; d.N = 1024; d.K = 1024; d.mode = 0; d.WT = (bf16*)(a.ws + WS_WO) + (size_t)j * 1024 * 1024; }
    else if ((r -= 256) < 896) { d.W = a.in[22] + (size_t)j * 1024 * 3584; d.N = 3584; d.K = 1024; d.mode = 1; d.WT = (bf16*)(a.ws + WS_FF13) + (size_t)j * 7168 * 1024; if (f8) d.f8s = F8_W13; }
    else if ((r -= 896) < 896) { d.W = a.in[23] + (size_t)j * 1024 * 3584; d.N = 3584; d.K = 1024; d.mode = 2; d.WT = (bf16*)(a.ws + WS_FF13) + (size_t)j * 7168 * 1024; if (f8) d.f8s = F8_W13; }
    else { r -= 896; d.W = a.in[24] + (size_t)j * 3584 * 1024; d.N = 1024; d.K = 3584; d.mode = 0; d.WT = (bf16*)(a.ws + WS_FF2) + (size_t)j * 1024 * 3584; if (f8) d.f8s = F8_W2; }
    d.item = r; return d;
}
__device__ __forceinline__ ConvDesc dec_moe(const Args& a, int jm, int sel, int it) {
    ConvDesc d; const int per = (sel == 0) ? 2688 : (sel == 1 ? 1792 : 896);
    const int e = it / per; int r = it - e * per; if (sel == 2) r += 1792;
    const size_t eo = (size_t)(jm * 8 + e);
    unsigned char* m13 = a.ws + WS_MOE13 + (size_t)e * 7168 * 1024; unsigned char* m2 = a.ws + WS_MOE2 + (size_t)e * 1024 * 3584;
    if (r < 896) { d.W = a.in[26] + eo * 1024 * 3584; d.N = 3584; d.K = 1024; d.mode = 1; d.WT = (bf16*)m13; d.f8s = F8_W13; }
    else if ((r -= 896) < 896) { d.W = a.in[27] + eo * 1024 * 3584; d.N = 3584; d.K = 1024; d.mode = 2; d.WT = (bf16*)m13; d.f8s = F8_W13; }
    else { r -= 896; d.W = a.in[28] + eo * 3584 * 1024; d.N = 1024; d.K = 3584; d.mode = 0; d.WT = (bf16*)m2; d.f8s = F8_W2; }
    d.item = r; return d;
}
__device__ __forceinline__ void conv_run(const Args& a, int n_non, int jm, int sel, int moe_lo, int moe_hi, int gw, int NGW, LAS float* scr, int lane) {
    const int total = n_non + ((moe_hi > moe_lo) ? moe_hi - moe_lo : 0);
    if (gw >= total) return;
    ConvDesc cur = (gw < n_non) ? dec_nonmoe(a, gw) : dec_moe(a, jm, sel, gw - n_non + moe_lo);
    f32x4 r[16]; conv_ld(cur, lane, r);
    for (int it = gw; it < total; it += NGW) {
        const int nx = it + NGW; ConvDesc nxt = cur; f32x4 rn[16];
        if (nx < total) { nxt = (nx < n_non) ? dec_nonmoe(a, nx) : dec_moe(a, jm, sel, nx - n_non + moe_lo); conv_ld(nxt, lane, rn); }
        conv_st(cur, scr, lane, r);
        if (nx < total) {
#pragma unroll
            for (int i = 0; i < 16; ++i) r[i] = rn[i];
            cur = nxt; }
    }
}
__device__ __forceinline__ int moe_items(int sel) { return 8 * ((sel == 0) ? 2688 : (sel == 1 ? 1792 : 896)); }
struct TailPlan { int nl[4]; int e[5]; };
__device__ __forceinline__ int last_round_units(int n, int G) { const int r = n % G; return r == 0 ? G : r; }
__device__ __forceinline__ void tail_plan(int G, int att_units, TailPlan& t) {
    t.nl[0] = last_round_units((MT / 256) * 16, G); t.nl[1] = last_round_units((MT / 256) * 28, G); t.nl[2] = last_round_units((MT / 256) * 6, G); t.nl[3] = last_round_units(att_units, G);
    const int quota[4] = {2, 2, 3, 1}; t.e[0] = 0;
#pragma unroll
    for (int k = 0; k < 4; ++k) t.e[k + 1] = t.e[k] + (G - t.nl[k]) * NWAVES * quota[k];
}
__device__ __forceinline__ void tail_fill(const Args& a, Frame& F, const TailPlan& t, int k, int jm, int sel, int wid = -1) {
    const int me = (wid >= 0) ? wid : F.bid;
    const int nl = t.nl[k]; if (me < nl || nl >= F.G) return;
    const int tot = moe_items(sel), lo = t.e[k] < tot ? t.e[k] : tot, hi = t.e[k + 1] < tot ? t.e[k + 1] : tot;
    __syncthreads();
    conv_run(a, 0, jm, sel, lo, hi, (me - nl) * NWAVES + F.wave, (F.G - nl) * NWAVES, (LAS float*)(F.lds + F.wave * 16640), F.lane);
}
__device__ __forceinline__ void conv_moe_all(const Args& a, Frame& F, int jm, int sel, int w0, int nw, int wid = -1, int lo = 0, int hi = -1) {
    const int me = (wid >= 0) ? wid : F.bid;
    if (me < w0 || me >= w0 + nw) return;
    conv_run(a, 0, jm, sel, lo, (hi < 0) ? moe_items(sel) : hi, (me - w0) * NWAVES + F.wave, nw * NWAVES, (LAS float*)(F.lds + F.wave * 16640), F.lane);
}
__device__ __forceinline__ void sincos_d(double x, double& s, double& c) {
    const double TWO_PI = 6.283185307179586476925286766559;
    const double k = __builtin_rint(x / TWO_PI); const double r = x - k * TWO_PI, r2 = r * r;
    double ts = r, ss = r, tc = 1.0, cs = 1.0;
#pragma unroll 1
    for (int n = 1; n <= 14; ++n) { tc = -tc * r2 / (double)((2 * n - 1) * (2 * n)); cs += tc; ts = -ts * r2 / (double)((2 * n) * (2 * n + 1)); ss += ts; }
    s = ss; c = cs;
}
__device__ __forceinline__ void prologue_phase(const Args& a, Frame& F) {
    const int gw = F.bid * NWAVES + F.wave, NGW = F.G * NWAVES;
    {
        LAS float* sc = (LAS float*)F.lds; LAS float* red = sc + 9 * 1024;
        { float cv[18];
#pragma unroll
          for (int q = 0; q < 18; ++q) { const int i = F.tid + q * (NWAVES * 64); cv[q] = (q < 16) ? a.in[1][i] : a.in[3][i - 8192]; }
#pragma unroll
          for (int q = 0; q < 18; ++q) { const int i = F.tid + q * (NWAVES * 64); sc[i] = cv[q] * fsigm(cv[q]); } }
        __syncthreads();
        float* MOD = (float*)(a.ws + WS_MOD);
        for (int job = F.bid; job < 768; job += F.G) {
            const int li = job / 192, nb = job - li * 192; const int cl = F.tid & 31, kg = F.tid >> 5;
            const float* w = a.in[4] + (size_t)li * 1024 * 6144 + (size_t)(kg * 64) * 6144 + nb * 32 + cl;
            float acc[9];
#pragma unroll
            for (int r = 0; r < 9; ++r) acc[r] = 0.f;
            float wv[2][16];
#pragma unroll
            for (int i = 0; i < 16; ++i) wv[0][i] = __builtin_nontemporal_load(w + (size_t)i * 6144);
#pragma unroll
            for (int kq = 0; kq < 4; ++kq) { const int kb = 16 * kq;
                if (kq < 3) {
#pragma unroll
                    for (int i = 0; i < 16; ++i) wv[(kq + 1) & 1][i] = __builtin_nontemporal_load(w + (size_t)(kb + 16 + i) * 6144); }
#pragma unroll
                for (int i4 = 0; i4 < 4; ++i4)
#pragma unroll
                    for (int r = 0; r < 9; ++r) { const f32x4 sv = *(const LAS f32x4*)(sc + r * 1024 + kg * 64 + kb + 4 * i4);
                        acc[r] += (sv[0] * wv[kq & 1][4 * i4] + sv[1] * wv[kq & 1][4 * i4 + 1]) + (sv[2] * wv[kq & 1][4 * i4 + 2] + sv[3] * wv[kq & 1][4 * i4 + 3]); } }
#pragma unroll
            for (int r = 0; r < 9; ++r) red[(kg * 9 + r) * 32 + cl] = acc[r];
            __syncthreads();
            for (int o = F.tid; o < 9 * 32; o += NWAVES * 64) { const int r = o >> 5, c = o & 31; float sum = 0.f;
#pragma unroll
                for (int g = 0; g < 16; ++g) sum += red[(g * 9 + r) * 32 + c];
                MOD[(size_t)(li * 9 + r) * 6144 + nb * 32 + c] = sum + a.in[5][li * 6144 + nb * 32 + c]; }
            __syncthreads();
        }
    }
    {
        const int gt = F.bid * (NWAVES * 64) + F.tid, NT = F.G * NWAVES * 64;
        if (gt < 1024) { const int pos = gt >> 4, i = gt & 15; const float ang = (float)pos * INVF[i]; double s, c; sincos_d((double)ang, s, c);
            float* rp = (float*)(a.ws + WS_ROPE) + gt * 2; rp[0] = (float)c; rp[1] = (float)s; }
        bf16* wsb = (bf16*)(a.ws + WS_WSB);
        for (int i = gt; i < 2 * 8 * 128 * 128 / 2; i += NT) { const float2 v = *(const float2*)(a.in[11] + 2 * i); *(unsigned*)(wsb + 2 * i) = pkbf(v.x, v.y); }
    }
    __syncthreads();
    { TailPlan tp; tail_plan(F.G, 1152, tp); const int tot = moe_items(0), lo = tp.e[4] < tot ? tp.e[4] : tot;
      conv_run(a, 2 * 4864, 0, 0, lo, tot, gw, NGW, (LAS float*)(F.lds + F.wave * 16640), F.lane); }
}

__device__ __forceinline__ void norm_row_core(const float* xsrc32, const bf16* xsrc16, bf16* xdst, const bf16* ys, const float* g2p, const float* gn, const float* scp, const float* shp, bf16* hdst, int lane, f32x4 (&h)[4],
                                              const float* pbp = nullptr, int nS = 0, const float* pgp = nullptr, bool h8 = false) {
    f32x4 v[4];
    if (xsrc32) {
#pragma unroll
        for (int j = 0; j < 4; ++j) v[j] = __builtin_nontemporal_load((const GAS f32x4*)(xsrc32 + 4 * lane + 256 * j));
    } else {
#pragma unroll
        for (int j = 0; j < 4; ++j) { const v2u x = *(const GAS v2u*)(xsrc16 + 4 * lane + 256 * j); v[j] = (f32x4){bflo(x.x), bfhi(x.x), bflo(x.y), bfhi(x.y)}; }
    }
    if (pbp) {
        f32x4 ps[4];
#pragma unroll
        for (int j = 0; j < 4; ++j) ps[j] = (f32x4){0.f, 0.f, 0.f, 0.f};
        v2u pq[8][4];
#pragma unroll
        for (int q = 0; q < 8; ++q) { const int qq = q < nS ? q : nS - 1;
#pragma unroll
            for (int j = 0; j < 4; ++j) pq[q][j] = *(const GAS v2u*)((const bf16*)pbp + (size_t)qq * 2048 * 1024 + 4 * lane + 256 * j); }
#pragma unroll
        for (int q = 0; q < 8; ++q) if (q < nS) {
#pragma unroll
            for (int j = 0; j < 4; ++j) ps[j] = ps[j] + (f32x4){bflo(pq[q][j].x), bfhi(pq[q][j].x), bflo(pq[q][j].y), bfhi(pq[q][j].y)}; }
#pragma unroll
        for (int j = 0; j < 4; ++j) v[j] = v[j] + *(const GAS f32x4*)(pgp + 4 * lane + 256 * j) * ps[j];
    }
    if (ys) {
#pragma unroll
        for (int j = 0; j < 4; ++j) { const v2u y0 = *(const GAS v2u*)(ys + 4 * lane + 256 * j), y1 = *(const GAS v2u*)(ys + 1024 + 4 * lane + 256 * j); const f32x4 g = *(const GAS f32x4*)(g2p + 4 * lane + 256 * j);
            v[j].x += g.x * (bflo(y0.x) + bflo(y1.x)); v[j].y += g.y * (bfhi(y0.x) + bfhi(y1.x)); v[j].z += g.z * (bflo(y0.y) + bflo(y1.y)); v[j].w += g.w * (bfhi(y0.y) + bfhi(y1.y)); }
    }
    if (xdst) {
#pragma unroll
        for (int j = 0; j < 4; ++j) { v2u o; o.x = pkbf(v[j].x, v[j].y); o.y = pkbf(v[j].z, v[j].w); *(GAS v2u*)(xdst + 4 * lane + 256 * j) = o; }
    }
    float ss = 0.f;
#pragma unroll
    for (int j = 0; j < 4; ++j) ss += (v[j].x * v[j].x + v[j].y * v[j].y) + (v[j].z * v[j].z + v[j].w * v[j].w);
    const float r = 1.0f / sqrtf(wave_sum(ss) * (1.0f / 1024.0f) + EPS);
#pragma unroll
    for (int j = 0; j < 4; ++j) { const f32x4 g = *(const GAS f32x4*)(gn + 4 * lane + 256 * j), sc = *(const GAS f32x4*)(scp + 4 * lane + 256 * j), sh = *(const GAS f32x4*)(shp + 4 * lane + 256 * j);
        h[j] = (v[j] * r) * g * (sc + 1.0f) + sh;
        if (h8) { *(GAS unsigned*)((unsigned char*)hdst + 4 * lane + 256 * j) = pk4f8(h[j].x, h[j].y, h[j].z, h[j].w); }
        else { v2u o; o.x = pkbf(h[j].x, h[j].y); o.y = pkbf(h[j].z, h[j].w); *(GAS v2u*)(hdst + 4 * lane + 256 * j) = o; } }
}
__device__ __forceinline__ void norm_phase(const Args& a, Frame& F, int li, int which, int nrows, bool src_in, int pend_li, int nS = 0, int rs0 = 0, const float* pgate = nullptr, bool h8 = false) {
    const int gw = F.bid * NWAVES + F.wave, NGW = F.G * NWAVES;
    bf16* X = (bf16*)(a.ws + WS_X); bf16* H = (bf16*)(a.ws + WS_H); const float* MOD = (const float*)(a.ws + WS_MOD); const bf16* YS = (const bf16*)(a.ws + WS_YS);
    const float* gn = (which == 0 ? a.in[6] : a.in[7]) + li * 1024;
    for (int row = gw; row < nrows; row += NGW) {
        const int mr = (row < ML) ? (row >> 11) : 8;
        const float* mp = MOD + (size_t)(li * 9 + mr) * 6144 + (which ? 3 * 1024 : 0);
        const float* xs = src_in ? ((row < ML) ? a.in[0] + (size_t)row * 1024 : a.in[2] + (size_t)(row - ML) * 1024) : nullptr;
        const bool part = (nS > 0) && (row >= rs0);
        const bool wx = src_in || (pend_li >= 0) || part;
        f32x4 h[4];
        norm_row_core(xs, X + (size_t)row * 1024, wx ? X + (size_t)row * 1024 : nullptr, (pend_li >= 0) ? YS + (size_t)row * 2048 : nullptr, MOD + (size_t)((pend_li >= 0 ? pend_li : 0) * 9 + mr) * 6144 + 5 * 1024,
                      gn, mp + 1024, mp, h8 ? (bf16*)((unsigned char*)H + (size_t)row * 1024) : H + (size_t)row * 1024, F.lane, h, part ? (const float*)((const bf16*)(a.ws + WS_PB) + (size_t)(row - rs0) * 1024) : nullptr, nS, part ? pgate + (size_t)mr * 6144 : nullptr, h8);
    }
}
__device__ __forceinline__ void norm_router_phase(const Args& a, Frame& F, int li, int nrows, int nS, int rs0, const float* pgate) {
    constexpr int RPW = 72;
    bf16* X = (bf16*)(a.ws + WS_X); bf16* H = (bf16*)(a.ws + WS_H); const float* MOD = (const float*)(a.ws + WS_MOD);
    int4* TOKI = (int4*)(a.ws + WS_TOKI); float2* TOKW = (float2*)(a.ws + WS_TOKW); int* TOKLIST = (int*)(a.ws + WS_TOKLIST); float* TOKWT = (float*)(a.ws + WS_TOKWT); unsigned char* HP8 = a.ws + WS_HP;
    const int jm = li >> 1;
    LAS float* Rt = (LAS float*)F.lds;
    LAS int* lcnt = (LAS int*)(F.lds + 32768);
    LAS int* lbase = (LAS int*)(F.lds + 32768 + 64);
    LAS int* rinfo = (LAS int*)(F.lds + 32768 + 128);
    LAS float* rwt = (LAS float*)(F.lds + 32768 + 128 + 72 * 16);
    const float* router = a.in[25] + (size_t)jm * 1024 * 8;
    for (int i = F.tid; i < 8192; i += NWAVES * 64) { const int col = i >> 3, e = i & 7; Rt[e * 1024 + col] = router[i]; }
    if (F.tid < 8) lcnt[F.tid] = 0;
    __syncthreads();
    const float* gn = a.in[7] + li * 1024;
    gu32* CNT = F.ctl + CW_CNT + 16 * jm;
    for (int base = F.bid * RPW; base < nrows; base += F.G * RPW) {
        for (int i = 0; i < 9; ++i) {
            const int lr = F.wave * 9 + i, row = base + lr;
            if (row < nrows) {
                const int mr = (row < ML) ? (row >> 11) : 8; const float* mp = MOD + (size_t)(li * 9 + mr) * 6144 + 3 * 1024;
                f32x4 h[4];
                const bool part = (nS > 0) && (row >= rs0);
                norm_row_core(nullptr, X + (size_t)row * 1024, part ? X + (size_t)row * 1024 : nullptr, nullptr, nullptr, gn, mp + 1024, mp, (bf16*)((unsigned char*)H + (size_t)row * 1024), F.lane, h,
                              part ? (const float*)((const bf16*)(a.ws + WS_PB) + (size_t)(row - rs0) * 1024) : nullptr, nS, part ? pgate + (size_t)mr * 6144 : nullptr, true);
                float lg[8];
#pragma unroll
                for (int e = 0; e < 8; ++e) { float p = 0.f;
#pragma unroll
                    for (int j = 0; j < 4; ++j) { const f32x4 rv = *(const LAS f32x4*)(Rt + e * 1024 + 4 * F.lane + 256 * j); p += (h[j].x * rv.x + h[j].y * rv.y) + (h[j].z * rv.z + h[j].w * rv.w); }
                    lg[e] = wave_sum(p); }
                int i0 = 0; float l0 = lg[0];
#pragma unroll
                for (int e = 1; e < 8; ++e) if (lg[e] > l0) { l0 = lg[e]; i0 = e; }
                int i1 = -1; float l1 = -3.0e38f;
#pragma unroll
                for (int e = 0; e < 8; ++e) if (e != i0 && lg[e] > l1) { l1 = lg[e]; i1 = e; }
                const float w0 = 1.0f / (1.0f + __expf(l1 - l0)), w1 = 1.0f - w0;
                if (F.lane == 0) { const int r0 = __hip_atomic_fetch_add(lcnt + i0, 1, __ATOMIC_RELAXED, __HIP_MEMORY_SCOPE_WORKGROUP), r1 = __hip_atomic_fetch_add(lcnt + i1, 1, __ATOMIC_RELAXED, __HIP_MEMORY_SCOPE_WORKGROUP);
                    rinfo[lr * 4 + 0] = i0; rinfo[lr * 4 + 1] = i1; rinfo[lr * 4 + 2] = r0; rinfo[lr * 4 + 3] = r1; rwt[lr * 2] = w0; rwt[lr * 2 + 1] = w1; }
            }
        }
        __syncthreads();
        if (F.tid < 8) { const int c = lcnt[F.tid]; lbase[F.tid] = (int)__hip_atomic_fetch_add(CNT + F.tid, (unsigned)c, RLX_AGENT); lcnt[F.tid] = 0; }
        __syncthreads();
        if (F.tid < RPW) { const int row = base + F.tid; if (row < nrows) { const int e0 = rinfo[F.tid * 4], e1 = rinfo[F.tid * 4 + 1];
            const int p0 = lbase[e0] + rinfo[F.tid * 4 + 2], p1 = lbase[e1] + rinfo[F.tid * 4 + 3]; const float w0 = rwt[F.tid * 2], w1 = rwt[F.tid * 2 + 1];
            TOKI[row] = make_int4(e0 | (e1 << 8), p0, p1, 0); TOKW[row] = make_float2(w0, w1);
            TOKLIST[e0 * CAP + p0] = row * 2; TOKWT[e0 * CAP + p0] = w0; TOKLIST[e1 * CAP + p1] = row * 2 + 1; TOKWT[e1 * CAP + p1] = w1; } }
        for (int i = 0; i < 9; ++i) { const int lr = F.wave * 9 + i, row = base + lr;
            if (row < nrows) { const int e0 = rinfo[lr * 4], e1 = rinfo[lr * 4 + 1]; const int p0 = lbase[e0] + rinfo[lr * 4 + 2], p1 = lbase[e1] + rinfo[lr * 4 + 3];
                const v4u q = *((const GAS v4u*)((const unsigned char*)H + (size_t)row * 1024) + F.lane);
                *((GAS v4u*)(HP8 + ((size_t)e0 * CAP + p0) * 1024) + F.lane) = q; *((GAS v4u*)(HP8 + ((size_t)e1 * CAP + p1) * 1024) + F.lane) = q; } }
        __syncthreads();
    }
}
struct MoeSeg { int np[8]; int pst[9]; int cnt[8]; };
__device__ __forceinline__ void moe_seg(Frame& F, int jm, MoeSeg& s) {
    gu32* CNT = F.ctl + CW_CNT + 16 * jm; int acc = 0;
#pragma unroll
    for (int e = 0; e < 8; ++e) { const int c = __builtin_amdgcn_readfirstlane((int)__hip_atomic_load(CNT + e, RLX_AGENT)); s.cnt[e] = c; s.np[e] = (c + 255) >> 8; s.pst[e] = acc; acc += s.np[e]; }
    s.pst[8] = acc;
}
__device__ __forceinline__ int seg_start(const MoeSeg& s, int e) { int r = 0;
#pragma unroll
    for (int q = 0; q < 8; ++q) r += (q < e) ? s.np[q] : 0;
    return r; }
struct MoeOrder {
    int pst[9]; int cnt[8]; int nt, G, c, ntk; bool apan;
    int F_, R, S;
    __device__ __forceinline__ void no_split() { F_ = 0x7fffffff; R = 0; S = 1; }
    __device__ __forceinline__ void split_tail() { const int U = pst[8] * nt; F_ = (U / G) * G; R = U - F_; S = 1;
        if (R > 0) { S = (R * 7 <= G) ? 7 : (R * 2 <= G) ? 2 : 1; } if (S == 1) no_split(); }
    __device__ __forceinline__ int ps0() const { return (R > 0) ? (F_ / nt) * 256 : 0x7fffffff; }
    __device__ __forceinline__ int psrows() const { return (R > 0) ? ((R + nt - 1) / nt) * 256 : 0; }
    __device__ __forceinline__ bool next(int i, pg8::Unit& u) const {
        const int vc = (G % 8 == 0) ? (c % 8) * (G / 8) + c / 8 : c;
        const int L = i * G + vc; const int U = pst[8] * nt; const bool full = L < F_; const int q = L - F_;
        if (full ? (L >= U) : (q >= R * S)) return false;
        const int t2 = q / S, sp = q - t2 * S, nts = ntk / S; const int tile = full ? L : F_ + t2;
        const int nig = 8 * nt, grp = tile / nig, rr = tile - grp * nig, fm = grp * 8, gsz = (pst[8] - fm < 8) ? pst[8] - fm : 8;
        const int j = rr / gsz, p = fm + (rr - j * gsz); int e = 0;
#pragma unroll
        for (int q2 = 1; q2 < 8; ++q2) e += (p >= pst[q2]) ? 1 : 0;
        int ps = 0, cn = 0;
#pragma unroll
        for (int q2 = 0; q2 < 8; ++q2) { ps = (q2 == e) ? pst[q2] : ps; cn = (q2 == e) ? cnt[q2] : cn; }
        u.pm = p; u.e = e; u.j = j; u.pn = e * nt + j; u.k0 = full ? 0 : sp * nts * 64; u.nt = full ? ntk : nts; u.s = full ? 0 : sp + 1; u.pl = p - ps; u.cn = cn;
        u.pa = apan ? e * (CAP / 256) + (p - ps) : p; return true;
    }
    __device__ __forceinline__ void a_ready(const pg8::Unit&) const {}
    __device__ __forceinline__ void done(const pg8::Unit&) const {}
};

struct SplitOrder {
    int F_, R, S, ntk, G, vc;
    __device__ __forceinline__ void init(int M, int K, int G_, int c) { const int T = (M >> 8) * 4; G = G_; F_ = (T / G) * G; R = T - F_; ntk = K >> 6; vc = (G % 8 == 0) ? (c % 8) * (G / 8) + c / 8 : c;
        S = 1; if (R > 0) { const int want = (K == 3584 || K == 1792) ? 7 : (K == 2048 ? 8 : 4);   if (R * want <= G) S = want; } }
    __device__ __forceinline__ bool next(int i, pg8::Unit& u) const { const int L = i * G + vc; const bool full = L < F_; const int q = L - F_;
        if (!full && q >= R * S) return false;
        const int t2 = q / S, sp = q - t2 * S, nts = ntk / S; const int tile = full ? L : F_ + t2;
        u.e = full ? 0 : sp + 1; u.nt = full ? ntk : nts; u.k0 = full ? 0 : sp * nts * 64; u.pm = tile >> 2; u.pn = tile & 3; u.j = tile & 3; u.s = 0; u.pa = u.pm; u.pl = 0; u.cn = 0; return true; }
    __device__ __forceinline__ int nsplit() const { return R > 0 ? S : 0; }
    __device__ __forceinline__ int rs0() const { return (F_ >> 2) << 8; }
    __device__ __forceinline__ void a_ready(const pg8::Unit&) const {}
    __device__ __forceinline__ void done(const pg8::Unit&) const {}
};

__device__ __forceinline__ void gate_units(const Args& a, Frame& F, int j, int ubeg, int uend) {
    typedef short s16x4 __attribute__((ext_vector_type(4)));
    LAS float* stat = (LAS float*)F.lds;
    LAS bf16* VL = (LAS bf16*)(F.lds + 1024);
    LAS bf16* WSl = (LAS bf16*)(F.lds + 1024 + 34816);
    const bf16* U = (const bf16*)(a.ws + WS_U); const bf16* V = (const bf16*)(a.ws + WS_V); bf16* YAB = (bf16*)(a.ws + WS_YAB); const bf16* WSB = (const bf16*)(a.ws + WS_WSB);
    const float* STATS = (const float*)(a.ws + WS_STATS);
    const int lane = F.lane, w = F.wave, li15 = lane & 15, lq = lane >> 4, pr = 16 * w + li15;
    if (ubeg >= uend) return;
    v4u raw[4], wsv[4], uu[4]; float bsv; f32x4 lnv[4];
#define GT_LOAD(u_) do { const int n_ = (u_) >> 3, g_ = (u_) & 7, r0_ = n_ * 128; \
        _Pragma("unroll") for (int i = 0; i < 4; ++i) { const int idx = F.tid + 512 * i, p = idx >> 4, c8 = (idx & 15) << 3; \
            wsv[i] = *(const GAS v4u*)(WSB + ((size_t)((j * 8 + g_) * 128 + p)) * 128 + c8); raw[i] = *(const GAS v4u*)(V + (size_t)(r0_ + p) * 1024 + g_ * 128 + c8); } \
        _Pragma("unroll") for (int n2 = 0; n2 < 4; ++n2) uu[n2] = *(const GAS v4u*)(U + (size_t)(r0_ + pr) * 1024 + g_ * 128 + 32 * n2 + 8 * lq); \
        bsv = a.in[12][j * 1024 + g_ * 128 + pr]; \
        { const float* lg_ = a.in[9] + j * 1024 + g_ * 128 + ((F.tid & 15) << 3); const float* lb_ = a.in[10] + j * 1024 + g_ * 128 + ((F.tid & 15) << 3); \
          lnv[0] = *(const GAS f32x4*)lg_; lnv[1] = *(const GAS f32x4*)(lg_ + 4); lnv[2] = *(const GAS f32x4*)lb_; lnv[3] = *(const GAS f32x4*)(lb_ + 4); } } while (0)
    GT_LOAD(ubeg);
    int cur_n = -1;
    for (int u = ubeg; u < uend; ++u) {
        const int n = u >> 3, g = u & 7, r0 = n * 128;
        if (n != cur_n) { cur_n = n;
            if (F.tid < 128) { const float* sp = STATS + (size_t)(r0 + F.tid) * 32; float s1 = 0.f, s2 = 0.f;
#pragma unroll
                for (int i = 0; i < 8; ++i) { const f32x4 v = *(const GAS f32x4*)(sp + 4 * i); s1 += v.x + v.z; s2 += v.y + v.w; }
                const float mean = s1 * (1.0f / 1024.0f), var = s2 * (1.0f / 1024.0f) - mean * mean; stat[2 * F.tid] = mean; stat[2 * F.tid + 1] = 1.0f / sqrtf(fmaxf(var, 0.f) + EPS); } }
#pragma unroll
        for (int i = 0; i < 4; ++i) { const int idx = F.tid + 512 * i, p = idx >> 4, c8 = (idx & 15) << 3; *(LAS v4u*)(WSl + p * 136 + c8) = wsv[i]; }
        __syncthreads();
#pragma unroll
        for (int i = 0; i < 4; ++i) { const int idx = F.tid + 512 * i, p = idx >> 4, c8 = (idx & 15) << 3; const float mean = stat[2 * p], rstd = stat[2 * p + 1];
            const f32x4 ga = lnv[0], gb = lnv[1], ba = lnv[2], bb = lnv[3];
            v4u o; o.x = pkbf((bflo(raw[i].x) - mean) * rstd * ga.x + ba.x, (bfhi(raw[i].x) - mean) * rstd * ga.y + ba.y); o.y = pkbf((bflo(raw[i].y) - mean) * rstd * ga.z + ba.z, (bfhi(raw[i].y) - mean) * rstd * ga.w + ba.w);
            o.z = pkbf((bflo(raw[i].z) - mean) * rstd * gb.x + bb.x, (bfhi(raw[i].z) - mean) * rstd * gb.y + bb.y); o.w = pkbf((bflo(raw[i].w) - mean) * rstd * gb.z + bb.z, (bfhi(raw[i].w) - mean) * rstd * gb.w + bb.w);
            { const int g2 = c8 >> 5, a4 = ((c8 & 31) >> 3) << 2; v2u lo2, hi2; lo2.x = o.x; lo2.y = o.y; hi2.x = o.z; hi2.y = o.w;
              *(LAS v2u*)(VL + p * 136 + 32 * g2 + a4) = lo2; *(LAS v2u*)(VL + p * 136 + 32 * g2 + 16 + a4) = hi2; } }
        v4u cu[4]; const float cb = bsv;
#pragma unroll
        for (int n2 = 0; n2 < 4; ++n2) cu[n2] = uu[n2];
        __syncthreads();
        if (u + 1 < uend) GT_LOAD(u + 1);
        f32x4 acc[8];
#pragma unroll
        for (int nt = 0; nt < 8; ++nt) acc[nt] = (f32x4){0.f, 0.f, 0.f, 0.f};
#pragma unroll
        for (int ks = 0; ks < 4; ++ks) { const bf16x8 wf = *(const LAS bf16x8*)(WSl + pr * 136 + 32 * ks + 8 * lq);
#pragma unroll
            for (int nt = 0; nt < 8; ++nt) { const LAS bf16* vp = VL + (32 * ks + 8 * lq + (li15 >> 2)) * 136 + 16 * nt + 4 * (li15 & 3);
                const s16x4 lo = __builtin_bit_cast(s16x4, __builtin_amdgcn_ds_read_tr16_b64_v4i16((LAS s16x4*)vp));
                const s16x4 hi = __builtin_bit_cast(s16x4, __builtin_amdgcn_ds_read_tr16_b64_v4i16((LAS s16x4*)(vp + 4 * 136)));
                const bf16x8 vf = __builtin_shufflevector(lo, hi, 0, 1, 2, 3, 4, 5, 6, 7);
                acc[nt] = __builtin_amdgcn_mfma_f32_16x16x32_bf16(vf, wf, acc[nt], 0, 0, 0); } }
#pragma unroll
        for (int n2 = 0; n2 < 4; ++n2) { const f32x4 a0 = acc[2 * n2], a1 = acc[2 * n2 + 1]; const v4u uv = cu[n2]; v4u o;
            o.x = pkbf(bflo(uv.x) * (a0[0] + cb), bfhi(uv.x) * (a0[1] + cb)); o.y = pkbf(bflo(uv.y) * (a0[2] + cb), bfhi(uv.y) * (a0[3] + cb));
            o.z = pkbf(bflo(uv.z) * (a1[0] + cb), bfhi(uv.z) * (a1[1] + cb)); o.w = pkbf(bflo(uv.w) * (a1[2] + cb), bfhi(uv.w) * (a1[3] + cb));
            *(GAS v4u*)(YAB + (size_t)(r0 + pr) * 2048 + g * 128 + 32 * n2 + 8 * lq) = o; }
        __syncthreads();
    }
#undef GT_LOAD
}
__device__ __forceinline__ int seq_lo(int r) { return (r < ML) ? (r & ~2047) : (ML + ((r - ML) & ~255)); }
__device__ __forceinline__ void conv_phase(const Args& a, Frame& F, int j) {
    LAS float* wl = (LAS float*)F.lds;
    LAS float* cbl = wl + 31 * 1024;
    LAS float* cgl = cbl + 1024;
    const bf16* G = (const bf16*)(a.ws + WS_G); bf16* YAB = (bf16*)(a.ws + WS_YAB);
    __syncthreads();
    { f32x4 wv[16];
#pragma unroll
      for (int q = 0; q < 16; ++q) { const int i = F.tid + q * (NWAVES * 64); wv[q] = *(const GAS f32x4*)(a.in[13] + (size_t)j * 31 * 1024 + 4 * (i < 31 * 256 ? i : 31 * 256 - 1)); }
#pragma unroll
      for (int q = 0; q < 16; ++q) { const int i = F.tid + q * (NWAVES * 64); if (i < 31 * 256) *(LAS f32x4*)(wl + 4 * i) = wv[q]; } }
    if (F.tid < 256) { *(LAS f32x4*)(cbl + 4 * F.tid) = *(const GAS f32x4*)(a.in[14] + j * 1024 + 4 * F.tid); *(LAS f32x4*)(cgl + 4 * F.tid) = *(const GAS f32x4*)(a.in[15] + j * 1024 + 4 * F.tid); }
    __syncthreads();
    const int lane = F.lane, gw = F.bid * NWAVES + F.wave, NGW = F.G * NWAVES;
#define CV_LOAD(dst, ri, cbase) do { const int row_ = r0 - 15 + (ri); const int rc_ = row_ < lo ? lo : (row_ >= hi ? hi - 1 : row_); dst = *(const GAS v4u*)((const GAS char*)G + (size_t)rc_ * 2048 + (unsigned)((cbase) * 2)); } while (0)
#define CV_UNPACK(src, ri, d) do { const int row_ = r0 - 15 + (ri); const unsigned mk_ = (row_ >= lo && row_ < hi) ? 0xffffffffu : 0u; const unsigned x0_ = src.x & mk_, x1_ = src.y & mk_, x2_ = src.z & mk_, x3_ = src.w & mk_; \
        d[0] = (f32x4){bflo(x0_), bfhi(x0_), bflo(x1_), bfhi(x1_)}; d[1] = (f32x4){bflo(x2_), bfhi(x2_), bflo(x3_), bfhi(x3_)}; } while (0)
    for (int u = gw; u < MT / 6; u += NGW) {
        const int r0 = 6 * u; const int loA = seq_lo(r0), loB = seq_lo(r0 + 5); const int npass = (loA != loB) ? 2 : 1;
        for (int pass = 0; pass < npass; ++pass) {
            const int lo = pass ? loB : loA, hi = lo + ((lo < ML) ? 2048 : 256);
            f32x4 acc[2][6][2];
#pragma unroll
            for (int h = 0; h < 2; ++h) {
                int cbase = 512 * h + 8 * lane; asm volatile("" : "+v"(cbase));
                const f32x4 b0 = *(const LAS f32x4*)(cbl + cbase), b1 = *(const LAS f32x4*)(cbl + cbase + 4);
#pragma unroll
                for (int t = 0; t < 6; ++t) { acc[h][t][0] = b0; acc[h][t][1] = b1; }
                f32x4 ring[6][2]; v4u T[6];
                { v4u a[5];
#pragma unroll
                  for (int i = 0; i < 5; ++i) CV_LOAD(a[i], i, cbase);
#pragma unroll
                  for (int s2 = 0; s2 < 6; ++s2) CV_LOAD(T[s2], s2 + 5, cbase);
#pragma unroll
                  for (int i = 0; i < 5; ++i) CV_UNPACK(a[i], i, ring[i]); }
#pragma unroll 1
                for (int it = 0; it < 5; ++it) {
#pragma unroll
                    for (int s2 = 0; s2 < 6; ++s2) { const int k = 6 * it + s2;
                        CV_UNPACK(T[s2], k + 5, ring[(s2 + 5) % 6]);
                        CV_LOAD(T[s2], 6 * (it + 1) + s2 + 5, cbase);
                        const f32x4 w0 = *(const LAS f32x4*)(wl + k * 1024 + cbase), w1 = *(const LAS f32x4*)(wl + k * 1024 + cbase + 4);
#pragma unroll
                        for (int t = 0; t < 6; ++t) { acc[h][t][0] = acc[h][t][0] + ring[(s2 + t) % 6][0] * w0; acc[h][t][1] = acc[h][t][1] + ring[(s2 + t) % 6][1] * w1; }
                        __builtin_amdgcn_sched_barrier(0); }
                }
                { CV_UNPACK(T[0], 35, ring[5]);
                  const f32x4 w0 = *(const LAS f32x4*)(wl + 30 * 1024 + cbase), w1 = *(const LAS f32x4*)(wl + 30 * 1024 + cbase + 4);
#pragma unroll
                  for (int t = 0; t < 6; ++t) { acc[h][t][0] = acc[h][t][0] + ring[t][0] * w0; acc[h][t][1] = acc[h][t][1] + ring[t][1] * w1; } }
            }
#pragma unroll
            for (int t = 0; t < 6; ++t) { float ss = 0.f;
#pragma unroll
                for (int h = 0; h < 2; ++h)
#pragma unroll
                    for (int q = 0; q < 2; ++q) { const f32x4 v = acc[h][t][q]; ss += (v.x * v.x + v.y * v.y) + (v.z * v.z + v.w * v.w); }
                const float r = 1.0f / sqrtf(wave_sum(ss) * (1.0f / 1024.0f) + EPS); const int row = r0 + t;
                if (row >= lo && row < hi) {
#pragma unroll
                    for (int h = 0; h < 2; ++h) { int cbase = 512 * h + 8 * lane; asm volatile("" : "+v"(cbase)); const f32x4 g0 = *(const LAS f32x4*)(cgl + cbase), g1 = *(const LAS f32x4*)(cgl + cbase + 4);
                        const f32x4 y0 = acc[h][t][0] * r * g0, y1 = acc[h][t][1] * r * g1; v4u o;
                        o.x = pkbf(y0.x * fsigm(y0.x), y0.y * fsigm(y0.y)); o.y = pkbf(y0.z * fsigm(y0.z), y0.w * fsigm(y0.w)); o.z = pkbf(y1.x * fsigm(y1.x), y1.y * fsigm(y1.y)); o.w = pkbf(y1.z * fsigm(y1.z), y1.w * fsigm(y1.w));
                        *(GAS v4u*)(YAB + (size_t)row * 2048 + 1024 + cbase) = o; } } }
        }
    }
#undef CV_LOAD
#undef CV_UNPACK
    __syncthreads();
}
__device__ __forceinline__ void mix_phase(const Args& a, Frame& F, int j) {
#ifndef MK_GATE_REP
#define MK_GATE_REP 1
#endif
#ifndef MK_CONV_REP
#define MK_CONV_REP 1
#endif
    for (int rep = 0; rep < MK_GATE_REP; ++rep)
    gate_units(a, F, j, (int)(((long)F.bid * 1152) / F.G), (int)(((long)(F.bid + 1) * 1152) / F.G));
    for (int rep = 0; rep < MK_CONV_REP; ++rep)
    conv_phase(a, F, j);
}

__device__ __forceinline__ void qkrope_phase(const Args& a, Frame& F, int jm, int nrows) {
    const int gw = F.bid * NWAVES + F.wave, NGW = F.G * NWAVES, lane = F.lane;
    const bf16* QKV = (const bf16*)(a.ws + WS_QKV); bf16* Q = (bf16*)(a.ws + WS_Q); bf16* Kb = (bf16*)(a.ws + WS_K); const float* ROPE = (const float*)(a.ws + WS_ROPE);
    const float* qg = a.in[18] + jm * 64; const float* kg = a.in[19] + jm * 64; const int sub = lane & 15;
    float gq[4], gk[4];
#pragma unroll
    for (int k = 0; k < 4; ++k) { gq[k] = qg[sub + 16 * k]; gk[k] = kg[sub + 16 * k]; }
    for (int row = gw; row < nrows; row += NGW) {
        const bool lat = row < ML; float cr = 1.f, sr = 0.f, cc = 1.f, sc = 0.f;
        if (lat) { const int t = row & 2047, pr = t >> 6, pc = t & 63; const float2 a0 = *(const float2*)(ROPE + (pr * 16 + sub) * 2), a1 = *(const float2*)(ROPE + (pc * 16 + sub) * 2); cr = a0.x; sr = a0.y; cc = a1.x; sc = a1.y; }
#pragma unroll
        for (int hg = 0; hg < 5; ++hg) { const int head = 4 * hg + (lane >> 4); const bf16* src = QKV + (size_t)row * 1536 + head * 64 + sub;
            float x[4];
#pragma unroll
            for (int k = 0; k < 4; ++k) x[k] = bf2f(src[16 * k]);
            float ss = (x[0] * x[0] + x[1] * x[1]) + (x[2] * x[2] + x[3] * x[3]);
            ss += __shfl_xor(ss, 1); ss += __shfl_xor(ss, 2); ss += __shfl_xor(ss, 4); ss += __shfl_xor(ss, 8);
            const float r = 1.0f / sqrtf(ss * (1.0f / 64.0f) + EPS);
            float y[4];
#pragma unroll
            for (int k = 0; k < 4; ++k) y[k] = x[k] * r * (hg < 4 ? gq[k] : gk[k]);
            float o[4]; o[0] = y[0] * cr - y[1] * sr; o[1] = y[1] * cr + y[0] * sr; o[2] = y[2] * cc - y[3] * sc; o[3] = y[3] * cc + y[2] * sc;
            if (hg < 4) { bf16* d = Q + (size_t)row * 1024 + head * 64 + sub;
#pragma unroll
                for (int k = 0; k < 4; ++k) d[16 * k] = (bf16)(pkbf(o[k] * QSCALE, 0.f) & 0xffffu); }
            else { bf16* d = Kb + (size_t)row * 256 + (head - 16) * 64 + sub;
#pragma unroll
                for (int k = 0; k < 4; ++k) d[16 * k] = (bf16)(pkbf(o[k], 0.f) & 0xffffu); } }
    }
}
__device__ __forceinline__ void attn_phase(const Args& a, Frame& F, int jm, int nunits) {
    typedef short s16x4 __attribute__((ext_vector_type(4)));
    const bf16* Q = (const bf16*)(a.ws + WS_Q); const bf16* Kb = (const bf16*)(a.ws + WS_K); const bf16* Vb = (const bf16*)(a.ws + WS_QKV); bf16* O = (bf16*)(a.ws + WS_O);
    LAS bf16* Kl = (LAS bf16*)F.lds;
    LAS bf16* Vl = (LAS bf16*)(F.lds + 18432);
    const int lane = F.lane, w = F.wave, li15 = lane & 15, lq = lane >> 4, hsel = w >> 2, qw = (w & 3) * 32;
    const int lkey = F.tid >> 3, ld8 = (F.tid & 7) << 3;
#define KROW(si) (((si) < nw) ? (b * 2048 + q0 - 128 + 64 * (wlo + (si))) : (ML + b * 256 + 64 * ((si) - nw)))
    const int vcu = (F.G % 8 == 0) ? (F.bid % 8) * (F.G / 8) + F.bid / 8 : F.bid;
    for (int ui = vcu; ui < nunits; ui += F.G) {
        int b, hp, q0, qrow0, wlo, nw;
        if (ui < 1024) { b = ui >> 7; hp = (ui >> 4) & 7; const int qb = ui & 15; q0 = qb * 128; qrow0 = b * 2048 + q0; wlo = (qb == 0) ? 2 : 0; nw = (qb == 0 || qb == 15) ? 4 : 6; }
        else { const int v = ui - 1024; b = v >> 4; hp = (v >> 1) & 7; q0 = (v & 1) * 128; qrow0 = ML + b * 256 + q0; wlo = 0; nw = 0; }
        const int ntile = nw + 4, hq = 2 * hp + hsel, kvh = hp >> 1;
        const bf16* qp = Q + (size_t)(qrow0 + qw + li15) * 1024 + hq * 64 + 8 * lq;
        bf16x8 qf[2][2];
#pragma unroll
        for (int mt = 0; mt < 2; ++mt)
#pragma unroll
            for (int ks = 0; ks < 2; ++ks) qf[mt][ks] = *(const GAS bf16x8*)(qp + (size_t)mt * 16 * 1024 + 32 * ks);
        const float sinkv = a.in[20][jm * 16 + hq] * LOG2E;
        float m[2], l[2]; f32x4 o[2][4];
#pragma unroll
        for (int mt = 0; mt < 2; ++mt) { m[mt] = sinkv; l[mt] = (lq == 0) ? 1.0f : 0.0f;
#pragma unroll
            for (int dt = 0; dt < 4; ++dt) o[mt][dt] = (f32x4){0.f, 0.f, 0.f, 0.f}; }
        v4u kreg[2], vreg[2];
#pragma unroll
        for (int h = 0; h < 2; ++h) { const int kr = KROW(h); kreg[h] = *(const GAS v4u*)(Kb + (size_t)(kr + lkey) * 256 + kvh * 64 + ld8); vreg[h] = *(const GAS v4u*)(Vb + (size_t)(kr + lkey) * 256 + kvh * 64 + ld8); }
        for (int si0 = 0; si0 < ntile; si0 += 2)
#pragma unroll
        for (int h = 0; h < 2; ++h) {
            const int si = si0 + h; const int bo = h * 4608;
            *(LAS v4u*)(Kl + bo + lkey * 72 + ld8) = kreg[h]; *(LAS v4u*)(Vl + bo + lkey * 72 + ld8) = vreg[h];
            if (si + 2 < ntile) { const int kr = KROW(si + 2);
                kreg[h] = *(const GAS v4u*)(Kb + (size_t)(kr + lkey) * 256 + kvh * 64 + ld8); vreg[h] = *(const GAS v4u*)(Vb + (size_t)(kr + lkey) * 256 + kvh * 64 + ld8); }
            __syncthreads();
            f32x4 s[2][4];
#pragma unroll
            for (int kt = 0; kt < 4; ++kt) { const LAS bf16* kp = Kl + bo + (16 * kt + li15) * 72 + 8 * lq; const bf16x8 k0 = *(const LAS bf16x8*)kp, k1 = *(const LAS bf16x8*)(kp + 32);
#pragma unroll
                for (int mt = 0; mt < 2; ++mt) { s[mt][kt] = __builtin_amdgcn_mfma_f32_16x16x32_bf16(k0, qf[mt][0], (f32x4){0.f, 0.f, 0.f, 0.f}, 0, 0, 0);
                    s[mt][kt] = __builtin_amdgcn_mfma_f32_16x16x32_bf16(k1, qf[mt][1], s[mt][kt], 0, 0, 0); } }
            const int tt = wlo + si;
            if (si < nw && (tt < 2 || tt > 3)) { const int kpos0 = q0 - 128 + 64 * tt; asm volatile("; window-edge tile" ::: "memory");
#pragma unroll
                for (int mt = 0; mt < 2; ++mt) { const int qpos = q0 + qw + 16 * mt + li15;
#pragma unroll
                    for (int kt = 0; kt < 4; ++kt)
#pragma unroll
                        for (int jj = 0; jj < 4; ++jj) { const int dlt = qpos - (kpos0 + 16 * kt + 4 * lq + jj); if (dlt > 128 || dlt < -128) s[mt][kt][jj] = -INFINITY; } } }
            bf16x8 pb[2][2]; float lm[2];
#pragma unroll
            for (int mt = 0; mt < 2; ++mt) { const f32x4 mv = (f32x4){m[mt], m[mt], m[mt], m[mt]};
#pragma unroll
                for (int kt = 0; kt < 4; ++kt) s[mt][kt] = s[mt][kt] - mv;
                float tm = fmaxf(fmaxf(s[mt][0][0], s[mt][0][1]), fmaxf(s[mt][0][2], s[mt][0][3]));
#pragma unroll
                for (int kt = 1; kt < 4; ++kt) tm = fmaxf(tm, fmaxf(fmaxf(s[mt][kt][0], s[mt][kt][1]), fmaxf(s[mt][kt][2], s[mt][kt][3])));
                lm[mt] = tm; }
            if (__builtin_amdgcn_ballot_w64(fmaxf(lm[0], lm[1]) > 8.0f) != 0ull) {
                asm volatile("; raise the references" ::: "memory");
#pragma unroll
                for (int mt = 0; mt < 2; ++mt) { float tm = lm[mt]; tm = fmaxf(tm, __shfl_xor(tm, 16)); tm = fmaxf(tm, __shfl_xor(tm, 32));
                    const float dl = fmaxf(tm, 0.f), alpha = __builtin_amdgcn_exp2f(-dl); m[mt] += dl; l[mt] *= alpha; const f32x4 dv = (f32x4){dl, dl, dl, dl};
#pragma unroll
                    for (int kt = 0; kt < 4; ++kt) s[mt][kt] = s[mt][kt] - dv;
#pragma unroll
                    for (int dt = 0; dt < 4; ++dt) o[mt][dt] = o[mt][dt] * alpha; } }
#pragma unroll
            for (int mt = 0; mt < 2; ++mt) {
                f32x4 lsv = (f32x4){0.f, 0.f, 0.f, 0.f};
#pragma unroll
                for (int kt = 0; kt < 4; ++kt) { f32x4 pv;
#pragma unroll
                    for (int jj = 0; jj < 4; ++jj) pv[jj] = __builtin_amdgcn_exp2f(s[mt][kt][jj]);
                    s[mt][kt] = pv; lsv = lsv + pv; }
                l[mt] += (lsv[0] + lsv[1]) + (lsv[2] + lsv[3]);
#pragma unroll
                for (int s2 = 0; s2 < 2; ++s2) { v4u pw; pw.x = pkbf(s[mt][2 * s2][0], s[mt][2 * s2][1]); pw.y = pkbf(s[mt][2 * s2][2], s[mt][2 * s2][3]);
                    pw.z = pkbf(s[mt][2 * s2 + 1][0], s[mt][2 * s2 + 1][1]); pw.w = pkbf(s[mt][2 * s2 + 1][2], s[mt][2 * s2 + 1][3]); pb[mt][s2] = __builtin_bit_cast(bf16x8, pw); }
            }
#pragma unroll
            for (int s2 = 0; s2 < 2; ++s2)
#pragma unroll
                for (int dt = 0; dt < 4; ++dt) { const LAS bf16* vp = Vl + bo + (32 * s2 + 4 * lq + (li15 >> 2)) * 72 + 16 * dt + 4 * (li15 & 3);
                    const s16x4 lo = __builtin_bit_cast(s16x4, __builtin_amdgcn_ds_read_tr16_b64_v4i16((LAS s16x4*)vp));
                    const s16x4 hi = __builtin_bit_cast(s16x4, __builtin_amdgcn_ds_read_tr16_b64_v4i16((LAS s16x4*)(vp + 16 * 72)));
                    const bf16x8 af = __builtin_shufflevector(lo, hi, 0, 1, 2, 3, 4, 5, 6, 7);
#pragma unroll
                    for (int mt = 0; mt < 2; ++mt) o[mt][dt] = __builtin_amdgcn_mfma_f32_16x16x32_bf16(af, pb[mt][s2], o[mt][dt], 0, 0, 0); }
        }
#pragma unroll
        for (int mt = 0; mt < 2; ++mt) { float lt = l[mt]; lt += __shfl_xor(lt, 16); lt += __shfl_xor(lt, 32); const float inv = 1.0f / lt;
            bf16* op = O + (size_t)(qrow0 + qw + 16 * mt + li15) * 1024 + hq * 64 + 4 * lq;
#pragma unroll
            for (int dt = 0; dt < 4; ++dt) { v2u ov; ov.x = pkbf(o[mt][dt][0] * inv, o[mt][dt][1] * inv); ov.y = pkbf(o[mt][dt][2] * inv, o[mt][dt][3] * inv); *(GAS v2u*)(op + 16 * dt) = ov; } }
    }
#undef KROW
}
__device__ __forceinline__ void final_phase(const Args& a, Frame& F) {
    const int gw = F.bid * NWAVES + F.wave, NGW = F.G * NWAVES, lane = F.lane;
    const bf16* X = (const bf16*)(a.ws + WS_X); const bf16* YS = (const bf16*)(a.ws + WS_YS); const float* MOD = (const float*)(a.ws + WS_MOD); const bf16* PB = (const bf16*)(a.ws + WS_PB);
    const int4* TOKI = (const int4*)(a.ws + WS_TOKI); const float2* TOKW = (const float2*)(a.ws + WS_TOKW);
    MoeSeg sg; moe_seg(F, 1, sg); MoeOrder S;
#pragma unroll
    for (int q = 0; q < 9; ++q) S.pst[q] = sg.pst[q];
#pragma unroll
    for (int q = 0; q < 8; ++q) S.cnt[q] = sg.cnt[q];
    S.apan = false; S.nt = 4; S.G = F.G; S.c = 0; S.ntk = 28; S.split_tail();
    const int ps0 = S.ps0(), psrows = S.psrows(), nS = S.S;
    for (int row = gw; row < ML; row += NGW) {
        const float* g2p = MOD + (size_t)(3 * 9 + (row >> 11)) * 6144 + 5 * 1024; const bf16* ys = YS + (size_t)row * 2048;
        const int4 ti = TOKI[row]; const float2 tw = TOKW[row];
        const int p0 = seg_start(sg, ti.x & 255) * 256 + ti.y, p1 = seg_start(sg, ti.x >> 8) * 256 + ti.z;
        f32x4 y[4];
#pragma unroll
        for (int j = 0; j < 4; ++j) y[j] = (f32x4){0.f, 0.f, 0.f, 0.f};
#pragma unroll
        for (int sl = 0; sl < 2; ++sl) { const int pr = sl ? p1 : p0; const float wsl = sl ? tw.y : tw.x;
            if (pr >= ps0) { f32x4 ps[4];
#pragma unroll
                for (int j = 0; j < 4; ++j) ps[j] = (f32x4){0.f, 0.f, 0.f, 0.f};
                v2u pq[7][4];
#pragma unroll
                for (int q = 0; q < 7; ++q) { const int qq = q < nS ? q : nS - 1;
#pragma unroll
                    for (int j = 0; j < 4; ++j) pq[q][j] = *(const GAS v2u*)(PB + ((size_t)qq * psrows + (size_t)(pr - ps0)) * 1024 + 4 * lane + 256 * j); }
#pragma unroll
                for (int q = 0; q < 7; ++q) if (q < nS) {
#pragma unroll
                    for (int j = 0; j < 4; ++j) ps[j] = ps[j] + (f32x4){bflo(pq[q][j].x), bfhi(pq[q][j].x), bflo(pq[q][j].y), bfhi(pq[q][j].y)}; }
#pragma unroll
                for (int j = 0; j < 4; ++j) y[j] = y[j] + ps[j] * wsl; }
            else {
#pragma unroll
                for (int j = 0; j < 4; ++j) { const v2u yy = *(const GAS v2u*)(ys + sl * 1024 + 4 * lane + 256 * j); y[j] = y[j] + (f32x4){bflo(yy.x), bfhi(yy.x), bflo(yy.y), bfhi(yy.y)}; } } }
#pragma unroll
        for (int j = 0; j < 4; ++j) { const v2u xx = *(const GAS v2u*)(X + (size_t)row * 1024 + 4 * lane + 256 * j); f32x4 v = (f32x4){bflo(xx.x), bfhi(xx.x), bflo(xx.y), bfhi(xx.y)};
            const f32x4 g = *(const GAS f32x4*)(g2p + 4 * lane + 256 * j);
            __builtin_nontemporal_store(v + g * y[j], (GAS f32x4*)(a.out + (size_t)row * 1024 + 4 * lane + 256 * j)); }
    }
}

#define GRID_BAR() do { if (!MK_PER_PHASE) xcd_barrier(bar); } while (0)
#define IN(k) (lo <= (k) && (k) < hi)
#define BOTH(k) (IN(k) && IN((k) + 1))
#ifndef MK_MASK
#define MK_MASK 0xFFFFFFFFu
#endif
#define EN(b) (((MK_MASK) >> (b)) & 1u)
#ifndef MK_DUP_MASK
#define MK_DUP_MASK 0u
#endif
#define REP(b) ((((MK_DUP_MASK) >> (b)) & 1u) ? 3 : 1)
#define FRESH() do { int t_ = threadIdx.x, b_ = blockIdx.x; asm volatile("" : "+v"(t_)); asm volatile("" : "+s"(b_)); F.tid = t_; F.lane = t_ & 63; F.wave = __builtin_amdgcn_readfirstlane(t_ >> 6); F.bid = b_; } while (0)
template <int jp> __device__ __forceinline__ void layer_pair(const Args& args, Frame& F, const XcdBarrier& bar, const int lo, const int hi) {
    unsigned char* ws = args.ws;
    bf16* X = (bf16*)(ws + WS_X); const float* MOD = (const float*)(ws + WS_MOD); bf16* H = (bf16*)(ws + WS_H);
        const int pb = 1 + 16 * jp, le = 2 * jp, lo_ = 2 * jp + 1;
        const int rows_tail = (jp == 1) ? ML : MT;
        if (EN(1) && IN(pb + 0)) { FRESH();
_Pragma("unroll 1") for (int rep_ = 0; rep_ < REP(1); ++rep_) { if (jp == 1) { TailPlan tp; tail_plan(F.G, 1024, tp); conv_moe_all(args, F, 1, 2, 0, F.G, -1, tp.e[4] < moe_items(2) ? tp.e[4] : moe_items(2), moe_items(2)); }
            norm_phase(args, F, le, 0, MT, jp == 0, jp == 1 ? 1 : -1); if (rep_ + 1 < REP(1)) GRID_BAR(); } if (BOTH(pb + 0)) GRID_BAR(); }
        if (EN(2) && IN(pb + 1)) { FRESH();
_Pragma("unroll 1") for (int rep_ = 0; rep_ < REP(2); ++rep_) { pg8::Gemm g{H, (const bf16*)(ws + WS_WIN) + (size_t)jp * 4096 * 1024, MT, 4096, 1024}; pg8::StaticOrder S; S.init(MT, 4096, 1024, F.G, F.bid);
            pg8::EpiWin E{(bf16*)(ws + WS_U), (bf16*)(ws + WS_V), (bf16*)(ws + WS_G), (float*)(ws + WS_STATS)};
            pg8::gemm_phase<pg8::EpiWin, pg8::StaticOrder, true, true, 16>(F.lds + RING_OFF, g, S, E); { TailPlan tp; tail_plan(F.G, (jp == 1) ? 1024 : 1152, tp); tail_fill(args, F, tp, 0, jp, jp == 0 ? 0 : 2); } if (rep_ + 1 < REP(2)) GRID_BAR(); } if (BOTH(pb + 1)) GRID_BAR(); }
        if (EN(3) && IN(pb + 2)) { FRESH();
_Pragma("unroll 1") for (int rep_ = 0; rep_ < REP(3); ++rep_) { mix_phase(args, F, jp); if (rep_ + 1 < REP(3)) GRID_BAR(); } if (BOTH(pb + 2)) GRID_BAR(); }
        if (EN(4) && IN(pb + 3)) { FRESH();
_Pragma("unroll 1") for (int rep_ = 0; rep_ < REP(4); ++rep_) { pg8::Gemm g{(const bf16*)(ws + WS_YAB), (const bf16*)(ws + WS_WOUT) + (size_t)jp * 1024 * 2048, MT, 1024, 2048}; SplitOrder S; S.init(MT, 2048, F.G, F.bid);
            pg8::EpiResid E{X, MOD + (size_t)(le * 9) * 6144 + 2 * 1024, (float*)(ws + WS_PB), S.rs0(), args.gmul};
            pg8::gemm_phase<pg8::EpiResid, SplitOrder, true, true>(F.lds + RING_OFF, g, S, E); if (rep_ + 1 < REP(4)) GRID_BAR(); } if (BOTH(pb + 3)) GRID_BAR(); }
        if (EN(5) && IN(pb + 4)) { FRESH();
_Pragma("unroll 1") for (int rep_ = 0; rep_ < REP(5); ++rep_) { SplitOrder SP; SP.init(MT, 2048, F.G, F.bid); norm_phase(args, F, le, 1, MT, false, -1, SP.nsplit(), SP.rs0(), MOD + (size_t)(le * 9) * 6144 + 2 * 1024, MK_FP8_FFN2 && jp == 1); if (rep_ + 1 < REP(5)) GRID_BAR(); } if (BOTH(pb + 4)) GRID_BAR(); }
        if (EN(6) && IN(pb + 5)) { FRESH();
_Pragma("unroll 1") for (int rep_ = 0; rep_ < REP(6); ++rep_) { if (MK_FP8_FFN2 && jp == 1) { pg8::Gemm g{H, (const bf16*)(ws + WS_FF13) + (size_t)jp * 7168 * 1024, MT, 7168, 512}; pg8::StaticOrder S; S.init(MT, 7168, 512, F.G, F.bid);
            pg8::EpiSwiGLU8 E{(unsigned char*)(ws + WS_T), FF, 1.0f / F8_W13};
            pg8::gemm_phase<pg8::EpiSwiGLU8, pg8::StaticOrder, true, true, 8, true>(F.lds + RING_OFF, g, S, E); } else {
            pg8::Gemm g{H, (const bf16*)(ws + WS_FF13) + (size_t)jp * 7168 * 1024, MT, 7168, 1024}; pg8::StaticOrder S; S.init(MT, 7168, 1024, F.G, F.bid);
            pg8::EpiSwiGLU E{(bf16*)(ws + WS_T), FF, args.gmul};
            pg8::gemm_phase<pg8::EpiSwiGLU, pg8::StaticOrder, true, true, 16>(F.lds + RING_OFF, g, S, E); } { TailPlan tp; tail_plan(F.G, (jp == 1) ? 1024 : 1152, tp); tail_fill(args, F, tp, 1, jp, jp == 0 ? 0 : 2); } if (rep_ + 1 < REP(6)) GRID_BAR(); } if (BOTH(pb + 5)) GRID_BAR(); }
        if (EN(7) && IN(pb + 6)) { FRESH();
_Pragma("unroll 1") for (int rep_ = 0; rep_ < REP(7); ++rep_) { if (MK_FP8_FFN2 && jp == 1) { pg8::Gemm g{(const bf16*)(ws + WS_T), (const bf16*)(ws + WS_FF2) + (size_t)jp * 1024 * 3584, MT, 1024, FF / 2}; SplitOrder S; S.init(MT, FF / 2, F.G, F.bid);
            pg8::EpiResid E{X, MOD + (size_t)(le * 9) * 6144 + 5 * 1024, (float*)(ws + WS_PB), S.rs0(), args.gmul * (1.0f / F8_W2), 1.0f / F8_W2};
            pg8::gemm_phase<pg8::EpiResid, SplitOrder, true, true, 0, true>(F.lds + RING_OFF, g, S, E); } else {
            pg8::Gemm g{(const bf16*)(ws + WS_T), (const bf16*)(ws + WS_FF2) + (size_t)jp * 1024 * 3584, MT, 1024, FF}; SplitOrder S; S.init(MT, FF, F.G, F.bid);
            pg8::EpiResid E{X, MOD + (size_t)(le * 9) * 6144 + 5 * 1024, (float*)(ws + WS_PB), S.rs0(), args.gmul};
            pg8::gemm_phase<pg8::EpiResid, SplitOrder, true, true>(F.lds + RING_OFF, g, S, E); } if (rep_ + 1 < REP(7)) GRID_BAR(); } if (BOTH(pb + 6)) GRID_BAR(); }
        if (EN(8) && IN(pb + 7)) { FRESH();
_Pragma("unroll 1") for (int rep_ = 0; rep_ < REP(8); ++rep_) { SplitOrder SP; SP.init(MT, (MK_FP8_FFN2 && jp == 1) ? FF / 2 : FF, F.G, F.bid); norm_phase(args, F, lo_, 0, MT, false, -1, SP.nsplit(), SP.rs0(), MOD + (size_t)(le * 9) * 6144 + 5 * 1024); if (rep_ + 1 < REP(8)) GRID_BAR(); } if (BOTH(pb + 7)) GRID_BAR(); }
        if (EN(9) && IN(pb + 8)) { FRESH();
_Pragma("unroll 1") for (int rep_ = 0; rep_ < REP(9); ++rep_) { pg8::Gemm g{H, (const bf16*)(ws + WS_WQKV) + (size_t)jp * 1536 * 1024, MT, 1536, 1024}; pg8::StaticOrder S; S.init(MT, 1536, 1024, F.G, F.bid);
            pg8::EpiQKV E{(bf16*)(ws + WS_Q), (bf16*)(ws + WS_K), (bf16*)(ws + WS_QKV), args.in[18] + jp * 64, args.in[19] + jp * 64, (const float*)(ws + WS_ROPE), ML, QSCALE, EPS};
            pg8::gemm_phase<pg8::EpiQKV, pg8::StaticOrder, true, true, 16>(F.lds + RING_OFF, g, S, E); { TailPlan tp; tail_plan(F.G, (jp == 1) ? 1024 : 1152, tp); tail_fill(args, F, tp, 2, jp, jp == 0 ? 0 : 2); } if (rep_ + 1 < REP(9)) GRID_BAR(); } if (BOTH(pb + 8)) GRID_BAR(); }
        if (EN(11) && IN(pb + 10)) { FRESH();
_Pragma("unroll 1") for (int rep_ = 0; rep_ < REP(11); ++rep_) { attn_phase(args, F, jp, (jp == 1) ? 1024 : 1152); { TailPlan tp; tail_plan(F.G, (jp == 1) ? 1024 : 1152, tp); tail_fill(args, F, tp, 3, jp, jp == 0 ? 0 : 2, (F.G % 8 == 0) ? (F.bid % 8) * (F.G / 8) + F.bid / 8 : F.bid); } if (rep_ + 1 < REP(11)) GRID_BAR(); } if (BOTH(pb + 10)) GRID_BAR(); }
        if (EN(12) && IN(pb + 11)) { FRESH();
_Pragma("unroll 1") for (int rep_ = 0; rep_ < REP(12); ++rep_) { pg8::Gemm g{(const bf16*)(ws + WS_O), (const bf16*)(ws + WS_WO) + (size_t)jp * 1024 * 1024, rows_tail, 1024, 1024}; SplitOrder S; S.init(rows_tail, 1024, F.G, F.bid);
            pg8::EpiResid E{X, MOD + (size_t)(lo_ * 9) * 6144 + 2 * 1024, (float*)(ws + WS_PB), S.rs0(), args.gmul};
            pg8::gemm_phase<pg8::EpiResid, SplitOrder, true, true>(F.lds + RING_OFF, g, S, E); if (rep_ + 1 < REP(12)) GRID_BAR(); } if (BOTH(pb + 11)) GRID_BAR(); }
        if (EN(13) && IN(pb + 12)) { FRESH();
_Pragma("unroll 1") for (int rep_ = 0; rep_ < REP(13); ++rep_) { SplitOrder SP; SP.init(rows_tail, 1024, F.G, F.bid); norm_router_phase(args, F, lo_, rows_tail, SP.nsplit(), SP.rs0(), MOD + (size_t)(lo_ * 9) * 6144 + 2 * 1024); if (rep_ + 1 < REP(13)) GRID_BAR(); } if (BOTH(pb + 12)) GRID_BAR(); }
        if (EN(15) && IN(pb + 14)) { FRESH();
_Pragma("unroll 1") for (int rep_ = 0; rep_ < REP(15); ++rep_) { MoeSeg sg; moe_seg(F, jp, sg); MoeOrder S;
#pragma unroll
            for (int q = 0; q < 9; ++q) S.pst[q] = sg.pst[q];
#pragma unroll
            for (int q = 0; q < 8; ++q) S.cnt[q] = sg.cnt[q];
            S.nt = 28; S.G = F.G; S.c = F.bid; S.ntk = 8; S.apan = true; S.no_split();
            pg8::Gemm g{(const bf16*)(ws + WS_HP), (const bf16*)(ws + WS_MOE13), 0, 0, 512};
            pg8::EpiSwiGLU8 E{(unsigned char*)(ws + WS_TP), FF, 1.0f / F8_W13};
            pg8::gemm_phase<pg8::EpiSwiGLU8, MoeOrder, true, true, 8, true>(F.lds + RING_OFF, g, S, E); if (rep_ + 1 < REP(15)) GRID_BAR(); } if (BOTH(pb + 14)) GRID_BAR(); }
        if (EN(16) && IN(pb + 15)) { FRESH();
_Pragma("unroll 1") for (int rep_ = 0; rep_ < REP(16); ++rep_) { MoeSeg sg; moe_seg(F, jp, sg); MoeOrder S;
#pragma unroll
            for (int q = 0; q < 9; ++q) S.pst[q] = sg.pst[q];
#pragma unroll
            for (int q = 0; q < 8; ++q) S.cnt[q] = sg.cnt[q];
            S.apan = false; S.nt = 4; S.G = F.G; S.c = F.bid; S.ntk = 28; if (jp == 1) S.split_tail(); else S.no_split();
            pg8::Gemm g{(const bf16*)(ws + WS_TP), (const bf16*)(ws + WS_MOE2), 0, 0, FF / 2};
            pg8::EpiMoeDown E{(bf16*)(ws + WS_YS), (const int*)(ws + WS_TOKLIST), (const float*)(ws + WS_TOKWT), CAP, (bf16*)(ws + WS_PB), S.ps0(), S.psrows(), 1.0f / F8_W2};
            if (jp == 0) pg8::gemm_phase<pg8::EpiMoeDown, MoeOrder, true, true, 28, true>(F.lds + RING_OFF, g, S, E); else pg8::gemm_phase<pg8::EpiMoeDown, MoeOrder, true, true, 0, true>(F.lds + RING_OFF, g, S, E);
            if (jp == 0) { const int U = sg.pst[8] * 4, busy = (U > 2 * F.G) ? ((U - 2 * F.G < F.G) ? U - 2 * F.G : F.G) : 0;
                const int vcid = (F.G % 8 == 0) ? (F.bid % 8) * (F.G / 8) + F.bid / 8 : F.bid;
                if (busy < F.G) conv_moe_all(args, F, 1, 1, busy, F.G - busy, vcid); else conv_moe_all(args, F, 1, 1, 0, F.G, vcid); } if (rep_ + 1 < REP(16)) GRID_BAR(); } if (BOTH(pb + 15)) GRID_BAR(); }
}

__global__ void __launch_bounds__(NWAVES * 64, 2) mk_fwd(Args args) {
    extern __shared__ __attribute__((aligned(16))) unsigned char lds[];
    Frame F;
    F.lds = (LAS unsigned char*)lds; F.MISC = (volatile LAS unsigned*)(F.lds + MISC_OFF);
    F.tid = threadIdx.x; F.lane = F.tid & 63; F.wave = __builtin_amdgcn_readfirstlane(F.tid >> 6); F.G = gridDim.x; F.bid = blockIdx.x;
    F.ctl = (gu32*)(args.ws + WS_CTL);
    for (int u = F.tid; u < (LDS_BYTES - LDSCTL_OFF) / 4; u += NWAVES * 64) ((LAS unsigned*)(F.lds + LDSCTL_OFF))[u] = 0u;
    __syncthreads();
    XcdBarrier bar; bar.bar = (unsigned*)(F.ctl + CW_BAR); bar.x = 0; bar.st = nullptr;
    if (!MK_PER_PHASE) bar = xcd_barrier_post((unsigned*)(F.ctl + CW_BAR), F.MISC + 8);
    const int lo = args.ph_lo, hi = args.ph_hi;
    unsigned char* ws = args.ws;
    bf16* X = (bf16*)(ws + WS_X); const float* MOD = (const float*)(ws + WS_MOD); bf16* H = (bf16*)(ws + WS_H);

    if (EN(0) && IN(0)) { FRESH(); prologue_phase(args, F); if (BOTH(0)) GRID_BAR(); }

    layer_pair<0>(args, F, bar, lo, hi);
    layer_pair<1>(args, F, bar, lo, hi);
    if (EN(17) && IN(33)) { FRESH(); final_phase(args, F); }
#undef IN
#undef BOTH
}

extern "C" void kernel_launch(void* const* d_in, const int* in_sizes, int n_in, void* d_out, int out_size, void* d_ws, size_t ws_size, hipStream_t stream) {
    static int grid = 0;
    if (grid == 0) {
        if (n_in != 29 || out_size != ML * D || ws_size < WS_END) { fprintf(stderr, "kernel_launch: unexpected shapes (n_in %d out %d ws %zu)\n", n_in, out_size, ws_size); grid = -1; return; }
        int dev = 0, cus = 0;
        if (hipGetDevice(&dev) != hipSuccess || hipDeviceGetAttribute(&cus, hipDeviceAttributeMultiprocessorCount, dev) != hipSuccess) { grid = -1; return; }
        if (hipFuncSetAttribute((const void*)mk_fwd, hipFuncAttributeMaxDynamicSharedMemorySize, LDS_BYTES) != hipSuccess) { grid = -1; return; }
        int per_cu = 0; (void)hipOccupancyMaxActiveBlocksPerMultiprocessor(&per_cu, (const void*)mk_fwd, NWAVES * 64, LDS_BYTES); (void)hipGetLastError();
        grid = cus;
    }
    if (grid < 0) return;
    (void)hipMemsetAsync((char*)d_ws + WS_CTL, 0, CTL_ZERO_BYTES, stream);
    Args a{};
    for (int i = 0; i < 29; ++i) a.in[i] = (const float*)d_in[i];
    a.out = (float*)d_out; a.ws = (unsigned char*)d_ws; a.gmul = 1.f; a.pad = 0;
#if MK_PER_PHASE
#ifndef MK_REP_LIST
#define MK_REP_LIST -1
#endif
    const int reps[] = {MK_REP_LIST};
    for (int p = 0; p < N_PHASES; ++p) { int n = 1; for (int r : reps) if (r == p) n += 2;
        for (int q = 0; q < n; ++q) { a.ph_lo = p; a.ph_hi = p + 1; a.gmul = (q == 0) ? 1.f : 0.f; hipLaunchKernelGGL(mk_fwd, dim3(grid), dim3(NWAVES * 64), LDS_BYTES, stream, a); } }
#else
    a.ph_lo = 0; a.ph_hi = N_PHASES; hipLaunchKernelGGL(mk_fwd, dim3(grid), dim3(NWAVES * 64), LDS_BYTES, stream, a);
#endif
}
```

```cpp
#include <hip/hip_runtime.h>
#include <cstdio>
#include <cstdint>
namespace pg8 {
#define PG8_LAS __attribute__((address_space(3)))
typedef unsigned short bf16_t;
typedef short bf16x8 __attribute__((ext_vector_type(8)));
typedef float f32x4 __attribute__((ext_vector_type(4)));
typedef unsigned u32x4 __attribute__((ext_vector_type(4)));
typedef int v4i32 __attribute__((ext_vector_type(4)));
typedef int v8i32 __attribute__((ext_vector_type(8)));
constexpr int BM = 256, BK = 64, HALF = 128, HTB = HALF * BK * 2  , STAGE_BYTES = 8 * HTB, NXCD = 8, WGM = 8;

__host__ __device__ __forceinline__ int lds_byte(int r, int c) { const int st = (r >> 4) * 2 + (c >> 5), rr = r & 15, cc = c & 31, ob = rr * 64 + cc * 2; return st * 1024 + (ob ^ (((ob >> 9) & 1) << 5)); }
__host__ __device__ __forceinline__ void stage_rc(int b, int& R, int& C) { const int st = b / 1024, sb = b % 1024, swz = sb ^ (((sb >> 9) & 1) << 5); R = (st >> 1) * 16 + swz / 64; C = (st & 1) * 32 + (swz % 64) / 2; }
__host__ __device__ __forceinline__ int perm32(int rho) { const int n = rho >> 4, i = rho & 15; return 8 * (i >> 2) + 4 * n + (i & 3); }

struct Unit { int pm, pn, e, j, k0, nt, s, pa, pl, cn; };
struct Gemm { const bf16_t* A; const bf16_t* Bt; int M, N, K; };

struct StaticOrder {
    int nM, nN, nwg, G, c, ntk;
    __host__ __device__ void init(int M, int N, int K, int G_, int c_) { nM = M / BM; nN = N / BM; nwg = nM * nN; G = G_; c = c_; ntk = K / BK; }
    __host__ __device__ bool next(int i, Unit& u) const {
        const long L = (long)i * G + c; if (L >= nwg) return false;
        int wgid = (int)L; { const int q = nwg / NXCD, r = nwg % NXCD, xcd = wgid % NXCD, off = wgid / NXCD; wgid = (xcd < r ? xcd * (q + 1) : r * (q + 1) + (xcd - r) * q) + off; }
        const int nig = WGM * nN, gid = wgid / nig, fm = gid * WGM, gsz = (nM - fm) < WGM ? (nM - fm) : WGM;
        u.pm = fm + ((wgid % nig) % gsz); u.pn = (wgid % nig) / gsz; u.e = 0; u.j = u.pn; u.k0 = 0; u.nt = ntk; u.s = 0; u.pa = u.pm; u.pl = 0; u.cn = 0; return true;
    }
    __device__ __forceinline__ void a_ready(const Unit&) const {}
    __device__ __forceinline__ void done(const Unit&) const {}
};

__device__ __forceinline__ unsigned cvt_pk_bf16(float lo, float hi) { unsigned r; asm volatile("v_cvt_pk_bf16_f32 %0, %1, %2" : "=v"(r) : "v"(lo), "v"(hi)); return r; }
typedef float f32x2 __attribute__((ext_vector_type(2)));
__device__ __forceinline__ f32x2 gelu_pk(f32x2 v) {
    const f32x2 av = __builtin_elementwise_abs(v), d = av * 0.2316418882f + 1.0f;
    f32x2 t; t.x = __builtin_amdgcn_rcpf(d.x); t.y = __builtin_amdgcn_rcpf(d.y);
    f32x2 q = t * 0.5307027145f + (-0.7265760135f); q = q * t + 0.7107068705f; q = q * t + (-0.142248368f); q = q * t + 0.127414796f; q = q * t;
    const f32x2 s = (v * v) * (-0.72134752044f);
    f32x2 e; e.x = __builtin_amdgcn_exp2f(s.x); e.y = __builtin_amdgcn_exp2f(s.y);
    const f32x2 m = v * (q * e), r = v - m;
    f32x2 o; o.x = v.x < 0.f ? m.x : r.x; o.y = v.y < 0.f ? m.y : r.y; return o;
}

template <int ACT  > struct EpiBf16 {
    static constexpr bool PERM = true, AFTER_DRAIN = false; static_assert(ACT == 0 || ACT == 1, "EpiBf16: ACT is 0 (none) or 1 (gelu_pk)");
    bf16_t* O; int ldc; const float* bias; int split_cols; size_t split_stride; float scale0;
    __device__ __forceinline__ void operator()(const f32x4 (&acc)[2][2][4][2], const Unit& u, int wr, int wc, int fr, int fq) const {
        const int row0 = u.pm * BM + wr * 64 + fr; int colt = u.pn * BM; bf16_t* base = O;
        float sc = 1.f; if (split_cols) { const int t = colt / split_cols; base += (size_t)t * split_stride; colt -= t * split_cols; if (t == 0) sc = scale0; }
        const int col0 = colt + wc * 32 + 8 * fq, bcol0 = u.pn * BM + wc * 32 + 8 * fq;
        f32x4 bv[2][2];
#pragma unroll
        for (int bj = 0; bj < 2; ++bj)
#pragma unroll
            for (int n = 0; n < 2; ++n) bv[bj][n] = bias ? *(const f32x4*)(bias + bcol0 + bj * HALF + 4 * n) : (f32x4){0.f, 0.f, 0.f, 0.f};
#pragma unroll
        for (int ai = 0; ai < 2; ++ai)
#pragma unroll
            for (int m = 0; m < 4; ++m) { bf16_t* rowp = base + (size_t)(row0 + ai * HALF + m * 16) * ldc + col0;
#pragma unroll
                for (int bj = 0; bj < 2; ++bj) { f32x4 v0 = acc[ai][bj][m][0] + bv[bj][0], v1 = acc[ai][bj][m][1] + bv[bj][1];
                    if (ACT == 1) { f32x2 a = gelu_pk((f32x2){v0[0], v0[1]}), b = gelu_pk((f32x2){v0[2], v0[3]}), c = gelu_pk((f32x2){v1[0], v1[1]}), d = gelu_pk((f32x2){v1[2], v1[3]});
                        v0 = (f32x4){a.x, a.y, b.x, b.y}; v1 = (f32x4){c.x, c.y, d.x, d.y}; }
                    v0 = v0 * sc; v1 = v1 * sc; u32x4 w; w.x = cvt_pk_bf16(v0[0], v0[1]); w.y = cvt_pk_bf16(v0[2], v0[3]); w.z = cvt_pk_bf16(v1[0], v1[1]); w.w = cvt_pk_bf16(v1[2], v1[3]);
                    *(u32x4*)(rowp + bj * HALF) = w; } }
    }
};
__device__ __forceinline__ float sigm_f(float x) { return __builtin_amdgcn_rcpf(1.f + __builtin_amdgcn_exp2f(-1.4426950409f * x)); }
__device__ __forceinline__ float silu_f(float x) { return x * sigm_f(x); }
__device__ __forceinline__ f32x4 exp2_v(f32x4 x) { return (f32x4){__builtin_amdgcn_exp2f(x[0]), __builtin_amdgcn_exp2f(x[1]), __builtin_amdgcn_exp2f(x[2]), __builtin_amdgcn_exp2f(x[3])}; }
__device__ __forceinline__ f32x4 rcp_v(f32x4 x) { return (f32x4){__builtin_amdgcn_rcpf(x[0]), __builtin_amdgcn_rcpf(x[1]), __builtin_amdgcn_rcpf(x[2]), __builtin_amdgcn_rcpf(x[3])}; }
__device__ __forceinline__ f32x4 sigm_v(f32x4 x) { return rcp_v(1.f + exp2_v(x * -1.4426950409f)); }
__device__ __forceinline__ f32x4 swiglu_v(f32x4 a, f32x4 g, float sc) { const float k = 1.0f / (sc * sc); const f32x4 r = rcp_v(exp2_v(a * (-1.4426950409f * sc)) * k + k); return (a * g) * r; }
__device__ __forceinline__ f32x4 gelu_tanh_v(f32x4 x) { const f32x4 t = x * (x * x * (-2.3022082f * 0.044715f) + -2.3022082f); return x * rcp_v(1.f + exp2_v(t)); }
__device__ __forceinline__ float gelu_tanh_f(float x) { const float t = x * (1.f + 0.044715f * x * x); return x * __builtin_amdgcn_rcpf(1.f + __builtin_amdgcn_exp2f(-2.3022082f * t)); }

struct EpiWin {
    static constexpr bool PERM = true, AFTER_DRAIN = false;
    bf16_t *U, *V, *G; float* stats; float isc = 1.0f;
    __device__ __forceinline__ void operator()(const f32x4 (&acc)[2][2][4][2], const Unit& u, int wr, int wc, int fr, int fq) const {
        const int row0 = u.pm * BM + wr * 64 + fr;
        if (u.pn < 8) {
            bf16_t* base = (u.pn < 4) ? U : V; const int col0 = (u.pn & 3) * 256 + wc * 32 + 8 * fq;
#pragma unroll
            for (int ai = 0; ai < 2; ++ai)
#pragma unroll
                for (int m = 0; m < 4; ++m) { bf16_t* rowp = base + (size_t)(row0 + ai * HALF + m * 16) * 1024 + col0; f32x4 sv1 = (f32x4){0.f, 0.f, 0.f, 0.f}, sv2 = (f32x4){0.f, 0.f, 0.f, 0.f};
#pragma unroll
                    for (int bj = 0; bj < 2; ++bj) { const f32x4 g0 = gelu_tanh_v(acc[ai][bj][m][0] * isc), g1 = gelu_tanh_v(acc[ai][bj][m][1] * isc);
                        sv1 = sv1 + (g0 + g1); sv2 = sv2 + (g0 * g0 + g1 * g1);
                        u32x4 w; w.x = cvt_pk_bf16(g0[0], g0[1]); w.y = cvt_pk_bf16(g0[2], g0[3]); w.z = cvt_pk_bf16(g1[0], g1[1]); w.w = cvt_pk_bf16(g1[2], g1[3]);
                        *(u32x4*)(rowp + bj * HALF) = w; }
                    float s1 = (sv1[0] + sv1[1]) + (sv1[2] + sv1[3]), s2 = (sv2[0] + sv2[1]) + (sv2[2] + sv2[3]);
                    if (u.pn >= 4) { s1 += __shfl_xor(s1, 16); s1 += __shfl_xor(s1, 32); s2 += __shfl_xor(s2, 16); s2 += __shfl_xor(s2, 32);
                        if (fq == 0) { f32x2 sv; sv.x = s1; sv.y = s2; *(f32x2*)(stats + (size_t)(row0 + ai * HALF + m * 16) * 32 + ((u.pn - 4) * 4 + wc) * 2) = sv; } } }
        } else {
            const int col0 = (u.pn - 8) * 128 + wc * 32 + 8 * fq;
#pragma unroll
            for (int ai = 0; ai < 2; ++ai)
#pragma unroll
                for (int m = 0; m < 4; ++m) { bf16_t* rowp = G + (size_t)(row0 + ai * HALF + m * 16) * 1024 + col0;
                    const f32x4 a0 = acc[ai][0][m][0] * isc, a1 = acc[ai][0][m][1] * isc, g0 = acc[ai][1][m][0] * isc, g1 = acc[ai][1][m][1] * isc; u32x4 w;
                    const f32x4 y0 = a0 * sigm_v(g0), y1 = a1 * sigm_v(g1);
                    w.x = cvt_pk_bf16(y0[0], y0[1]); w.y = cvt_pk_bf16(y0[2], y0[3]); w.z = cvt_pk_bf16(y1[0], y1[1]); w.w = cvt_pk_bf16(y1[2], y1[3]);
                    *(u32x4*)rowp = w; }
        }
    }
};
struct EpiSwiGLU {
    static constexpr bool PERM = true, AFTER_DRAIN = false;
    bf16_t* T; int ldc; float gmul;
    __device__ __forceinline__ void operator()(const f32x4 (&acc)[2][2][4][2], const Unit& u, int wr, int wc, int fr, int fq) const {
#ifdef MK_SKIP_EPI
        if (gmul == 0.f) return;
#endif
        const int row0 = u.pm * BM + wr * 64 + fr; const int col0 = u.j * 128 + wc * 32 + 8 * fq;
#pragma unroll
        for (int ai = 0; ai < 2; ++ai)
#pragma unroll
            for (int m = 0; m < 4; ++m) { bf16_t* rowp = T + (size_t)(row0 + ai * HALF + m * 16) * ldc + col0;
                const f32x4 a0 = acc[ai][0][m][0], a1 = acc[ai][0][m][1], g0 = acc[ai][1][m][0], g1 = acc[ai][1][m][1]; u32x4 w;
                const f32x4 y0 = swiglu_v(a0, g0, 1.0f), y1 = swiglu_v(a1, g1, 1.0f);
                w.x = cvt_pk_bf16(y0[0], y0[1]); w.y = cvt_pk_bf16(y0[2], y0[3]); w.z = cvt_pk_bf16(y1[0], y1[1]); w.w = cvt_pk_bf16(y1[2], y1[3]);
                *(u32x4*)rowp = w; }
    }
};
struct EpiSwiGLU8 {
    static constexpr bool PERM = true, AFTER_DRAIN = false;
    unsigned char* T; int ldc; float isc;
    __device__ __forceinline__ void operator()(const f32x4 (&acc)[2][2][4][2], const Unit& u, int wr, int wc, int fr, int fq) const {
        const int row0 = u.pm * BM + wr * 64 + fr; const int col0 = u.j * 128 + wc * 32 + 8 * fq;
#pragma unroll
        for (int ai = 0; ai < 2; ++ai)
#pragma unroll
            for (int m = 0; m < 4; ++m) { unsigned char* rowp = T + (size_t)(row0 + ai * HALF + m * 16) * ldc + col0;
                const f32x4 y0 = swiglu_v(acc[ai][0][m][0], acc[ai][1][m][0], isc), y1 = swiglu_v(acc[ai][0][m][1], acc[ai][1][m][1], isc);
                int p0 = 0, p1 = 0;
                p0 = __builtin_amdgcn_cvt_pk_fp8_f32(y0[0], y0[1], p0, false); p0 = __builtin_amdgcn_cvt_pk_fp8_f32(y0[2], y0[3], p0, true);
                p1 = __builtin_amdgcn_cvt_pk_fp8_f32(y1[0], y1[1], p1, false); p1 = __builtin_amdgcn_cvt_pk_fp8_f32(y1[2], y1[3], p1, true);
                *(unsigned long long*)rowp = (unsigned long long)(unsigned)p0 | ((unsigned long long)(unsigned)p1 << 32); }
    }
};
struct EpiResid {
    static constexpr bool PERM = true, AFTER_DRAIN = false;
    bf16_t* X; const float* gate; float* PB; int rs0; float gmul; float psc = 1.0f;
    __device__ __forceinline__ void operator()(const f32x4 (&acc)[2][2][4][2], const Unit& u, int wr, int wc, int fr, int fq) const {
        const int col0 = u.pn * BM + wc * 32 + 8 * fq;
        if (u.e == 0) {
            const int mr = (u.pm < 64) ? (u.pm >> 3) : 8; const float* gp = gate + (size_t)mr * 6144;
            f32x4 gv[2][2];
#pragma unroll
            for (int bj = 0; bj < 2; ++bj)
#pragma unroll
                for (int n = 0; n < 2; ++n) gv[bj][n] = *(const f32x4*)(gp + col0 + bj * HALF + 4 * n) * gmul;
#pragma unroll
            for (int ai = 0; ai < 2; ++ai) { bf16_t* xb = X + (size_t)(u.pm * BM + ai * HALF + wr * 64 + fr) * 1024 + col0; u32x4 xv[4][2];
#pragma unroll
                for (int m = 0; m < 4; ++m)
#pragma unroll
                    for (int bj = 0; bj < 2; ++bj) xv[m][bj] = *(const u32x4*)(xb + (size_t)m * 16 * 1024 + bj * HALF);
                asm volatile("" ::: "memory");
#pragma unroll
                for (int m = 0; m < 4; ++m)
#pragma unroll
                    for (int bj = 0; bj < 2; ++bj) { const u32x4 x = xv[m][bj]; const f32x4 a0 = acc[ai][bj][m][0] * gv[bj][0], a1 = acc[ai][bj][m][1] * gv[bj][1]; u32x4 w;
                        w.x = cvt_pk_bf16(__uint_as_float(x.x << 16) + a0[0], __uint_as_float(x.x & 0xffff0000u) + a0[1]); w.y = cvt_pk_bf16(__uint_as_float(x.y << 16) + a0[2], __uint_as_float(x.y & 0xffff0000u) + a0[3]);
                        w.z = cvt_pk_bf16(__uint_as_float(x.z << 16) + a1[0], __uint_as_float(x.z & 0xffff0000u) + a1[1]); w.w = cvt_pk_bf16(__uint_as_float(x.w << 16) + a1[2], __uint_as_float(x.w & 0xffff0000u) + a1[3]);
                        *(u32x4*)(xb + (size_t)m * 16 * 1024 + bj * HALF) = w; }
                asm volatile("" ::: "memory"); }
        } else {
            bf16_t* pb = (bf16_t*)PB + (size_t)(u.e - 1) * 2048 * 1024;
#pragma unroll
            for (int ai = 0; ai < 2; ++ai)
#pragma unroll
                for (int m = 0; m < 4; ++m) { bf16_t* xp = pb + (size_t)(u.pm * BM + ai * HALF + wr * 64 + m * 16 + fr - rs0) * 1024 + col0;
#pragma unroll
                    for (int bj = 0; bj < 2; ++bj) { const f32x4 v0 = acc[ai][bj][m][0] * psc, v1 = acc[ai][bj][m][1] * psc; u32x4 w; w.x = cvt_pk_bf16(v0[0], v0[1]); w.y = cvt_pk_bf16(v0[2], v0[3]); w.z = cvt_pk_bf16(v1[0], v1[1]); w.w = cvt_pk_bf16(v1[2], v1[3]);
                        *(u32x4*)(xp + bj * HALF) = w; } }
        }
    }
};
struct EpiMoeDown {
    static constexpr bool PERM = true, AFTER_DRAIN = false;
    bf16_t* YS; const int* toklist; const float* tokwt; int cap; bf16_t* PB; int ps0, psrows; float osc;
    __device__ __forceinline__ void operator()(const f32x4 (&acc)[2][2][4][2], const Unit& u, int wr, int wc, int fr, int fq) const {
        const int col0 = u.j * BM + wc * 32 + 8 * fq;
        if (u.s > 0) {
#pragma unroll
            for (int ai = 0; ai < 2; ++ai)
#pragma unroll
                for (int m = 0; m < 4; ++m) { const int prow = u.pm * BM + ai * HALF + wr * 64 + m * 16 + fr; bf16_t* pp = PB + ((size_t)(u.s - 1) * psrows + (size_t)(prow - ps0)) * 1024 + col0;
#pragma unroll
                    for (int bj = 0; bj < 2; ++bj) { const f32x4 v0 = acc[ai][bj][m][0] * osc, v1 = acc[ai][bj][m][1] * osc; u32x4 w; w.x = cvt_pk_bf16(v0[0], v0[1]); w.y = cvt_pk_bf16(v0[2], v0[3]); w.z = cvt_pk_bf16(v1[0], v1[1]); w.w = cvt_pk_bf16(v1[2], v1[3]);
                        *(u32x4*)(pp + bj * HALF) = w; } }
            return; }
        int tsv[2][4]; float wv[2][4];
#pragma unroll
        for (int ai = 0; ai < 2; ++ai)
#pragma unroll
            for (int m = 0; m < 4; ++m) { const int pos = u.pl * BM + ai * HALF + wr * 64 + m * 16 + fr; const int tl = toklist[u.e * cap + pos]; wv[ai][m] = tokwt[u.e * cap + pos]; tsv[ai][m] = (pos < u.cn) ? tl : -1; }
        asm volatile("" ::: "memory");
#pragma unroll
        for (int ai = 0; ai < 2; ++ai)
#pragma unroll
            for (int m = 0; m < 4; ++m) { const int ts = tsv[ai][m]; const float w = wv[ai][m] * osc;
                if (ts >= 0) { bf16_t* yp = YS + (size_t)ts * 1024 + col0;
#pragma unroll
                    for (int bj = 0; bj < 2; ++bj) { const f32x4 v0 = acc[ai][bj][m][0] * w, v1 = acc[ai][bj][m][1] * w; u32x4 o; o.x = cvt_pk_bf16(v0[0], v0[1]); o.y = cvt_pk_bf16(v0[2], v0[3]); o.z = cvt_pk_bf16(v1[0], v1[1]); o.w = cvt_pk_bf16(v1[2], v1[3]);
                        *(u32x4*)(yp + bj * HALF) = o; } } }
    }
};
struct EpiQKV {
    static constexpr bool PERM = true, AFTER_DRAIN = false;
    bf16_t *Q, *K, *V; const float *qg, *kg, *rope; int nlat; float qsc, eps;
    __device__ __forceinline__ void operator()(const f32x4 (&acc)[2][2][4][2], const Unit& u, int wr, int wc, int fr, int fq) const {
        const int row0 = u.pm * BM + wr * 64 + fr;
        if (u.pn == 5) {
#pragma unroll
            for (int ai = 0; ai < 2; ++ai)
#pragma unroll
                for (int m = 0; m < 4; ++m) { bf16_t* rowp = V + (size_t)(row0 + ai * HALF + m * 16) * 256 + wc * 32 + 8 * fq;
#pragma unroll
                    for (int bj = 0; bj < 2; ++bj) { const f32x4 v0 = acc[ai][bj][m][0], v1 = acc[ai][bj][m][1]; u32x4 w; w.x = cvt_pk_bf16(v0[0], v0[1]); w.y = cvt_pk_bf16(v0[2], v0[3]); w.z = cvt_pk_bf16(v1[0], v1[1]); w.w = cvt_pk_bf16(v1[2], v1[3]);
                        *(u32x4*)(rowp + bj * HALF) = w; } }
        } else {
            const bool isq = u.pn < 4; const float* gp = isq ? qg : kg; const float osc = isq ? qsc : 1.0f;
            f32x4 gv[2][2];
#pragma unroll
            for (int bj = 0; bj < 2; ++bj)
#pragma unroll
                for (int n = 0; n < 2; ++n) gv[bj][n] = *(const f32x4*)(gp + 32 * bj + 16 * n + 4 * fq);
            const bool lat = u.pm * BM < nlat;
            f32x4 rA[2][2];
#pragma unroll
            for (int ai = 0; ai < 2; ++ai) { const float* tp = rope + ((((row0 + ai * HALF) & 2047) >> 6) * 16 + 4 * fq) * 2; rA[ai][0] = *(const f32x4*)tp; rA[ai][1] = *(const f32x4*)(tp + 4); }
#pragma unroll
            for (int m = 0; m < 4; ++m) { f32x4 rB[2];
                { const float* tp = rope + (((row0 + m * 16) & 63) * 16 + 4 * fq) * 2; rB[0] = *(const f32x4*)tp; rB[1] = *(const f32x4*)(tp + 4); }
#pragma unroll
                for (int ai = 0; ai < 2; ++ai) { const int row = row0 + ai * HALF + m * 16;
                    float ss = 0.f;
#pragma unroll
                    for (int bj = 0; bj < 2; ++bj)
#pragma unroll
                        for (int n = 0; n < 2; ++n) { const f32x4 x = acc[ai][bj][m][n]; ss += (x[0] * x[0] + x[1] * x[1]) + (x[2] * x[2] + x[3] * x[3]); }
                    ss += __shfl_xor(ss, 16); ss += __shfl_xor(ss, 32);
                    const float r = osc / sqrtf(ss * (1.0f / 64.0f) + eps);
                    f32x4 y[2][2];
#pragma unroll
                    for (int bj = 0; bj < 2; ++bj)
#pragma unroll
                        for (int n = 0; n < 2; ++n) y[bj][n] = acc[ai][bj][m][n] * r * gv[bj][n];
                    if (lat) {
#pragma unroll
                        for (int bj = 0; bj < 2; ++bj) { const f32x4 c01 = bj ? rB[0] : rA[ai][0], c23 = bj ? rB[1] : rA[ai][1];
                            const f32x4 cs = (f32x4){c01[0], c01[2], c23[0], c23[2]}, sn = (f32x4){c01[1], c01[3], c23[1], c23[3]};
                            const f32x4 a = y[bj][0], b = y[bj][1]; y[bj][0] = a * cs - b * sn; y[bj][1] = b * cs + a * sn; } }
                    bf16_t* dp = (isq ? Q + (size_t)row * 1024 + (4 * u.pn + wc) * 64 : K + (size_t)row * 256 + wc * 64) + 8 * fq;
#pragma unroll
                    for (int bj = 0; bj < 2; ++bj) { const f32x4 v0 = y[bj][0], v1 = y[bj][1]; u32x4 w; w.x = cvt_pk_bf16(v0[0], v0[1]); w.y = cvt_pk_bf16(v0[2], v0[3]); w.z = cvt_pk_bf16(v1[0], v1[1]); w.w = cvt_pk_bf16(v1[2], v1[3]);
                        *(u32x4*)(dp + 32 * bj) = w; } } }
        }
    }
};
template <class Epi, class Sched, bool ALIGN_EPI = false, bool SP2 = false, int NTC = 0, bool FP8 = false>
__device__ __forceinline__ void gemm_phase(PG8_LAS unsigned char* lds, const Gemm g, const Sched& S, const Epi& E) {
    int tid_ = threadIdx.x; asm volatile("" : "+v"(tid_));
    const int tid = tid_, wid = __builtin_amdgcn_readfirstlane(tid >> 6), lane = tid & 63, wr = wid >> 2, wc = wid & 3, fr = lane & 15, fq = lane >> 4;
    const int K = g.K;
    unsigned voffA[2], voffB[2];
#pragma unroll
    for (int i = 0; i < 2; ++i) { int R, C; stage_rc(tid * 16 + i * 8192, R, C); const int Rb = Epi::PERM ? ((R & ~31) + perm32(R & 31)) : R;
        voffA[i] = (unsigned)(R * K + C) * 2u; voffB[i] = (unsigned)(Rb * K + C) * 2u; }
    const size_t kstep = (size_t)(BK * 2);
    const size_t hstep = (size_t)HALF * K * 2;
    const size_t tstep = 2 * hstep;
    const unsigned ldsw = (unsigned)wid * 1024u;
    const int aoff = lds_byte(wr * 64 + fr, fq * 8), boff = lds_byte(wc * 32 + fr, fq * 8);
#define PG8_SA(b, h) (((b) * 2 + (h)) * HTB)
#define PG8_SB(b, h) ((4 + (b) * 2 + (h)) * HTB)
#define PG8_STAGE(bufoff, gbase, voff) do { _Pragma("unroll") for (int _i = 0; _i < 2; ++_i) \
        __builtin_amdgcn_global_load_lds((const unsigned*)((const char*)(gbase) + (voff)[_i]), (PG8_LAS unsigned*)(lds + (bufoff) + ldsw + _i * 8192), 16, 0, 0); } while (0)
#define PG8_LDA(dst, b, h) do { if constexpr (FP8) { _Pragma("unroll") for (int m = 0; m < 4; ++m) { const v4i32 l0_ = *(const PG8_LAS v4i32*)(lds + PG8_SA(b, h) + aoff + m * 2048), l1_ = *(const PG8_LAS v4i32*)(lds + PG8_SA(b, h) + aoff + m * 2048 + 1024); \
            dst##8[m] = __builtin_shufflevector(l0_, l1_, 0, 1, 2, 3, 4, 5, 6, 7); } } \
        else { _Pragma("unroll") for (int m = 0; m < 4; ++m) _Pragma("unroll") for (int k = 0; k < 2; ++k) dst[m][k] = *(const PG8_LAS bf16x8*)(lds + PG8_SA(b, h) + aoff + m * 2048 + k * 1024); } } while (0)
#define PG8_LDB(dst, b, h) do { if constexpr (FP8) { _Pragma("unroll") for (int n = 0; n < 2; ++n) { const v4i32 l0_ = *(const PG8_LAS v4i32*)(lds + PG8_SB(b, h) + boff + n * 2048), l1_ = *(const PG8_LAS v4i32*)(lds + PG8_SB(b, h) + boff + n * 2048 + 1024); \
            dst##8[n] = __builtin_shufflevector(l0_, l1_, 0, 1, 2, 3, 4, 5, 6, 7); } } \
        else { _Pragma("unroll") for (int n = 0; n < 2; ++n) _Pragma("unroll") for (int k = 0; k < 2; ++k) dst[n][k] = *(const PG8_LAS bf16x8*)(lds + PG8_SB(b, h) + boff + n * 2048 + k * 1024); } } while (0)
#define PG8_MMA(ai, bj, At, Bt) do { __builtin_amdgcn_s_setprio(1); \
        if constexpr (FP8) { asm volatile("s_nop 1"); _Pragma("unroll") for (int m = 0; m < 4; ++m) _Pragma("unroll") for (int n = 0; n < 2; ++n) \
            asm volatile("v_mfma_scale_f32_16x16x128_f8f6f4 %0, %1, %2, %0, %3, %3 op_sel_hi:[0,0,0]" : "+v"(acc[ai][bj][m][n]) : "v"(Bt##8[n]), "v"(At##8[m]), "v"(f8one)); } \
        else { _Pragma("unroll") for (int m = 0; m < 4; ++m) _Pragma("unroll") for (int n = 0; n < 2; ++n) _Pragma("unroll") for (int k = 0; k < 2; ++k) \
            acc[ai][bj][m][n] = __builtin_amdgcn_mfma_f32_16x16x32_bf16(Bt[n][k], At[m][k], acc[ai][bj][m][n], 0, 0, 0); } \
        __builtin_amdgcn_s_setprio(0); } while (0)
#define PG8_WAIT_V(n) asm volatile("s_waitcnt vmcnt(" #n ")" ::: "memory")
#define PG8_WAIT_L(n) asm volatile("s_waitcnt lgkmcnt(" #n ")" ::: "memory")
#define PG8_BAR __builtin_amdgcn_s_barrier()
#define PG8_SCHED __builtin_amdgcn_sched_barrier(0)
    Unit cur, nxt; int ui = 0;
    if (!S.next(0, cur)) return;
    f32x4 acc[2][2][4][2];
#pragma unroll
    for (int a = 0; a < 2; ++a)
#pragma unroll
        for (int b = 0; b < 2; ++b)
#pragma unroll
            for (int m = 0; m < 4; ++m)
#pragma unroll
                for (int n = 0; n < 2; ++n) acc[a][b][m][n] = (f32x4){0.f, 0.f, 0.f, 0.f};
    bf16x8 At[4][2], B0[2][2], B1[2][2];
    const int f8one = 0x7f7f7f7f;
    v8i32 At8[4], B08[2], B18[2];
    const char* cA = (const char*)g.A + (size_t)cur.pa * tstep + (size_t)cur.k0 * 2; const char* cB = (const char*)g.Bt + (size_t)cur.pn * tstep + (size_t)cur.k0 * 2;
    S.a_ready(cur);
    if constexpr (SP2) {
        PG8_STAGE(PG8_SB(0, 0), cB, voffB); PG8_STAGE(PG8_SB(0, 1), cB + hstep, voffB); PG8_STAGE(PG8_SA(0, 0), cA, voffA); PG8_STAGE(PG8_SA(0, 1), cA + hstep, voffA);
        if (wr == 1) PG8_BAR;
        PG8_WAIT_V(2); PG8_BAR;
        PG8_STAGE(PG8_SB(1, 0), cB + kstep, voffB); PG8_STAGE(PG8_SA(1, 0), cA + kstep, voffA); PG8_STAGE(PG8_SB(1, 1), cB + hstep + kstep, voffB);
        PG8_WAIT_V(6); PG8_BAR;
    } else {
        PG8_STAGE(PG8_SB(0, 0), cB, voffB); PG8_STAGE(PG8_SA(0, 0), cA, voffA); PG8_STAGE(PG8_SB(0, 1), cB + hstep, voffB); PG8_STAGE(PG8_SA(0, 1), cA + hstep, voffA);
        if (wr == 1) PG8_BAR;
        PG8_WAIT_V(4); PG8_BAR;
        PG8_STAGE(PG8_SB(1, 0), cB + kstep, voffB); PG8_STAGE(PG8_SA(1, 0), cA + kstep, voffA); PG8_STAGE(PG8_SB(1, 1), cB + hstep + kstep, voffB);
        PG8_WAIT_V(6); PG8_BAR;
    }
    for (;;) {
        const bool has_next = S.next(ui + 1, nxt);
        const char* nA = has_next ? (const char*)g.A + (size_t)nxt.pa * tstep + (size_t)nxt.k0 * 2 : cA; const char* nB = has_next ? (const char*)g.Bt + (size_t)nxt.pn * tstep + (size_t)nxt.k0 * 2 : cB;
        const int nt = NTC ? NTC : cur.nt;
#pragma unroll 1
        for (int t = 0; t < nt; t += 2) {
            const bool last = (t == nt - 2);
            const char* a1 = cA + (size_t)(t + 1) * kstep;
            const char* a2 = last ? nA : cA + (size_t)(t + 2) * kstep; const char* b2 = last ? nB : cB + (size_t)(t + 2) * kstep;
            const char* a3 = a2 + kstep; const char* b3 = b2 + kstep;
            if (last && has_next) S.a_ready(nxt);
            if constexpr (SP2) {
            PG8_LDB(B0, 0, 0); PG8_LDB(B1, 0, 1); PG8_SCHED; PG8_LDA(At, 0, 0); PG8_STAGE(PG8_SA(1, 1), a1 + hstep, voffA);
            PG8_WAIT_V(8); PG8_WAIT_L(0); PG8_BAR; PG8_MMA(0, 0, At, B0); PG8_MMA(0, 1, At, B1); PG8_BAR; PG8_SCHED;
            PG8_LDA(At, 0, 1); PG8_STAGE(PG8_SB(0, 0), b2, voffB); PG8_STAGE(PG8_SB(0, 1), b2 + hstep, voffB); PG8_STAGE(PG8_SA(0, 0), a2, voffA);
            PG8_WAIT_V(8); PG8_WAIT_L(0); PG8_BAR; PG8_MMA(1, 0, At, B0); PG8_MMA(1, 1, At, B1); PG8_BAR; PG8_SCHED;
            PG8_LDB(B0, 1, 0); PG8_LDB(B1, 1, 1); PG8_SCHED; PG8_LDA(At, 1, 0); PG8_STAGE(PG8_SA(0, 1), a2 + hstep, voffA);
            PG8_WAIT_V(8); PG8_WAIT_L(0); PG8_BAR; PG8_MMA(0, 0, At, B0); PG8_MMA(0, 1, At, B1); PG8_BAR; PG8_SCHED;
            PG8_LDA(At, 1, 1); PG8_STAGE(PG8_SB(1, 0), b3, voffB); PG8_STAGE(PG8_SB(1, 1), b3 + hstep, voffB); PG8_STAGE(PG8_SA(1, 0), a3, voffA);
            PG8_WAIT_V(8); PG8_WAIT_L(0); PG8_BAR; PG8_MMA(1, 0, At, B0); PG8_MMA(1, 1, At, B1); PG8_BAR; PG8_SCHED;
            } else {
            PG8_LDB(B0, 0, 0); PG8_SCHED; PG8_LDA(At, 0, 0); PG8_STAGE(PG8_SA(1, 1), a1 + hstep, voffA);
            PG8_WAIT_L(8); PG8_BAR; PG8_WAIT_L(0); PG8_MMA(0, 0, At, B0); PG8_BAR; PG8_SCHED;
            PG8_LDB(B1, 0, 1); PG8_STAGE(PG8_SB(0, 0), b2, voffB);
            PG8_BAR; PG8_WAIT_L(0); PG8_MMA(0, 1, At, B1); PG8_BAR;
            PG8_LDA(At, 0, 1); PG8_STAGE(PG8_SA(0, 0), a2, voffA);
            PG8_BAR; PG8_WAIT_L(0); PG8_MMA(1, 0, At, B0); PG8_BAR; PG8_SCHED;
            PG8_STAGE(PG8_SB(0, 1), b2 + hstep, voffB);
            PG8_WAIT_V(6); PG8_BAR; PG8_MMA(1, 1, At, B1); PG8_BAR;
            PG8_LDB(B0, 1, 0); PG8_SCHED; PG8_LDA(At, 1, 0); PG8_STAGE(PG8_SA(0, 1), a2 + hstep, voffA);
            PG8_WAIT_L(8); PG8_BAR; PG8_WAIT_L(0); PG8_MMA(0, 0, At, B0); PG8_BAR; PG8_SCHED;
            PG8_LDB(B1, 1, 1); PG8_STAGE(PG8_SB(1, 0), b3, voffB);
            PG8_BAR; PG8_WAIT_L(0); PG8_MMA(0, 1, At, B1); PG8_BAR;
            PG8_LDA(At, 1, 1); PG8_STAGE(PG8_SA(1, 0), a3, voffA);
            PG8_BAR; PG8_WAIT_L(0); PG8_MMA(1, 0, At, B0); PG8_BAR; PG8_SCHED;
            PG8_STAGE(PG8_SB(1, 1), b3 + hstep, voffB);
            PG8_WAIT_V(6); PG8_BAR; PG8_MMA(1, 1, At, B1); PG8_BAR;
            }
        }
        if constexpr (ALIGN_EPI) { if (wr == 0) PG8_BAR; }
        if constexpr (FP8) { asm volatile("s_nop 15\n\ts_nop 15\n\ts_nop 15\n\ts_nop 15" ::: "memory"); }
        if constexpr (!Epi::AFTER_DRAIN) { E(acc, cur, wr, wc, fr, fq); S.done(cur); }
        if (!has_next) break;
#pragma unroll
        for (int a = 0; a < 2; ++a)
#pragma unroll
            for (int b = 0; b < 2; ++b)
#pragma unroll
                for (int m = 0; m < 4; ++m)
#pragma unroll
                    for (int n = 0; n < 2; ++n) acc[a][b][m][n] = (f32x4){0.f, 0.f, 0.f, 0.f};
        cur = nxt; cA = nA; cB = nB; ++ui;
        if constexpr (ALIGN_EPI) { if (wr == 1) PG8_BAR; }
    }
    PG8_WAIT_V(0);
    if constexpr (!ALIGN_EPI) { if (wr == 0) PG8_BAR; }
    PG8_BAR;
    if constexpr (Epi::AFTER_DRAIN) { E.fused(acc, cur, wr, wc, fr, fq, lds, wid, lane); S.done(cur); }
#undef PG8_SA
#undef PG8_SB
#undef PG8_STAGE
#undef PG8_LDA
#undef PG8_LDB
#undef PG8_MMA
#undef PG8_WAIT_V
#undef PG8_WAIT_L
#undef PG8_BAR
#undef PG8_SCHED
}
}
#define GAS __attribute__((address_space(1)))
#define LAS __attribute__((address_space(3)))
typedef unsigned short bf16;
typedef unsigned v4u __attribute__((ext_vector_type(4)));
typedef float f32x4 __attribute__((ext_vector_type(4)));
typedef short bf16x8 __attribute__((ext_vector_type(8)));
typedef GAS unsigned gu32;
typedef GAS unsigned long long gu64;
#define RLX_AGENT __ATOMIC_RELAXED, __HIP_MEMORY_SCOPE_AGENT
#define LDS_WAIT() asm volatile("s_waitcnt lgkmcnt(0)" ::: "memory")
#define VM_WAIT() asm volatile("s_waitcnt vmcnt(0)" ::: "memory")
__device__ __forceinline__ unsigned long long rt() { return __builtin_amdgcn_s_memrealtime(); }
__device__ __forceinline__ unsigned f2bf(float f) { unsigned u = __builtin_bit_cast(unsigned, f); return (u + 0x7fffu + ((u >> 16) & 1u)) >> 16; }
__device__ __forceinline__ unsigned pk2(float lo, float hi) { return f2bf(lo) | (f2bf(hi) << 16); }

#define XB_TMO      128
#define XB_XCNT(j)  (256  + 64 * (j))
#define XB_XSUB(j)  (1280 + 64 * (j))
#define XB_XGEN(j)  (2304 + 64 * (j))
#define XB_TOP      3328
#define XB_TOPGEN   3392
#define XCD_BAR_WORDS 3456
#define XB_SPIN_CAP (1u << 18)

__device__ __forceinline__ unsigned xb_ld(unsigned* p)              { return __hip_atomic_load(p, __ATOMIC_RELAXED, __HIP_MEMORY_SCOPE_AGENT); }
__device__ __forceinline__ unsigned xb_add(unsigned* p, unsigned v) { return __hip_atomic_fetch_add(p, v, __ATOMIC_RELAXED, __HIP_MEMORY_SCOPE_AGENT); }
__device__ __forceinline__ unsigned xb_xcc_id() { return (unsigned)__builtin_amdgcn_s_getreg((3 << 11) | 20) & 0xFu; }
#define XB_SPIN(cond, bar) do { unsigned _sp = 0; while (cond) { __builtin_amdgcn_s_sleep(1); \
    if ((++_sp & 255u) == 0u) { if (xb_ld(&(bar)[XB_TMO])) break; if (_sp > XB_SPIN_CAP) { atomicAdd(&(bar)[XB_TMO], 1u); break; } } } } while (0)

struct XcdBarrier {
    unsigned* bar; unsigned x;
    volatile LAS unsigned* st;
};

__device__ __forceinline__ XcdBarrier xcd_barrier_post(unsigned* bar, volatile LAS unsigned* st) {
    XcdBarrier b; b.bar = bar; b.x = xb_xcc_id(); b.st = st;
    if (threadIdx.x == 0) (void)xb_add(&bar[XB_XCNT(b.x)], 1u);
    return b;
}
__device__ __forceinline__ void xcd_barrier_complete(unsigned* bar, unsigned x, unsigned& nloc, unsigned& nx) {
    const unsigned G = gridDim.x * gridDim.y * gridDim.z;
    unsigned sum, cnt, mine, sp = 0u;
    for (;;) {
        sum = 0u; cnt = 0u; mine = 0u;
#pragma unroll
        for (unsigned j = 0; j < 16; ++j) { const unsigned c = xb_ld(&bar[XB_XCNT(j)]); sum += c; cnt += (c > 0u) ? 1u : 0u; mine = (j == x) ? c : mine; }
        if (sum == G) break;
        __builtin_amdgcn_s_sleep(1);
        if ((++sp & 255u) == 0u) { if (xb_ld(&bar[XB_TMO])) break; if (sp > XB_SPIN_CAP) { atomicAdd(&bar[XB_TMO], 1u); break; } }
    }
    nloc = mine > 0u ? mine : 1u; nx = cnt > 0u ? cnt : 1u;
}

__device__ __forceinline__ void xcd_barrier(const XcdBarrier& b) {
    asm volatile("s_waitcnt vmcnt(0)" ::: "memory");
    __syncthreads();
    if (threadIdx.x == 0) {
        unsigned* bar = b.bar;
        __builtin_amdgcn_s_waitcnt(0);
        unsigned nloc = b.st[0], nx = b.st[1];
        if (nloc == 0u) { xcd_barrier_complete(bar, b.x, nloc, nx); b.st[0] = nloc; b.st[1] = nx; }
        const unsigned old = xb_add(&bar[XB_XSUB(b.x)], 1u);
        const unsigned gen = old / nloc;
        if (old + 1u == (gen + 1u) * nloc) {
            __builtin_amdgcn_fence(__ATOMIC_RELEASE, "agent");
            asm volatile("s_waitcnt vmcnt(0)" ::: "memory");
            const unsigned og = xb_add(&bar[XB_TOP], 1u);
            const unsigned tg = og / nx;
            if (og + 1u == (tg + 1u) * nx) xb_add(&bar[XB_TOPGEN], 1u);
            else XB_SPIN(xb_ld(&bar[XB_TOPGEN]) == tg, bar);
            __builtin_amdgcn_fence(__ATOMIC_ACQUIRE, "agent");
            xb_add(&bar[XB_XGEN(b.x)], 1u);
            asm volatile("s_waitcnt vmcnt(0)" ::: "memory");
        } else {
            XB_SPIN(xb_ld(&bar[XB_XGEN(b.x)]) == gen, bar);
            __builtin_amdgcn_fence(__ATOMIC_ACQUIRE, "agent");
            asm volatile("s_waitcnt vmcnt(0)" ::: "memory");
        }
    }
    __syncthreads();
}
constexpr int NWAVES = 8;
#ifndef MK_PER_PHASE
#define MK_PER_PHASE 0
#endif
constexpr int D = 1024, NB = 8, SEQ = 2048, CTXL = 256, ML = NB * SEQ, MC = NB * CTXL, MT = ML + MC;
constexpr int FF = 3584, NE = 8;
constexpr float EPS = 1e-6f;
constexpr float LOG2E = 1.4426950408889634f;
constexpr float QSCALE = 0.125f * LOG2E;
#ifndef MK_FP8_WIN2
#define MK_FP8_WIN2 1
#endif
#ifndef MK_FP8_FFN2
#define MK_FP8_FFN2 1
#endif
constexpr float F8_W13 = 32.0f, F8_W2 = 64.0f;
constexpr int N_PHASES = 34;
constexpr size_t MiB = 1u << 20;
constexpr size_t WS_CTL = 0, CTL_ZERO_BYTES = 1 * MiB;
constexpr size_t WS_MOD = 1 * MiB;
constexpr size_t WS_ROPE = 2 * MiB;
constexpr size_t WS_WSB = 2 * MiB + 65536;
constexpr size_t WS_TOKI = 3 * MiB;
constexpr size_t WS_TOKW = 3 * MiB + 524288;
constexpr int CAP = MT;
constexpr size_t WS_TOKLIST = 4 * MiB;
constexpr size_t WS_TOKWT = 4 * MiB + 655360;
constexpr size_t WS_STATS = 5 * MiB + 524288;
constexpr size_t WS_WIN = 8 * MiB, WS_WOUT = 24 * MiB, WS_WQKV = 32 * MiB, WS_WO = 38 * MiB, WS_FF13 = 42 * MiB, WS_FF2 = 70 * MiB;
constexpr size_t WS_MOE13 = 84 * MiB, WS_MOE2 = 196 * MiB;
constexpr size_t WS_X = 252 * MiB;
constexpr size_t WS_H = 324 * MiB;
constexpr size_t WS_R = 360 * MiB;
constexpr size_t WS_U = WS_R, WS_V = WS_R + 36 * MiB, WS_G = WS_R + 72 * MiB, WS_YAB = WS_R + 108 * MiB;
constexpr size_t WS_QKV = WS_R, WS_Q = WS_R + 54 * MiB, WS_K = WS_R + 90 * MiB, WS_O = WS_R + 99 * MiB;
constexpr size_t WS_T = WS_R;
constexpr size_t WS_HP = WS_R, WS_TP = WS_R + 144 * MiB, WS_YS = WS_R + 342 * MiB;
constexpr size_t WS_PB = WS_R + 414 * MiB;
constexpr size_t WS_END = WS_PB + 64 * MiB;
constexpr int CW_TMO = 0, CW_CODE = 1, CW_CNT = 64, CW_BAR = 4096;
constexpr int RING_OFF = 0;
constexpr int LDSCTL_OFF = 143360, MISC_OFF = LDSCTL_OFF + 64;
constexpr int LDS_BYTES = 147456;
__constant__ float INVF[16] = {1.0f, 0.5623413324356079f, 0.3162277638912201f, 0.17782793939113617f, 0.10000000149011612f, 0.05623413249850273f, 0.03162277489900589f, 0.017782794311642647f,
    0.009999999776482582f, 0.005623413249850273f, 0.003162277629598975f, 0.0017782794311642647f, 0.0010000000474974513f, 0.000562341301701963f, 0.0003162277571391314f, 0.00017782794020604342f};

typedef unsigned v2u __attribute__((ext_vector_type(2)));
struct Args { const float* in[29]; float* out; unsigned char* ws; int ph_lo, ph_hi; float gmul; int pad; };
struct Frame { LAS unsigned char* lds; volatile LAS unsigned* MISC; gu32* ctl; int tid, lane, wave, G, bid; };

__device__ __forceinline__ float wave_sum(float v) {
#pragma unroll
    for (int o = 1; o < 64; o <<= 1) v += __shfl_xor(v, o);
    return v;
}
__device__ __forceinline__ float bf2f(unsigned short b) { return __uint_as_float((unsigned)b << 16); }
__device__ __forceinline__ float bflo(unsigned w) { return __uint_as_float(w << 16); }
__device__ __forceinline__ float bfhi(unsigned w) { return __uint_as_float(w & 0xffff0000u); }
__device__ __forceinline__ unsigned pkbf(float lo, float hi) { return pg8::cvt_pk_bf16(lo, hi); }
__device__ __forceinline__ float fsigm(float x) { return pg8::sigm_f(x); }
__device__ __forceinline__ unsigned pk4f8(float a, float b, float c, float d) { int p = 0; p = __builtin_amdgcn_cvt_pk_fp8_f32(a, b, p, false); p = __builtin_amdgcn_cvt_pk_fp8_f32(c, d, p, true); return (unsigned)p; }

__device__ __forceinline__ int dst_row(int mode, int n) {
    if (mode == 0) return n;
    if (mode == 1) return ((n >> 7) << 8) + (n & 127);
    if (mode == 2) return ((n >> 7) << 8) + 128 + (n & 127);
    if (mode == 4) { if (n >= 1280) return n;
        const int tile = n >> 8, r = n & 255, wc = r >> 6, d = r & 63, bj = d >> 5, dh = d & 31, nn = dh >> 4, fq = (dh & 15) >> 2, e = dh & 3; return (tile << 8) + 128 * bj + 32 * wc + 8 * fq + 4 * nn + e; }
    if (n < 2048) return n;
    if (n < 3072) { const int j = n - 2048; return 2048 + ((j >> 7) << 8) + (j & 127); }
    { const int j = n - 3072; return 2048 + ((j >> 7) << 8) + 128 + (j & 127); }
}
struct ConvDesc { const float* W; bf16* WT; int N, K, mode, item; float f8s; };
__device__ __forceinline__ void conv_ld(const ConvDesc& d, int lane, f32x4 (&r)[16]) {
    const int nblk = d.N >> 6, kb = d.item / nblk, nb = d.item - kb * nblk, k0 = kb << 6, n0 = nb << 6; const int c4 = (lane & 15) << 2, kr = lane >> 4;
#pragma unroll
    for (int i = 0; i < 16; ++i) r[i] = __builtin_nontemporal_load((const GAS f32x4*)(d.W + (size_t)(k0 + 4 * i + kr) * d.N + n0 + c4));
}
__device__ __forceinline__ void conv_st(const ConvDesc& d, LAS float* scr, int lane, const f32x4 (&r)[16]) {
    const int nblk = d.N >> 6, kb = d.item / nblk, nb = d.item - kb * nblk, k0 = kb << 6, n0 = nb << 6; const int c4 = (lane & 15) << 2, kr = lane >> 4;
#pragma unroll
    for (int i = 0; i < 16; ++i) { LAS float* s = scr + (4 * i + kr) * 65 + c4; s[0] = r[i].x; s[1] = r[i].y; s[2] = r[i].z; s[3] = r[i].w; }
    LDS_WAIT(); asm volatile("" ::: "memory");
    if (d.f8s != 0.f) {
        const float sc = d.f8s; unsigned char* W8 = (unsigned char*)d.WT;
#pragma unroll
        for (int jj = 0; jj < 4; ++jj) { const int id = lane + 64 * jj, n = id >> 2, c = id & 3; const LAS float* s = scr + (16 * c) * 65 + n; v4u o;
            o.x = pk4f8(s[0] * sc, s[65] * sc, s[130] * sc, s[195] * sc); o.y = pk4f8(s[260] * sc, s[325] * sc, s[390] * sc, s[455] * sc);
            o.z = pk4f8(s[520] * sc, s[585] * sc, s[650] * sc, s[715] * sc); o.w = pk4f8(s[780] * sc, s[845] * sc, s[910] * sc, s[975] * sc);
            *(GAS v4u*)(W8 + (size_t)dst_row(d.mode, n0 + n) * d.K + k0 + 16 * c) = o; }
    } else {
    const int c = lane & 7;
#pragma unroll
    for (int jj = 0; jj < 8; ++jj) { const int n = (lane >> 3) + 8 * jj; const LAS float* s = scr + (8 * c) * 65 + n;
        v4u o; o.x = pkbf(s[0], s[65]); o.y = pkbf(s[130], s[195]); o.z = pkbf(s[260], s[325]); o.w = pkbf(s[390], s[455]);
        *(GAS v4u*)(d.WT + (size_t)dst_row(d.mode, n0 + n) * d.K + k0 + 8 * c) = o; }
    }
    LDS_WAIT(); asm volatile("" ::: "memory");
}
__device__ __forceinline__ ConvDesc dec_nonmoe(const Args& a, int it) {
    ConvDesc d; d.f8s = 0.f; const int j = it / 4864; int r = it - j * 4864; const bool f8 = MK_FP8_FFN2 && (j == 1);
    if (r < 1024) { d.W = a.in[8] + (size_t)j * 1024 * 4096; d.N = 4096; d.K = 1024; d.mode = 3; d.WT = (bf16*)(a.ws + WS_WIN) + (size_t)j * 4096 * 1024; if (MK_FP8_WIN2 && j == 1) d.f8s = F8_W13; }
    else if ((r -= 1024) < 512) { d.W = a.in[16] + (size_t)j * 2048 * 1024; d.N = 1024; d.K = 2048; d.mode = 0; d.WT = (bf16*)(a.ws + WS_WOUT) + (size_t)j * 1024 * 2048; }
    else if ((r -= 512) < 384) { d.W = a.in[17] + (size_t)j * 1024 * 1536; d.N = 1536; d.K = 1024; d.mode = 4; d.WT = (bf16*)(a.ws + WS_WQKV) + (size_t)j * 1536 * 1024; }
    else if ((r -= 384) < 256) { d.W = a.in[21] + (size_t)j * 1024 * 1024; d.N = 1024; d.K = 1024; d.mode = 0; d.WT = (bf16*)(a.ws + WS_WO) + (size_t)j * 1024 * 1024; }
    else if ((r -= 256) < 896) { d.W = a.in[22] + (size_t)j * 1024 * 3584; d.N = 3584; d.K = 1024; d.mode = 1; d.WT = (bf16*)(a.ws + WS_FF13) + (size_t)j * 7168 * 1024; if (f8) d.f8s = F8_W13; }
    else if ((r -= 896) < 896) { d.W = a.in[23] + (size_t)j * 1024 * 3584; d.N = 3584; d.K = 1024; d.mode = 2; d.WT = (bf16*)(a.ws + WS_FF13) + (size_t)j * 7168 * 1024; if (f8) d.f8s = F8_W13; }
    else { r -= 896; d.W = a.in[24] + (size_t)j * 3584 * 1024; d.N = 1024; d.K = 3584; d.mode = 0; d.WT = (bf16*)(a.ws + WS_FF2) + (size_t)j * 1024 * 3584; if (f8) d.f8s = F8_W2; }
    d.item = r; return d;
}
__device__ __forceinline__ ConvDesc dec_moe(const Args& a, int jm, int sel, int it) {
    ConvDesc d; const int per = (sel == 0) ? 2688 : (sel == 1 ? 1792 : 896);
    const int e = it / per; int r = it - e * per; if (sel == 2) r += 1792;
    const size_t eo = (size_t)(jm * 8 + e);
    unsigned char* m13 = a.ws + WS_MOE13 + (size_t)e * 7168 * 1024; unsigned char* m2 = a.ws + WS_MOE2 + (size_t)e * 1024 * 3584;
    if (r < 896) { d.W = a.in[26] + eo * 1024 * 3584; d.N = 3584; d.K = 1024; d.mode = 1; d.WT = (bf16*)m13; d.f8s = F8_W13; }
    else if ((r -= 896) < 896) { d.W = a.in[27] + eo * 1024 * 3584; d.N = 3584; d.K = 1024; d.mode = 2; d.WT = (bf16*)m13; d.f8s = F8_W13; }
    else { r -= 896; d.W = a.in[28] + eo * 3584 * 1024; d.N = 1024; d.K = 3584; d.mode = 0; d.WT = (bf16*)m2; d.f8s = F8_W2; }
    d.item = r; return d;
}
__device__ __forceinline__ void conv_run(const Args& a, int n_non, int jm, int sel, int moe_lo, int moe_hi, int gw, int NGW, LAS float* scr, int lane) {
    const int total = n_non + ((moe_hi > moe_lo) ? moe_hi - moe_lo : 0);
    if (gw >= total) return;
    ConvDesc cur = (gw < n_non) ? dec_nonmoe(a, gw) : dec_moe(a, jm, sel, gw - n_non + moe_lo);
    f32x4 r[16]; conv_ld(cur, lane, r);
    for (int it = gw; it < total; it += NGW) {
        const int nx = it + NGW; ConvDesc nxt = cur; f32x4 rn[16];
        if (nx < total) { nxt = (nx < n_non) ? dec_nonmoe(a, nx) : dec_moe(a, jm, sel, nx - n_non + moe_lo); conv_ld(nxt, lane, rn); }
        conv_st(cur, scr, lane, r);
        if (nx < total) {
#pragma unroll
            for (int i = 0; i < 16; ++i) r[i] = rn[i];
            cur = nxt; }
    }
}
__device__ __forceinline__ int moe_items(int sel) { return 8 * ((sel == 0) ? 2688 : (sel == 1 ? 1792 : 896)); }
struct TailPlan { int nl[4]; int e[5]; };
__device__ __forceinline__ int last_round_units(int n, int G) { const int r = n % G; return r == 0 ? G : r; }
__device__ __forceinline__ void tail_plan(int G, int att_units, TailPlan& t) {
    t.nl[0] = last_round_units((MT / 256) * 16, G); t.nl[1] = last_round_units((MT / 256) * 28, G); t.nl[2] = last_round_units((MT / 256) * 6, G); t.nl[3] = last_round_units(att_units, G);
    const int quota[4] = {3, 3, 4, 1}; t.e[0] = 0;
#pragma unroll
    for (int k = 0; k < 4; ++k) t.e[k + 1] = t.e[k] + (G - t.nl[k]) * NWAVES * quota[k];
}
__device__ __forceinline__ void tail_fill(const Args& a, Frame& F, const TailPlan& t, int k, int jm, int sel, int wid = -1) {
    const int me = (wid >= 0) ? wid : F.bid;
    const int nl = t.nl[k]; if (me < nl || nl >= F.G) return;
    const int tot = moe_items(sel), lo = t.e[k] < tot ? t.e[k] : tot, hi = t.e[k + 1] < tot ? t.e[k + 1] : tot;
    __syncthreads();
    conv_run(a, 0, jm, sel, lo, hi, (me - nl) * NWAVES + F.wave, (F.G - nl) * NWAVES, (LAS float*)(F.lds + F.wave * 16640), F.lane);
}
__device__ __forceinline__ void conv_moe_all(const Args& a, Frame& F, int jm, int sel, int w0, int nw, int wid = -1, int lo = 0, int hi = -1) {
    const int me = (wid >= 0) ? wid : F.bid;
    if (me < w0 || me >= w0 + nw) return;
    conv_run(a, 0, jm, sel, lo, (hi < 0) ? moe_items(sel) : hi, (me - w0) * NWAVES + F.wave, nw * NWAVES, (LAS float*)(F.lds + F.wave * 16640), F.lane);
}
__device__ __forceinline__ void sincos_d(double x, double& s, double& c) {
    const double TWO_PI = 6.283185307179586476925286766559;
    const double k = __builtin_rint(x / TWO_PI); const double r = x - k * TWO_PI, r2 = r * r;
    double ts = r, ss = r, tc = 1.0, cs = 1.0;
#pragma unroll 1
    for (int n = 1; n <= 14; ++n) { tc = -tc * r2 / (double)((2 * n - 1) * (2 * n)); cs += tc; ts = -ts * r2 / (double)((2 * n) * (2 * n + 1)); ss += ts; }
    s = ss; c = cs;
}
__device__ __forceinline__ void prologue_phase(const Args& a, Frame& F) {
    const int gw = F.bid * NWAVES + F.wave, NGW = F.G * NWAVES;
    {
        LAS float* sc = (LAS float*)F.lds; LAS float* red = sc + 9 * 1024;
        { float cv[18];
#pragma unroll
          for (int q = 0; q < 18; ++q) { const int i = F.tid + q * (NWAVES * 64); cv[q] = (q < 16) ? a.in[1][i] : a.in[3][i - 8192]; }
#pragma unroll
          for (int q = 0; q < 18; ++q) { const int i = F.tid + q * (NWAVES * 64); sc[i] = cv[q] * fsigm(cv[q]); } }
        __syncthreads();
        float* MOD = (float*)(a.ws + WS_MOD);
        for (int job = F.bid; job < 768; job += F.G) {
            const int li = job / 192, nb = job - li * 192; const int cl = F.tid & 31, kg = F.tid >> 5;
            const float* w = a.in[4] + (size_t)li * 1024 * 6144 + (size_t)(kg * 64) * 6144 + nb * 32 + cl;
            float acc[9];
#pragma unroll
            for (int r = 0; r < 9; ++r) acc[r] = 0.f;
            float wv[2][16];
#pragma unroll
            for (int i = 0; i < 16; ++i) wv[0][i] = __builtin_nontemporal_load(w + (size_t)i * 6144);
#pragma unroll
            for (int kq = 0; kq < 4; ++kq) { const int kb = 16 * kq;
                if (kq < 3) {
#pragma unroll
                    for (int i = 0; i < 16; ++i) wv[(kq + 1) & 1][i] = __builtin_nontemporal_load(w + (size_t)(kb + 16 + i) * 6144); }
#pragma unroll
                for (int i4 = 0; i4 < 4; ++i4)
#pragma unroll
                    for (int r = 0; r < 9; ++r) { const f32x4 sv = *(const LAS f32x4*)(sc + r * 1024 + kg * 64 + kb + 4 * i4);
                        acc[r] += (sv[0] * wv[kq & 1][4 * i4] + sv[1] * wv[kq & 1][4 * i4 + 1]) + (sv[2] * wv[kq & 1][4 * i4 + 2] + sv[3] * wv[kq & 1][4 * i4 + 3]); } }
#pragma unroll
            for (int r = 0; r < 9; ++r) red[(kg * 9 + r) * 32 + cl] = acc[r];
            __syncthreads();
            for (int o = F.tid; o < 9 * 32; o += NWAVES * 64) { const int r = o >> 5, c = o & 31; float sum = 0.f;
#pragma unroll
                for (int g = 0; g < 16; ++g) sum += red[(g * 9 + r) * 32 + c];
                MOD[(size_t)(li * 9 + r) * 6144 + nb * 32 + c] = sum + a.in[5][li * 6144 + nb * 32 + c]; }
            __syncthreads();
        }
    }
    {
        const int gt = F.bid * (NWAVES * 64) + F.tid, NT = F.G * NWAVES * 64;
        if (gt < 1024) { const int pos = gt >> 4, i = gt & 15; const float ang = (float)pos * INVF[i]; double s, c; sincos_d((double)ang, s, c);
            float* rp = (float*)(a.ws + WS_ROPE) + gt * 2; rp[0] = (float)c; rp[1] = (float)s; }
        bf16* wsb = (bf16*)(a.ws + WS_WSB);
        for (int i = gt; i < 2 * 8 * 128 * 128 / 2; i += NT) { const float2 v = *(const float2*)(a.in[11] + 2 * i); *(unsigned*)(wsb + 2 * i) = pkbf(v.x, v.y); }
    }
    __syncthreads();
    { TailPlan tp; tail_plan(F.G, 1152, tp); const int tot = moe_items(0), lo = tp.e[4] < tot ? tp.e[4] : tot;
      conv_run(a, 2 * 4864, 0, 0, lo, tot, gw, NGW, (LAS float*)(F.lds + F.wave * 16640), F.lane); }
}

__device__ __forceinline__ void norm_row_core(const float* xsrc32, const bf16* xsrc16, bf16* xdst, const bf16* ys, const float* g2p, const float* gn, const float* scp, const float* shp, bf16* hdst, int lane, f32x4 (&h)[4],
                                              const float* pbp = nullptr, int nS = 0, const float* pgp = nullptr, bool h8 = false) {
    f32x4 v[4], gq[4], scq[4], shq[4];
#pragma unroll
    for (int j = 0; j < 4; ++j) { gq[j] = *(const GAS f32x4*)(gn + 4 * lane + 256 * j); scq[j] = *(const GAS f32x4*)(scp + 4 * lane + 256 * j); shq[j] = *(const GAS f32x4*)(shp + 4 * lane + 256 * j); }
    if (xsrc32) {
#pragma unroll
        for (int j = 0; j < 4; ++j) v[j] = __builtin_nontemporal_load((const GAS f32x4*)(xsrc32 + 4 * lane + 256 * j));
    } else {
#pragma unroll
        for (int j = 0; j < 4; ++j) { const v2u x = *(const GAS v2u*)(xsrc16 + 4 * lane + 256 * j); v[j] = (f32x4){bflo(x.x), bfhi(x.x), bflo(x.y), bfhi(x.y)}; }
    }
    if (pbp) {
        f32x4 ps[4];
#pragma unroll
        for (int j = 0; j < 4; ++j) ps[j] = (f32x4){0.f, 0.f, 0.f, 0.f};
        f32x4 pg[4];
#pragma unroll
        for (int j = 0; j < 4; ++j) pg[j] = *(const GAS f32x4*)(pgp + 4 * lane + 256 * j);
        v2u pq[8][4];
#pragma unroll
        for (int q = 0; q < 8; ++q) { const int qq = q < nS ? q : nS - 1;
#pragma unroll
            for (int j = 0; j < 4; ++j) pq[q][j] = *(const GAS v2u*)((const bf16*)pbp + (size_t)qq * 2048 * 1024 + 4 * lane + 256 * j); }
#pragma unroll
        for (int q = 0; q < 8; ++q) if (q < nS) {
#pragma unroll
            for (int j = 0; j < 4; ++j) ps[j] = ps[j] + (f32x4){bflo(pq[q][j].x), bfhi(pq[q][j].x), bflo(pq[q][j].y), bfhi(pq[q][j].y)}; }
#pragma unroll
        for (int j = 0; j < 4; ++j) v[j] = v[j] + pg[j] * ps[j];
    }
    if (ys) {
#pragma unroll
        for (int j = 0; j < 4; ++j) { const v2u y0 = *(const GAS v2u*)(ys + 4 * lane + 256 * j), y1 = *(const GAS v2u*)(ys + 1024 + 4 * lane + 256 * j); const f32x4 g = *(const GAS f32x4*)(g2p + 4 * lane + 256 * j);
            v[j].x += g.x * (bflo(y0.x) + bflo(y1.x)); v[j].y += g.y * (bfhi(y0.x) + bfhi(y1.x)); v[j].z += g.z * (bflo(y0.y) + bflo(y1.y)); v[j].w += g.w * (bfhi(y0.y) + bfhi(y1.y)); }
    }
    if (xdst) {
#pragma unroll
        for (int j = 0; j < 4; ++j) { v2u o; o.x = pkbf(v[j].x, v[j].y); o.y = pkbf(v[j].z, v[j].w); *(GAS v2u*)(xdst + 4 * lane + 256 * j) = o; }
    }
    float ss = 0.f;
#pragma unroll
    for (int j = 0; j < 4; ++j) ss += (v[j].x * v[j].x + v[j].y * v[j].y) + (v[j].z * v[j].z + v[j].w * v[j].w);
    const float r = 1.0f / sqrtf(wave_sum(ss) * (1.0f / 1024.0f) + EPS);
#pragma unroll
    for (int j = 0; j < 4; ++j) { const f32x4 g = gq[j], sc = scq[j], sh = shq[j];
        h[j] = (v[j] * r) * g * (sc + 1.0f) + sh;
        if (h8) { *(GAS unsigned*)((unsigned char*)hdst + 4 * lane + 256 * j) = pk4f8(h[j].x, h[j].y, h[j].z, h[j].w); }
        else { v2u o; o.x = pkbf(h[j].x, h[j].y); o.y = pkbf(h[j].z, h[j].w); *(GAS v2u*)(hdst + 4 * lane + 256 * j) = o; } }
}
__device__ __forceinline__ void norm_phase(const Args& a, Frame& F, int li, int which, int nrows, bool src_in, int pend_li, int nS = 0, int rs0 = 0, const float* pgate = nullptr, bool h8 = false) {
    const int gw = F.bid * NWAVES + F.wave, NGW = F.G * NWAVES;
    bf16* X = (bf16*)(a.ws + WS_X); bf16* H = (bf16*)(a.ws + WS_H); const float* MOD = (const float*)(a.ws + WS_MOD); const bf16* YS = (const bf16*)(a.ws + WS_YS);
    const float* gn = (which == 0 ? a.in[6] : a.in[7]) + li * 1024;
    for (int row = gw; row < nrows; row += NGW) {
        const int mr = (row < ML) ? (row >> 11) : 8;
        const float* mp = MOD + (size_t)(li * 9 + mr) * 6144 + (which ? 3 * 1024 : 0);
        const float* xs = src_in ? ((row < ML) ? a.in[0] + (size_t)row * 1024 : a.in[2] + (size_t)(row - ML) * 1024) : nullptr;
        const bool part = (nS > 0) && (row >= rs0);
        const bool wx = src_in || (pend_li >= 0) || part;
        f32x4 h[4];
        norm_row_core(xs, X + (size_t)row * 1024, wx ? X + (size_t)row * 1024 : nullptr, (pend_li >= 0) ? YS + (size_t)row * 2048 : nullptr, MOD + (size_t)((pend_li >= 0 ? pend_li : 0) * 9 + mr) * 6144 + 5 * 1024,
                      gn, mp + 1024, mp, h8 ? (bf16*)((unsigned char*)H + (size_t)row * 1024) : H + (size_t)row * 1024, F.lane, h, part ? (const float*)((const bf16*)(a.ws + WS_PB) + (size_t)(row - rs0) * 1024) : nullptr, nS, part ? pgate + (size_t)mr * 6144 : nullptr, h8);
    }
}
__device__ __forceinline__ void norm_router_phase(const Args& a, Frame& F, int li, int nrows, int nS, int rs0, const float* pgate) {
    constexpr int RPW = 72;
    bf16* X = (bf16*)(a.ws + WS_X); bf16* H = (bf16*)(a.ws + WS_H); const float* MOD = (const float*)(a.ws + WS_MOD);
    int4* TOKI = (int4*)(a.ws + WS_TOKI); float2* TOKW = (float2*)(a.ws + WS_TOKW); int* TOKLIST = (int*)(a.ws + WS_TOKLIST); float* TOKWT = (float*)(a.ws + WS_TOKWT); unsigned char* HP8 = a.ws + WS_HP;
    const int jm = li >> 1;
    LAS float* Rt = (LAS float*)F.lds;
    LAS int* lcnt = (LAS int*)(F.lds + 32768);
    LAS int* lbase = (LAS int*)(F.lds + 32768 + 64);
    LAS int* rinfo = (LAS int*)(F.lds + 32768 + 128);
    LAS float* rwt = (LAS float*)(F.lds + 32768 + 128 + 72 * 16);
    const float* router = a.in[25] + (size_t)jm * 1024 * 8;
    for (int i = F.tid; i < 8192; i += NWAVES * 64) { const int col = i >> 3, e = i & 7; Rt[e * 1024 + col] = router[i]; }
    if (F.tid < 8) lcnt[F.tid] = 0;
    __syncthreads();
    const float* gn = a.in[7] + li * 1024;
    gu32* CNT = F.ctl + CW_CNT + 16 * jm;
    for (int base = F.bid * RPW; base < nrows; base += F.G * RPW) {
        for (int i = 0; i < 9; ++i) {
            const int lr = F.wave * 9 + i, row = base + lr;
            if (row < nrows) {
                const int mr = (row < ML) ? (row >> 11) : 8; const float* mp = MOD + (size_t)(li * 9 + mr) * 6144 + 3 * 1024;
                f32x4 h[4];
                const bool part = (nS > 0) && (row >= rs0);
                norm_row_core(nullptr, X + (size_t)row * 1024, part ? X + (size_t)row * 1024 : nullptr, nullptr, nullptr, gn, mp + 1024, mp, (bf16*)((unsigned char*)H + (size_t)row * 1024), F.lane, h,
                              part ? (const float*)((const bf16*)(a.ws + WS_PB) + (size_t)(row - rs0) * 1024) : nullptr, nS, part ? pgate + (size_t)mr * 6144 : nullptr, true);
                float lg[8];
#pragma unroll
                for (int e = 0; e < 8; ++e) { float p = 0.f;
#pragma unroll
                    for (int j = 0; j < 4; ++j) { const f32x4 rv = *(const LAS f32x4*)(Rt + e * 1024 + 4 * F.lane + 256 * j); p += (h[j].x * rv.x + h[j].y * rv.y) + (h[j].z * rv.z + h[j].w * rv.w); }
                    lg[e] = wave_sum(p); }
                int i0 = 0; float l0 = lg[0];
#pragma unroll
                for (int e = 1; e < 8; ++e) if (lg[e] > l0) { l0 = lg[e]; i0 = e; }
                int i1 = -1; float l1 = -3.0e38f;
#pragma unroll
                for (int e = 0; e < 8; ++e) if (e != i0 && lg[e] > l1) { l1 = lg[e]; i1 = e; }
                const float w0 = 1.0f / (1.0f + __expf(l1 - l0)), w1 = 1.0f - w0;
                if (F.lane == 0) { const int r0 = __hip_atomic_fetch_add(lcnt + i0, 1, __ATOMIC_RELAXED, __HIP_MEMORY_SCOPE_WORKGROUP), r1 = __hip_atomic_fetch_add(lcnt + i1, 1, __ATOMIC_RELAXED, __HIP_MEMORY_SCOPE_WORKGROUP);
                    rinfo[lr * 4 + 0] = i0; rinfo[lr * 4 + 1] = i1; rinfo[lr * 4 + 2] = r0; rinfo[lr * 4 + 3] = r1; rwt[lr * 2] = w0; rwt[lr * 2 + 1] = w1; }
            }
        }
        __syncthreads();
        if (F.tid < 8) { const int c = lcnt[F.tid]; lbase[F.tid] = (int)__hip_atomic_fetch_add(CNT + F.tid, (unsigned)c, RLX_AGENT); lcnt[F.tid] = 0; }
        __syncthreads();
        if (F.tid < RPW) { const int row = base + F.tid; if (row < nrows) { const int e0 = rinfo[F.tid * 4], e1 = rinfo[F.tid * 4 + 1];
            const int p0 = lbase[e0] + rinfo[F.tid * 4 + 2], p1 = lbase[e1] + rinfo[F.tid * 4 + 3]; const float w0 = rwt[F.tid * 2], w1 = rwt[F.tid * 2 + 1];
            TOKI[row] = make_int4(e0 | (e1 << 8), p0, p1, 0); TOKW[row] = make_float2(w0, w1);
            TOKLIST[e0 * CAP + p0] = row * 2; TOKWT[e0 * CAP + p0] = w0; TOKLIST[e1 * CAP + p1] = row * 2 + 1; TOKWT[e1 * CAP + p1] = w1; } }
        { v4u qv[9];
#pragma unroll
          for (int i = 0; i < 9; ++i) { const int row = base + F.wave * 9 + i, rc = row < nrows ? row : nrows - 1; qv[i] = *((const GAS v4u*)((const unsigned char*)H + (size_t)rc * 1024) + F.lane); }
#pragma unroll
          for (int i = 0; i < 9; ++i) { const int lr = F.wave * 9 + i, row = base + lr;
            if (row < nrows) { const int e0 = rinfo[lr * 4], e1 = rinfo[lr * 4 + 1]; const int p0 = lbase[e0] + rinfo[lr * 4 + 2], p1 = lbase[e1] + rinfo[lr * 4 + 3];
                *((GAS v4u*)(HP8 + ((size_t)e0 * CAP + p0) * 1024) + F.lane) = qv[i]; *((GAS v4u*)(HP8 + ((size_t)e1 * CAP + p1) * 1024) + F.lane) = qv[i]; } } }
        __syncthreads();
    }
}
struct MoeSeg { int np[8]; int pst[9]; int cnt[8]; };
__device__ __forceinline__ void moe_seg(Frame& F, int jm, MoeSeg& s) {
    gu32* CNT = F.ctl + CW_CNT + 16 * jm; int acc = 0;
    const int cl = (int)__hip_atomic_load(CNT + (F.lane & 7), RLX_AGENT);
#pragma unroll
    for (int e = 0; e < 8; ++e) { const int c = __builtin_amdgcn_readlane(cl, e); s.cnt[e] = c; s.np[e] = (c + 255) >> 8; s.pst[e] = acc; acc += s.np[e]; }
    s.pst[8] = acc;
}
__device__ __forceinline__ int seg_start(const MoeSeg& s, int e) { int r = 0;
#pragma unroll
    for (int q = 0; q < 8; ++q) r += (q < e) ? s.np[q] : 0;
    return r; }
struct MoeOrder {
    int pst[9]; int cnt[8]; int nt, G, c, ntk; bool apan;
    int F_, R, S;
    __device__ __forceinline__ void no_split() { F_ = 0x7fffffff; R = 0; S = 1; }
    __device__ __forceinline__ void split_tail() { const int U = pst[8] * nt; F_ = (U / G) * G; R = U - F_; S = 1;
        if (R > 0) { S = (R * 7 <= G) ? 7 : (R * 2 <= G) ? 2 : 1; } if (S == 1) no_split(); }
    __device__ __forceinline__ int ps0() const { return (R > 0) ? (F_ / nt) * 256 : 0x7fffffff; }
    __device__ __forceinline__ int psrows() const { return (R > 0) ? ((R + nt - 1) / nt) * 256 : 0; }
    __device__ __forceinline__ bool next(int i, pg8::Unit& u) const {
        const int vc = (G % 8 == 0) ? (c % 8) * (G / 8) + c / 8 : c;
        const int L = i * G + vc; const int U = pst[8] * nt; const bool full = L < F_; const int q = L - F_;
        if (full ? (L >= U) : (q >= R * S)) return false;
        const int t2 = q / S, sp = q - t2 * S, nts = ntk / S; const int tile = full ? L : F_ + t2;
        const int nig = 8 * nt, grp = tile / nig, rr = tile - grp * nig, fm = grp * 8, gsz = (pst[8] - fm < 8) ? pst[8] - fm : 8;
        const int j = rr / gsz, p = fm + (rr - j * gsz); int e = 0;
#pragma unroll
        for (int q2 = 1; q2 < 8; ++q2) e += (p >= pst[q2]) ? 1 : 0;
        int ps = 0, cn = 0;
#pragma unroll
        for (int q2 = 0; q2 < 8; ++q2) { ps = (q2 == e) ? pst[q2] : ps; cn = (q2 == e) ? cnt[q2] : cn; }
        u.pm = p; u.e = e; u.j = j; u.pn = e * nt + j; u.k0 = full ? 0 : sp * nts * 64; u.nt = full ? ntk : nts; u.s = full ? 0 : sp + 1; u.pl = p - ps; u.cn = cn;
        u.pa = apan ? e * (CAP / 256) + (p - ps) : p; return true;
    }
    __device__ __forceinline__ void a_ready(const pg8::Unit&) const {}
    __device__ __forceinline__ void done(const pg8::Unit&) const {}
};

struct SplitOrder {
    int F_, R, S, ntk, G, vc;
    __device__ __forceinline__ void init(int M, int K, int G_, int c) { const int T = (M >> 8) * 4; G = G_; F_ = (T / G) * G; R = T - F_; ntk = K >> 6; vc = (G % 8 == 0) ? (c % 8) * (G / 8) + c / 8 : c;
        S = 1; if (R > 0) { const int want = (K == 3584 || K == 1792) ? 7 : (K == 2048 ? 8 : 4);   if (R * want <= G) S = want; } }
    __device__ __forceinline__ bool next(int i, pg8::Unit& u) const { const int L = i * G + vc; const bool full = L < F_; const int q = L - F_;
        if (!full && q >= R * S) return false;
        const int t2 = q / S, sp = q - t2 * S, nts = ntk / S; const int tile = full ? L : F_ + t2;
        u.e = full ? 0 : sp + 1; u.nt = full ? ntk : nts; u.k0 = full ? 0 : sp * nts * 64; u.pm = tile >> 2; u.pn = tile & 3; u.j = tile & 3; u.s = 0; u.pa = u.pm; u.pl = 0; u.cn = 0; return true; }
    __device__ __forceinline__ int nsplit() const { return R > 0 ? S : 0; }
    __device__ __forceinline__ int rs0() const { return (F_ >> 2) << 8; }
    __device__ __forceinline__ void a_ready(const pg8::Unit&) const {}
    __device__ __forceinline__ void done(const pg8::Unit&) const {}
};

__device__ __forceinline__ void gate_units(const Args& a, Frame& F, int j, int ubeg, int uend) {
    typedef short s16x4 __attribute__((ext_vector_type(4)));
    LAS float* stat = (LAS float*)F.lds;
    LAS bf16* VL = (LAS bf16*)(F.lds + 1024);
    LAS bf16* WSl = (LAS bf16*)(F.lds + 1024 + 34816);
    const bf16* U = (const bf16*)(a.ws + WS_U); const bf16* V = (const bf16*)(a.ws + WS_V); bf16* YAB = (bf16*)(a.ws + WS_YAB); const bf16* WSB = (const bf16*)(a.ws + WS_WSB);
    const float* STATS = (const float*)(a.ws + WS_STATS);
    const int lane = F.lane, w = F.wave, li15 = lane & 15, lq = lane >> 4, pr = 16 * w + li15;
    if (ubeg >= uend) return;
    v4u raw[4], wsv[4], uu[4]; float bsv; f32x4 lnv[4];
#define GT_LOAD(u_) do { const int n_ = (u_) >> 3, g_ = (u_) & 7, r0_ = n_ * 128; \
        _Pragma("unroll") for (int i = 0; i < 4; ++i) { const int idx = F.tid + 512 * i, p = idx >> 4, c8 = (idx & 15) << 3; \
            wsv[i] = *(const GAS v4u*)(WSB + ((size_t)((j * 8 + g_) * 128 + p)) * 128 + c8); raw[i] = *(const GAS v4u*)(V + (size_t)(r0_ + p) * 1024 + g_ * 128 + c8); } \
        _Pragma("unroll") for (int n2 = 0; n2 < 4; ++n2) uu[n2] = *(const GAS v4u*)(U + (size_t)(r0_ + pr) * 1024 + g_ * 128 + 32 * n2 + 8 * lq); \
        bsv = a.in[12][j * 1024 + g_ * 128 + pr]; \
        { const float* lg_ = a.in[9] + j * 1024 + g_ * 128 + ((F.tid & 15) << 3); const float* lb_ = a.in[10] + j * 1024 + g_ * 128 + ((F.tid & 15) << 3); \
          lnv[0] = *(const GAS f32x4*)lg_; lnv[1] = *(const GAS f32x4*)(lg_ + 4); lnv[2] = *(const GAS f32x4*)lb_; lnv[3] = *(const GAS f32x4*)(lb_ + 4); } } while (0)
    GT_LOAD(ubeg);
    int cur_n = -1;
    for (int u = ubeg; u < uend; ++u) {
        const int n = u >> 3, g = u & 7, r0 = n * 128;
        if (n != cur_n) { cur_n = n;
            if (F.tid < 128) { const float* sp = STATS + (size_t)(r0 + F.tid) * 32; float s1 = 0.f, s2 = 0.f;
#pragma unroll
                for (int i = 0; i < 8; ++i) { const f32x4 v = *(const GAS f32x4*)(sp + 4 * i); s1 += v.x + v.z; s2 += v.y + v.w; }
                const float mean = s1 * (1.0f / 1024.0f), var = s2 * (1.0f / 1024.0f) - mean * mean; stat[2 * F.tid] = mean; stat[2 * F.tid + 1] = 1.0f / sqrtf(fmaxf(var, 0.f) + EPS); } }
#pragma unroll
        for (int i = 0; i < 4; ++i) { const int idx = F.tid + 512 * i, p = idx >> 4, c8 = (idx & 15) << 3; *(LAS v4u*)(WSl + p * 136 + c8) = wsv[i]; }
        __syncthreads();
#pragma unroll
        for (int i = 0; i < 4; ++i) { const int idx = F.tid + 512 * i, p = idx >> 4, c8 = (idx & 15) << 3; const float mean = stat[2 * p], rstd = stat[2 * p + 1];
            const f32x4 ga = lnv[0], gb = lnv[1], ba = lnv[2], bb = lnv[3];
            v4u o; o.x = pkbf((bflo(raw[i].x) - mean) * rstd * ga.x + ba.x, (bfhi(raw[i].x) - mean) * rstd * ga.y + ba.y); o.y = pkbf((bflo(raw[i].y) - mean) * rstd * ga.z + ba.z, (bfhi(raw[i].y) - mean) * rstd * ga.w + ba.w);
            o.z = pkbf((bflo(raw[i].z) - mean) * rstd * gb.x + bb.x, (bfhi(raw[i].z) - mean) * rstd * gb.y + bb.y); o.w = pkbf((bflo(raw[i].w) - mean) * rstd * gb.z + bb.z, (bfhi(raw[i].w) - mean) * rstd * gb.w + bb.w);
            { const int g2 = c8 >> 5, a4 = ((c8 & 31) >> 3) << 2; v2u lo2, hi2; lo2.x = o.x; lo2.y = o.y; hi2.x = o.z; hi2.y = o.w;
              *(LAS v2u*)(VL + p * 136 + 32 * g2 + a4) = lo2; *(LAS v2u*)(VL + p * 136 + 32 * g2 + 16 + a4) = hi2; } }
        v4u cu[4]; const float cb = bsv;
#pragma unroll
        for (int n2 = 0; n2 < 4; ++n2) cu[n2] = uu[n2];
        __syncthreads();
        if (u + 1 < uend) GT_LOAD(u + 1);
        f32x4 acc[8];
#pragma unroll
        for (int nt = 0; nt < 8; ++nt) acc[nt] = (f32x4){0.f, 0.f, 0.f, 0.f};
#pragma unroll
        for (int ks = 0; ks < 4; ++ks) { const bf16x8 wf = *(const LAS bf16x8*)(WSl + pr * 136 + 32 * ks + 8 * lq);
#pragma unroll
            for (int nt = 0; nt < 8; ++nt) { const LAS bf16* vp = VL + (32 * ks + 8 * lq + (li15 >> 2)) * 136 + 16 * nt + 4 * (li15 & 3);
                const s16x4 lo = __builtin_bit_cast(s16x4, __builtin_amdgcn_ds_read_tr16_b64_v4i16((LAS s16x4*)vp));
                const s16x4 hi = __builtin_bit_cast(s16x4, __builtin_amdgcn_ds_read_tr16_b64_v4i16((LAS s16x4*)(vp + 4 * 136)));
                const bf16x8 vf = __builtin_shufflevector(lo, hi, 0, 1, 2, 3, 4, 5, 6, 7);
                acc[nt] = __builtin_amdgcn_mfma_f32_16x16x32_bf16(vf, wf, acc[nt], 0, 0, 0); } }
#pragma unroll
        for (int n2 = 0; n2 < 4; ++n2) { const f32x4 a0 = acc[2 * n2], a1 = acc[2 * n2 + 1]; const v4u uv = cu[n2]; v4u o;
            o.x = pkbf(bflo(uv.x) * (a0[0] + cb), bfhi(uv.x) * (a0[1] + cb)); o.y = pkbf(bflo(uv.y) * (a0[2] + cb), bfhi(uv.y) * (a0[3] + cb));
            o.z = pkbf(bflo(uv.z) * (a1[0] + cb), bfhi(uv.z) * (a1[1] + cb)); o.w = pkbf(bflo(uv.w) * (a1[2] + cb), bfhi(uv.w) * (a1[3] + cb));
            *(GAS v4u*)(YAB + (size_t)(r0 + pr) * 2048 + g * 128 + 32 * n2 + 8 * lq) = o; }
        __syncthreads();
    }
#undef GT_LOAD
}
__device__ __forceinline__ int seq_lo(int r) { return (r < ML) ? (r & ~2047) : (ML + ((r - ML) & ~255)); }
__device__ __forceinline__ void conv_phase(const Args& a, Frame& F, int j) {
    LAS float* wl = (LAS float*)F.lds;
    LAS float* cbl = wl + 31 * 1024;
    LAS float* cgl = cbl + 1024;
    const bf16* G = (const bf16*)(a.ws + WS_G); bf16* YAB = (bf16*)(a.ws + WS_YAB);
    __syncthreads();
    { f32x4 wv[16];
#pragma unroll
      for (int q = 0; q < 16; ++q) { const int i = F.tid + q * (NWAVES * 64); wv[q] = *(const GAS f32x4*)(a.in[13] + (size_t)j * 31 * 1024 + 4 * (i < 31 * 256 ? i : 31 * 256 - 1)); }
#pragma unroll
      for (int q = 0; q < 16; ++q) { const int i = F.tid + q * (NWAVES * 64); if (i < 31 * 256) *(LAS f32x4*)(wl + 4 * i) = wv[q]; } }
    if (F.tid < 256) { *(LAS f32x4*)(cbl + 4 * F.tid) = *(const GAS f32x4*)(a.in[14] + j * 1024 + 4 * F.tid); *(LAS f32x4*)(cgl + 4 * F.tid) = *(const GAS f32x4*)(a.in[15] + j * 1024 + 4 * F.tid); }
    __syncthreads();
    const int lane = F.lane, gw = F.bid * NWAVES + F.wave, NGW = F.G * NWAVES;
#define CV_LOAD(dst, ri, cbase) do { const int row_ = r0 - 15 + (ri); const int rc_ = row_ < lo ? lo : (row_ >= hi ? hi - 1 : row_); dst = *(const GAS v4u*)((const GAS char*)G + (size_t)rc_ * 2048 + (unsigned)((cbase) * 2)); } while (0)
#define CV_UNPACK(src, ri, d) do { const int row_ = r0 - 15 + (ri); const unsigned mk_ = (row_ >= lo && row_ < hi) ? 0xffffffffu : 0u; const unsigned x0_ = src.x & mk_, x1_ = src.y & mk_, x2_ = src.z & mk_, x3_ = src.w & mk_; \
        d[0] = (f32x4){bflo(x0_), bfhi(x0_), bflo(x1_), bfhi(x1_)}; d[1] = (f32x4){bflo(x2_), bfhi(x2_), bflo(x3_), bfhi(x3_)}; } while (0)
    const int UPW = (MT / 6 + F.G - 1) / F.G;
    for (int iu = F.wave; iu < UPW; iu += NWAVES) { const int u = F.bid * UPW + iu; if (u >= MT / 6) break;
        const int r0 = 6 * u; const int loA = seq_lo(r0), loB = seq_lo(r0 + 5); const int npass = (loA != loB) ? 2 : 1;
        for (int pass = 0; pass < npass; ++pass) {
            const int lo = pass ? loB : loA, hi = lo + ((lo < ML) ? 2048 : 256);
            f32x4 acc[2][6][2];
#pragma unroll
            for (int h = 0; h < 2; ++h) {
                int cbase = 512 * h + 8 * lane; asm volatile("" : "+v"(cbase));
                const f32x4 b0 = *(const LAS f32x4*)(cbl + cbase), b1 = *(const LAS f32x4*)(cbl + cbase + 4);
#pragma unroll
                for (int t = 0; t < 6; ++t) { acc[h][t][0] = b0; acc[h][t][1] = b1; }
                f32x4 ring[6][2]; v4u T[6];
                { v4u a[5];
#pragma unroll
                  for (int i = 0; i < 5; ++i) CV_LOAD(a[i], i, cbase);
#pragma unroll
                  for (int s2 = 0; s2 < 6; ++s2) CV_LOAD(T[s2], s2 + 5, cbase);
#pragma unroll
                  for (int i = 0; i < 5; ++i) CV_UNPACK(a[i], i, ring[i]); }
#pragma unroll 1
                for (int it = 0; it < 5; ++it) {
#pragma unroll
                    for (int s2 = 0; s2 < 6; ++s2) { const int k = 6 * it + s2;
                        CV_UNPACK(T[s2], k + 5, ring[(s2 + 5) % 6]);
                        CV_LOAD(T[s2], 6 * (it + 1) + s2 + 5, cbase);
                        const f32x4 w0 = *(const LAS f32x4*)(wl + k * 1024 + cbase), w1 = *(const LAS f32x4*)(wl + k * 1024 + cbase + 4);
#pragma unroll
                        for (int t = 0; t < 6; ++t) { acc[h][t][0] = acc[h][t][0] + ring[(s2 + t) % 6][0] * w0; acc[h][t][1] = acc[h][t][1] + ring[(s2 + t) % 6][1] * w1; }
                        __builtin_amdgcn_sched_barrier(0); }
                }
                { CV_UNPACK(T[0], 35, ring[5]);
                  const f32x4 w0 = *(const LAS f32x4*)(wl + 30 * 1024 + cbase), w1 = *(const LAS f32x4*)(wl + 30 * 1024 + cbase + 4);
#pragma unroll
                  for (int t = 0; t < 6; ++t) { acc[h][t][0] = acc[h][t][0] + ring[t][0] * w0; acc[h][t][1] = acc[h][t][1] + ring[t][1] * w1; } }
            }
#pragma unroll
            for (int t = 0; t < 6; ++t) { float ss = 0.f;
#pragma unroll
                for (int h = 0; h < 2; ++h)
#pragma unroll
                    for (int q = 0; q < 2; ++q) { const f32x4 v = acc[h][t][q]; ss += (v.x * v.x + v.y * v.y) + (v.z * v.z + v.w * v.w); }
                const float r = 1.0f / sqrtf(wave_sum(ss) * (1.0f / 1024.0f) + EPS); const int row = r0 + t;
                if (row >= lo && row < hi) {
#pragma unroll
                    for (int h = 0; h < 2; ++h) { int cbase = 512 * h + 8 * lane; asm volatile("" : "+v"(cbase)); const f32x4 g0 = *(const LAS f32x4*)(cgl + cbase), g1 = *(const LAS f32x4*)(cgl + cbase + 4);
                        const f32x4 y0 = acc[h][t][0] * r * g0, y1 = acc[h][t][1] * r * g1; v4u o;
                        o.x = pkbf(y0.x * fsigm(y0.x), y0.y * fsigm(y0.y)); o.y = pkbf(y0.z * fsigm(y0.z), y0.w * fsigm(y0.w)); o.z = pkbf(y1.x * fsigm(y1.x), y1.y * fsigm(y1.y)); o.w = pkbf(y1.z * fsigm(y1.z), y1.w * fsigm(y1.w));
                        *(GAS v4u*)(YAB + (size_t)row * 2048 + 1024 + cbase) = o; } } }
        }
    }
#undef CV_LOAD
#undef CV_UNPACK
    __syncthreads();
}
__device__ __forceinline__ void mix_phase(const Args& a, Frame& F, int j) {
#ifndef MK_GATE_REP
#define MK_GATE_REP 1
#endif
#ifndef MK_CONV_REP
#define MK_CONV_REP 1
#endif
    for (int rep = 0; rep < MK_GATE_REP; ++rep)
    gate_units(a, F, j, (int)(((long)F.bid * 1152) / F.G), (int)(((long)(F.bid + 1) * 1152) / F.G));
    for (int rep = 0; rep < MK_CONV_REP; ++rep)
    conv_phase(a, F, j);
}

__device__ __forceinline__ void qkrope_phase(const Args& a, Frame& F, int jm, int nrows) {
    const int gw = F.bid * NWAVES + F.wave, NGW = F.G * NWAVES, lane = F.lane;
    const bf16* QKV = (const bf16*)(a.ws + WS_QKV); bf16* Q = (bf16*)(a.ws + WS_Q); bf16* Kb = (bf16*)(a.ws + WS_K); const float* ROPE = (const float*)(a.ws + WS_ROPE);
    const float* qg = a.in[18] + jm * 64; const float* kg = a.in[19] + jm * 64; const int sub = lane & 15;
    float gq[4], gk[4];
#pragma unroll
    for (int k = 0; k < 4; ++k) { gq[k] = qg[sub + 16 * k]; gk[k] = kg[sub + 16 * k]; }
    for (int row = gw; row < nrows; row += NGW) {
        const bool lat = row < ML; float cr = 1.f, sr = 0.f, cc = 1.f, sc = 0.f;
        if (lat) { const int t = row & 2047, pr = t >> 6, pc = t & 63; const float2 a0 = *(const float2*)(ROPE + (pr * 16 + sub) * 2), a1 = *(const float2*)(ROPE + (pc * 16 + sub) * 2); cr = a0.x; sr = a0.y; cc = a1.x; sc = a1.y; }
#pragma unroll
        for (int hg = 0; hg < 5; ++hg) { const int head = 4 * hg + (lane >> 4); const bf16* src = QKV + (size_t)row * 1536 + head * 64 + sub;
            float x[4];
#pragma unroll
            for (int k = 0; k < 4; ++k) x[k] = bf2f(src[16 * k]);
            float ss = (x[0] * x[0] + x[1] * x[1]) + (x[2] * x[2] + x[3] * x[3]);
            ss += __shfl_xor(ss, 1); ss += __shfl_xor(ss, 2); ss += __shfl_xor(ss, 4); ss += __shfl_xor(ss, 8);
            const float r = 1.0f / sqrtf(ss * (1.0f / 64.0f) + EPS);
            float y[4];
#pragma unroll
            for (int k = 0; k < 4; ++k) y[k] = x[k] * r * (hg < 4 ? gq[k] : gk[k]);
            float o[4]; o[0] = y[0] * cr - y[1] * sr; o[1] = y[1] * cr + y[0] * sr; o[2] = y[2] * cc - y[3] * sc; o[3] = y[3] * cc + y[2] * sc;
            if (hg < 4) { bf16* d = Q + (size_t)row * 1024 + head * 64 + sub;
#pragma unroll
                for (int k = 0; k < 4; ++k) d[16 * k] = (bf16)(pkbf(o[k] * QSCALE, 0.f) & 0xffffu); }
            else { bf16* d = Kb + (size_t)row * 256 + (head - 16) * 64 + sub;
#pragma unroll
                for (int k = 0; k < 4; ++k) d[16 * k] = (bf16)(pkbf(o[k], 0.f) & 0xffffu); } }
    }
}
__device__ __forceinline__ void attn_phase(const Args& a, Frame& F, int jm, int nunits) {
    typedef short s16x4 __attribute__((ext_vector_type(4)));
    const bf16* Q = (const bf16*)(a.ws + WS_Q); const bf16* Kb = (const bf16*)(a.ws + WS_K); const bf16* Vb = (const bf16*)(a.ws + WS_QKV); bf16* O = (bf16*)(a.ws + WS_O);
    LAS bf16* Kl = (LAS bf16*)F.lds;
    LAS bf16* Vl = (LAS bf16*)(F.lds + 36864);
    const int lane = F.lane, w = F.wave, li15 = lane & 15, lq = lane >> 4, hsel = w >> 1, qw = (w & 1) * 32;
    const int lkey = F.tid >> 3, ld8 = (F.tid & 7) << 3;
#define KROW(si) (((si) < nw) ? (b * 2048 + q0 - 128 + 64 * (wlo + (si))) : (ML + b * 256 + 64 * ((si) - nw)))
    const int vcu = (F.G % 8 == 0) ? (F.bid % 8) * (F.G / 8) + F.bid / 8 : F.bid;
    for (int ui = vcu; ui < nunits; ui += F.G) {
        int b, kvh, q0, qrow0, wlo, nw;
        if (ui < 1024) { b = ui >> 7; kvh = (ui >> 5) & 3; const int qb = ui & 31; q0 = qb * 64; qrow0 = b * 2048 + q0; wlo = (qb == 0) ? 2 : (qb == 1 ? 1 : 0); nw = (qb == 0 || qb == 31) ? 3 : ((qb == 1 || qb == 30) ? 4 : 5); }
        else { const int v = ui - 1024; b = v >> 4; kvh = (v >> 2) & 3; q0 = (v & 3) * 64; qrow0 = ML + b * 256 + q0; wlo = 0; nw = 0; }
        const int ntile = nw + 4, hq = 4 * kvh + hsel;
        const bf16* qp = Q + (size_t)(qrow0 + qw + li15) * 1024 + hq * 64 + 8 * lq;
        bf16x8 qf[2][2];
#pragma unroll
        for (int mt = 0; mt < 2; ++mt)
#pragma unroll
            for (int ks = 0; ks < 2; ++ks) qf[mt][ks] = *(const GAS bf16x8*)(qp + (size_t)mt * 16 * 1024 + 32 * ks);
        const float sinkv = a.in[20][jm * 16 + hq] * LOG2E;
        float m[2], l[2]; f32x4 o[2][4];
#pragma unroll
        for (int mt = 0; mt < 2; ++mt) { m[mt] = sinkv; l[mt] = (lq == 0) ? 1.0f : 0.0f;
#pragma unroll
            for (int dt = 0; dt < 4; ++dt) o[mt][dt] = (f32x4){0.f, 0.f, 0.f, 0.f}; }
        v4u kreg[2], vreg[2];
#pragma unroll
        for (int h = 0; h < 2; ++h) { const int kr = KROW(h); kreg[h] = *(const GAS v4u*)(Kb + (size_t)(kr + lkey) * 256 + kvh * 64 + ld8); vreg[h] = *(const GAS v4u*)(Vb + (size_t)(kr + lkey) * 256 + kvh * 64 + ld8); }
        bf16x8 pbp[2][2];
#pragma unroll
        for (int mt = 0; mt < 2; ++mt)
#pragma unroll
            for (int s2 = 0; s2 < 2; ++s2) pbp[mt][s2] = __builtin_bit_cast(bf16x8, (v4u){0u, 0u, 0u, 0u});
#define AT_VFRAG(BASE, s2_, dt_, dst) do { const LAS bf16* vp_ = Vl + (BASE) + (32 * (s2_) + 4 * lq + (li15 >> 2)) * 72 + 16 * (dt_) + 4 * (li15 & 3); \
            const s16x4 lo_ = __builtin_bit_cast(s16x4, __builtin_amdgcn_ds_read_tr16_b64_v4i16((LAS s16x4*)vp_)); \
            const s16x4 hi_ = __builtin_bit_cast(s16x4, __builtin_amdgcn_ds_read_tr16_b64_v4i16((LAS s16x4*)(vp_ + 16 * 72))); \
            dst = __builtin_shufflevector(lo_, hi_, 0, 1, 2, 3, 4, 5, 6, 7); } while (0)
#define AT_PV_PLAIN(BASE) do { _Pragma("unroll") for (int s2_ = 0; s2_ < 2; ++s2_) _Pragma("unroll") for (int dt_ = 0; dt_ < 4; ++dt_) { bf16x8 af_; AT_VFRAG(BASE, s2_, dt_, af_); \
            _Pragma("unroll") for (int mt_ = 0; mt_ < 2; ++mt_) o[mt_][dt_] = __builtin_amdgcn_mfma_f32_16x16x32_bf16(af_, pbp[mt_][s2_], o[mt_][dt_], 0, 0, 0); } } while (0)
        for (int si0 = 0; si0 < ntile; si0 += 2)
#pragma unroll
        for (int h = 0; h < 2; ++h) if (si0 + h < ntile) {
            const int si = si0 + h; const int bo = (si & 3) * 4608, bp = ((si + 3) & 3) * 4608;
            *(LAS v4u*)(Kl + bo + lkey * 72 + ld8) = kreg[h]; *(LAS v4u*)(Vl + bo + lkey * 72 + ld8) = vreg[h];
            if (si + 2 < ntile) { const int kr = KROW(si + 2);
                kreg[h] = *(const GAS v4u*)(Kb + (size_t)(kr + lkey) * 256 + kvh * 64 + ld8); vreg[h] = *(const GAS v4u*)(Vb + (size_t)(kr + lkey) * 256 + kvh * 64 + ld8); }
            __syncthreads();
            f32x4 s[2][4]; const f32x4 nmv[2] = {(f32x4){-m[0], -m[0], -m[0], -m[0]}, (f32x4){-m[1], -m[1], -m[1], -m[1]}};
#pragma unroll
            for (int kt = 0; kt < 4; ++kt) { const LAS bf16* kp = Kl + bo + (16 * kt + li15) * 72 + 8 * lq; const bf16x8 k0 = *(const LAS bf16x8*)kp, k1 = *(const LAS bf16x8*)(kp + 32);
#pragma unroll
                for (int mt = 0; mt < 2; ++mt) { s[mt][kt] = __builtin_amdgcn_mfma_f32_16x16x32_bf16(k0, qf[mt][0], nmv[mt], 0, 0, 0);
                    s[mt][kt] = __builtin_amdgcn_mfma_f32_16x16x32_bf16(k1, qf[mt][1], s[mt][kt], 0, 0, 0); } }
            const int tt = wlo + si;
            if (si < nw && (tt == 0 || tt == 4)) { const int kpos0 = q0 - 128 + 64 * tt; asm volatile("; window-edge tile" ::: "memory");
#pragma unroll
                for (int mt = 0; mt < 2; ++mt) { const int qpos = q0 + qw + 16 * mt + li15;
#pragma unroll
                    for (int kt = 0; kt < 4; ++kt)
#pragma unroll
                        for (int jj = 0; jj < 4; ++jj) { const int dlt = qpos - (kpos0 + 16 * kt + 4 * lq + jj); if (dlt > 128 || dlt < -128) s[mt][kt][jj] = -INFINITY; } } }
            int im = 0;
#pragma unroll
            for (int mt = 0; mt < 2; ++mt)
#pragma unroll
                for (int kt = 0; kt < 4; ++kt) { const int a0 = __float_as_int(s[mt][kt][0]), a1 = __float_as_int(s[mt][kt][1]), a2 = __float_as_int(s[mt][kt][2]), a3 = __float_as_int(s[mt][kt][3]);
                    const int b0 = a0 > a1 ? a0 : a1, b1 = a2 > a3 ? a2 : a3, b2 = b0 > b1 ? b0 : b1; im = im > b2 ? im : b2; }
            const bool resc = __builtin_amdgcn_ballot_w64(im > 0x41000000) != 0ull;
            if (resc) {
                asm volatile("; raise the references" ::: "memory");
                if (si > 0) AT_PV_PLAIN(bp);
#pragma unroll
                for (int mt = 0; mt < 2; ++mt) { float tm = fmaxf(fmaxf(s[mt][0][0], s[mt][0][1]), fmaxf(s[mt][0][2], s[mt][0][3]));
#pragma unroll
                    for (int kt = 1; kt < 4; ++kt) tm = fmaxf(tm, fmaxf(fmaxf(s[mt][kt][0], s[mt][kt][1]), fmaxf(s[mt][kt][2], s[mt][kt][3])));
                    tm = fmaxf(tm, __shfl_xor(tm, 16)); tm = fmaxf(tm, __shfl_xor(tm, 32));
                    const float dl = fmaxf(tm, 0.f), alpha = __builtin_amdgcn_exp2f(-dl); m[mt] += dl; l[mt] *= alpha; const f32x4 dv = (f32x4){dl, dl, dl, dl};
#pragma unroll
                    for (int kt = 0; kt < 4; ++kt) s[mt][kt] = s[mt][kt] - dv;
#pragma unroll
                    for (int dt = 0; dt < 4; ++dt) o[mt][dt] = o[mt][dt] * alpha; } }
            f32x4 lsv[2] = {(f32x4){0.f, 0.f, 0.f, 0.f}, (f32x4){0.f, 0.f, 0.f, 0.f}};
            bf16x8 afn; if (si > 0 && !resc) AT_VFRAG(bp, 0, 0, afn);
            if (si > 0 && !resc) {
#pragma unroll
                for (int g = 0; g < 8; ++g) { const int mt = g >> 2, kt = g & 3;
                    const bf16x8 af = afn; if (g < 7) AT_VFRAG(bp, (g + 1) >> 2, (g + 1) & 3, afn);
                    o[0][g & 3] = __builtin_amdgcn_mfma_f32_16x16x32_bf16(af, pbp[0][g >> 2], o[0][g & 3], 0, 0, 0);
                    o[1][g & 3] = __builtin_amdgcn_mfma_f32_16x16x32_bf16(af, pbp[1][g >> 2], o[1][g & 3], 0, 0, 0);
                    asm volatile("" : "+v"(s[mt][kt]));
                    f32x4 pv;
#pragma unroll
                    for (int jj = 0; jj < 4; ++jj) pv[jj] = __builtin_amdgcn_exp2f(s[mt][kt][jj]);
                    s[mt][kt] = pv; lsv[mt] = lsv[mt] + pv;
                    asm volatile("" : "+v"(s[mt][kt]));
                    __builtin_amdgcn_sched_barrier(0); }
            } else {
#pragma unroll
                for (int mt = 0; mt < 2; ++mt)
#pragma unroll
                    for (int kt = 0; kt < 4; ++kt) { f32x4 pv;
#pragma unroll
                        for (int jj = 0; jj < 4; ++jj) pv[jj] = __builtin_amdgcn_exp2f(s[mt][kt][jj]);
                        s[mt][kt] = pv; lsv[mt] = lsv[mt] + pv; }
            }
#pragma unroll
            for (int mt = 0; mt < 2; ++mt) { l[mt] += (lsv[mt][0] + lsv[mt][1]) + (lsv[mt][2] + lsv[mt][3]);
#pragma unroll
                for (int s2 = 0; s2 < 2; ++s2) { v4u pw; pw.x = pkbf(s[mt][2 * s2][0], s[mt][2 * s2][1]); pw.y = pkbf(s[mt][2 * s2][2], s[mt][2 * s2][3]);
                    pw.z = pkbf(s[mt][2 * s2 + 1][0], s[mt][2 * s2 + 1][1]); pw.w = pkbf(s[mt][2 * s2 + 1][2], s[mt][2 * s2 + 1][3]); pbp[mt][s2] = __builtin_bit_cast(bf16x8, pw); } }
        }
        AT_PV_PLAIN(((ntile - 1) & 3) * 4608);
#undef AT_PV_PLAIN
#undef AT_VFRAG
        __syncthreads();
#pragma unroll
        for (int mt = 0; mt < 2; ++mt) { float lt = l[mt]; lt += __shfl_xor(lt, 16); lt += __shfl_xor(lt, 32); const float inv = 1.0f / lt;
            bf16* op = O + (size_t)(qrow0 + qw + 16 * mt + li15) * 1024 + hq * 64 + 4 * lq;
#pragma unroll
            for (int dt = 0; dt < 4; ++dt) { v2u ov; ov.x = pkbf(o[mt][dt][0] * inv, o[mt][dt][1] * inv); ov.y = pkbf(o[mt][dt][2] * inv, o[mt][dt][3] * inv); *(GAS v2u*)(op + 16 * dt) = ov; } }
    }
#undef KROW
}
__device__ __forceinline__ void final_phase(const Args& a, Frame& F) {
    const int gw = F.bid * NWAVES + F.wave, NGW = F.G * NWAVES, lane = F.lane;
    const bf16* X = (const bf16*)(a.ws + WS_X); const bf16* YS = (const bf16*)(a.ws + WS_YS); const float* MOD = (const float*)(a.ws + WS_MOD); const bf16* PB = (const bf16*)(a.ws + WS_PB);
    const int4* TOKI = (const int4*)(a.ws + WS_TOKI); const float2* TOKW = (const float2*)(a.ws + WS_TOKW);
    MoeSeg sg; moe_seg(F, 1, sg); MoeOrder S;
#pragma unroll
    for (int q = 0; q < 9; ++q) S.pst[q] = sg.pst[q];
#pragma unroll
    for (int q = 0; q < 8; ++q) S.cnt[q] = sg.cnt[q];
    S.apan = false; S.nt = 4; S.G = F.G; S.c = 0; S.ntk = 28; S.split_tail();
    const int ps0 = S.ps0(), psrows = S.psrows(), nS = S.S;
    for (int row = gw; row < ML; row += NGW) {
        const float* g2p = MOD + (size_t)(3 * 9 + (row >> 11)) * 6144 + 5 * 1024; const bf16* ys = YS + (size_t)row * 2048;
        const int4 ti = TOKI[row]; const float2 tw = TOKW[row];
        v2u xq[4]; f32x4 gq[4];
#pragma unroll
        for (int j = 0; j < 4; ++j) { xq[j] = *(const GAS v2u*)(X + (size_t)row * 1024 + 4 * lane + 256 * j); gq[j] = *(const GAS f32x4*)(g2p + 4 * lane + 256 * j); }
        const int p0 = seg_start(sg, ti.x & 255) * 256 + ti.y, p1 = seg_start(sg, ti.x >> 8) * 256 + ti.z;
        f32x4 y[4];
#pragma unroll
        for (int j = 0; j < 4; ++j) y[j] = (f32x4){0.f, 0.f, 0.f, 0.f};
#pragma unroll
        for (int sl = 0; sl < 2; ++sl) { const int pr = sl ? p1 : p0; const float wsl = sl ? tw.y : tw.x;
            if (pr >= ps0) { f32x4 ps[4];
#pragma unroll
                for (int j = 0; j < 4; ++j) ps[j] = (f32x4){0.f, 0.f, 0.f, 0.f};
                v2u pq[7][4];
#pragma unroll
                for (int q = 0; q < 7; ++q) { const int qq = q < nS ? q : nS - 1;
#pragma unroll
                    for (int j = 0; j < 4; ++j) pq[q][j] = *(const GAS v2u*)(PB + ((size_t)qq * psrows + (size_t)(pr - ps0)) * 1024 + 4 * lane + 256 * j); }
#pragma unroll
                for (int q = 0; q < 7; ++q) if (q < nS) {
#pragma unroll
                    for (int j = 0; j < 4; ++j) ps[j] = ps[j] + (f32x4){bflo(pq[q][j].x), bfhi(pq[q][j].x), bflo(pq[q][j].y), bfhi(pq[q][j].y)}; }
#pragma unroll
                for (int j = 0; j < 4; ++j) y[j] = y[j] + ps[j] * wsl; }
            else {
#pragma unroll
                for (int j = 0; j < 4; ++j) { const v2u yy = *(const GAS v2u*)(ys + sl * 1024 + 4 * lane + 256 * j); y[j] = y[j] + (f32x4){bflo(yy.x), bfhi(yy.x), bflo(yy.y), bfhi(yy.y)}; } } }
#pragma unroll
        for (int j = 0; j < 4; ++j) { const v2u xx = xq[j]; f32x4 v = (f32x4){bflo(xx.x), bfhi(xx.x), bflo(xx.y), bfhi(xx.y)};
            __builtin_nontemporal_store(v + gq[j] * y[j], (GAS f32x4*)(a.out + (size_t)row * 1024 + 4 * lane + 256 * j)); }
    }
}

#define GRID_BAR() do { if (!MK_PER_PHASE) xcd_barrier(bar); } while (0)
#define IN(k) (lo <= (k) && (k) < hi)
#define BOTH(k) (IN(k) && IN((k) + 1))
#ifndef MK_MASK
#define MK_MASK 0xFFFFFFFFu
#endif
#define EN(b) (((MK_MASK) >> (b)) & 1u)
#ifndef MK_DUP_MASK
#define MK_DUP_MASK 0u
#endif
#define REP(b) ((((MK_DUP_MASK) >> (b)) & 1u) ? 3 : 1)
#define FRESH() do { int t_ = threadIdx.x, b_ = blockIdx.x; asm volatile("" : "+v"(t_)); asm volatile("" : "+s"(b_)); F.tid = t_; F.lane = t_ & 63; F.wave = __builtin_amdgcn_readfirstlane(t_ >> 6); F.bid = b_; } while (0)
template <int jp> __device__ __forceinline__ void layer_pair(const Args& args, Frame& F, const XcdBarrier& bar, const int lo, const int hi) {
    unsigned char* ws = args.ws;
    bf16* X = (bf16*)(ws + WS_X); const float* MOD = (const float*)(ws + WS_MOD); bf16* H = (bf16*)(ws + WS_H);
        const int pb = 1 + 16 * jp, le = 2 * jp, lo_ = 2 * jp + 1;
        const int rows_tail = (jp == 1) ? ML : MT;
        if (EN(1) && IN(pb + 0)) { FRESH();
_Pragma("unroll 1") for (int rep_ = 0; rep_ < REP(1); ++rep_) { if (jp == 1) { TailPlan tp; tail_plan(F.G, 1024, tp); conv_moe_all(args, F, 1, 2, 0, F.G, -1, tp.e[4] < moe_items(2) ? tp.e[4] : moe_items(2), moe_items(2)); }
            norm_phase(args, F, le, 0, MT, jp == 0, jp == 1 ? 1 : -1, 0, 0, nullptr, MK_FP8_WIN2 && jp == 1); if (rep_ + 1 < REP(1)) GRID_BAR(); } if (BOTH(pb + 0)) GRID_BAR(); }
        if (EN(2) && IN(pb + 1)) { FRESH();
_Pragma("unroll 1") for (int rep_ = 0; rep_ < REP(2); ++rep_) { if (MK_FP8_WIN2 && jp == 1) { pg8::Gemm g{H, (const bf16*)(ws + WS_WIN) + (size_t)jp * 4096 * 1024, MT, 4096, 512}; pg8::StaticOrder S; S.init(MT, 4096, 512, F.G, F.bid);
            pg8::EpiWin E{(bf16*)(ws + WS_U), (bf16*)(ws + WS_V), (bf16*)(ws + WS_G), (float*)(ws + WS_STATS), 1.0f / F8_W13};
            pg8::gemm_phase<pg8::EpiWin, pg8::StaticOrder, true, true, 8, true>(F.lds + RING_OFF, g, S, E); } else {
            pg8::Gemm g{H, (const bf16*)(ws + WS_WIN) + (size_t)jp * 4096 * 1024, MT, 4096, 1024}; pg8::StaticOrder S; S.init(MT, 4096, 1024, F.G, F.bid);
            pg8::EpiWin E{(bf16*)(ws + WS_U), (bf16*)(ws + WS_V), (bf16*)(ws + WS_G), (float*)(ws + WS_STATS)};
            pg8::gemm_phase<pg8::EpiWin, pg8::StaticOrder, true, true, 16>(F.lds + RING_OFF, g, S, E); } { TailPlan tp; tail_plan(F.G, (jp == 1) ? 1024 : 1152, tp); tail_fill(args, F, tp, 0, jp, jp == 0 ? 0 : 2); } if (rep_ + 1 < REP(2)) GRID_BAR(); } if (BOTH(pb + 1)) GRID_BAR(); }
        if (EN(3) && IN(pb + 2)) { FRESH();
_Pragma("unroll 1") for (int rep_ = 0; rep_ < REP(3); ++rep_) { mix_phase(args, F, jp); if (rep_ + 1 < REP(3)) GRID_BAR(); } if (BOTH(pb + 2)) GRID_BAR(); }
        if (EN(4) && IN(pb + 3)) { FRESH();
_Pragma("unroll 1") for (int rep_ = 0; rep_ < REP(4); ++rep_) { pg8::Gemm g{(const bf16*)(ws + WS_YAB), (const bf16*)(ws + WS_WOUT) + (size_t)jp * 1024 * 2048, MT, 1024, 2048}; SplitOrder S; S.init(MT, 2048, F.G, F.bid);
            pg8::EpiResid E{X, MOD + (size_t)(le * 9) * 6144 + 2 * 1024, (float*)(ws + WS_PB), S.rs0(), args.gmul};
            pg8::gemm_phase<pg8::EpiResid, SplitOrder, true, true>(F.lds + RING_OFF, g, S, E); if (rep_ + 1 < REP(4)) GRID_BAR(); } if (BOTH(pb + 3)) GRID_BAR(); }
        if (EN(5) && IN(pb + 4)) { FRESH();
_Pragma("unroll 1") for (int rep_ = 0; rep_ < REP(5); ++rep_) { SplitOrder SP; SP.init(MT, 2048, F.G, F.bid); norm_phase(args, F, le, 1, MT, false, -1, SP.nsplit(), SP.rs0(), MOD + (size_t)(le * 9) * 6144 + 2 * 1024, MK_FP8_FFN2 && jp == 1); if (rep_ + 1 < REP(5)) GRID_BAR(); } if (BOTH(pb + 4)) GRID_BAR(); }
        if (EN(6) && IN(pb + 5)) { FRESH();
_Pragma("unroll 1") for (int rep_ = 0; rep_ < REP(6); ++rep_) { if (MK_FP8_FFN2 && jp == 1) { pg8::Gemm g{H, (const bf16*)(ws + WS_FF13) + (size_t)jp * 7168 * 1024, MT, 7168, 512}; pg8::StaticOrder S; S.init(MT, 7168, 512, F.G, F.bid);
            pg8::EpiSwiGLU8 E{(unsigned char*)(ws + WS_T), FF, 1.0f / F8_W13};
            pg8::gemm_phase<pg8::EpiSwiGLU8, pg8::StaticOrder, true, true, 8, true>(F.lds + RING_OFF, g, S, E); } else {
            pg8::Gemm g{H, (const bf16*)(ws + WS_FF13) + (size_t)jp * 7168 * 1024, MT, 7168, 1024}; pg8::StaticOrder S; S.init(MT, 7168, 1024, F.G, F.bid);
            pg8::EpiSwiGLU E{(bf16*)(ws + WS_T), FF, args.gmul};
            pg8::gemm_phase<pg8::EpiSwiGLU, pg8::StaticOrder, true, true, 16>(F.lds + RING_OFF, g, S, E); } { TailPlan tp; tail_plan(F.G, (jp == 1) ? 1024 : 1152, tp); tail_fill(args, F, tp, 1, jp, jp == 0 ? 0 : 2); } if (rep_ + 1 < REP(6)) GRID_BAR(); } if (BOTH(pb + 5)) GRID_BAR(); }
        if (EN(7) && IN(pb + 6)) { FRESH();
_Pragma("unroll 1") for (int rep_ = 0; rep_ < REP(7); ++rep_) { if (MK_FP8_FFN2 && jp == 1) { pg8::Gemm g{(const bf16*)(ws + WS_T), (const bf16*)(ws + WS_FF2) + (size_t)jp * 1024 * 3584, MT, 1024, FF / 2}; SplitOrder S; S.init(MT, FF / 2, F.G, F.bid);
            pg8::EpiResid E{X, MOD + (size_t)(le * 9) * 6144 + 5 * 1024, (float*)(ws + WS_PB), S.rs0(), args.gmul * (1.0f / F8_W2), 1.0f / F8_W2};
            pg8::gemm_phase<pg8::EpiResid, SplitOrder, true, true, 0, true>(F.lds + RING_OFF, g, S, E); } else {
            pg8::Gemm g{(const bf16*)(ws + WS_T), (const bf16*)(ws + WS_FF2) + (size_t)jp * 1024 * 3584, MT, 1024, FF}; SplitOrder S; S.init(MT, FF, F.G, F.bid);
            pg8::EpiResid E{X, MOD + (size_t)(le * 9) * 6144 + 5 * 1024, (float*)(ws + WS_PB), S.rs0(), args.gmul};
            pg8::gemm_phase<pg8::EpiResid, SplitOrder, true, true>(F.lds + RING_OFF, g, S, E); } if (rep_ + 1 < REP(7)) GRID_BAR(); } if (BOTH(pb + 6)) GRID_BAR(); }
        if (EN(8) && IN(pb + 7)) { FRESH();
_Pragma("unroll 1") for (int rep_ = 0; rep_ < REP(8); ++rep_) { SplitOrder SP; SP.init(MT, (MK_FP8_FFN2 && jp == 1) ? FF / 2 : FF, F.G, F.bid); norm_phase(args, F, lo_, 0, MT, false, -1, SP.nsplit(), SP.rs0(), MOD + (size_t)(le * 9) * 6144 + 5 * 1024); if (rep_ + 1 < REP(8)) GRID_BAR(); } if (BOTH(pb + 7)) GRID_BAR(); }
        if (EN(9) && IN(pb + 8)) { FRESH();
_Pragma("unroll 1") for (int rep_ = 0; rep_ < REP(9); ++rep_) { pg8::Gemm g{H, (const bf16*)(ws + WS_WQKV) + (size_t)jp * 1536 * 1024, MT, 1536, 1024}; pg8::StaticOrder S; S.init(MT, 1536, 1024, F.G, F.bid);
            pg8::EpiQKV E{(bf16*)(ws + WS_Q), (bf16*)(ws + WS_K), (bf16*)(ws + WS_QKV), args.in[18] + jp * 64, args.in[19] + jp * 64, (const float*)(ws + WS_ROPE), ML, QSCALE, EPS};
            pg8::gemm_phase<pg8::EpiQKV, pg8::StaticOrder, true, true, 16>(F.lds + RING_OFF, g, S, E); { TailPlan tp; tail_plan(F.G, (jp == 1) ? 1024 : 1152, tp); tail_fill(args, F, tp, 2, jp, jp == 0 ? 0 : 2); } if (rep_ + 1 < REP(9)) GRID_BAR(); } if (BOTH(pb + 8)) GRID_BAR(); }
        if (EN(11) && IN(pb + 10)) { FRESH();
_Pragma("unroll 1") for (int rep_ = 0; rep_ < REP(11); ++rep_) { attn_phase(args, F, jp, (jp == 1) ? 1024 : 1152); { TailPlan tp; tail_plan(F.G, (jp == 1) ? 1024 : 1152, tp); tail_fill(args, F, tp, 3, jp, jp == 0 ? 0 : 2, (F.G % 8 == 0) ? (F.bid % 8) * (F.G / 8) + F.bid / 8 : F.bid); } if (rep_ + 1 < REP(11)) GRID_BAR(); } if (BOTH(pb + 10)) GRID_BAR(); }
        if (EN(12) && IN(pb + 11)) { FRESH();
_Pragma("unroll 1") for (int rep_ = 0; rep_ < REP(12); ++rep_) { pg8::Gemm g{(const bf16*)(ws + WS_O), (const bf16*)(ws + WS_WO) + (size_t)jp * 1024 * 1024, rows_tail, 1024, 1024}; SplitOrder S; S.init(rows_tail, 1024, F.G, F.bid);
            pg8::EpiResid E{X, MOD + (size_t)(lo_ * 9) * 6144 + 2 * 1024, (float*)(ws + WS_PB), S.rs0(), args.gmul};
            pg8::gemm_phase<pg8::EpiResid, SplitOrder, true, true>(F.lds + RING_OFF, g, S, E); if (rep_ + 1 < REP(12)) GRID_BAR(); } if (BOTH(pb + 11)) GRID_BAR(); }
        if (EN(13) && IN(pb + 12)) { FRESH();
_Pragma("unroll 1") for (int rep_ = 0; rep_ < REP(13); ++rep_) { SplitOrder SP; SP.init(rows_tail, 1024, F.G, F.bid); norm_router_phase(args, F, lo_, rows_tail, SP.nsplit(), SP.rs0(), MOD + (size_t)(lo_ * 9) * 6144 + 2 * 1024); if (rep_ + 1 < REP(13)) GRID_BAR(); } if (BOTH(pb + 12)) GRID_BAR(); }
        if (EN(15) && IN(pb + 14)) { FRESH();
_Pragma("unroll 1") for (int rep_ = 0; rep_ < REP(15); ++rep_) { MoeSeg sg; moe_seg(F, jp, sg); MoeOrder S;
#pragma unroll
            for (int q = 0; q < 9; ++q) S.pst[q] = sg.pst[q];
#pragma unroll
            for (int q = 0; q < 8; ++q) S.cnt[q] = sg.cnt[q];
            S.nt = 28; S.G = F.G; S.c = F.bid; S.ntk = 8; S.apan = true; S.no_split();
            pg8::Gemm g{(const bf16*)(ws + WS_HP), (const bf16*)(ws + WS_MOE13), 0, 0, 512};
            pg8::EpiSwiGLU8 E{(unsigned char*)(ws + WS_TP), FF, 1.0f / F8_W13};
            pg8::gemm_phase<pg8::EpiSwiGLU8, MoeOrder, true, true, 8, true>(F.lds + RING_OFF, g, S, E); if (rep_ + 1 < REP(15)) GRID_BAR(); } if (BOTH(pb + 14)) GRID_BAR(); }
        if (EN(16) && IN(pb + 15)) { FRESH();
_Pragma("unroll 1") for (int rep_ = 0; rep_ < REP(16); ++rep_) { MoeSeg sg; moe_seg(F, jp, sg); MoeOrder S;
#pragma unroll
            for (int q = 0; q < 9; ++q) S.pst[q] = sg.pst[q];
#pragma unroll
            for (int q = 0; q < 8; ++q) S.cnt[q] = sg.cnt[q];
            S.apan = false; S.nt = 4; S.G = F.G; S.c = F.bid; S.ntk = 28; if (jp == 1) S.split_tail(); else S.no_split();
            pg8::Gemm g{(const bf16*)(ws + WS_TP), (const bf16*)(ws + WS_MOE2), 0, 0, FF / 2};
            pg8::EpiMoeDown E{(bf16*)(ws + WS_YS), (const int*)(ws + WS_TOKLIST), (const float*)(ws + WS_TOKWT), CAP, (bf16*)(ws + WS_PB), S.ps0(), S.psrows(), 1.0f / F8_W2};
            if (jp == 0) pg8::gemm_phase<pg8::EpiMoeDown, MoeOrder, true, true, 28, true>(F.lds + RING_OFF, g, S, E); else pg8::gemm_phase<pg8::EpiMoeDown, MoeOrder, true, true, 0, true>(F.lds + RING_OFF, g, S, E);
            if (jp == 0) { const int U = sg.pst[8] * 4, busy = (U > 2 * F.G) ? ((U - 2 * F.G < F.G) ? U - 2 * F.G : F.G) : 0;
                const int vcid = (F.G % 8 == 0) ? (F.bid % 8) * (F.G / 8) + F.bid / 8 : F.bid;
                if (busy < F.G) conv_moe_all(args, F, 1, 1, busy, F.G - busy, vcid); else conv_moe_all(args, F, 1, 1, 0, F.G, vcid); } if (rep_ + 1 < REP(16)) GRID_BAR(); } if (BOTH(pb + 15)) GRID_BAR(); }
}

__global__ void __launch_bounds__(NWAVES * 64, 2) mk_fwd(Args args) {
    extern __shared__ __attribute__((aligned(16))) unsigned char lds[];
    Frame F;
    F.lds = (LAS unsigned char*)lds; F.MISC = (volatile LAS unsigned*)(F.lds + MISC_OFF);
    F.tid = threadIdx.x; F.lane = F.tid & 63; F.wave = __builtin_amdgcn_readfirstlane(F.tid >> 6); F.G = gridDim.x; F.bid = blockIdx.x;
    F.ctl = (gu32*)(args.ws + WS_CTL);
    for (int u = F.tid; u < (LDS_BYTES - LDSCTL_OFF) / 4; u += NWAVES * 64) ((LAS unsigned*)(F.lds + LDSCTL_OFF))[u] = 0u;
    __syncthreads();
    XcdBarrier bar; bar.bar = (unsigned*)(F.ctl + CW_BAR); bar.x = 0; bar.st = nullptr;
    if (!MK_PER_PHASE) bar = xcd_barrier_post((unsigned*)(F.ctl + CW_BAR), F.MISC + 8);
    const int lo = args.ph_lo, hi = args.ph_hi;
    unsigned char* ws = args.ws;
    bf16* X = (bf16*)(ws + WS_X); const float* MOD = (const float*)(ws + WS_MOD); bf16* H = (bf16*)(ws + WS_H);

    if (EN(0) && IN(0)) { FRESH(); prologue_phase(args, F); if (BOTH(0)) GRID_BAR(); }

    layer_pair<0>(args, F, bar, lo, hi);
    layer_pair<1>(args, F, bar, lo, hi);
    if (EN(17) && IN(33)) { FRESH(); final_phase(args, F); }
#undef IN
#undef BOTH
}

extern "C" void kernel_launch(void* const* d_in, const int* in_sizes, int n_in, void* d_out, int out_size, void* d_ws, size_t ws_size, hipStream_t stream) {
    static int grid = 0;
    if (grid == 0) {
        if (n_in != 29 || out_size != ML * D || ws_size < WS_END) { fprintf(stderr, "kernel_launch: unexpected shapes (n_in %d out %d ws %zu)\n", n_in, out_size, ws_size); grid = -1; return; }
        int dev = 0, cus = 0;
        if (hipGetDevice(&dev) != hipSuccess || hipDeviceGetAttribute(&cus, hipDeviceAttributeMultiprocessorCount, dev) != hipSuccess) { grid = -1; return; }
        if (hipFuncSetAttribute((const void*)mk_fwd, hipFuncAttributeMaxDynamicSharedMemorySize, LDS_BYTES) != hipSuccess) { grid = -1; return; }
        int per_cu = 0; (void)hipOccupancyMaxActiveBlocksPerMultiprocessor(&per_cu, (const void*)mk_fwd, NWAVES * 64, LDS_BYTES); (void)hipGetLastError();
        grid = cus;
    }
    if (grid < 0) return;
    (void)hipMemsetAsync((char*)d_ws + WS_CTL, 0, CTL_ZERO_BYTES, stream);
    Args a{};
    for (int i = 0; i < 29; ++i) a.in[i] = (const float*)d_in[i];
    a.out = (float*)d_out; a.ws = (unsigned char*)d_ws; a.gmul = 1.f; a.pad = 0;
#if MK_PER_PHASE
#ifndef MK_REP_LIST
#define MK_REP_LIST -1
#endif
    const int reps[] = {MK_REP_LIST};
    for (int p = 0; p < N_PHASES; ++p) { int n = 1; for (int r : reps) if (r == p) n += 2;
        for (int q = 0; q < n; ++q) { a.ph_lo = p; a.ph_hi = p + 1; a.gmul = (q == 0) ? 1.f : 0.f; hipLaunchKernelGGL(mk_fwd, dim3(grid), dim3(NWAVES * 64), LDS_BYTES, stream, a); } }
#else
    a.ph_lo = 0; a.ph_hi = N_PHASES; hipLaunchKernelGGL(mk_fwd, dim3(grid), dim3(NWAVES * 64), LDS_BYTES, stream, a);
#endif
}
```
